# Optimizing an MI355X kernel written in HIP

```python
import jax, jax.numpy as jnp
from jax import lax
import numpy as np

D_MODEL = 2048
BATCH = 2
SEQ = 8192
DEPTH = 1

N_META = 16
D_FF = 5632
FFN_RES = 0.5
EPS = 1e-6
DSA_HEADS = 8
DSA_HEAD_DIM = 128
DSA_WIDTH = DSA_HEADS * DSA_HEAD_DIM
IDX_HEADS = 16
IDX_DIM = 64
TOPK_MAX = 256
Q_BLOCK = 128
GLA_HEADS = 4
GLA_DK = 128
GLA_DV = 256
GLA_KEY_WIDTH = GLA_HEADS * GLA_DK
GLA_WIDTH = GLA_HEADS * GLA_DV
GLA_GATE_RANK = 16
GLA_TAU = 16.0
GLA_CHUNK = 64
MIX_WIDTH = DSA_WIDTH + GLA_WIDTH
IN_SPLITS = (DSA_WIDTH, DSA_WIDTH, DSA_WIDTH,
             IDX_HEADS * IDX_DIM, IDX_DIM, IDX_HEADS,
             GLA_KEY_WIDTH, GLA_KEY_WIDTH, GLA_WIDTH,
             GLA_GATE_RANK, GLA_WIDTH)
IN_WIDTH = sum(IN_SPLITS)

kernel_name = "hymba_dsa_gla_macaron_layer"


def rms_norm(x, g):
    x32 = x.astype(jnp.float32)
    y = x32 * lax.rsqrt(jnp.mean(x32 * x32, axis=-1, keepdims=True) + EPS)
    return (y * g.astype(jnp.float32)).astype(x.dtype)


def swiglu(x, w_gate, w_up, w_down):
    return (jax.nn.silu(x @ w_gate) * (x @ w_up)) @ w_down


def dsa_attention(q, k, v, q_idx, k_idx, w_idx, top_k):
    b, t, nh, dh = q.shape
    n_blk = -(-t // Q_BLOCK)
    t_pad = n_blk * Q_BLOCK

    def blocks(a):
        a = jnp.pad(a, [(0, 0), (0, t_pad - t)] + [(0, 0)] * (a.ndim - 2))
        a = a.reshape((b, n_blk, Q_BLOCK) + a.shape[2:])
        return jnp.moveaxis(a, 1, 0)

    pos_q = jnp.arange(t_pad, dtype=jnp.int32).reshape(n_blk, Q_BLOCK)
    key_pos = jnp.arange(t, dtype=jnp.int32)
    scale = DSA_HEAD_DIM ** -0.5
    gather = jax.vmap(lambda a, i: a[i])

    def one_block(args):
        qb, qib, wb, pq = args
        logits = jnp.einsum('bqhd,bsd->bqhs', qib, k_idx)
        score = jnp.einsum('bqhs,bqh->bqs', jax.nn.relu(logits), wb).astype(jnp.float32)
        causal = key_pos[None, :] <= pq[:, None]
        score = jnp.where(causal[None], score, -jnp.inf)
        _, sel = lax.top_k(score, top_k)
        valid = sel <= pq[None, :, None]
        ks = gather(k, sel)
        vs = gather(v, sel)
        s = jnp.einsum('bqhd,bqkhd->bhqk', qb, ks).astype(jnp.float32) * scale
        s = jnp.where(valid[:, None], s, -1e30)
        p = jax.nn.softmax(s, axis=-1).astype(v.dtype)
        return jnp.einsum('bhqk,bqkhd->bqhd', p, vs)

    out = lax.map(one_block, (blocks(q), blocks(q_idx), blocks(w_idx), pos_q))
    out = jnp.moveaxis(out, 0, 1).reshape(b, t_pad, nh, dh)
    return out[:, :t]


def gla_chunked(q, k, v, log_g):
    b, t, h, dk = q.shape
    dv = v.shape[-1]
    lead = GLA_CHUNK - N_META
    f32 = jnp.float32

    def prep(a):
        a = jnp.pad(a, [(0, 0), (lead, 0), (0, 0), (0, 0)])
        n = a.shape[1] // GLA_CHUNK
        a = a.reshape(b, n, GLA_CHUNK, h, a.shape[-1])
        return jnp.moveaxis(a, 1, 0)

    causal = jnp.tril(jnp.ones((GLA_CHUNK, GLA_CHUNK), dtype=bool))[None, :, :, None, None]

    def step(state, inp):
        qi, ki, vi, gi = inp
        qf, kf, vf = qi.astype(f32), ki.astype(f32), vi.astype(f32)
        bcum = jnp.cumsum(gi.astype(f32), axis=1)
        o_inter = jnp.einsum('bchk,bhkv->bchv', qf * jnp.exp(bcum), state)
        diff = bcum[:, :, None] - bcum[:, None, :]
        decay = jnp.exp(jnp.where(causal, diff, -jnp.inf))
        attn = jnp.einsum('bihk,bjhk,bijhk->bhij', qf, kf, decay)
        o_intra = jnp.einsum('bhij,bjhv->bihv', attn, vf)
        b_last = bcum[:, -1]
        k_dec = kf * jnp.exp(b_last[:, None] - bcum)
        state = state * jnp.exp(b_last)[..., None] + jnp.einsum('bchk,bchv->bhkv', k_dec, vf)
        return state, (o_inter + o_intra).astype(v.dtype)

    state0 = jnp.zeros((b, h, dk, dv), f32)
    _, out = lax.scan(step, state0, (prep(q), prep(k), prep(v), prep(log_g)))
    out = jnp.moveaxis(out, 0, 1).reshape(b, lead + t, h, dv)
    return out[:, lead:]


def hybrid_mixer(h, w_in, w_gate_up, b_gate, gla_norm_g, w_out, top_k):
    b, t, _ = h.shape
    proj = h @ w_in
    (dq, dk_, dv_, iq, ik, iw, gq, gk, gv, g_low, g_out) = jnp.split(
        proj, np.cumsum(IN_SPLITS)[:-1].tolist(), axis=-1)
    dq = dq.reshape(b, t, DSA_HEADS, DSA_HEAD_DIM)
    dk_ = dk_.reshape(b, t, DSA_HEADS, DSA_HEAD_DIM)
    dv_ = dv_.reshape(b, t, DSA_HEADS, DSA_HEAD_DIM)
    iq = iq.reshape(b, t, IDX_HEADS, IDX_DIM) * (IDX_DIM ** -0.5)
    iw = iw * (IDX_HEADS ** -0.5)
    o_dsa = dsa_attention(dq, dk_, dv_, iq, ik, iw, top_k).reshape(b, t, DSA_WIDTH)
    gq = gq.reshape(b, t, GLA_HEADS, GLA_DK) * (GLA_DK ** -0.5)
    gk = gk.reshape(b, t, GLA_HEADS, GLA_DK)
    gv = gv.reshape(b, t, GLA_HEADS, GLA_DV)
    gate_logit = (g_low @ w_gate_up + b_gate).astype(jnp.float32)
    log_g = (jax.nn.log_sigmoid(gate_logit) / GLA_TAU).reshape(b, t, GLA_HEADS, GLA_DK)
    o_gla = gla_chunked(gq, gk, gv, log_g)
    o_gla = rms_norm(o_gla, gla_norm_g) * jax.nn.silu(g_out.reshape(b, t, GLA_HEADS, GLA_DV))
    o_gla = o_gla.reshape(b, t, GLA_WIDTH)
    return jnp.concatenate([o_dsa, o_gla], axis=-1) @ w_out


def setup_inputs(seed: int = 0) -> dict:
    key = jax.random.key(seed)
    ks = jax.random.split(key, 20)
    f32 = jnp.float32

    def w(k, shape, fan_in):
        return jax.random.normal(k, shape, f32) * (fan_in ** -0.5)

    def gain(k, shape):
        return 1.0 + 0.02 * jax.random.normal(k, shape, f32)

    L = DEPTH
    return {
        "x": jax.random.normal(ks[0], (BATCH, SEQ, D_MODEL), f32),
        "meta_tokens": jax.random.normal(ks[1], (N_META, D_MODEL), f32),
        "ffn1_pre_g": gain(ks[2], (L, D_MODEL)),
        "ffn1_w_gate": w(ks[3], (L, D_MODEL, D_FF), D_MODEL),
        "ffn1_w_up": w(ks[4], (L, D_MODEL, D_FF), D_MODEL),
        "ffn1_w_down": w(ks[5], (L, D_FF, D_MODEL), D_FF),
        "ffn1_post_g": gain(ks[6], (L, D_MODEL)),
        "mix_pre_g": gain(ks[7], (L, D_MODEL)),
        "w_in": w(ks[8], (L, D_MODEL, IN_WIDTH), D_MODEL),
        "w_gate_up": w(ks[9], (L, GLA_GATE_RANK, GLA_KEY_WIDTH), GLA_GATE_RANK),
        "b_gate": 0.01 * jax.random.normal(ks[10], (L, GLA_KEY_WIDTH), f32),
        "gla_norm_g": gain(ks[11], (L, GLA_DV)),
        "w_out": w(ks[12], (L, MIX_WIDTH, D_MODEL), MIX_WIDTH),
        "mix_post_g": gain(ks[13], (L, D_MODEL)),
        "ffn2_pre_g": gain(ks[14], (L, D_MODEL)),
        "ffn2_w_gate": w(ks[15], (L, D_MODEL, D_FF), D_MODEL),
        "ffn2_w_up": w(ks[16], (L, D_MODEL, D_FF), D_MODEL),
        "ffn2_w_down": w(ks[17], (L, D_FF, D_MODEL), D_FF),
        "ffn2_post_g": gain(ks[18], (L, D_MODEL)),
    }


def reference(x, meta_tokens, ffn1_pre_g, ffn1_w_gate, ffn1_w_up, ffn1_w_down, ffn1_post_g,
              mix_pre_g, w_in, w_gate_up, b_gate, gla_norm_g, w_out, mix_post_g,
              ffn2_pre_g, ffn2_w_gate, ffn2_w_up, ffn2_w_down, ffn2_post_g):
    b = x.shape[0]
    top_k = min(TOPK_MAX, SEQ // 4)
    meta = jnp.broadcast_to(meta_tokens[None].astype(x.dtype), (b, N_META, x.shape[-1]))
    hs = jnp.concatenate([meta, x], axis=1)
    for l in range(DEPTH):
        f = swiglu(rms_norm(hs, ffn1_pre_g[l]), ffn1_w_gate[l], ffn1_w_up[l], ffn1_w_down[l])
        hs = hs + FFN_RES * rms_norm(f, ffn1_post_g[l])
        m = hybrid_mixer(rms_norm(hs, mix_pre_g[l]), w_in[l], w_gate_up[l], b_gate[l],
                         gla_norm_g[l], w_out[l], top_k)
        hs = hs + rms_norm(m, mix_post_g[l])
        f = swiglu(rms_norm(hs, ffn2_pre_g[l]), ffn2_w_gate[l], ffn2_w_up[l], ffn2_w_down[l])
        hs = hs + FFN_RES * rms_norm(f, ffn2_post_g[l])
    return hs[:, N_META:]
```

```cpp
#include <hip/hip_runtime.h>
#include <cstdio>
#include <cstdint>
#define MK_PER_PHASE 0
namespace pg8 {
#define PG8_LAS __attribute__((address_space(3)))
typedef unsigned short bf16_t;
typedef short bf16x8 __attribute__((ext_vector_type(8)));
typedef float f32x4 __attribute__((ext_vector_type(4)));
typedef unsigned u32x4 __attribute__((ext_vector_type(4)));
constexpr int BM = 256, BK = 64, HALF = 128, HTB = HALF * BK * 2  , STAGE_BYTES = 8 * HTB, NXCD = 8, WGM = 8;

__host__ __device__ __forceinline__ int lds_byte(int r, int c) { const int st = (r >> 4) * 2 + (c >> 5), rr = r & 15, cc = c & 31, ob = rr * 64 + cc * 2; return st * 1024 + (ob ^ (((ob >> 9) & 1) << 5)); }
__host__ __device__ __forceinline__ void stage_rc(int b, int& R, int& C) { const int st = b / 1024, sb = b % 1024, swz = sb ^ (((sb >> 9) & 1) << 5); R = (st >> 1) * 16 + swz / 64; C = (st & 1) * 32 + (swz % 64) / 2; }
__host__ __device__ __forceinline__ int perm32(int rho) { const int n = rho >> 4, i = rho & 15; return 8 * (i >> 2) + 4 * n + (i & 3); }

struct Unit { int pm, pn; };
struct Gemm { const bf16_t* A; const bf16_t* Bt; int M, N, K; };

struct StaticOrder {
    int nM, nN, nwg, G, c;
    __host__ __device__ void init(int M, int N, int G_, int c_) { nM = M / BM; nN = N / BM; nwg = nM * nN; G = G_; c = c_; }
    __host__ __device__ bool next(int i, Unit& u) const {
        const long L = (long)i * G + c; if (L >= nwg) return false;
        int wgid = (int)L; { const int q = nwg / NXCD, r = nwg % NXCD, xcd = wgid % NXCD, off = wgid / NXCD; wgid = (xcd < r ? xcd * (q + 1) : r * (q + 1) + (xcd - r) * q) + off; }
        const int nig = WGM * nN, gid = wgid / nig, fm = gid * WGM, gsz = (nM - fm) < WGM ? (nM - fm) : WGM;
        u.pm = fm + ((wgid % nig) % gsz); u.pn = (wgid % nig) / gsz; return true;
    }
    __device__ __forceinline__ void a_ready(const Unit&) const {}
    __device__ __forceinline__ void done(const Unit&) const {}
};

__device__ __forceinline__ unsigned cvt_pk_bf16(float lo, float hi) { unsigned r; asm volatile("v_cvt_pk_bf16_f32 %0, %1, %2" : "=v"(r) : "v"(lo), "v"(hi)); return r; }
typedef float f32x2 __attribute__((ext_vector_type(2)));

__device__ __forceinline__ void st8bf(bf16_t* p, const f32x4 v0, const f32x4 v1) {
    u32x4 w; w.x = cvt_pk_bf16(v0[0], v0[1]); w.y = cvt_pk_bf16(v0[2], v0[3]); w.z = cvt_pk_bf16(v1[0], v1[1]); w.w = cvt_pk_bf16(v1[2], v1[3]);
    *(u32x4*)p = w;
}
__device__ __forceinline__ float silu_f(float x) { return x * __builtin_amdgcn_rcpf(1.0f + __builtin_amdgcn_exp2f(-1.4426950408889634f * x)); }

struct EpiStoreBf16 {
    static constexpr bool PERM = true, AFTER_DRAIN = false;
    bf16_t* O; int ldc;
    __device__ __forceinline__ void operator()(const f32x4 (&acc)[2][2][4][2], const Unit& u, int wr, int wc, int fr, int fq) const {
        const int row0 = u.pm * BM + wr * 64 + fr, col0 = u.pn * BM + wc * 32 + 8 * fq;
#pragma unroll
        for (int ai = 0; ai < 2; ++ai)
#pragma unroll
            for (int m = 0; m < 4; ++m) { bf16_t* rowp = O + (size_t)(row0 + ai * HALF + m * 16) * ldc + col0;
#pragma unroll
                for (int bj = 0; bj < 2; ++bj) st8bf(rowp + bj * HALF, acc[ai][bj][m][0], acc[ai][bj][m][1]); }
    }
};
struct EpiSwiGLU {
    static constexpr bool PERM = true, AFTER_DRAIN = false;
    bf16_t* O; int ldc; const float* rstd;
    __device__ __forceinline__ void operator()(const f32x4 (&acc)[2][2][4][2], const Unit& u, int wr, int wc, int fr, int fq) const {
        const int row0 = u.pm * BM + wr * 64 + fr, col0 = u.pn * HALF + wc * 32 + 8 * fq;
#pragma unroll
        for (int ai = 0; ai < 2; ++ai)
#pragma unroll
            for (int m = 0; m < 4; ++m) { const int row = row0 + ai * HALF + m * 16; const float rs = rstd[row];
                f32x4 o0, o1;
#pragma unroll
                for (int j = 0; j < 4; ++j) { o0[j] = silu_f(acc[ai][0][m][0][j] * rs) * (acc[ai][1][m][0][j] * rs); o1[j] = silu_f(acc[ai][0][m][1][j] * rs) * (acc[ai][1][m][1][j] * rs); }
                st8bf(O + (size_t)row * ldc + col0, o0, o1); }
    }
};
struct EpiProj {
    static constexpr bool PERM = true, AFTER_DRAIN = false;
    static constexpr int TKV = 8256;
    const float* rstd;
    bf16_t *Qh, *Kh, *Vh, *IQ, *GQ, *GK, *GV, *GO, *IK; float *IW, *GLOW;
    __device__ __forceinline__ void operator()(const f32x4 (&acc)[2][2][4][2], const Unit& u, int wr, int wc, int fr, int fq) const {
        const int pn = u.pn;
        const int row0 = u.pm * BM + wr * 64 + fr;
#pragma unroll
        for (int ai = 0; ai < 2; ++ai)
#pragma unroll
            for (int m = 0; m < 4; ++m) {
                const int row = row0 + ai * HALF + m * 16; const float rs = rstd[row];
                const bool mainr = row < 16384, metar = (row >= 16384) && (row < 16400);
                const int b = row >> 13, s = row & 8191, mi = row - 16384;
#pragma unroll
                for (int bj = 0; bj < 2; ++bj) {
                    const int col = bj * HALF + wc * 32 + 8 * fq;
                    f32x4 v0 = acc[ai][bj][m][0] * rs, v1 = acc[ai][bj][m][1] * rs;
                    if (pn < 4) {
                        if (mainr) { const int h = pn * 2 + (col >> 7), d = col & 127; st8bf(Qh + ((size_t)(b * 8 + h) * 8192 + s) * 128 + d, v0, v1); }
                    } else if (pn < 12) {
                        bf16_t* base = pn < 8 ? Kh : Vh; const int h = (pn & 3) * 2 + (col >> 7), d = col & 127;
                        if (mainr) st8bf(base + ((size_t)(b * 8 + h) * TKV + 16 + s) * 128 + d, v0, v1);
                        else if (metar) { st8bf(base + ((size_t)h * TKV + mi) * 128 + d, v0, v1); st8bf(base + ((size_t)(8 + h) * TKV + mi) * 128 + d, v0, v1); }
                    } else if (pn < 16) {
                        if (mainr) st8bf(IQ + (size_t)row * 1024 + (pn - 12) * 256 + col, v0 * 0.125f, v1 * 0.125f);
                    } else if (pn < 18) {
                        if (mainr) st8bf(GQ + ((size_t)b * TKV + 64 + s) * 512 + (pn - 16) * 256 + col, v0 * 0.08838834764831845f, v1 * 0.08838834764831845f);
                    } else if (pn < 20) {
                        const int c = (pn - 18) * 256 + col;
                        if (mainr) st8bf(GK + ((size_t)b * TKV + 64 + s) * 512 + c, v0, v1);
                        else if (metar) { st8bf(GK + ((size_t)48 + mi) * 512 + c, v0, v1); st8bf(GK + ((size_t)TKV + 48 + mi) * 512 + c, v0, v1); }
                    } else if (pn < 24) {
                        const int c = (pn - 20) * 256 + col;
                        if (mainr) st8bf(GV + ((size_t)b * TKV + 64 + s) * 1024 + c, v0, v1);
                        else if (metar) { st8bf(GV + ((size_t)48 + mi) * 1024 + c, v0, v1); st8bf(GV + ((size_t)TKV + 48 + mi) * 1024 + c, v0, v1); }
                    } else if (pn < 28) {
                        if (mainr) st8bf(GO + (size_t)row * 1024 + (pn - 24) * 256 + col, v0, v1);
                    } else {
                        if (col < 64) {
                            if (mainr) st8bf(IK + ((size_t)b * TKV + 16 + s) * 64 + col, v0, v1);
                            else if (metar) { st8bf(IK + ((size_t)mi) * 64 + col, v0, v1); st8bf(IK + ((size_t)TKV + mi) * 64 + col, v0, v1); }
                        } else if (col < 80) {
                            if (mainr) { float* p = IW + (size_t)row * 16 + (col - 64); *(f32x4*)p = v0 * 0.25f; *(f32x4*)(p + 4) = v1 * 0.25f; }
                        } else if (col < 96) {
                            const int c = col - 80;
                            if (mainr) { float* p = GLOW + ((size_t)b * TKV + 64 + s) * 16 + c; *(f32x4*)p = v0; *(f32x4*)(p + 4) = v1; }
                            else if (metar) { float* p = GLOW + ((size_t)48 + mi) * 16 + c; *(f32x4*)p = v0; *(f32x4*)(p + 4) = v1;
                                              float* p2 = GLOW + ((size_t)TKV + 48 + mi) * 16 + c; *(f32x4*)p2 = v0; *(f32x4*)(p2 + 4) = v1; }
                        }
                    }
                }
            }
    }
};
template <class Epi, class Sched, bool ALIGN_EPI = false, bool SP2 = false>
__device__ __forceinline__ void gemm_phase(PG8_LAS unsigned char* lds, const Gemm g, const Sched& S, const Epi& E) {
    const int tid = threadIdx.x, wid = __builtin_amdgcn_readfirstlane(tid >> 6), lane = tid & 63, wr = wid >> 2, wc = wid & 3, fr = lane & 15, fq = lane >> 4;
    const int K = g.K, nt = K / BK;
    unsigned voffA[2], voffB[2];
#pragma unroll
    for (int i = 0; i < 2; ++i) { int R, C; stage_rc(tid * 16 + i * 8192, R, C); const int Rb = Epi::PERM ? ((R & ~31) + perm32(R & 31)) : R;
        voffA[i] = (unsigned)(R * K + C) * 2u; voffB[i] = (unsigned)(Rb * K + C) * 2u; }
    const size_t kstep = (size_t)(BK * 2);
    const size_t hstep = (size_t)HALF * K * 2;
    const size_t tstep = 2 * hstep;
    const unsigned ldsw = (unsigned)wid * 1024u;
    const int aoff = lds_byte(wr * 64 + fr, fq * 8), boff = lds_byte(wc * 32 + fr, fq * 8);
#define PG8_SA(b, h) (((b) * 2 + (h)) * HTB)
#define PG8_SB(b, h) ((4 + (b) * 2 + (h)) * HTB)
#define PG8_STAGE(bufoff, gbase, voff) do { _Pragma("unroll") for (int _i = 0; _i < 2; ++_i) \
        __builtin_amdgcn_global_load_lds((const unsigned*)((const char*)(gbase) + (voff)[_i]), (PG8_LAS unsigned*)(lds + (bufoff) + ldsw + _i * 8192), 16, 0, 0); } while (0)
#define PG8_LDA(dst, b, h) do { _Pragma("unroll") for (int m = 0; m < 4; ++m) _Pragma("unroll") for (int k = 0; k < 2; ++k) dst[m][k] = *(const PG8_LAS bf16x8*)(lds + PG8_SA(b, h) + aoff + m * 2048 + k * 1024); } while (0)
#define PG8_LDB(dst, b, h) do { _Pragma("unroll") for (int n = 0; n < 2; ++n) _Pragma("unroll") for (int k = 0; k < 2; ++k) dst[n][k] = *(const PG8_LAS bf16x8*)(lds + PG8_SB(b, h) + boff + n * 2048 + k * 1024); } while (0)
#define PG8_MMA(ai, bj, At, Bt) do { __builtin_amdgcn_s_setprio(1); _Pragma("unroll") for (int m = 0; m < 4; ++m) _Pragma("unroll") for (int n = 0; n < 2; ++n) _Pragma("unroll") for (int k = 0; k < 2; ++k) \
        acc[ai][bj][m][n] = __builtin_amdgcn_mfma_f32_16x16x32_bf16(Bt[n][k], At[m][k], acc[ai][bj][m][n], 0, 0, 0); __builtin_amdgcn_s_setprio(0); } while (0)
#define PG8_WAIT_V(n) asm volatile("s_waitcnt vmcnt(" #n ")" ::: "memory")
#define PG8_WAIT_L(n) asm volatile("s_waitcnt lgkmcnt(" #n ")" ::: "memory")
#define PG8_BAR __builtin_amdgcn_s_barrier()
#define PG8_SCHED __builtin_amdgcn_sched_barrier(0)
    Unit cur, nxt; int ui = 0;
    if (!S.next(0, cur)) return;
    f32x4 acc[2][2][4][2];
#pragma unroll
    for (int a = 0; a < 2; ++a)
#pragma unroll
        for (int b = 0; b < 2; ++b)
#pragma unroll
            for (int m = 0; m < 4; ++m)
#pragma unroll
                for (int n = 0; n < 2; ++n) acc[a][b][m][n] = (f32x4){0.f, 0.f, 0.f, 0.f};
    bf16x8 At[4][2], B0[2][2], B1[2][2];
    const char* cA = (const char*)g.A + (size_t)cur.pm * tstep; const char* cB = (const char*)g.Bt + (size_t)cur.pn * tstep;
    S.a_ready(cur);
    if constexpr (SP2) {
        PG8_STAGE(PG8_SB(0, 0), cB, voffB); PG8_STAGE(PG8_SB(0, 1), cB + hstep, voffB); PG8_STAGE(PG8_SA(0, 0), cA, voffA); PG8_STAGE(PG8_SA(0, 1), cA + hstep, voffA);
        if (wr == 1) PG8_BAR;
        PG8_WAIT_V(2); PG8_BAR;
        PG8_STAGE(PG8_SB(1, 0), cB + kstep, voffB); PG8_STAGE(PG8_SA(1, 0), cA + kstep, voffA); PG8_STAGE(PG8_SB(1, 1), cB + hstep + kstep, voffB);
        PG8_WAIT_V(6); PG8_BAR;
    } else {
        PG8_STAGE(PG8_SB(0, 0), cB, voffB); PG8_STAGE(PG8_SA(0, 0), cA, voffA); PG8_STAGE(PG8_SB(0, 1), cB + hstep, voffB); PG8_STAGE(PG8_SA(0, 1), cA + hstep, voffA);
        if (wr == 1) PG8_BAR;
        PG8_WAIT_V(4); PG8_BAR;
        PG8_STAGE(PG8_SB(1, 0), cB + kstep, voffB); PG8_STAGE(PG8_SA(1, 0), cA + kstep, voffA); PG8_STAGE(PG8_SB(1, 1), cB + hstep + kstep, voffB);
        PG8_WAIT_V(6); PG8_BAR;
    }
    for (;;) {
        const bool has_next = S.next(ui + 1, nxt);
        const char* nA = has_next ? (const char*)g.A + (size_t)nxt.pm * tstep : cA; const char* nB = has_next ? (const char*)g.Bt + (size_t)nxt.pn * tstep : cB;
        for (int t = 0; t < nt; t += 2) {
            const bool last = (t == nt - 2);
            const char* a1 = cA + (size_t)(t + 1) * kstep;
            const char* a2 = last ? nA : cA + (size_t)(t + 2) * kstep; const char* b2 = last ? nB : cB + (size_t)(t + 2) * kstep;
            const char* a3 = a2 + kstep; const char* b3 = b2 + kstep;
            if (last && has_next) S.a_ready(nxt);
            if constexpr (SP2) {
            PG8_LDB(B0, 0, 0); PG8_LDB(B1, 0, 1); PG8_SCHED; PG8_LDA(At, 0, 0); PG8_STAGE(PG8_SA(1, 1), a1 + hstep, voffA);
            PG8_WAIT_V(8); PG8_WAIT_L(0); PG8_BAR; PG8_MMA(0, 0, At, B0); PG8_MMA(0, 1, At, B1); PG8_BAR; PG8_SCHED;
            PG8_LDA(At, 0, 1); PG8_STAGE(PG8_SB(0, 0), b2, voffB); PG8_STAGE(PG8_SB(0, 1), b2 + hstep, voffB); PG8_STAGE(PG8_SA(0, 0), a2, voffA);
            PG8_WAIT_V(8); PG8_WAIT_L(0); PG8_BAR; PG8_MMA(1, 0, At, B0); PG8_MMA(1, 1, At, B1); PG8_BAR; PG8_SCHED;
            PG8_LDB(B0, 1, 0); PG8_LDB(B1, 1, 1); PG8_SCHED; PG8_LDA(At, 1, 0); PG8_STAGE(PG8_SA(0, 1), a2 + hstep, voffA);
            PG8_WAIT_V(8); PG8_WAIT_L(0); PG8_BAR; PG8_MMA(0, 0, At, B0); PG8_MMA(0, 1, At, B1); PG8_BAR; PG8_SCHED;
            PG8_LDA(At, 1, 1); PG8_STAGE(PG8_SB(1, 0), b3, voffB); PG8_STAGE(PG8_SB(1, 1), b3 + hstep, voffB); PG8_STAGE(PG8_SA(1, 0), a3, voffA);
            PG8_WAIT_V(8); PG8_WAIT_L(0); PG8_BAR; PG8_MMA(1, 0, At, B0); PG8_MMA(1, 1, At, B1); PG8_BAR; PG8_SCHED;
            } else {
            PG8_LDB(B0, 0, 0); PG8_SCHED; PG8_LDA(At, 0, 0); PG8_STAGE(PG8_SA(1, 1), a1 + hstep, voffA);
            PG8_WAIT_L(8); PG8_BAR; PG8_WAIT_L(0); PG8_MMA(0, 0, At, B0); PG8_BAR; PG8_SCHED;
            PG8_LDB(B1, 0, 1); PG8_STAGE(PG8_SB(0, 0), b2, voffB);
            PG8_BAR; PG8_WAIT_L(0); PG8_MMA(0, 1, At, B1); PG8_BAR;
            PG8_LDA(At, 0, 1); PG8_STAGE(PG8_SA(0, 0), a2, voffA);
            PG8_BAR; PG8_WAIT_L(0); PG8_MMA(1, 0, At, B0); PG8_BAR; PG8_SCHED;
            PG8_STAGE(PG8_SB(0, 1), b2 + hstep, voffB);
            PG8_WAIT_V(6); PG8_BAR; PG8_MMA(1, 1, At, B1); PG8_BAR;
            PG8_LDB(B0, 1, 0); PG8_SCHED; PG8_LDA(At, 1, 0); PG8_STAGE(PG8_SA(0, 1), a2 + hstep, voffA);
            PG8_WAIT_L(8); PG8_BAR; PG8_WAIT_L(0); PG8_MMA(0, 0, At, B0); PG8_BAR; PG8_SCHED;
            PG8_LDB(B1, 1, 1); PG8_STAGE(PG8_SB(1, 0), b3, voffB);
            PG8_BAR; PG8_WAIT_L(0); PG8_MMA(0, 1, At, B1); PG8_BAR;
            PG8_LDA(At, 1, 1); PG8_STAGE(PG8_SA(1, 0), a3, voffA);
            PG8_BAR; PG8_WAIT_L(0); PG8_MMA(1, 0, At, B0); PG8_BAR; PG8_SCHED;
            PG8_STAGE(PG8_SB(1, 1), b3 + hstep, voffB);
            PG8_WAIT_V(6); PG8_BAR; PG8_MMA(1, 1, At, B1); PG8_BAR;
            }
        }
        if constexpr (ALIGN_EPI) { if (wr == 0) PG8_BAR; }
        if constexpr (!Epi::AFTER_DRAIN) { E(acc, cur, wr, wc, fr, fq); S.done(cur); }
        if (!has_next) break;
#pragma unroll
        for (int a = 0; a < 2; ++a)
#pragma unroll
            for (int b = 0; b < 2; ++b)
#pragma unroll
                for (int m = 0; m < 4; ++m)
#pragma unroll
                    for (int n = 0; n < 2; ++n) acc[a][b][m][n] = (f32x4){0.f, 0.f, 0.f, 0.f};
        cur = nxt; cA = nA; cB = nB; ++ui;
        if constexpr (ALIGN_EPI) { if (wr == 1) PG8_BAR; }
    }
    PG8_WAIT_V(0);
    if constexpr (!ALIGN_EPI) { if (wr == 0) PG8_BAR; }
    PG8_BAR;
    if constexpr (Epi::AFTER_DRAIN) { E.fused(acc, cur, wr, wc, fr, fq, lds, wid, lane); S.done(cur); }
#undef PG8_SA
#undef PG8_SB
#undef PG8_STAGE
#undef PG8_LDA
#undef PG8_LDB
#undef PG8_MMA
#undef PG8_WAIT_V
#undef PG8_WAIT_L
#undef PG8_BAR
#undef PG8_SCHED
}
}

namespace att {
typedef unsigned short bf16;
typedef short bf16x8 __attribute__((ext_vector_type(8)));
typedef short s16x4 __attribute__((ext_vector_type(4)));
typedef float f32x16 __attribute__((ext_vector_type(16)));
typedef float f32x4 __attribute__((ext_vector_type(4)));
typedef unsigned u32x4 __attribute__((ext_vector_type(4)));
typedef unsigned long long u64;
constexpr int HD = 128, NW = 8, QBLK = 32, KVBLK = 64, QB = NW * QBLK;
constexpr int SHM_V = KVBLK * HD * 2, SHM_K = KVBLK * HD * 2;
constexpr int ATT_LDS_BYTES = 2 * SHM_V + 2 * SHM_K + NW * 64 * 4;
constexpr float SCALE = 0.08838834764831845f;
constexpr float THR = 8.f;
constexpr int OSTR = 2048;
constexpr int MWORDS = 129;

#define KSWZ(row, colB) ((row) * 256 + ((colB) ^ (((row) & 7) << 4)))
#define SBAR() __builtin_amdgcn_sched_barrier(0)
__device__ __forceinline__ int v_st(int k, int c) { const int kk = (k & ~0xC) | ((k & 4) << 1) | ((k & 8) >> 1); return ((kk >> 3) * 4 + (c >> 5)) * 512 + ((kk & 7) * 32 + (c & 31)) * 2; }
__device__ __forceinline__ int v_rd_base(int lane) { return ((lane & 3) << 3) | (((lane >> 2) & 3) << 6) | (((lane >> 4) & 1) << 5) | (((lane >> 5) & 1) << 8); }
constexpr int v_rd_off(int d0, int ks, int half) { return d0 * 512 + ks * 4096 + half * 2048; }
__device__ __forceinline__ int crow(int r, int hi) { return (r & 3) + 8 * (r >> 2) + 4 * hi; }
__device__ __forceinline__ unsigned cvtpk(float lo, float hi) {
    unsigned r; asm volatile("v_cvt_pk_bf16_f32 %0, %1, %2" : "=v"(r) : "v"(lo), "v"(hi)); return r;
}
__device__ __forceinline__ bf16x8 load8(const bf16* p) { return *reinterpret_cast<const bf16x8*>(p); }
__device__ __forceinline__ void mask_bits(f32x16& p0, f32x16& p1, u64 mw, int hi) {
    const float NEG = -__builtin_inff();
    const unsigned m0 = (unsigned)mw >> (4 * hi), m1 = (unsigned)(mw >> 32) >> (4 * hi);
#pragma unroll
    for (int r = 0; r < 16; ++r) {
        const int c = (r & 3) + 8 * (r >> 2);
        if (!((m0 >> c) & 1u)) p0[r] = NEG;
        if (!((m1 >> c) & 1u)) p1[r] = NEG;
    }
}
__device__ __forceinline__ void partialSM(f32x16& p0, f32x16& p1, float& m_reg, float& mn, float& alpha) {
    float pmax = p0[0]; for (int r = 1; r < 16; ++r) pmax = fmaxf(pmax, p0[r]); for (int r = 0; r < 16; ++r) pmax = fmaxf(pmax, p1[r]);
    { auto rr = __builtin_amdgcn_permlane32_swap(__float_as_uint(pmax), __float_as_uint(pmax), false, false);
      pmax = fmaxf(__uint_as_float(rr[0]), __uint_as_float(rr[1])); }
    constexpr float C2 = 1.4426950408889634f * SCALE;
    if (__builtin_expect(__all((pmax - m_reg) * SCALE <= THR), 1)) { mn = m_reg; alpha = 1.f; }
    else { mn = fmaxf(m_reg, pmax); alpha = __builtin_amdgcn_exp2f((m_reg - mn) * C2); m_reg = mn; }
    const float mnL = -mn * C2;
    for (int r = 0; r < 16; ++r) p0[r] = fmaf(p0[r], C2, mnL); for (int r = 0; r < 16; ++r) p1[r] = fmaf(p1[r], C2, mnL);
    for (int r = 0; r < 16; ++r) p0[r] = __builtin_amdgcn_exp2f(p0[r]);
}
__device__ __forceinline__ void finishSM(f32x16& p0, f32x16& p1, float alpha, float& l_reg, bf16x8& pa0, bf16x8& pa1, bf16x8& pa2, bf16x8& pa3) {
    for (int r = 0; r < 16; ++r) p1[r] = __builtin_amdgcn_exp2f(p1[r]);
    float ps = 0; for (int r = 0; r < 16; ++r) ps += p0[r]; for (int r = 0; r < 16; ++r) ps += p1[r];
    { auto rr = __builtin_amdgcn_permlane32_swap(__float_as_uint(ps), __float_as_uint(ps), false, false);
      ps = __uint_as_float(rr[0]) + __uint_as_float(rr[1]); }
    l_reg = l_reg * alpha + ps;
#define PK4(P, B_, OUT) do { unsigned a0 = cvtpk(P[B_+0], P[B_+1]), a1 = cvtpk(P[B_+2], P[B_+3]);                          \
        unsigned b0 = cvtpk(P[B_+4], P[B_+5]), b1 = cvtpk(P[B_+6], P[B_+7]);                                             \
        auto r0 = __builtin_amdgcn_permlane32_swap(a0, b0, false, false); auto r1 = __builtin_amdgcn_permlane32_swap(a1, b1, false, false); \
        u32x4 w = {r0[0], r1[0], r0[1], r1[1]}; OUT = *reinterpret_cast<bf16x8*>(&w); } while (0)
    PK4(p0, 0, pa0); PK4(p0, 8, pa1); PK4(p1, 0, pa2); PK4(p1, 8, pa3);
#undef PK4
}
template <int KB>
__device__ __forceinline__ void qkt(f32x16& p0, f32x16& p1, const char* K_lds, int r32, int hi, const bf16x8* qr) {
    p0 = f32x16{}; p1 = f32x16{};
    const char* kb[4];
#pragma unroll
    for (int dd = 0; dd < 4; ++dd) kb[dd] = K_lds + KB * SHM_K + KSWZ(r32, (dd * 16 + hi * 8) * 2);
#pragma unroll
    for (int d0 = 0; d0 < 8; ++d0) { const char* a = kb[d0 & 3] + (d0 >> 2) * 128;
        bf16x8 b0 = *reinterpret_cast<const bf16x8*>(a);
        bf16x8 b1 = *reinterpret_cast<const bf16x8*>(a + 32 * 256);
        p0 = __builtin_amdgcn_mfma_f32_32x32x16_bf16(b0, qr[d0], p0, 0, 0, 0);
        p1 = __builtin_amdgcn_mfma_f32_32x32x16_bf16(b1, qr[d0], p1, 0, 0, 0); }
}
template <int VB>
__device__ __forceinline__ void pv_tile(f32x16* o, int vb0, bf16x8 pa0, bf16x8 pa1, bf16x8 pa2, bf16x8 pa3) {
#define TRRD(dst, off) asm volatile("ds_read_b64_tr_b16 %0, %1 offset:%2" : "=&v"(dst) : "v"(vb0), "i"(off) : "memory")
#define PV_D0(d0) do { s16x4 l0, l1, l2, l3, h0, h1, h2, h3; constexpr int b_ = VB * SHM_V + v_rd_off(d0, 0, 0);     \
        TRRD(l0, b_); TRRD(h0, b_ + 2048); TRRD(l1, b_ + 4096); TRRD(h1, b_ + 6144); TRRD(l2, b_ + 8192); TRRD(h2, b_ + 10240); TRRD(l3, b_ + 12288); TRRD(h3, b_ + 14336); \
        asm volatile("s_waitcnt lgkmcnt(0)" ::: "memory"); SBAR();             \
        o[d0] = __builtin_amdgcn_mfma_f32_32x32x16_bf16(pa0, (bf16x8){l0[0], l0[1], l0[2], l0[3], h0[0], h0[1], h0[2], h0[3]}, o[d0], 0, 0, 0);   \
        o[d0] = __builtin_amdgcn_mfma_f32_32x32x16_bf16(pa1, (bf16x8){l1[0], l1[1], l1[2], l1[3], h1[0], h1[1], h1[2], h1[3]}, o[d0], 0, 0, 0);   \
        o[d0] = __builtin_amdgcn_mfma_f32_32x32x16_bf16(pa2, (bf16x8){l2[0], l2[1], l2[2], l2[3], h2[0], h2[1], h2[2], h2[3]}, o[d0], 0, 0, 0);   \
        o[d0] = __builtin_amdgcn_mfma_f32_32x32x16_bf16(pa3, (bf16x8){l3[0], l3[1], l3[2], l3[3], h3[0], h3[1], h3[2], h3[3]}, o[d0], 0, 0, 0); } while (0)
    PV_D0(0); PV_D0(1); PV_D0(2); PV_D0(3);
#undef PV_D0
#undef TRRD
}

struct BlockRef { const bf16* Q; const bf16* K; const bf16* V; bf16* O; const u64* M; int NT; };
struct Seam { bf16x8 qr[8]; bf16x8 st_v0, st_v1, st_k0, st_k1; };
#define ROW(p, k0, rr) ((const bf16*)((const char*)(p) + (unsigned)((((k0) + (rr)) * HD + sc) * 2)))
#define VMW() asm volatile("s_waitcnt vmcnt(0)" ::: "memory")
#define VMWN(n) asm volatile("s_waitcnt vmcnt(%0)" :: "i"(n) : "memory")
#define SLOAD_H(Kp, Vp, k0) do { S.st_v0 = load8(ROW(Vp, k0, sr)); S.st_v1 = load8(ROW(Vp, k0, 32 + sr));              \
                         S.st_k0 = load8(ROW(Kp, k0, sr)); S.st_k1 = load8(ROW(Kp, k0, 32 + sr)); } while (0)
#define SWRITE_HK(bf) do { *(bf16x8*)(K_lds + (bf) * SHM_K + kws) = S.st_k0; *(bf16x8*)(K_lds + (bf) * SHM_K + kws + 32 * 256) = S.st_k1; } while (0)
#define SWRITE_HV(bf) do { *(bf16x8*)(V_lds + (bf) * SHM_V + vst0) = S.st_v0; *(bf16x8*)(V_lds + (bf) * SHM_V + vst1) = S.st_v1; } while (0)
#define SWRITE_H(bf) do { SWRITE_HV(bf); SWRITE_HK(bf); } while (0)
__device__ __forceinline__ void att_prime(const BlockRef& cur, char* lds, Seam& S) {
    const int tid = threadIdx.x, wid = __builtin_amdgcn_readfirstlane(tid >> 6), lane = tid & 63, r32 = lane & 31, hi = lane >> 5;
    const int sr = tid >> 4, sc = (tid & 15) * 8, kws = KSWZ(sr, sc * 2); char* K_lds = lds + 2 * SHM_V;
#pragma unroll
    for (int d0 = 0; d0 < 8; ++d0) S.qr[d0] = load8((const bf16*)((const char*)cur.Q + (unsigned)(((wid * QBLK + r32) * HD + hi * 8) * 2 + d0 * 32)));
    SLOAD_H(cur.K, cur.V, 0); VMW(); SWRITE_HK(0);
    __syncthreads();
}
__device__ __forceinline__ void att_block(const BlockRef& cur, const BlockRef& nxt, char* lds, Seam& S) {
    const int tid = threadIdx.x, wid = __builtin_amdgcn_readfirstlane(tid >> 6), lane = tid & 63, r32 = lane & 31, hi = lane >> 5;
    const int NT = cur.NT;
    char* V_lds = lds; char* K_lds = lds + 2 * SHM_V;
    float* ws = (float*)(lds + 2 * SHM_V + 2 * SHM_K) + wid * 64; float* li_l = ws, * al_l = ws + 32;
    float m_reg = -1e30f, l_reg = 0; f32x16 o[4] = {};
    const int sr = tid >> 4, sc = (tid & 15) * 8, vst0 = v_st(sr, sc), vst1 = v_st(32 + sr, sc), kws = KSWZ(sr, sc * 2);
    const int vb0 = (int)(uintptr_t)V_lds + v_rd_base(lane);
    const bf16* Kh = cur.K; const bf16* Vh = cur.V;
    const char* Mb = (const char*)cur.M; const unsigned moff = (unsigned)((wid * QBLK + r32) * (MWORDS * 8));
#define MLOAD(t) (*(const u64*)(Mb + (moff + (unsigned)(t) * 8u)))
    u64 mwA = MLOAD(0), mwB = MLOAD(NT > 1 ? 1 : 0);
#define RESC(a) do { if (__any((a) < 1.f)) { if (hi == 0) al_l[r32] = (a); asm volatile("s_waitcnt lgkmcnt(0)" ::: "memory");              \
                     for (int d_ = 0; d_ < 4; ++d_) for (int r = 0; r < 16; ++r) o[d_][r] *= al_l[crow(r, hi)]; } } while (0)
#define KBASE(t) ((t) * KVBLK)
    constexpr int NQL = 8;
#define SEAM_K0() do { VMWN(NQL); SWRITE_HK(0); SBAR(); } while (0)
    f32x16 pA0, pA1, pB0, pB1; float mnA, mnB, alA, alB; bf16x8 pa0, pa1, pa2, pa3;
    SWRITE_HV(0); SBAR();
    if (NT > 1) { SLOAD_H(Kh, Vh, KBASE(1)); }
    SBAR(); qkt<0>(pA0, pA1, K_lds, r32, hi, S.qr);
    mask_bits(pA0, pA1, mwA, hi); partialSM(pA0, pA1, m_reg, mnA, alA);
    if (NT > 1) { VMW(); SWRITE_H(1); }
    __syncthreads();
#define HALF_STEP(PX0, PX1, mnX, alX, PY0, PY1, alY, t, KB, VB, SB, MWX, MWY) do {                                             \
        MWY = MLOAD((t) + 1 < NT ? (t) + 1 : (t));                                                                               \
        SBAR(); qkt<KB>(PX0, PX1, K_lds, r32, hi, S.qr);                                                                      \
        finishSM(PY0, PY1, alY, l_reg, pa0, pa1, pa2, pa3); SBAR();                                                           \
        if ((t) + 1 < NT) { SLOAD_H(Kh, Vh, KBASE((t) + 1)); SBAR(); }                                                        \
        pv_tile<VB>(o, vb0, pa0, pa1, pa2, pa3); mask_bits(PX0, PX1, MWX, hi); partialSM(PX0, PX1, m_reg, mnX, alX);          \
        __syncthreads();                                                                                                      \
        if ((t) + 1 < NT) { VMW(); SWRITE_H(SB); }                                                                            \
        RESC(alX); __syncthreads(); } while (0)
    for (int t = 1; t + 1 < NT; t += 2) {
        HALF_STEP(pB0, pB1, mnB, alB, pA0, pA1, alA, t, 1, 0, 0, mwB, mwA);
        HALF_STEP(pA0, pA1, mnA, alA, pB0, pB1, alB, t + 1, 0, 1, 1, mwA, mwB);
    }
    const bool even = (NT & 1) == 0;
    if (even) { SBAR(); qkt<1>(pB0, pB1, K_lds, r32, hi, S.qr); SBAR(); }
    SLOAD_H(nxt.K, nxt.V, 0); SBAR();
#pragma unroll
    for (int d0 = 0; d0 < 8; ++d0) S.qr[d0] = load8((const bf16*)((const char*)nxt.Q + (unsigned)(((wid * QBLK + r32) * HD + hi * 8) * 2 + d0 * 32)));
    SBAR();
    finishSM(pA0, pA1, alA, l_reg, pa0, pa1, pa2, pa3); SBAR();
    pv_tile<0>(o, vb0, pa0, pa1, pa2, pa3);
    if (even) { mask_bits(pB0, pB1, mwB, hi); partialSM(pB0, pB1, m_reg, mnB, alB); __syncthreads(); RESC(alB);
        finishSM(pB0, pB1, alB, l_reg, pa0, pa1, pa2, pa3); SBAR(); pv_tile<1>(o, vb0, pa0, pa1, pa2, pa3); }
    SBAR(); SEAM_K0();
    if (hi == 0) li_l[r32] = l_reg; asm volatile("s_waitcnt lgkmcnt(0)" ::: "memory");
    float rli[16];
#pragma unroll
    for (int r = 0; r < 16; ++r) rli[r] = __builtin_amdgcn_rcpf(li_l[crow(r, hi)]);
    char* Owb = (char*)(cur.O + (size_t)(wid * QBLK) * OSTR);
    int hi_e = hi, r32_e = r32; asm volatile("" : "+v"(hi_e), "+v"(r32_e));
    const unsigned lane_off = (unsigned)(4 * hi_e * OSTR + r32_e) * 2u;
#pragma unroll
    for (int r = 0; r < 16; ++r) { constexpr int dummy = 0; (void)dummy; const unsigned rowb = (unsigned)(((r & 3) + 8 * (r >> 2)) * OSTR * 2);
#pragma unroll
        for (int d0 = 0; d0 < 4; ++d0) { const float v = o[d0][r] * rli[r];
            const float vn = __shfl_xor(v, 1);
            if ((r32 & 1) == 0) *(unsigned*)(Owb + rowb + d0 * 64 + lane_off) = cvtpk(v, vn); } }
    __syncthreads();
#undef RESC
#undef KBASE
#undef SEAM_K0
#undef HALF_STEP
#undef MLOAD
}
#undef ROW
#undef VMW
#undef VMWN
#undef SLOAD_H
#undef SWRITE_HK
#undef SWRITE_HV
#undef SWRITE_H
#undef KSWZ
#undef SBAR
}

constexpr int NWAVES = 8;
#ifndef MK_PER_PHASE
#define MK_PER_PHASE 0
#endif
constexpr int N_PHASES = 13;

constexpr int DM = 2048, SEQ = 8192, NBATCH = 2, NMETA = 16, DFF = 5632;
constexpr int R = NBATCH * SEQ;
constexpr int RP = 16640;
constexpr int TKV = 8256;
constexpr int NPROJ = 7424;
constexpr int NGU = 2 * DFF;
constexpr float EPS = 1e-6f;

constexpr size_t MiB = 1u << 20;
constexpr size_t WS_CTL = 0, CTL_ZERO_BYTES = 1 * MiB;
constexpr size_t WS_AB = 1 * MiB;
constexpr size_t WS_WB = 66 * MiB;
constexpr size_t WS_WGU = WS_WB, WS_WD = WS_WB + 44 * MiB, WS_WIN = WS_WB, WS_WOUT = WS_WB + 29 * MiB, WS_MASK = WS_WB + 40 * MiB;
constexpr size_t WS_SMALL = 132 * MiB;
constexpr size_t WS_RSTD1 = WS_SMALL, WS_RSTD2 = WS_SMALL + 128 * 1024, WS_RSTD3 = WS_SMALL + 256 * 1024, WS_DEC = WS_SMALL + 384 * 1024;
constexpr size_t WS_ACT = 133 * MiB;
constexpr size_t WS_F = 312 * MiB;
constexpr size_t WS_MIXA = 133 * MiB;
constexpr size_t WS_QH = 197 * MiB;
constexpr size_t WS_KH = 229 * MiB, WS_VH = 262 * MiB;
constexpr size_t WS_IQ = 295 * MiB;
constexpr size_t WS_GQ = 327 * MiB, WS_GK = 344 * MiB;
constexpr size_t WS_GV = 361 * MiB;
constexpr size_t WS_GO = 394 * MiB;
constexpr size_t WS_IK = 426 * MiB;
constexpr size_t WS_IW = 429 * MiB;
constexpr size_t WS_GLOW = 430 * MiB;
constexpr size_t WS_ST = 432 * MiB;
constexpr size_t WS_END = 496 * MiB;
constexpr int CW_BAR = 4096;

constexpr int SCR_BYTES = 147456;
constexpr int MISC_OFF = SCR_BYTES;
constexpr int LDS_BYTES = SCR_BYTES + 2048;

#define GAS __attribute__((address_space(1)))
#define LAS __attribute__((address_space(3)))
typedef unsigned short bf16;
typedef unsigned v4u __attribute__((ext_vector_type(4)));
typedef unsigned v2u __attribute__((ext_vector_type(2)));
typedef float f32x4 __attribute__((ext_vector_type(4)));
typedef float f32x16 __attribute__((ext_vector_type(16)));
typedef short bf16x8 __attribute__((ext_vector_type(8)));
typedef unsigned long long u64;
typedef GAS unsigned gu32;
#define RLX_AGENT __ATOMIC_RELAXED, __HIP_MEMORY_SCOPE_AGENT
#define LDS_WAIT() asm volatile("s_waitcnt lgkmcnt(0)" ::: "memory")
#define VM_WAIT() asm volatile("s_waitcnt vmcnt(0)" ::: "memory")
__device__ __forceinline__ unsigned f2bf(float f) { unsigned u = __builtin_bit_cast(unsigned, f); return (u + 0x7fffu + ((u >> 16) & 1u)) >> 16; }
__device__ __forceinline__ unsigned pk2(float lo, float hi) { return f2bf(lo) | (f2bf(hi) << 16); }
__device__ __forceinline__ float bf2f(unsigned short b) { return __builtin_bit_cast(float, (unsigned)b << 16); }
__device__ __forceinline__ float bflo(unsigned w) { return __builtin_bit_cast(float, w << 16); }
__device__ __forceinline__ float bfhi(unsigned w) { return __builtin_bit_cast(float, w & 0xffff0000u); }
#define XB_TMO      128
#define XB_XCNT(j)  (256  + 64 * (j))
#define XB_XSUB(j)  (1280 + 64 * (j))
#define XB_XGEN(j)  (2304 + 64 * (j))
#define XB_TOP      3328
#define XB_TOPGEN   3392
#define XCD_BAR_WORDS 3456
#define XB_SPIN_CAP (1u << 22)

__device__ __forceinline__ unsigned xb_ld(unsigned* p)              { return __hip_atomic_load(p, __ATOMIC_RELAXED, __HIP_MEMORY_SCOPE_AGENT); }
__device__ __forceinline__ unsigned xb_add(unsigned* p, unsigned v) { return __hip_atomic_fetch_add(p, v, __ATOMIC_RELAXED, __HIP_MEMORY_SCOPE_AGENT); }
__device__ __forceinline__ unsigned xb_xcc_id() { return (unsigned)__builtin_amdgcn_s_getreg((3 << 11) | 20) & 0xFu; }
#define XB_SPIN(cond, bar) do { unsigned _sp = 0; while (cond) { __builtin_amdgcn_s_sleep(1); \
    if ((++_sp & 255u) == 0u) { if (xb_ld(&(bar)[XB_TMO])) break; if (_sp > XB_SPIN_CAP) { atomicAdd(&(bar)[XB_TMO], 1u); break; } } } } while (0)

struct XcdBarrier {
    unsigned* bar; unsigned x;
    volatile LAS unsigned* st;
};

__device__ __forceinline__ XcdBarrier xcd_barrier_post(unsigned* bar, volatile LAS unsigned* st) {
    XcdBarrier b; b.bar = bar; b.x = xb_xcc_id(); b.st = st;
    if (threadIdx.x == 0) (void)xb_add(&bar[XB_XCNT(b.x)], 1u);
    return b;
}
__device__ __forceinline__ void xcd_barrier_complete(unsigned* bar, unsigned x, unsigned& nloc, unsigned& nx) {
    const unsigned G = gridDim.x * gridDim.y * gridDim.z;
    unsigned sum, cnt, mine, sp = 0u;
    for (;;) {
        sum = 0u; cnt = 0u; mine = 0u;
#pragma unroll
        for (unsigned j = 0; j < 16; ++j) { const unsigned c = xb_ld(&bar[XB_XCNT(j)]); sum += c; cnt += (c > 0u) ? 1u : 0u; mine = (j == x) ? c : mine; }
        if (sum == G) break;
        __builtin_amdgcn_s_sleep(1);
        if ((++sp & 255u) == 0u) { if (xb_ld(&bar[XB_TMO])) break; if (sp > XB_SPIN_CAP) { atomicAdd(&bar[XB_TMO], 1u); break; } }
    }
    nloc = mine > 0u ? mine : 1u; nx = cnt > 0u ? cnt : 1u;
}

__device__ __forceinline__ void xcd_barrier(const XcdBarrier& b) {
    asm volatile("s_waitcnt vmcnt(0)" ::: "memory");
    __syncthreads();
    if (threadIdx.x == 0) {
        unsigned* bar = b.bar;
        __builtin_amdgcn_s_waitcnt(0);
        unsigned nloc = b.st[0], nx = b.st[1];
        if (nloc == 0u) { xcd_barrier_complete(bar, b.x, nloc, nx); b.st[0] = nloc; b.st[1] = nx; }
        const unsigned old = xb_add(&bar[XB_XSUB(b.x)], 1u);
        const unsigned gen = old / nloc;
        if (old + 1u == (gen + 1u) * nloc) {
            __builtin_amdgcn_fence(__ATOMIC_RELEASE, "agent");
            asm volatile("s_waitcnt vmcnt(0)" ::: "memory");
            const unsigned og = xb_add(&bar[XB_TOP], 1u);
            const unsigned tg = og / nx;
            if (og + 1u == (tg + 1u) * nx) xb_add(&bar[XB_TOPGEN], 1u);
            else XB_SPIN(xb_ld(&bar[XB_TOPGEN]) == tg, bar);
            __builtin_amdgcn_fence(__ATOMIC_ACQUIRE, "agent");
            xb_add(&bar[XB_XGEN(b.x)], 1u);
            asm volatile("s_waitcnt vmcnt(0)" ::: "memory");
        } else {
            XB_SPIN(xb_ld(&bar[XB_XGEN(b.x)]) == gen, bar);
            __builtin_amdgcn_fence(__ATOMIC_ACQUIRE, "agent");
            asm volatile("s_waitcnt vmcnt(0)" ::: "memory");
        }
    }
    __syncthreads();
}

struct Frame {
    LAS unsigned char* lds;
    unsigned char* ldsg;
    volatile LAS unsigned* MISC;
    unsigned* ctl;
    int tid, lane, wave, vcu, G;
    float* out; unsigned char* ws;
};
enum { I_X = 0, I_META, I_G1PRE, I_W1G, I_W1U, I_W1D, I_G1POST, I_GMIX, I_WIN, I_WGATE, I_BGATE, I_GGLA, I_WOUT, I_GMIXPOST, I_G2PRE, I_W2G, I_W2U, I_W2D, I_G2POST };

__device__ __forceinline__ float wave_sum(float v) {
#pragma unroll
    for (int o = 1; o < 64; o <<= 1) v += __shfl_xor(v, o);
    return v;
}
__device__ __forceinline__ unsigned wave_sum_u(unsigned v) {
#pragma unroll
    for (int o = 1; o < 64; o <<= 1) v += (unsigned)__shfl_xor((int)v, o);
    return v;
}

__device__ __forceinline__ void tr_item(const float* W, int N, int K, bf16* WT, int drow0, int scol, const float* gain, LAS float* scr, int k0, int lane) {
#pragma unroll 8
    for (int i = 0; i < 32; ++i) { const int kk = 2 * i + (lane >> 5); float v = 0.f;
        if (scol >= 0) v = W[(size_t)(k0 + kk) * N + scol];
        if (gain) v *= gain[k0 + kk];
        scr[kk * 33 + (lane & 31)] = v; }
    LDS_WAIT(); asm volatile("" ::: "memory");
    const int c = lane & 7;
#pragma unroll
    for (int j = 0; j < 4; ++j) { const int n = (lane >> 3) + 8 * j; const LAS float* s = scr + (8 * c) * 33 + n;
        v4u o; o.x = pk2(s[0 * 33], s[1 * 33]); o.y = pk2(s[2 * 33], s[3 * 33]); o.z = pk2(s[4 * 33], s[5 * 33]); o.w = pk2(s[6 * 33], s[7 * 33]);
        *(GAS v4u*)(WT + (size_t)(drow0 + n) * K + k0 + 8 * c) = o; }
    LDS_WAIT(); asm volatile("" ::: "memory");
}
__device__ __forceinline__ void convert_ffn(Frame& F, const float* Wg, const float* Wu, const float* Wd, const float* gain, bf16* WGU, bf16* WD) {
    LAS float* scr = (LAS float*)(F.lds + F.wave * 16384);
    const int gw = F.vcu * NWAVES + F.wave, NGW = F.G * NWAVES;
    constexpr int I_GU = (NGU / 32) * (DM / 64), I_D = (DM / 32) * (DFF / 64);
    for (int it = gw; it < I_GU + I_D; it += NGW) {
        if (it < I_GU) { const int g = it % (NGU / 32), kb = it / (NGU / 32), tile = g >> 3, w = g & 7;
            tr_item(w < 4 ? Wg : Wu, DFF, DM, WGU, g * 32, tile * 128 + (w & 3) * 32 + (F.lane & 31), gain, scr, kb * 64, F.lane); }
        else { const int r = it - I_GU, g = r % (DM / 32), kb = r / (DM / 32);
            tr_item(Wd, DM, DFF, WD, g * 32, g * 32 + (F.lane & 31), nullptr, scr, kb * 64, F.lane); }
    }
}
__device__ __forceinline__ int win_src_col(int j) {
    const int t = j >> 8, c = j & 255;
    if (t < 16) return j;
    if (t < 18) return 4176 + (j - 4096);
    if (t < 20) return 4688 + (j - 4608);
    if (t < 24) return 5200 + (j - 5120);
    if (t < 28) return 6240 + (j - 6144);
    if (c < 64) return 4096 + c;
    if (c < 80) return 4160 + (c - 64);
    if (c < 96) return 6224 + (c - 80);
    return -1;
}
__device__ __forceinline__ void convert_mix(Frame& F, const float* Win, const float* Wout, const float* gain, bf16* WIN, bf16* WOUT) {
    LAS float* scr = (LAS float*)(F.lds + F.wave * 16384);
    const int gw = F.vcu * NWAVES + F.wave, NGW = F.G * NWAVES;
    constexpr int I_IN = (NPROJ / 32) * (DM / 64), I_OUT = (DM / 32) * (DM / 64);
    for (int it = gw; it < I_IN + I_OUT; it += NGW) {
        if (it < I_IN) { const int g = it % (NPROJ / 32), kb = it / (NPROJ / 32);
            tr_item(Win, 7264, DM, WIN, g * 32, win_src_col(g * 32 + (F.lane & 31)), gain, scr, kb * 64, F.lane); }
        else { const int r = it - I_IN, g = r % (DM / 32), kb = r / (DM / 32);
            tr_item(Wout, DM, DM, WOUT, g * 32, g * 32 + (F.lane & 31), nullptr, scr, kb * 64, F.lane); }
    }
}

__device__ __forceinline__ void p0_rows(Frame& F, const float* X, const float* META) {
    const int gw = F.vcu * NWAVES + F.wave, NGW = F.G * NWAVES;
    bf16* AB = (bf16*)(F.ws + WS_AB); float* rstd = (float*)(F.ws + WS_RSTD1);
    for (int row = gw; row < RP; row += NGW) {
        GAS v2u* o = (GAS v2u*)(AB + (size_t)row * DM) + F.lane;
        if (row < R + NMETA) {
            const float* xr = row < R ? X + (size_t)row * DM : META + (size_t)(row - R) * DM;
            const GAS f32x4* xp = (const GAS f32x4*)xr + F.lane;
            f32x4 v[8]; float ss = 0.f;
#pragma unroll
            for (int j = 0; j < 8; ++j) { v[j] = xp[64 * j]; ss += (v[j].x * v[j].x + v[j].y * v[j].y) + (v[j].z * v[j].z + v[j].w * v[j].w); }
            ss = wave_sum(ss);
#pragma unroll
            for (int j = 0; j < 8; ++j) o[64 * j] = (v2u){pk2(v[j].x, v[j].y), pk2(v[j].z, v[j].w)};
            if (F.lane == 0) rstd[row] = 1.0f / sqrtf(ss * (1.0f / DM) + EPS);
        } else {
#pragma unroll
            for (int j = 0; j < 8; ++j) o[64 * j] = (v2u){0u, 0u};
            if (F.lane == 0) rstd[row] = 0.f;
        }
    }
}
template <int MODE>
__device__ __forceinline__ void norm_rows(Frame& F, const float* g, float* rstd_out, const float* X, const float* META) {
    const int gw = F.vcu * NWAVES + F.wave, NGW = F.G * NWAVES;
    bf16* AB = (bf16*)(F.ws + WS_AB); const bf16* FB = (const bf16*)(F.ws + WS_F);
    const int nrows = (MODE == 0) ? RP : R;
    f32x4 gv[8];
#pragma unroll
    for (int j = 0; j < 8; ++j) gv[j] = ((const GAS f32x4*)g)[64 * j + F.lane];
    for (int row = gw; row < nrows; row += NGW) {
        if (MODE == 0 && row >= R + NMETA) { if (F.lane == 0) rstd_out[row] = 0.f; continue; }
        const GAS v2u* fp = (const GAS v2u*)(FB + (size_t)row * DM) + F.lane;
        GAS v2u* ab = (GAS v2u*)(AB + (size_t)row * DM) + F.lane;
        f32x4 f[8], h[8]; float ss = 0.f;
#pragma unroll
        for (int j = 0; j < 8; ++j) { const v2u w = fp[64 * j]; f[j] = (f32x4){bflo(w.x), bfhi(w.x), bflo(w.y), bfhi(w.y)};
            ss += (f[j].x * f[j].x + f[j].y * f[j].y) + (f[j].z * f[j].z + f[j].w * f[j].w); }
        if (MODE == 0) {
            const float* xr = row < R ? X + (size_t)row * DM : META + (size_t)(row - R) * DM;
            const GAS f32x4* xp = (const GAS f32x4*)xr + F.lane;
#pragma unroll
            for (int j = 0; j < 8; ++j) h[j] = xp[64 * j];
        } else {
#pragma unroll
            for (int j = 0; j < 8; ++j) { const v2u w = ab[64 * j]; h[j] = (f32x4){bflo(w.x), bfhi(w.x), bflo(w.y), bfhi(w.y)}; }
        }
        ss = wave_sum(ss);
        const float rf = (MODE == 1 ? 1.0f : 0.5f) / sqrtf(ss * (1.0f / DM) + EPS);
        float s2 = 0.f;
#pragma unroll
        for (int j = 0; j < 8; ++j) { h[j] = h[j] + f[j] * gv[j] * rf; s2 += (h[j].x * h[j].x + h[j].y * h[j].y) + (h[j].z * h[j].z + h[j].w * h[j].w); }
        if (MODE == 2) {
            GAS f32x4* op = (GAS f32x4*)(F.out + (size_t)row * DM) + F.lane;
#pragma unroll
            for (int j = 0; j < 8; ++j) op[64 * j] = h[j];
        } else {
            s2 = wave_sum(s2);
#pragma unroll
            for (int j = 0; j < 8; ++j) ab[64 * j] = (v2u){pk2(h[j].x, h[j].y), pk2(h[j].z, h[j].w)};
            if (F.lane == 0) rstd_out[row] = 1.0f / sqrtf(s2 * (1.0f / DM) + EPS);
        }
    }
}

__device__ __forceinline__ void zero_pads(Frame& F) {
    const int gt = F.vcu * (NWAVES * 64) + F.tid, NG = F.G * NWAVES * 64;
    bf16* Kh = (bf16*)(F.ws + WS_KH); bf16* Vh = (bf16*)(F.ws + WS_VH); bf16* IK = (bf16*)(F.ws + WS_IK);
    const v4u z = {0u, 0u, 0u, 0u};
    for (int i = gt; i < 2 * 16 * 768 + 2 * 384; i += NG) {
        if (i < 2 * 16 * 768) { const int which = i / (16 * 768), r = i % (16 * 768), bh = r / 768, o = r % 768;
            *(GAS v4u*)((which ? Vh : Kh) + ((size_t)bh * TKV + 8208) * 128 + o * 8) = z; }
        else { const int r = i - 2 * 16 * 768, b = r / 384, o = r % 384; *(GAS v4u*)(IK + ((size_t)b * TKV + 8208) * 64 + o * 8) = z; }
    }
}

__device__ __forceinline__ void p5_item(Frame& F, int b, int t) {
    const int lane = F.lane, wid = F.wave, r32 = lane & 31, hi = lane >> 5;
    const bf16* IQ = (const bf16*)(F.ws + WS_IQ); const bf16* IK = (const bf16*)(F.ws + WS_IK); const float* IW = (const float*)(F.ws + WS_IW);
    u64* MASK = (u64*)(F.ws + WS_MASK);
    LAS unsigned short* S16 = (LAS unsigned short*)F.lds;
    constexpr int SROW = 8320;
    const int s0 = 8 * t, qb = s0 >> 8, nwords = 4 * qb + 5, nd = (nwords + 1) >> 1;
    const int kmax = 16 + s0 + 7, nkt = (kmax >> 5) + 1;
    bf16x8 Af[4][4]; float wv[4][16];
    {
        const int qo = (r32 >> 2) & 1, h = (r32 & 3) + 4 * (r32 >> 3);
#pragma unroll
        for (int rb = 0; rb < 4; ++rb) {
            const bf16* qp = IQ + ((size_t)(b * SEQ + s0 + 2 * rb + qo)) * 1024 + h * 64 + 8 * hi;
#pragma unroll
            for (int ks = 0; ks < 4; ++ks) Af[rb][ks] = *(const bf16x8*)(qp + ks * 16);
            const float* wp = IW + ((size_t)(b * SEQ + s0 + 2 * rb + hi)) * 16;
#pragma unroll
            for (int r4 = 0; r4 < 4; ++r4) { const f32x4 w4 = *(const f32x4*)(wp + 4 * r4); wv[rb][4 * r4 + 0] = w4.x; wv[rb][4 * r4 + 1] = w4.y; wv[rb][4 * r4 + 2] = w4.z; wv[rb][4 * r4 + 3] = w4.w; }
        }
    }
    for (int kt = wid; kt < nkt; kt += 8) {
        const int key = kt * 32 + r32;
        const bf16* kp = IK + ((size_t)b * TKV + key) * 64 + 8 * hi;
        bf16x8 Bf[4];
#pragma unroll
        for (int ks = 0; ks < 4; ++ks) Bf[ks] = *(const bf16x8*)(kp + ks * 16);
#pragma unroll
        for (int rb = 0; rb < 4; ++rb) {
            f32x16 acc = {};
#pragma unroll
            for (int ks = 0; ks < 4; ++ks) acc = __builtin_amdgcn_mfma_f32_32x32x16_bf16(Af[rb][ks], Bf[ks], acc, 0, 0, 0);
            float sc = 0.f;
#pragma unroll
            for (int r = 0; r < 16; ++r) sc = fmaf(fmaxf(acc[r], 0.f), wv[rb][r], sc);
            sc = fminf(fmaxf(sc, -60000.f), 60000.f);
            const _Float16 hf = (_Float16)sc;
            const unsigned hb = (unsigned)__builtin_bit_cast(unsigned short, hf);
            unsigned sk = (hb & 0x8000u) ? (~hb & 0xffffu) : (hb | 0x8000u);
            if (key > 16 + s0 + 2 * rb + hi) sk = 0x03ffu;
            S16[(2 * rb + hi) * SROW + key] = (unsigned short)sk;
        }
    }
    { const int lo = nkt * 32, n = nd * 128 - lo;
      for (int i = F.tid; i < 8 * n; i += NWAVES * 64) { const int q = i / n, k = i - q * n; S16[q * SROW + lo + k] = (unsigned short)0x03ffu; } }
    __syncthreads();
    {
        const LAS unsigned* srow = (const LAS unsigned*)(S16 + wid * SROW);
        unsigned thr = 0u;
        for (int bit = 15; bit >= 0; --bit) {
            const unsigned cand = thr | (1u << bit); unsigned cnt = 0u;
            for (int j = 0; j < nd; ++j) { const unsigned d = srow[j * 64 + lane]; cnt += ((d & 0xffffu) >= cand ? 1u : 0u) + ((d >> 16) >= cand ? 1u : 0u); }
            cnt = wave_sum_u(cnt);
            if (cnt >= 256u) thr = cand;
        }
        if (thr < 0x0400u) thr = 0x0400u;
        unsigned cgt = 0u;
        for (int j = 0; j < nd; ++j) { const unsigned d = srow[j * 64 + lane]; cgt += ((d & 0xffffu) > thr ? 1u : 0u) + ((d >> 16) > thr ? 1u : 0u); }
        cgt = wave_sum_u(cgt);
        const int need = 256 - (int)cgt;
        const LAS unsigned short* s16 = S16 + wid * SROW;
        u64* mout = MASK + ((size_t)(b * SEQ + s0 + wid)) * 129;
        int tie_seen = 0; u64 myword = 0ull;
        for (int jj = 0; jj < nwords; ++jj) {
            const unsigned k = s16[jj * 64 + lane];
            const bool gt = k > thr, eq = k == thr;
            const u64 em = __ballot(eq);
            const int rank = tie_seen + (int)__builtin_amdgcn_mbcnt_hi((unsigned)(em >> 32), __builtin_amdgcn_mbcnt_lo((unsigned)em, 0u));
            const bool sel = gt || (eq && rank < need);
            const u64 w = __ballot(sel);
            tie_seen += __popcll(em);
            if (lane == (jj & 63)) myword = w;
            if ((jj & 63) == 63) mout[(jj & ~63) + lane] = myword;
        }
        const int rem = nwords & 63;
        if (lane < rem) mout[(nwords & ~63) + lane] = myword;
    }
    __syncthreads();
}

template <int KSTEPS>
__device__ __forceinline__ void mma_ll(f32x16& acc, const LAS bf16* A, int sa, const LAS bf16* B, int sb, int r32, int hi) {
#pragma unroll
    for (int ks = 0; ks < KSTEPS; ++ks) {
        const bf16x8 a = *(const LAS bf16x8*)(A + r32 * sa + ks * 16 + 8 * hi), bb = *(const LAS bf16x8*)(B + r32 * sb + ks * 16 + 8 * hi);
        acc = __builtin_amdgcn_mfma_f32_32x32x16_bf16(a, bb, acc, 0, 0, 0);
    }
}
__device__ __forceinline__ float log_sigmoid_f(float z) { return -(fmaxf(-z, 0.f) + logf(1.0f + expf(-fabsf(z)))); }
__device__ __forceinline__ void gla_bcum(Frame& F, LAS float* BC, int b, int h, int n, const float* Wg, const float* bg) {
    const float* GLOW = (const float*)(F.ws + WS_GLOW);
    for (int e = F.tid; e < 8192; e += NWAVES * 64) {
        const int i = e >> 7, k = e & 127, pp = 64 * n + i; float lg = 0.f;
        if (!(n == 0 && i < 48)) {
            const f32x4* gl = (const f32x4*)(GLOW + ((size_t)b * TKV + pp) * 16); float z = bg[h * 128 + k];
#pragma unroll
            for (int r4 = 0; r4 < 4; ++r4) { const f32x4 g4 = gl[r4];
                z = fmaf(g4.x, Wg[(4 * r4 + 0) * 512 + h * 128 + k], z); z = fmaf(g4.y, Wg[(4 * r4 + 1) * 512 + h * 128 + k], z);
                z = fmaf(g4.z, Wg[(4 * r4 + 2) * 512 + h * 128 + k], z); z = fmaf(g4.w, Wg[(4 * r4 + 3) * 512 + h * 128 + k], z); }
            lg = log_sigmoid_f(z) * (1.0f / 16.0f);
        }
        BC[e] = lg;
    }
    __syncthreads();
    if (F.tid < 128) { float a = 0.f; for (int i = 0; i < 64; ++i) { a += BC[i * 128 + F.tid]; BC[i * 128 + F.tid] = a; } }
    __syncthreads();
}
__device__ __forceinline__ void gla_load_vt(Frame& F, LAS bf16* VT, int b, int h, int n) {
    const bf16* GV = (const bf16*)(F.ws + WS_GV);
    const int v0 = 8 * (F.tid & 31);
#pragma unroll
    for (int pass = 0; pass < 4; ++pass) {
        const int i = (F.tid >> 5) + 16 * pass, pp = 64 * n + i;
        v4u raw = {0u, 0u, 0u, 0u};
        if (!(n == 0 && i < 48)) raw = *(const GAS v4u*)(GV + ((size_t)b * TKV + pp) * 1024 + h * 256 + v0);
        VT[(v0 + 0) * 72 + i] = (bf16)(raw.x & 0xffffu); VT[(v0 + 1) * 72 + i] = (bf16)(raw.x >> 16);
        VT[(v0 + 2) * 72 + i] = (bf16)(raw.y & 0xffffu); VT[(v0 + 3) * 72 + i] = (bf16)(raw.y >> 16);
        VT[(v0 + 4) * 72 + i] = (bf16)(raw.z & 0xffffu); VT[(v0 + 5) * 72 + i] = (bf16)(raw.z >> 16);
        VT[(v0 + 6) * 72 + i] = (bf16)(raw.w & 0xffffu); VT[(v0 + 7) * 72 + i] = (bf16)(raw.w >> 16);
    }
}
__device__ __forceinline__ void g1_unit(Frame& F, int b, int h, int n, const float* Wg, const float* bg) {
    const int lane = F.lane, wid = F.wave, r32 = lane & 31, hi = lane >> 5, tid = F.tid;
    LAS float* BC = (LAS float*)F.lds; LAS bf16* KDT = (LAS bf16*)(F.lds + 32768); LAS bf16* VT = (LAS bf16*)(F.lds + 51200);
    const bf16* GK = (const bf16*)(F.ws + WS_GK); bf16* ST = (bf16*)(F.ws + WS_ST); float* DEC = (float*)(F.ws + WS_DEC);
    gla_bcum(F, BC, b, h, n, Wg, bg);
    { const int k0 = 8 * (tid & 15);
#pragma unroll
      for (int pass = 0; pass < 2; ++pass) {
        const int i = (tid >> 4) + 32 * pass, pp = 64 * n + i;
        v4u raw = {0u, 0u, 0u, 0u};
        if (!(n == 0 && i < 48)) raw = *(const GAS v4u*)(GK + ((size_t)b * TKV + pp) * 512 + h * 128 + k0);
        const unsigned rw[4] = {raw.x, raw.y, raw.z, raw.w};
#pragma unroll
        for (int j = 0; j < 8; ++j) { const float kv = (j & 1) ? bfhi(rw[j >> 1]) : bflo(rw[j >> 1]);
            const float d = __expf(BC[63 * 128 + k0 + j] - BC[i * 128 + k0 + j]);
            KDT[(k0 + j) * 72 + i] = (bf16)f2bf(kv * d); }
      } }
    gla_load_vt(F, VT, b, h, n);
    __syncthreads();
    bf16* dst = ST + ((size_t)((b * 4 + h) * 128 + n) * 256) * 128;
#pragma unroll
    for (int cb = 0; cb < 4; ++cb) {
        f32x16 acc = {};
        mma_ll<4>(acc, VT + (32 * wid) * 72, 72, KDT + (32 * cb) * 72, 72, r32, hi);
#pragma unroll
        for (int r = 0; r < 16; ++r) { const int dv = 32 * wid + (r & 3) + 8 * (r >> 2) + 4 * hi; const float v = acc[r], vn = __shfl_xor(v, 1);
            if ((r32 & 1) == 0) *(GAS unsigned*)(dst + (size_t)dv * 128 + 32 * cb + r32) = pk2(v, vn); }
    }
    if (tid < 128) DEC[(size_t)((b * 4 + h) * 128 + n) * 128 + tid] = __expf(BC[63 * 128 + tid]);
    __syncthreads();
}
__device__ __forceinline__ void g2_scan(Frame& F) {
    bf16* ST = (bf16*)(F.ws + WS_ST); const float* DEC = (const float*)(F.ws + WS_DEC);
    const int NG = F.G * NWAVES * 64;
    for (int e = F.vcu * (NWAVES * 64) + F.tid; e < 8 * 16384; e += NG) {
        const int bh = e >> 14, rem = e & 16383, v = rem >> 6, k = (rem & 63) * 2;
        GAS unsigned* p = (GAS unsigned*)(ST + ((size_t)bh * 128 * 256 + v) * 128 + k);
        const float* d = DEC + (size_t)bh * 128 * 128 + k;
        float s0 = 0.f, s1 = 0.f;
        for (int n = 0; n < 128; n += 8) {
            unsigned w[8]; float d0[8], d1[8];
#pragma unroll
            for (int u = 0; u < 8; ++u) { w[u] = p[(size_t)(n + u) * 16384]; d0[u] = d[(n + u) * 128]; d1[u] = d[(n + u) * 128 + 1]; }
#pragma unroll
            for (int u = 0; u < 8; ++u) { s0 = fmaf(s0, d0[u], bflo(w[u])); s1 = fmaf(s1, d1[u], bfhi(w[u])); p[(size_t)(n + u) * 16384] = pk2(s0, s1); }
        }
    }
}
__device__ __forceinline__ void g3_unit(Frame& F, int b, int h, int c, const float* Wg, const float* bg, const float* ggla) {
    const int lane = F.lane, wid = F.wave, r32 = lane & 31, hi = lane >> 5, tid = F.tid;
    LAS float* BC = (LAS float*)F.lds; LAS bf16* Q1 = (LAS bf16*)(F.lds + 32768); LAS bf16* Q2 = (LAS bf16*)(F.lds + 50176); LAS bf16* KD = (LAS bf16*)(F.lds + 67584);
    LAS bf16* VT = (LAS bf16*)(F.lds + 84992); LAS bf16* AT = (LAS bf16*)(F.lds + 121856); LAS float* OS = (LAS float*)F.lds;
    const bf16* GQ = (const bf16*)(F.ws + WS_GQ); const bf16* GK = (const bf16*)(F.ws + WS_GK); const bf16* GO = (const bf16*)(F.ws + WS_GO);
    const bf16* ST = (const bf16*)(F.ws + WS_ST); bf16* MIXA = (bf16*)(F.ws + WS_MIXA);
    gla_bcum(F, BC, b, h, c, Wg, bg);
    { const int k0 = 8 * (tid & 15);
#pragma unroll
      for (int pass = 0; pass < 2; ++pass) {
        const int i = (tid >> 4) + 32 * pass, pp = 64 * c + i;
        const v4u rq = *(const GAS v4u*)(GQ + ((size_t)b * TKV + pp) * 512 + h * 128 + k0);
        const v4u rk = *(const GAS v4u*)(GK + ((size_t)b * TKV + pp) * 512 + h * 128 + k0);
        const unsigned qw[4] = {rq.x, rq.y, rq.z, rq.w}, kw[4] = {rk.x, rk.y, rk.z, rk.w};
        float q1[8], q2[8], kd[8];
#pragma unroll
        for (int j = 0; j < 8; ++j) { const float qv = (j & 1) ? bfhi(qw[j >> 1]) : bflo(qw[j >> 1]), kv = (j & 1) ? bfhi(kw[j >> 1]) : bflo(kw[j >> 1]);
            const float bc = BC[i * 128 + k0 + j], bl = BC[63 * 128 + k0 + j];
            q1[j] = qv * __expf(bc); q2[j] = qv * __expf(bc - bl); kd[j] = kv * __expf(bl - bc); }
        *(LAS v4u*)(Q1 + i * 136 + k0) = (v4u){pk2(q1[0], q1[1]), pk2(q1[2], q1[3]), pk2(q1[4], q1[5]), pk2(q1[6], q1[7])};
        *(LAS v4u*)(Q2 + i * 136 + k0) = (v4u){pk2(q2[0], q2[1]), pk2(q2[2], q2[3]), pk2(q2[4], q2[5]), pk2(q2[6], q2[7])};
        *(LAS v4u*)(KD + i * 136 + k0) = (v4u){pk2(kd[0], kd[1]), pk2(kd[2], kd[3]), pk2(kd[4], kd[5]), pk2(kd[6], kd[7])};
      } }
    gla_load_vt(F, VT, b, h, c);
    __syncthreads();
    const int rbI = wid & 1, cbV = (wid >> 1) * 2;
    f32x16 acc[2] = {};
    {
        const bf16* sp = ST + ((size_t)((b * 4 + h) * 128 + (c - 1)) * 256) * 128;
#pragma unroll
        for (int ks = 0; ks < 8; ++ks) {
            const bf16x8 a = *(const LAS bf16x8*)(Q1 + (32 * rbI + r32) * 136 + ks * 16 + 8 * hi);
#pragma unroll
            for (int t = 0; t < 2; ++t) { const bf16x8 bb = *(const bf16x8*)(sp + (size_t)(32 * (cbV + t) + r32) * 128 + ks * 16 + 8 * hi);
                acc[t] = __builtin_amdgcn_mfma_f32_32x32x16_bf16(a, bb, acc[t], 0, 0, 0); }
        }
    }
    if (wid < 4) {
        const int ib = wid & 1, jb = wid >> 1;
        f32x16 at = {};
        mma_ll<8>(at, Q2 + (32 * ib) * 136, 136, KD + (32 * jb) * 136, 136, r32, hi);
#pragma unroll
        for (int r = 0; r < 16; ++r) { const int i = 32 * ib + (r & 3) + 8 * (r >> 2) + 4 * hi, j = 32 * jb + r32;
            AT[i * 72 + j] = (bf16)f2bf(j <= i ? at[r] : 0.f); }
    }
    __syncthreads();
#pragma unroll
    for (int t = 0; t < 2; ++t) mma_ll<4>(acc[t], AT + (32 * rbI) * 72, 72, VT + (32 * (cbV + t)) * 72, 72, r32, hi);
    __syncthreads();
#pragma unroll
    for (int t = 0; t < 2; ++t)
#pragma unroll
        for (int r = 0; r < 16; ++r) OS[(32 * rbI + (r & 3) + 8 * (r >> 2) + 4 * hi) * 260 + 32 * (cbV + t) + r32] = acc[t][r];
    __syncthreads();
    {
        const int i = tid >> 3, seg = tid & 7; const LAS float* orow = OS + i * 260 + 32 * seg;
        float ss = 0.f; f32x4 ov[8];
#pragma unroll
        for (int q = 0; q < 8; ++q) { ov[q] = *(const LAS f32x4*)(orow + 4 * q); ss += (ov[q].x * ov[q].x + ov[q].y * ov[q].y) + (ov[q].z * ov[q].z + ov[q].w * ov[q].w); }
        ss += __shfl_xor(ss, 1); ss += __shfl_xor(ss, 2); ss += __shfl_xor(ss, 4);
        const float rs = 1.0f / sqrtf(ss * (1.0f / 256.0f) + EPS);
        const size_t row = (size_t)b * SEQ + 64 * (c - 1) + i;
        const float* gn = ggla + 32 * seg;
        const bf16* gp = GO + row * 1024 + h * 256 + 32 * seg;
        bf16* op = MIXA + row * 2048 + 1024 + h * 256 + 32 * seg;
#pragma unroll
        for (int q2 = 0; q2 < 4; ++q2) {
            const v4u gw = *(const GAS v4u*)(gp + 8 * q2);
            const f32x4 g0 = *(const f32x4*)(gn + 8 * q2), g1 = *(const f32x4*)(gn + 8 * q2 + 4);
            const f32x4 a = ov[2 * q2], bq = ov[2 * q2 + 1];
            float y[8];
            y[0] = a.x * rs * g0.x * pg8::silu_f(bflo(gw.x)); y[1] = a.y * rs * g0.y * pg8::silu_f(bfhi(gw.x));
            y[2] = a.z * rs * g0.z * pg8::silu_f(bflo(gw.y)); y[3] = a.w * rs * g0.w * pg8::silu_f(bfhi(gw.y));
            y[4] = bq.x * rs * g1.x * pg8::silu_f(bflo(gw.z)); y[5] = bq.y * rs * g1.y * pg8::silu_f(bfhi(gw.z));
            y[6] = bq.z * rs * g1.z * pg8::silu_f(bflo(gw.w)); y[7] = bq.w * rs * g1.w * pg8::silu_f(bfhi(gw.w));
            *(GAS v4u*)(op + 8 * q2) = (v4u){pk2(y[0], y[1]), pk2(y[2], y[3]), pk2(y[4], y[5]), pk2(y[6], y[7])};
        }
    }
    __syncthreads();
}

__device__ __forceinline__ att::BlockRef att_ref(Frame& F, int bh, int qb) {
    const int b = bh >> 3, h = bh & 7; att::BlockRef r;
    r.Q = (const bf16*)(F.ws + WS_QH) + ((size_t)bh * SEQ + (size_t)qb * 256) * 128;
    r.K = (const bf16*)(F.ws + WS_KH) + (size_t)bh * TKV * 128; r.V = (const bf16*)(F.ws + WS_VH) + (size_t)bh * TKV * 128;
    r.O = (bf16*)(F.ws + WS_MIXA) + ((size_t)b * SEQ + (size_t)qb * 256) * 2048 + h * 128;
    r.M = (const u64*)(F.ws + WS_MASK) + ((size_t)b * SEQ + (size_t)qb * 256) * 129;
    r.NT = 4 * qb + 5;
    return r;
}
__device__ __forceinline__ void p7_attention(Frame& F) {
    constexpr int total = 256;
    int L = F.vcu; if (L >= total) return;
    int pass = 0;
    att::BlockRef cur = att_ref(F, L >> 4, L & 15);
    att::Seam S;
    att::att_prime(cur, (char*)F.ldsg, S);
    for (;;) {
        const bool more_pass = pass == 0, more_item = L + F.G < total, last = !more_pass && !more_item;
        int passn = pass + 1, Ln = L;
        if (!more_pass) { passn = 0; Ln = more_item ? L + F.G : L; }
        const att::BlockRef nxt = last ? cur : att_ref(F, Ln >> 4, passn ? 31 - (Ln & 15) : (Ln & 15));
        att::att_block(cur, nxt, (char*)F.ldsg, S);
        if (last) break;
        cur = nxt; pass = passn; L = Ln;
    }
}

struct Args { const float* in[19]; float* out; unsigned char* ws; int ph_lo, ph_hi; };
#ifndef PG8_SP2
#define PG8_SP2 true
#endif
#ifndef PG8_ALIGN
#define PG8_ALIGN true
#endif
__global__ void __launch_bounds__(NWAVES * 64, 2) hymba_fwd(Args args) {
    extern __shared__ __attribute__((aligned(16))) unsigned char lds[];
    Frame F;
    F.lds = (LAS unsigned char*)lds; F.ldsg = lds;
    F.MISC = (volatile LAS unsigned*)(F.lds + MISC_OFF);
    F.tid = threadIdx.x; F.lane = F.tid & 63; F.wave = __builtin_amdgcn_readfirstlane(F.tid >> 6);
    F.G = gridDim.x; { const int bx = blockIdx.x; F.vcu = (F.G % 8 == 0) ? (bx % 8) * (F.G / 8) + bx / 8 : bx; }
    F.ws = args.ws; F.ctl = (unsigned*)(args.ws + WS_CTL); F.out = args.out;
    for (int u = F.tid; u < (LDS_BYTES - MISC_OFF) / 4; u += NWAVES * 64) ((LAS unsigned*)(F.lds + MISC_OFF))[u] = 0u;
    __syncthreads();
    XcdBarrier bar; bar.bar = F.ctl + CW_BAR; bar.x = 0; bar.st = nullptr;
    if (!MK_PER_PHASE) bar = xcd_barrier_post(F.ctl + CW_BAR, F.MISC + 8);
    const int lo = args.ph_lo, hi = args.ph_hi;
#ifndef PH_MASK
#define PH_MASK 0x1fff
#endif
#define IN(k) ((((PH_MASK) >> (k)) & 1) && lo <= (k) && (k) < hi)
#define SEAM(k) do { if (!MK_PER_PHASE && IN((k) + 1)) xcd_barrier(bar); } while (0)
    bf16* AB = (bf16*)(F.ws + WS_AB); bf16* ACT = (bf16*)(F.ws + WS_ACT); bf16* FB = (bf16*)(F.ws + WS_F);
    bf16* WGU = (bf16*)(F.ws + WS_WGU); bf16* WD = (bf16*)(F.ws + WS_WD); bf16* WIN = (bf16*)(F.ws + WS_WIN); bf16* WOUT = (bf16*)(F.ws + WS_WOUT);
    float* rstd1 = (float*)(F.ws + WS_RSTD1); float* rstd2 = (float*)(F.ws + WS_RSTD2); float* rstd3 = (float*)(F.ws + WS_RSTD3);

    if (IN(0)) { convert_ffn(F, args.in[I_W1G], args.in[I_W1U], args.in[I_W1D], args.in[I_G1PRE], WGU, WD); p0_rows(F, args.in[I_X], args.in[I_META]); SEAM(0); }
    if (IN(1)) {
        pg8::Gemm g{AB, WGU, RP, NGU, DM}; pg8::StaticOrder S; S.init(RP, NGU, F.G, (int)blockIdx.x);
        pg8::EpiSwiGLU E{ACT, DFF, rstd1};
        pg8::gemm_phase<pg8::EpiSwiGLU, pg8::StaticOrder, PG8_ALIGN, PG8_SP2>(F.lds, g, S, E);
        SEAM(1);
    }
    if (IN(2)) {
        pg8::Gemm g{ACT, WD, RP, DM, DFF}; pg8::StaticOrder S; S.init(RP, DM, F.G, (int)blockIdx.x);
        pg8::EpiStoreBf16 E{FB, DM};
        pg8::gemm_phase<pg8::EpiStoreBf16, pg8::StaticOrder, PG8_ALIGN, PG8_SP2>(F.lds, g, S, E);
        SEAM(2);
    }
    if (IN(3)) { norm_rows<0>(F, args.in[I_G1POST], rstd2, args.in[I_X], args.in[I_META]); convert_mix(F, args.in[I_WIN], args.in[I_WOUT], args.in[I_GMIX], WIN, WOUT); SEAM(3); }
    if (IN(4)) {
        zero_pads(F);
        pg8::Gemm g{AB, WIN, RP, NPROJ, DM}; pg8::StaticOrder S; S.init(RP, NPROJ, F.G, (int)blockIdx.x);
        pg8::EpiProj E{rstd2, (bf16*)(F.ws + WS_QH), (bf16*)(F.ws + WS_KH), (bf16*)(F.ws + WS_VH), (bf16*)(F.ws + WS_IQ), (bf16*)(F.ws + WS_GQ), (bf16*)(F.ws + WS_GK),
                       (bf16*)(F.ws + WS_GV), (bf16*)(F.ws + WS_GO), (bf16*)(F.ws + WS_IK), (float*)(F.ws + WS_IW), (float*)(F.ws + WS_GLOW)};
        pg8::gemm_phase<pg8::EpiProj, pg8::StaticOrder, PG8_ALIGN, PG8_SP2>(F.lds, g, S, E);
        SEAM(4);
    }
    if (IN(5)) {
        for (int v = F.vcu; v < 256; v += F.G)
            for (int bq = 0; bq < 8; ++bq) { const int b = bq >> 2, q = bq & 3; const int t = q == 0 ? v : (q == 1 ? 511 - v : (q == 2 ? 512 + v : 1023 - v)); p5_item(F, b, t); }
        for (int u = F.vcu; u < 1024; u += F.G) g1_unit(F, u >> 9, (u >> 7) & 3, u & 127, args.in[I_WGATE], args.in[I_BGATE]);
        SEAM(5);
    }
    if (IN(6)) { g2_scan(F); SEAM(6); }
    if (IN(7)) {
#ifndef SKIP_ATT
        p7_attention(F);
#endif
#ifndef SKIP_G3
        for (int u = F.vcu; u < 1024; u += F.G) g3_unit(F, u >> 9, (u >> 7) & 3, (u & 127) + 1, args.in[I_WGATE], args.in[I_BGATE], args.in[I_GGLA]);
#endif
        SEAM(7);
    }
    if (IN(8)) {
        pg8::Gemm g{(const bf16*)(F.ws + WS_MIXA), WOUT, R, DM, DM}; pg8::StaticOrder S; S.init(R, DM, F.G, (int)blockIdx.x);
        pg8::EpiStoreBf16 E{FB, DM};
        pg8::gemm_phase<pg8::EpiStoreBf16, pg8::StaticOrder, PG8_ALIGN, PG8_SP2>(F.lds, g, S, E);
        SEAM(8);
    }
    if (IN(9)) { norm_rows<1>(F, args.in[I_GMIXPOST], rstd3, nullptr, nullptr); convert_ffn(F, args.in[I_W2G], args.in[I_W2U], args.in[I_W2D], args.in[I_G2PRE], WGU, WD); SEAM(9); }
    if (IN(10)) {
        pg8::Gemm g{AB, WGU, R, NGU, DM}; pg8::StaticOrder S; S.init(R, NGU, F.G, (int)blockIdx.x);
        pg8::EpiSwiGLU E{ACT, DFF, rstd3};
        pg8::gemm_phase<pg8::EpiSwiGLU, pg8::StaticOrder, PG8_ALIGN, PG8_SP2>(F.lds, g, S, E);
        SEAM(10);
    }
    if (IN(11)) {
        pg8::Gemm g{ACT, WD, R, DM, DFF}; pg8::StaticOrder S; S.init(R, DM, F.G, (int)blockIdx.x);
        pg8::EpiStoreBf16 E{FB, DM};
        pg8::gemm_phase<pg8::EpiStoreBf16, pg8::StaticOrder, PG8_ALIGN, PG8_SP2>(F.lds, g, S, E);
        SEAM(11);
    }
    if (IN(12)) { norm_rows<2>(F, args.in[I_G2POST], nullptr, nullptr, nullptr); }
#undef IN
#undef SEAM
}

extern "C" void kernel_launch(void* const* d_in, const int* in_sizes, int n_in, void* d_out, int out_size, void* d_ws, size_t ws_size, hipStream_t stream) {
    static int grid = 0;
    if (grid == 0) {
        if (n_in != 19 || in_sizes[0] != R * DM || out_size != R * DM || ws_size < WS_END) {
            fprintf(stderr, "kernel_launch: unexpected shapes (n_in %d, in0 %d, out %d, ws %zu; need ws >= %zu); nothing launched\n", n_in, n_in > 0 ? in_sizes[0] : -1, out_size, ws_size, (size_t)WS_END); grid = -1; return; }
        int dev = 0, cus = 0, per_cu = 0;
        if (hipGetDevice(&dev) != hipSuccess || hipDeviceGetAttribute(&cus, hipDeviceAttributeMultiprocessorCount, dev) != hipSuccess) { grid = -1; return; }
        if (hipFuncSetAttribute((const void*)hymba_fwd, hipFuncAttributeMaxDynamicSharedMemorySize, LDS_BYTES) != hipSuccess) { fprintf(stderr, "kernel_launch: hipFuncSetAttribute failed\n"); grid = -1; return; }
        if (hipOccupancyMaxActiveBlocksPerMultiprocessor(&per_cu, (const void*)hymba_fwd, NWAVES * 64, LDS_BYTES) != hipSuccess || per_cu < 1)
            fprintf(stderr, "kernel_launch: note: occupancy query reports %d workgroups per CU\n", per_cu);
        (void)hipGetLastError();
        grid = cus;
    }
    if (grid < 0) return;
    if (hipMemsetAsync((char*)d_ws + WS_CTL, 0, CTL_ZERO_BYTES, stream) != hipSuccess) return;
    Args a{};
    for (int i = 0; i < 19; ++i) a.in[i] = (const float*)d_in[i];
    a.out = (float*)d_out; a.ws = (unsigned char*)d_ws;
#if MK_PER_PHASE
    for (int p = 0; p < N_PHASES; ++p) { a.ph_lo = p; a.ph_hi = p + 1; hipLaunchKernelGGL(hymba_fwd, dim3(grid), dim3(NWAVES * 64), LDS_BYTES, stream, a); }
#else
    a.ph_lo = 0; a.ph_hi = N_PHASES;
    hipLaunchKernelGGL(hymba_fwd, dim3(grid), dim3(NWAVES * 64), LDS_BYTES, stream, a);
#endif
    const hipError_t le = hipPeekAtLastError();
    if (le != hipSuccess) fprintf(stderr, "kernel_launch: launch failed: %s\n", hipGetErrorName(le));
}
```

```cpp
#include <hip/hip_runtime.h>
#include <cstdio>
#include <cstdint>
#define MK_PER_PHASE 0
namespace pg8 {
#define PG8_LAS __attribute__((address_space(3)))
typedef unsigned short bf16_t;
typedef short bf16x8 __attribute__((ext_vector_type(8)));
typedef float f32x4 __attribute__((ext_vector_type(4)));
typedef unsigned u32x4 __attribute__((ext_vector_type(4)));
constexpr int BM = 256, BK = 64, HALF = 128, HTB = HALF * BK * 2  , STAGE_BYTES = 8 * HTB, NXCD = 8, WGM = 8;

__host__ __device__ __forceinline__ int lds_byte(int r, int c) { const int st = (r >> 4) * 2 + (c >> 5), rr = r & 15, cc = c & 31, ob = rr * 64 + cc * 2; return st * 1024 + (ob ^ (((ob >> 9) & 1) << 5)); }
__host__ __device__ __forceinline__ void stage_rc(int b, int& R, int& C) { const int st = b / 1024, sb = b % 1024, swz = sb ^ (((sb >> 9) & 1) << 5); R = (st >> 1) * 16 + swz / 64; C = (st & 1) * 32 + (swz % 64) / 2; }
__host__ __device__ __forceinline__ int perm32(int rho) { const int n = rho >> 4, i = rho & 15; return 8 * (i >> 2) + 4 * n + (i & 3); }

struct Unit { int pm, pn; };
struct Gemm { const bf16_t* A; const bf16_t* Bt; int M, N, K; };

struct StaticOrder {
    int nM, nN, nwg, G, c;
    __host__ __device__ void init(int M, int N, int G_, int c_) { nM = M / BM; nN = N / BM; nwg = nM * nN; G = G_; c = c_; }
    __host__ __device__ bool next(int i, Unit& u) const {
        const long L = (long)i * G + c; if (L >= nwg) return false;
        int wgid = (int)L; { const int q = nwg / NXCD, r = nwg % NXCD, xcd = wgid % NXCD, off = wgid / NXCD; wgid = (xcd < r ? xcd * (q + 1) : r * (q + 1) + (xcd - r) * q) + off; }
        const int nig = WGM * nN, gid = wgid / nig, fm = gid * WGM, gsz = (nM - fm) < WGM ? (nM - fm) : WGM;
        u.pm = fm + ((wgid % nig) % gsz); u.pn = (wgid % nig) / gsz; return true;
    }
    __device__ __forceinline__ void a_ready(const Unit&) const {}
    __device__ __forceinline__ void done(const Unit&) const {}
};

__device__ __forceinline__ unsigned cvt_pk_bf16(float lo, float hi) { unsigned r; asm volatile("v_cvt_pk_bf16_f32 %0, %1, %2" : "=v"(r) : "v"(lo), "v"(hi)); return r; }
typedef float f32x2 __attribute__((ext_vector_type(2)));

__device__ __forceinline__ void st8bf(bf16_t* p, const f32x4 v0, const f32x4 v1) {
    u32x4 w; w.x = cvt_pk_bf16(v0[0], v0[1]); w.y = cvt_pk_bf16(v0[2], v0[3]); w.z = cvt_pk_bf16(v1[0], v1[1]); w.w = cvt_pk_bf16(v1[2], v1[3]);
    *(u32x4*)p = w;
}
__device__ __forceinline__ float silu_f(float x) { return x * __builtin_amdgcn_rcpf(1.0f + __builtin_amdgcn_exp2f(-1.4426950408889634f * x)); }

struct EpiStoreBf16 {
    static constexpr bool PERM = true, AFTER_DRAIN = false;
    bf16_t* O; int ldc;
    __device__ __forceinline__ void operator()(const f32x4 (&acc)[2][2][4][2], const Unit& u, int wr, int wc, int fr, int fq) const {
        const int row0 = u.pm * BM + wr * 64 + fr, col0 = u.pn * BM + wc * 32 + 8 * fq;
#pragma unroll
        for (int ai = 0; ai < 2; ++ai)
#pragma unroll
            for (int m = 0; m < 4; ++m) { bf16_t* rowp = O + (size_t)(row0 + ai * HALF + m * 16) * ldc + col0;
#pragma unroll
                for (int bj = 0; bj < 2; ++bj) st8bf(rowp + bj * HALF, acc[ai][bj][m][0], acc[ai][bj][m][1]); }
    }
};
struct EpiSwiGLU {
    static constexpr bool PERM = true, AFTER_DRAIN = false;
    bf16_t* O; int ldc; const float* rstd;
    __device__ __forceinline__ void operator()(const f32x4 (&acc)[2][2][4][2], const Unit& u, int wr, int wc, int fr, int fq) const {
        const int row0 = u.pm * BM + wr * 64 + fr, col0 = u.pn * HALF + wc * 32 + 8 * fq;
#pragma unroll
        for (int ai = 0; ai < 2; ++ai)
#pragma unroll
            for (int m = 0; m < 4; ++m) { const int row = row0 + ai * HALF + m * 16; const float rs = rstd[row];
                f32x4 o0, o1;
#pragma unroll
                for (int j = 0; j < 4; ++j) { o0[j] = silu_f(acc[ai][0][m][0][j] * rs) * (acc[ai][1][m][0][j] * rs); o1[j] = silu_f(acc[ai][0][m][1][j] * rs) * (acc[ai][1][m][1][j] * rs); }
                st8bf(O + (size_t)row * ldc + col0, o0, o1); }
    }
};
struct EpiProj {
    static constexpr bool PERM = true, AFTER_DRAIN = false;
    static constexpr int TKV = 8256;
    unsigned char* ws; size_t o_rstd, o_qh, o_kh, o_vh, o_iq, o_gq, o_gk, o_gv, o_go, o_ik, o_iw, o_glow;
    __device__ __forceinline__ void operator()(const f32x4 (&acc)[2][2][4][2], const Unit& u, int wr, int wc, int fr, int fq) const {
        const float* rstd = (const float*)(ws + o_rstd);
        bf16_t* Qh = (bf16_t*)(ws + o_qh); bf16_t* Kh = (bf16_t*)(ws + o_kh); bf16_t* Vh = (bf16_t*)(ws + o_vh); bf16_t* IQ = (bf16_t*)(ws + o_iq); bf16_t* GQ = (bf16_t*)(ws + o_gq);
        bf16_t* GK = (bf16_t*)(ws + o_gk); bf16_t* GV = (bf16_t*)(ws + o_gv); bf16_t* GO = (bf16_t*)(ws + o_go); bf16_t* IK = (bf16_t*)(ws + o_ik); float* IW = (float*)(ws + o_iw); float* GLOW = (float*)(ws + o_glow);
        const int pn = u.pn;
        const int row0 = u.pm * BM + wr * 64 + fr;
#pragma unroll
        for (int ai = 0; ai < 2; ++ai)
#pragma unroll
            for (int m = 0; m < 4; ++m) {
                const int row = row0 + ai * HALF + m * 16; const float rs = rstd[row];
                const bool mainr = row < 16384, metar = (row >= 16384) && (row < 16400);
                const int b = row >> 13, s = row & 8191, mi = row - 16384;
#pragma unroll
                for (int bj = 0; bj < 2; ++bj) {
                    const int col = bj * HALF + wc * 32 + 8 * fq;
                    f32x4 v0 = acc[ai][bj][m][0] * rs, v1 = acc[ai][bj][m][1] * rs;
                    if (pn < 4) {
                        if (mainr) { const int h = pn * 2 + (col >> 7), d = col & 127; st8bf(Qh + ((size_t)(b * 8 + h) * 8192 + s) * 128 + d, v0, v1); }
                    } else if (pn < 12) {
                        bf16_t* base = pn < 8 ? Kh : Vh; const int h = (pn & 3) * 2 + (col >> 7), d = col & 127;
                        if (mainr) st8bf(base + ((size_t)(b * 8 + h) * TKV + 16 + s) * 128 + d, v0, v1);
                        else if (metar) { st8bf(base + ((size_t)h * TKV + mi) * 128 + d, v0, v1); st8bf(base + ((size_t)(8 + h) * TKV + mi) * 128 + d, v0, v1); }
                    } else if (pn < 16) {
                        if (mainr) st8bf(IQ + (size_t)row * 1024 + (pn - 12) * 256 + col, v0 * 0.125f, v1 * 0.125f);
                    } else if (pn < 18) {
                        if (mainr) st8bf(GQ + ((size_t)b * TKV + 64 + s) * 512 + (pn - 16) * 256 + col, v0 * 0.08838834764831845f, v1 * 0.08838834764831845f);
                    } else if (pn < 20) {
                        const int c = (pn - 18) * 256 + col;
                        if (mainr) st8bf(GK + ((size_t)b * TKV + 64 + s) * 512 + c, v0, v1);
                        else if (metar) { st8bf(GK + ((size_t)48 + mi) * 512 + c, v0, v1); st8bf(GK + ((size_t)TKV + 48 + mi) * 512 + c, v0, v1); }
                    } else if (pn < 24) {
                        const int c = (pn - 20) * 256 + col;
                        if (mainr) st8bf(GV + ((size_t)b * TKV + 64 + s) * 1024 + c, v0, v1);
                        else if (metar) { st8bf(GV + ((size_t)48 + mi) * 1024 + c, v0, v1); st8bf(GV + ((size_t)TKV + 48 + mi) * 1024 + c, v0, v1); }
                    } else if (pn < 28) {
                        if (mainr) st8bf(GO + (size_t)row * 1024 + (pn - 24) * 256 + col, v0, v1);
                    } else {
                        if (col < 64) {
                            if (mainr) st8bf(IK + ((size_t)b * TKV + 16 + s) * 64 + col, v0, v1);
                            else if (metar) { st8bf(IK + ((size_t)mi) * 64 + col, v0, v1); st8bf(IK + ((size_t)TKV + mi) * 64 + col, v0, v1); }
                        } else if (col < 80) {
                            if (mainr) { float* p = IW + (size_t)row * 16 + (col - 64); *(f32x4*)p = v0 * 0.25f; *(f32x4*)(p + 4) = v1 * 0.25f; }
                        } else if (col < 96) {
                            const int c = col - 80;
                            if (mainr) { float* p = GLOW + ((size_t)b * TKV + 64 + s) * 16 + c; *(f32x4*)p = v0; *(f32x4*)(p + 4) = v1; }
                            else if (metar) { float* p = GLOW + ((size_t)48 + mi) * 16 + c; *(f32x4*)p = v0; *(f32x4*)(p + 4) = v1;
                                              float* p2 = GLOW + ((size_t)TKV + 48 + mi) * 16 + c; *(f32x4*)p2 = v0; *(f32x4*)(p2 + 4) = v1; }
                        }
                    }
                }
            }
    }
};
template <class Epi, class Sched, bool ALIGN_EPI = false, bool SP2 = false>
__device__ __forceinline__ void gemm_phase(PG8_LAS unsigned char* lds, const Gemm g, const Sched& S, const Epi& E) {
    const int tid = threadIdx.x, wid = __builtin_amdgcn_readfirstlane(tid >> 6), lane = tid & 63, wr = wid >> 2, wc = wid & 3, fr = lane & 15, fq = lane >> 4;
    const int K = g.K, nt = K / BK;
    unsigned voffA[2], voffB[2];
#pragma unroll
    for (int i = 0; i < 2; ++i) { int R, C; stage_rc(tid * 16 + i * 8192, R, C); const int Rb = Epi::PERM ? ((R & ~31) + perm32(R & 31)) : R;
        voffA[i] = (unsigned)(R * K + C) * 2u; voffB[i] = (unsigned)(Rb * K + C) * 2u; }
    const size_t kstep = (size_t)(BK * 2);
    const size_t hstep = (size_t)HALF * K * 2;
    const size_t tstep = 2 * hstep;
    const unsigned ldsw = (unsigned)wid * 1024u;
    const int aoff = lds_byte(wr * 64 + fr, fq * 8), boff = lds_byte(wc * 32 + fr, fq * 8);
#define PG8_SA(b, h) (((b) * 2 + (h)) * HTB)
#define PG8_SB(b, h) ((4 + (b) * 2 + (h)) * HTB)
#define PG8_STAGE(bufoff, gbase, voff) do { _Pragma("unroll") for (int _i = 0; _i < 2; ++_i) \
        __builtin_amdgcn_global_load_lds((const unsigned*)((const char*)(gbase) + (voff)[_i]), (PG8_LAS unsigned*)(lds + (bufoff) + ldsw + _i * 8192), 16, 0, 0); } while (0)
#define PG8_LDA(dst, b, h) do { _Pragma("unroll") for (int m = 0; m < 4; ++m) _Pragma("unroll") for (int k = 0; k < 2; ++k) dst[m][k] = *(const PG8_LAS bf16x8*)(lds + PG8_SA(b, h) + aoff + m * 2048 + k * 1024); } while (0)
#define PG8_LDB(dst, b, h) do { _Pragma("unroll") for (int n = 0; n < 2; ++n) _Pragma("unroll") for (int k = 0; k < 2; ++k) dst[n][k] = *(const PG8_LAS bf16x8*)(lds + PG8_SB(b, h) + boff + n * 2048 + k * 1024); } while (0)
#define PG8_MMA(ai, bj, At, Bt) do { __builtin_amdgcn_s_setprio(1); _Pragma("unroll") for (int m = 0; m < 4; ++m) _Pragma("unroll") for (int n = 0; n < 2; ++n) _Pragma("unroll") for (int k = 0; k < 2; ++k) \
        acc[ai][bj][m][n] = __builtin_amdgcn_mfma_f32_16x16x32_bf16(Bt[n][k], At[m][k], acc[ai][bj][m][n], 0, 0, 0); __builtin_amdgcn_s_setprio(0); } while (0)
#define PG8_WAIT_V(n) asm volatile("s_waitcnt vmcnt(" #n ")" ::: "memory")
#define PG8_WAIT_L(n) asm volatile("s_waitcnt lgkmcnt(" #n ")" ::: "memory")
#define PG8_BAR __builtin_amdgcn_s_barrier()
#define PG8_SCHED __builtin_amdgcn_sched_barrier(0)
    Unit cur, nxt; int ui = 0;
    if (!S.next(0, cur)) return;
    f32x4 acc[2][2][4][2];
#pragma unroll
    for (int a = 0; a < 2; ++a)
#pragma unroll
        for (int b = 0; b < 2; ++b)
#pragma unroll
            for (int m = 0; m < 4; ++m)
#pragma unroll
                for (int n = 0; n < 2; ++n) acc[a][b][m][n] = (f32x4){0.f, 0.f, 0.f, 0.f};
    bf16x8 At[4][2], B0[2][2], B1[2][2];
    const char* cA = (const char*)g.A + (size_t)cur.pm * tstep; const char* cB = (const char*)g.Bt + (size_t)cur.pn * tstep;
    S.a_ready(cur);
    if constexpr (SP2) {
        PG8_STAGE(PG8_SB(0, 0), cB, voffB); PG8_STAGE(PG8_SB(0, 1), cB + hstep, voffB); PG8_STAGE(PG8_SA(0, 0), cA, voffA); PG8_STAGE(PG8_SA(0, 1), cA + hstep, voffA);
        if (wr == 1) PG8_BAR;
        PG8_WAIT_V(2); PG8_BAR;
        PG8_STAGE(PG8_SB(1, 0), cB + kstep, voffB); PG8_STAGE(PG8_SA(1, 0), cA + kstep, voffA); PG8_STAGE(PG8_SB(1, 1), cB + hstep + kstep, voffB);
        PG8_WAIT_V(6); PG8_BAR;
    } else {
        PG8_STAGE(PG8_SB(0, 0), cB, voffB); PG8_STAGE(PG8_SA(0, 0), cA, voffA); PG8_STAGE(PG8_SB(0, 1), cB + hstep, voffB); PG8_STAGE(PG8_SA(0, 1), cA + hstep, voffA);
        if (wr == 1) PG8_BAR;
        PG8_WAIT_V(4); PG8_BAR;
        PG8_STAGE(PG8_SB(1, 0), cB + kstep, voffB); PG8_STAGE(PG8_SA(1, 0), cA + kstep, voffA); PG8_STAGE(PG8_SB(1, 1), cB + hstep + kstep, voffB);
        PG8_WAIT_V(6); PG8_BAR;
    }
    for (;;) {
        const bool has_next = S.next(ui + 1, nxt);
        const char* nA = has_next ? (const char*)g.A + (size_t)nxt.pm * tstep : cA; const char* nB = has_next ? (const char*)g.Bt + (size_t)nxt.pn * tstep : cB;
        for (int t = 0; t < nt; t += 2) {
            const bool last = (t == nt - 2);
            const char* a1 = cA + (size_t)(t + 1) * kstep;
            const char* a2 = last ? nA : cA + (size_t)(t + 2) * kstep; const char* b2 = last ? nB : cB + (size_t)(t + 2) * kstep;
            const char* a3 = a2 + kstep; const char* b3 = b2 + kstep;
            if (last && has_next) S.a_ready(nxt);
            if constexpr (SP2) {
            PG8_LDB(B0, 0, 0); PG8_LDB(B1, 0, 1); PG8_SCHED; PG8_LDA(At, 0, 0); PG8_STAGE(PG8_SA(1, 1), a1 + hstep, voffA);
            PG8_WAIT_V(8); PG8_WAIT_L(0); PG8_BAR; PG8_MMA(0, 0, At, B0); PG8_MMA(0, 1, At, B1); PG8_BAR; PG8_SCHED;
            PG8_LDA(At, 0, 1); PG8_STAGE(PG8_SB(0, 0), b2, voffB); PG8_STAGE(PG8_SB(0, 1), b2 + hstep, voffB); PG8_STAGE(PG8_SA(0, 0), a2, voffA);
            PG8_WAIT_V(8); PG8_WAIT_L(0); PG8_BAR; PG8_MMA(1, 0, At, B0); PG8_MMA(1, 1, At, B1); PG8_BAR; PG8_SCHED;
            PG8_LDB(B0, 1, 0); PG8_LDB(B1, 1, 1); PG8_SCHED; PG8_LDA(At, 1, 0); PG8_STAGE(PG8_SA(0, 1), a2 + hstep, voffA);
            PG8_WAIT_V(8); PG8_WAIT_L(0); PG8_BAR; PG8_MMA(0, 0, At, B0); PG8_MMA(0, 1, At, B1); PG8_BAR; PG8_SCHED;
            PG8_LDA(At, 1, 1); PG8_STAGE(PG8_SB(1, 0), b3, voffB); PG8_STAGE(PG8_SB(1, 1), b3 + hstep, voffB); PG8_STAGE(PG8_SA(1, 0), a3, voffA);
            PG8_WAIT_V(8); PG8_WAIT_L(0); PG8_BAR; PG8_MMA(1, 0, At, B0); PG8_MMA(1, 1, At, B1); PG8_BAR; PG8_SCHED;
            } else {
            PG8_LDB(B0, 0, 0); PG8_SCHED; PG8_LDA(At, 0, 0); PG8_STAGE(PG8_SA(1, 1), a1 + hstep, voffA);
            PG8_WAIT_L(8); PG8_BAR; PG8_WAIT_L(0); PG8_MMA(0, 0, At, B0); PG8_BAR; PG8_SCHED;
            PG8_LDB(B1, 0, 1); PG8_STAGE(PG8_SB(0, 0), b2, voffB);
            PG8_BAR; PG8_WAIT_L(0); PG8_MMA(0, 1, At, B1); PG8_BAR;
            PG8_LDA(At, 0, 1); PG8_STAGE(PG8_SA(0, 0), a2, voffA);
            PG8_BAR; PG8_WAIT_L(0); PG8_MMA(1, 0, At, B0); PG8_BAR; PG8_SCHED;
            PG8_STAGE(PG8_SB(0, 1), b2 + hstep, voffB);
            PG8_WAIT_V(6); PG8_BAR; PG8_MMA(1, 1, At, B1); PG8_BAR;
            PG8_LDB(B0, 1, 0); PG8_SCHED; PG8_LDA(At, 1, 0); PG8_STAGE(PG8_SA(0, 1), a2 + hstep, voffA);
            PG8_WAIT_L(8); PG8_BAR; PG8_WAIT_L(0); PG8_MMA(0, 0, At, B0); PG8_BAR; PG8_SCHED;
            PG8_LDB(B1, 1, 1); PG8_STAGE(PG8_SB(1, 0), b3, voffB);
            PG8_BAR; PG8_WAIT_L(0); PG8_MMA(0, 1, At, B1); PG8_BAR;
            PG8_LDA(At, 1, 1); PG8_STAGE(PG8_SA(1, 0), a3, voffA);
            PG8_BAR; PG8_WAIT_L(0); PG8_MMA(1, 0, At, B0); PG8_BAR; PG8_SCHED;
            PG8_STAGE(PG8_SB(1, 1), b3 + hstep, voffB);
            PG8_WAIT_V(6); PG8_BAR; PG8_MMA(1, 1, At, B1); PG8_BAR;
            }
        }
        if constexpr (ALIGN_EPI) { if (wr == 0) PG8_BAR; }
        if constexpr (!Epi::AFTER_DRAIN) { E(acc, cur, wr, wc, fr, fq); S.done(cur); }
        if (!has_next) break;
#pragma unroll
        for (int a = 0; a < 2; ++a)
#pragma unroll
            for (int b = 0; b < 2; ++b)
#pragma unroll
                for (int m = 0; m < 4; ++m)
#pragma unroll
                    for (int n = 0; n < 2; ++n) acc[a][b][m][n] = (f32x4){0.f, 0.f, 0.f, 0.f};
        cur = nxt; cA = nA; cB = nB; ++ui;
        if constexpr (ALIGN_EPI) { if (wr == 1) PG8_BAR; }
    }
    PG8_WAIT_V(0);
    if constexpr (!ALIGN_EPI) { if (wr == 0) PG8_BAR; }
    PG8_BAR;
    if constexpr (Epi::AFTER_DRAIN) { E.fused(acc, cur, wr, wc, fr, fq, lds, wid, lane); S.done(cur); }
#undef PG8_SA
#undef PG8_SB
#undef PG8_STAGE
#undef PG8_LDA
#undef PG8_LDB
#undef PG8_MMA
#undef PG8_WAIT_V
#undef PG8_WAIT_L
#undef PG8_BAR
#undef PG8_SCHED
}
}

namespace att {
typedef unsigned short bf16;
typedef short bf16x8 __attribute__((ext_vector_type(8)));
typedef short s16x4 __attribute__((ext_vector_type(4)));
typedef float f32x16 __attribute__((ext_vector_type(16)));
typedef float f32x4 __attribute__((ext_vector_type(4)));
typedef unsigned u32x4 __attribute__((ext_vector_type(4)));
typedef unsigned long long u64;
constexpr int HD = 128, NW = 8, QBLK = 32, KVBLK = 64, QB = NW * QBLK;
constexpr int SHM_V = KVBLK * HD * 2, SHM_K = KVBLK * HD * 2;
constexpr int ATT_LDS_BYTES = 2 * SHM_V + 2 * SHM_K + NW * 64 * 4;
constexpr float SCALE = 0.08838834764831845f;
constexpr float THR = 8.f;
constexpr int OSTR = 2048;
constexpr int MWORDS = 130;

#define KSWZ(row, colB) ((row) * 256 + ((colB) ^ (((row) & 7) << 4)))
#define SBAR() __builtin_amdgcn_sched_barrier(0)
__device__ __forceinline__ int v_st(int k, int c) { const int kk = (k & ~0xC) | ((k & 4) << 1) | ((k & 8) >> 1); return ((kk >> 3) * 4 + (c >> 5)) * 512 + ((kk & 7) * 32 + (c & 31)) * 2; }
__device__ __forceinline__ int v_rd_base(int lane) { return ((lane & 3) << 3) | (((lane >> 2) & 3) << 6) | (((lane >> 4) & 1) << 5) | (((lane >> 5) & 1) << 8); }
constexpr int v_rd_off(int d0, int ks, int half) { return d0 * 512 + ks * 4096 + half * 2048; }
__device__ __forceinline__ int crow(int r, int hi) { return (r & 3) + 8 * (r >> 2) + 4 * hi; }
__device__ __forceinline__ unsigned cvtpk(float lo, float hi) {
    unsigned r; asm volatile("v_cvt_pk_bf16_f32 %0, %1, %2" : "=v"(r) : "v"(lo), "v"(hi)); return r;
}
__device__ __forceinline__ bf16x8 load8(const bf16* p) { return *reinterpret_cast<const bf16x8*>(p); }
__device__ __forceinline__ void mask_bits(f32x16& p0, f32x16& p1, unsigned mw) {
    const float NEG = -__builtin_inff();
#pragma unroll
    for (int r = 0; r < 16; ++r) {
        if (!((mw >> r) & 1u)) p0[r] = NEG;
        if (!((mw >> (16 + r)) & 1u)) p1[r] = NEG;
    }
}
__device__ __forceinline__ void partialSM(f32x16& p0, f32x16& p1, float& m_reg, float& mn, float& alpha) {
    float pmax = p0[0]; for (int r = 1; r < 16; ++r) pmax = fmaxf(pmax, p0[r]); for (int r = 0; r < 16; ++r) pmax = fmaxf(pmax, p1[r]);
    { auto rr = __builtin_amdgcn_permlane32_swap(__float_as_uint(pmax), __float_as_uint(pmax), false, false);
      pmax = fmaxf(__uint_as_float(rr[0]), __uint_as_float(rr[1])); }
    constexpr float C2 = 1.4426950408889634f * SCALE;
    if (__builtin_expect(__all((pmax - m_reg) * SCALE <= THR), 1)) { mn = m_reg; alpha = 1.f; }
    else { mn = fmaxf(m_reg, pmax); alpha = __builtin_amdgcn_exp2f((m_reg - mn) * C2); m_reg = mn; }
    const float mnL = -mn * C2;
    for (int r = 0; r < 16; ++r) p0[r] = fmaf(p0[r], C2, mnL); for (int r = 0; r < 16; ++r) p1[r] = fmaf(p1[r], C2, mnL);
    for (int r = 0; r < 16; ++r) p0[r] = __builtin_amdgcn_exp2f(p0[r]);
}
__device__ __forceinline__ void finishSM(f32x16& p0, f32x16& p1, float alpha, float& l_reg, bf16x8& pa0, bf16x8& pa1, bf16x8& pa2, bf16x8& pa3) {
    for (int r = 0; r < 16; ++r) p1[r] = __builtin_amdgcn_exp2f(p1[r]);
    float ps = 0; for (int r = 0; r < 16; ++r) ps += p0[r]; for (int r = 0; r < 16; ++r) ps += p1[r];
    { auto rr = __builtin_amdgcn_permlane32_swap(__float_as_uint(ps), __float_as_uint(ps), false, false);
      ps = __uint_as_float(rr[0]) + __uint_as_float(rr[1]); }
    l_reg = l_reg * alpha + ps;
#define PK4(P, B_, OUT) do { unsigned a0 = cvtpk(P[B_+0], P[B_+1]), a1 = cvtpk(P[B_+2], P[B_+3]);                          \
        unsigned b0 = cvtpk(P[B_+4], P[B_+5]), b1 = cvtpk(P[B_+6], P[B_+7]);                                             \
        auto r0 = __builtin_amdgcn_permlane32_swap(a0, b0, false, false); auto r1 = __builtin_amdgcn_permlane32_swap(a1, b1, false, false); \
        u32x4 w = {r0[0], r1[0], r0[1], r1[1]}; OUT = *reinterpret_cast<bf16x8*>(&w); } while (0)
    PK4(p0, 0, pa0); PK4(p0, 8, pa1); PK4(p1, 0, pa2); PK4(p1, 8, pa3);
#undef PK4
}
template <int KB>
__device__ __forceinline__ void qkt(f32x16& p0, f32x16& p1, const char* K_lds, int r32, int hi, const bf16x8* qr) {
    p0 = f32x16{}; p1 = f32x16{};
    const char* kb[4];
#pragma unroll
    for (int dd = 0; dd < 4; ++dd) kb[dd] = K_lds + KB * SHM_K + KSWZ(r32, (dd * 16 + hi * 8) * 2);
#pragma unroll
    for (int d0 = 0; d0 < 8; ++d0) { const char* a = kb[d0 & 3] + (d0 >> 2) * 128;
        bf16x8 b0 = *reinterpret_cast<const bf16x8*>(a);
        bf16x8 b1 = *reinterpret_cast<const bf16x8*>(a + 32 * 256);
        p0 = __builtin_amdgcn_mfma_f32_32x32x16_bf16(b0, qr[d0], p0, 0, 0, 0);
        p1 = __builtin_amdgcn_mfma_f32_32x32x16_bf16(b1, qr[d0], p1, 0, 0, 0); }
}
template <int VB>
__device__ __forceinline__ void pv_tile(f32x16* o, int vb0, bf16x8 pa0, bf16x8 pa1, bf16x8 pa2, bf16x8 pa3) {
#define TRRD(dst, off) asm volatile("ds_read_b64_tr_b16 %0, %1 offset:%2" : "=&v"(dst) : "v"(vb0), "i"(off) : "memory")
#define PV_D0(d0) do { s16x4 l0, l1, l2, l3, h0, h1, h2, h3; constexpr int b_ = VB * SHM_V + v_rd_off(d0, 0, 0);     \
        TRRD(l0, b_); TRRD(h0, b_ + 2048); TRRD(l1, b_ + 4096); TRRD(h1, b_ + 6144); TRRD(l2, b_ + 8192); TRRD(h2, b_ + 10240); TRRD(l3, b_ + 12288); TRRD(h3, b_ + 14336); \
        asm volatile("s_waitcnt lgkmcnt(0)" ::: "memory"); SBAR();             \
        o[d0] = __builtin_amdgcn_mfma_f32_32x32x16_bf16(pa0, (bf16x8){l0[0], l0[1], l0[2], l0[3], h0[0], h0[1], h0[2], h0[3]}, o[d0], 0, 0, 0);   \
        o[d0] = __builtin_amdgcn_mfma_f32_32x32x16_bf16(pa1, (bf16x8){l1[0], l1[1], l1[2], l1[3], h1[0], h1[1], h1[2], h1[3]}, o[d0], 0, 0, 0);   \
        o[d0] = __builtin_amdgcn_mfma_f32_32x32x16_bf16(pa2, (bf16x8){l2[0], l2[1], l2[2], l2[3], h2[0], h2[1], h2[2], h2[3]}, o[d0], 0, 0, 0);   \
        o[d0] = __builtin_amdgcn_mfma_f32_32x32x16_bf16(pa3, (bf16x8){l3[0], l3[1], l3[2], l3[3], h3[0], h3[1], h3[2], h3[3]}, o[d0], 0, 0, 0); } while (0)
    PV_D0(0); PV_D0(1); PV_D0(2); PV_D0(3);
#undef PV_D0
#undef TRRD
}

struct BlockRef { const bf16* Q; const bf16* K; const bf16* V; bf16* O; const u64* M; int NT; };
struct Seam { bf16x8 qr[8]; bf16x8 st_v0, st_v1, st_k0, st_k1; };
#define ROW(p, k0, rr) ((const bf16*)((const char*)(p) + (unsigned)((((k0) + (rr)) * HD + sc) * 2)))
#define VMW() asm volatile("s_waitcnt vmcnt(0)" ::: "memory")
#define VMWN(n) asm volatile("s_waitcnt vmcnt(%0)" :: "i"(n) : "memory")
#define SLOAD_H(Kp, Vp, k0) do { S.st_v0 = load8(ROW(Vp, k0, sr)); S.st_v1 = load8(ROW(Vp, k0, 32 + sr));              \
                         S.st_k0 = load8(ROW(Kp, k0, sr)); S.st_k1 = load8(ROW(Kp, k0, 32 + sr)); } while (0)
#define SWRITE_HK(bf) do { *(bf16x8*)(K_lds + (bf) * SHM_K + kws) = S.st_k0; *(bf16x8*)(K_lds + (bf) * SHM_K + kws + 32 * 256) = S.st_k1; } while (0)
#define SWRITE_HV(bf) do { *(bf16x8*)(V_lds + (bf) * SHM_V + vst0) = S.st_v0; *(bf16x8*)(V_lds + (bf) * SHM_V + vst1) = S.st_v1; } while (0)
#define SWRITE_H(bf) do { SWRITE_HV(bf); SWRITE_HK(bf); } while (0)
__device__ __forceinline__ void att_prime(const BlockRef& cur, char* lds, Seam& S) {
    const int tid = threadIdx.x, wid = __builtin_amdgcn_readfirstlane(tid >> 6), lane = tid & 63, r32 = lane & 31, hi = lane >> 5;
    const int sr = tid >> 4, sc = (tid & 15) * 8, kws = KSWZ(sr, sc * 2); char* K_lds = lds + 2 * SHM_V;
#pragma unroll
    for (int d0 = 0; d0 < 8; ++d0) S.qr[d0] = load8((const bf16*)((const char*)cur.Q + (unsigned)(((wid * QBLK + r32) * HD + hi * 8) * 2 + d0 * 32)));
    SLOAD_H(cur.K, cur.V, 0); VMW(); SWRITE_HK(0);
    __syncthreads();
}
__device__ __forceinline__ void att_block(const BlockRef& cur, const BlockRef& nxt, char* lds, Seam& S) {
    const int tid = threadIdx.x, wid = __builtin_amdgcn_readfirstlane(tid >> 6), lane = tid & 63, r32 = lane & 31, hi = lane >> 5;
    const int NT = cur.NT;
    char* V_lds = lds; char* K_lds = lds + 2 * SHM_V;
    float* ws = (float*)(lds + 2 * SHM_V + 2 * SHM_K) + wid * 64; float* li_l = ws, * al_l = ws + 32;
    float m_reg = -1e30f, l_reg = 0; f32x16 o[4] = {};
    const int sr = tid >> 4, sc = (tid & 15) * 8, vst0 = v_st(sr, sc), vst1 = v_st(32 + sr, sc), kws = KSWZ(sr, sc * 2);
    const int vb0 = (int)(uintptr_t)V_lds + v_rd_base(lane);
    const bf16* Kh = cur.K; const bf16* Vh = cur.V;
    const char* Mb = (const char*)cur.M; const unsigned moff = (unsigned)((wid * QBLK + r32) * (MWORDS * 8) + hi * 4);
#define MLOAD(t) (*(const unsigned*)(Mb + (moff + (unsigned)(t) * 8u)))
    unsigned mwA = MLOAD(0), mwB = 0u;
#define RESC(a) do { if (__any((a) < 1.f)) { if (hi == 0) al_l[r32] = (a); asm volatile("s_waitcnt lgkmcnt(0)" ::: "memory");              \
                     for (int d_ = 0; d_ < 4; ++d_) for (int r = 0; r < 16; ++r) o[d_][r] *= al_l[crow(r, hi)]; } } while (0)
#define KBASE(t) ((t) * KVBLK)
    constexpr int NQL = 8;
#define SEAM_K0() do { VMWN(NQL); SWRITE_HK(0); SBAR(); } while (0)
    f32x16 pA0, pA1, pB0, pB1; float mnA, mnB, alA, alB; bf16x8 pa0, pa1, pa2, pa3;
    SWRITE_HV(0); SBAR();
    if (NT > 1) { SLOAD_H(Kh, Vh, KBASE(1)); }
    SBAR(); qkt<0>(pA0, pA1, K_lds, r32, hi, S.qr);
    mask_bits(pA0, pA1, mwA); partialSM(pA0, pA1, m_reg, mnA, alA);
    if (NT > 1) { VMW(); SWRITE_H(1); }
    __syncthreads();
#define HALF_STEP(PX0, PX1, mnX, alX, PY0, PY1, alY, t, KB, VB, SB, MWX, MWY) do {                                             \
        MWX = MLOAD(t);                                                                                                       \
        SBAR(); qkt<KB>(PX0, PX1, K_lds, r32, hi, S.qr);                                                                      \
        finishSM(PY0, PY1, alY, l_reg, pa0, pa1, pa2, pa3); SBAR();                                                           \
        if ((t) + 1 < NT) { SLOAD_H(Kh, Vh, KBASE((t) + 1)); SBAR(); }                                                        \
        pv_tile<VB>(o, vb0, pa0, pa1, pa2, pa3); mask_bits(PX0, PX1, MWX); partialSM(PX0, PX1, m_reg, mnX, alX);          \
        __syncthreads();                                                                                                      \
        if ((t) + 1 < NT) { VMW(); SWRITE_H(SB); }                                                                            \
        RESC(alX); __syncthreads(); } while (0)
    for (int t = 1; t + 1 < NT; t += 2) {
        HALF_STEP(pB0, pB1, mnB, alB, pA0, pA1, alA, t, 1, 0, 0, mwB, mwA);
        HALF_STEP(pA0, pA1, mnA, alA, pB0, pB1, alB, t + 1, 0, 1, 1, mwA, mwB);
    }
    const bool even = (NT & 1) == 0;
    if (even) { mwB = MLOAD(NT - 1); SBAR(); qkt<1>(pB0, pB1, K_lds, r32, hi, S.qr); SBAR(); }
    SLOAD_H(nxt.K, nxt.V, 0); SBAR();
#pragma unroll
    for (int d0 = 0; d0 < 8; ++d0) S.qr[d0] = load8((const bf16*)((const char*)nxt.Q + (unsigned)(((wid * QBLK + r32) * HD + hi * 8) * 2 + d0 * 32)));
    SBAR();
    finishSM(pA0, pA1, alA, l_reg, pa0, pa1, pa2, pa3); SBAR();
    pv_tile<0>(o, vb0, pa0, pa1, pa2, pa3);
    if (even) { mask_bits(pB0, pB1, mwB); partialSM(pB0, pB1, m_reg, mnB, alB); __syncthreads(); RESC(alB);
        finishSM(pB0, pB1, alB, l_reg, pa0, pa1, pa2, pa3); SBAR(); pv_tile<1>(o, vb0, pa0, pa1, pa2, pa3); }
    SBAR(); SEAM_K0();
    if (hi == 0) li_l[r32] = l_reg; asm volatile("s_waitcnt lgkmcnt(0)" ::: "memory");
    float rli[16];
#pragma unroll
    for (int r = 0; r < 16; ++r) rli[r] = __builtin_amdgcn_rcpf(li_l[crow(r, hi)]);
    char* Owb = (char*)(cur.O + (size_t)(wid * QBLK) * OSTR);
    int hi_e = hi, r32_e = r32; asm volatile("" : "+v"(hi_e), "+v"(r32_e));
    const unsigned lane_off = (unsigned)(4 * hi_e * OSTR + r32_e) * 2u;
#pragma unroll
    for (int r = 0; r < 16; ++r) { constexpr int dummy = 0; (void)dummy; const unsigned rowb = (unsigned)(((r & 3) + 8 * (r >> 2)) * OSTR * 2);
#pragma unroll
        for (int d0 = 0; d0 < 4; ++d0) { const float v = o[d0][r] * rli[r];
            const float vn = __shfl_xor(v, 1);
            if ((r32 & 1) == 0) *(unsigned*)(Owb + rowb + d0 * 64 + lane_off) = cvtpk(v, vn); } }
    __syncthreads();
#undef RESC
#undef KBASE
#undef SEAM_K0
#undef HALF_STEP
#undef MLOAD
}
#undef ROW
#undef VMW
#undef VMWN
#undef SLOAD_H
#undef SWRITE_HK
#undef SWRITE_HV
#undef SWRITE_H
#undef KSWZ
#undef SBAR
}

constexpr int NWAVES = 8;
#ifndef MK_PER_PHASE
#define MK_PER_PHASE 0
#endif
constexpr int N_PHASES = 13;

constexpr int DM = 2048, SEQ = 8192, NBATCH = 2, NMETA = 16, DFF = 5632;
constexpr int R = NBATCH * SEQ;
constexpr int RP = 16640;
constexpr int TKV = 8256;
constexpr int NPROJ = 7424;
constexpr int NGU = 2 * DFF;
constexpr float EPS = 1e-6f;

constexpr size_t MiB = 1u << 20;
constexpr size_t WS_CTL = 0, CTL_ZERO_BYTES = 1 * MiB;
constexpr size_t WS_AB = 1 * MiB;
constexpr size_t WS_WB = 66 * MiB;
constexpr size_t WS_WGU = WS_WB, WS_WD = WS_WB + 44 * MiB, WS_WIN = WS_WB, WS_WOUT = WS_WB + 29 * MiB, WS_MASK = WS_WB + 40 * MiB;
constexpr size_t WS_SMALL = 132 * MiB;
constexpr size_t WS_RSTD1 = WS_SMALL, WS_RSTD2 = WS_SMALL + 128 * 1024, WS_RSTD3 = WS_SMALL + 256 * 1024, WS_DEC = WS_SMALL + 384 * 1024;
constexpr size_t WS_ACT = 133 * MiB;
constexpr size_t WS_F = 312 * MiB;
constexpr size_t WS_MIXA = 133 * MiB;
constexpr size_t WS_QH = 197 * MiB;
constexpr size_t WS_KH = 229 * MiB, WS_VH = 262 * MiB;
constexpr size_t WS_IQ = 295 * MiB;
constexpr size_t WS_GQ = 327 * MiB, WS_GK = 344 * MiB;
constexpr size_t WS_GV = 361 * MiB;
constexpr size_t WS_GO = 394 * MiB;
constexpr size_t WS_IK = 426 * MiB;
constexpr size_t WS_IW = 429 * MiB;
constexpr size_t WS_GLOW = 430 * MiB;
constexpr size_t WS_ST = 432 * MiB;
constexpr size_t WS_END = 496 * MiB;
constexpr int CW_BAR = 4096;

constexpr int SCR_BYTES = 147456;
constexpr int MISC_OFF = SCR_BYTES;
constexpr int LDS_BYTES = SCR_BYTES + 2048;

#define GAS __attribute__((address_space(1)))
#define LAS __attribute__((address_space(3)))
typedef unsigned short bf16;
typedef unsigned v4u __attribute__((ext_vector_type(4)));
typedef unsigned v2u __attribute__((ext_vector_type(2)));
typedef float f32x4 __attribute__((ext_vector_type(4)));
typedef float f32x16 __attribute__((ext_vector_type(16)));
typedef short bf16x8 __attribute__((ext_vector_type(8)));
typedef unsigned long long u64;
typedef GAS unsigned gu32;
#define RLX_AGENT __ATOMIC_RELAXED, __HIP_MEMORY_SCOPE_AGENT
#define LDS_WAIT() asm volatile("s_waitcnt lgkmcnt(0)" ::: "memory")
#define VM_WAIT() asm volatile("s_waitcnt vmcnt(0)" ::: "memory")
__device__ __forceinline__ unsigned f2bf(float f) { unsigned u = __builtin_bit_cast(unsigned, f); return (u + 0x7fffu + ((u >> 16) & 1u)) >> 16; }
__device__ __forceinline__ unsigned pk2(float lo, float hi) { return f2bf(lo) | (f2bf(hi) << 16); }
__device__ __forceinline__ float bf2f(unsigned short b) { return __builtin_bit_cast(float, (unsigned)b << 16); }
__device__ __forceinline__ float bflo(unsigned w) { return __builtin_bit_cast(float, w << 16); }
__device__ __forceinline__ float bfhi(unsigned w) { return __builtin_bit_cast(float, w & 0xffff0000u); }
#define XB_TMO      128
#define XB_XCNT(j)  (256  + 64 * (j))
#define XB_XSUB(j)  (1280 + 64 * (j))
#define XB_XGEN(j)  (2304 + 64 * (j))
#define XB_TOP      3328
#define XB_TOPGEN   3392
#define XCD_BAR_WORDS 3456
#define XB_SPIN_CAP (1u << 22)

__device__ __forceinline__ unsigned xb_ld(unsigned* p)              { return __hip_atomic_load(p, __ATOMIC_RELAXED, __HIP_MEMORY_SCOPE_AGENT); }
__device__ __forceinline__ unsigned xb_add(unsigned* p, unsigned v) { return __hip_atomic_fetch_add(p, v, __ATOMIC_RELAXED, __HIP_MEMORY_SCOPE_AGENT); }
__device__ __forceinline__ unsigned xb_xcc_id() { return (unsigned)__builtin_amdgcn_s_getreg((3 << 11) | 20) & 0xFu; }
#define XB_SPIN(cond, bar) do { unsigned _sp = 0; while (cond) { __builtin_amdgcn_s_sleep(1); \
    if ((++_sp & 255u) == 0u) { if (xb_ld(&(bar)[XB_TMO])) break; if (_sp > XB_SPIN_CAP) { atomicAdd(&(bar)[XB_TMO], 1u); break; } } } } while (0)

struct XcdBarrier {
    unsigned* bar; unsigned x;
    volatile LAS unsigned* st;
};

__device__ __forceinline__ XcdBarrier xcd_barrier_post(unsigned* bar, volatile LAS unsigned* st) {
    XcdBarrier b; b.bar = bar; b.x = xb_xcc_id(); b.st = st;
    if (threadIdx.x == 0) (void)xb_add(&bar[XB_XCNT(b.x)], 1u);
    return b;
}
__device__ __forceinline__ void xcd_barrier_complete(unsigned* bar, unsigned x, unsigned& nloc, unsigned& nx) {
    const unsigned G = gridDim.x * gridDim.y * gridDim.z;
    unsigned sum, cnt, mine, sp = 0u;
    for (;;) {
        sum = 0u; cnt = 0u; mine = 0u;
#pragma unroll
        for (unsigned j = 0; j < 16; ++j) { const unsigned c = xb_ld(&bar[XB_XCNT(j)]); sum += c; cnt += (c > 0u) ? 1u : 0u; mine = (j == x) ? c : mine; }
        if (sum == G) break;
        __builtin_amdgcn_s_sleep(1);
        if ((++sp & 255u) == 0u) { if (xb_ld(&bar[XB_TMO])) break; if (sp > XB_SPIN_CAP) { atomicAdd(&bar[XB_TMO], 1u); break; } }
    }
    nloc = mine > 0u ? mine : 1u; nx = cnt > 0u ? cnt : 1u;
}

__device__ __forceinline__ void xcd_barrier(const XcdBarrier& b) {
    asm volatile("s_waitcnt vmcnt(0)" ::: "memory");
    __syncthreads();
    if (threadIdx.x == 0) {
        unsigned* bar = b.bar;
        __builtin_amdgcn_s_waitcnt(0);
        unsigned nloc = b.st[0], nx = b.st[1];
        if (nloc == 0u) { xcd_barrier_complete(bar, b.x, nloc, nx); b.st[0] = nloc; b.st[1] = nx; }
        const unsigned old = xb_add(&bar[XB_XSUB(b.x)], 1u);
        const unsigned gen = old / nloc;
        if (old + 1u == (gen + 1u) * nloc) {
            __builtin_amdgcn_fence(__ATOMIC_RELEASE, "agent");
            asm volatile("s_waitcnt vmcnt(0)" ::: "memory");
            const unsigned og = xb_add(&bar[XB_TOP], 1u);
            const unsigned tg = og / nx;
            if (og + 1u == (tg + 1u) * nx) xb_add(&bar[XB_TOPGEN], 1u);
            else XB_SPIN(xb_ld(&bar[XB_TOPGEN]) == tg, bar);
            __builtin_amdgcn_fence(__ATOMIC_ACQUIRE, "agent");
            xb_add(&bar[XB_XGEN(b.x)], 1u);
            asm volatile("s_waitcnt vmcnt(0)" ::: "memory");
        } else {
            XB_SPIN(xb_ld(&bar[XB_XGEN(b.x)]) == gen, bar);
            __builtin_amdgcn_fence(__ATOMIC_ACQUIRE, "agent");
            asm volatile("s_waitcnt vmcnt(0)" ::: "memory");
        }
    }
    __syncthreads();
}

struct Frame {
    LAS unsigned char* lds;
    unsigned char* ldsg;
    volatile LAS unsigned* MISC;
    unsigned* ctl;
    int tid, lane, wave, vcu, G;
    float* out; unsigned char* ws;
};
enum { I_X = 0, I_META, I_G1PRE, I_W1G, I_W1U, I_W1D, I_G1POST, I_GMIX, I_WIN, I_WGATE, I_BGATE, I_GGLA, I_WOUT, I_GMIXPOST, I_G2PRE, I_W2G, I_W2U, I_W2D, I_G2POST };

__device__ __forceinline__ float wave_sum(float v) {
#pragma unroll
    for (int o = 1; o < 64; o <<= 1) v += __shfl_xor(v, o);
    return v;
}
__device__ __forceinline__ unsigned wave_sum_u(unsigned v) {
#pragma unroll
    for (int o = 1; o < 64; o <<= 1) v += (unsigned)__shfl_xor((int)v, o);
    return v;
}

__device__ __forceinline__ void tr_item(const float* W, int N, int K, bf16* WT, int drow0, int scol, const float* gain, LAS float* scr, int k0, int lane) {
#pragma unroll 8
    for (int i = 0; i < 32; ++i) { const int kk = 2 * i + (lane >> 5); float v = 0.f;
        if (scol >= 0) v = W[(size_t)(k0 + kk) * N + scol];
        if (gain) v *= gain[k0 + kk];
        scr[kk * 33 + (lane & 31)] = v; }
    LDS_WAIT(); asm volatile("" ::: "memory");
    const int c = lane & 7;
#pragma unroll
    for (int j = 0; j < 4; ++j) { const int n = (lane >> 3) + 8 * j; const LAS float* s = scr + (8 * c) * 33 + n;
        v4u o; o.x = pk2(s[0 * 33], s[1 * 33]); o.y = pk2(s[2 * 33], s[3 * 33]); o.z = pk2(s[4 * 33], s[5 * 33]); o.w = pk2(s[6 * 33], s[7 * 33]);
        *(GAS v4u*)(WT + (size_t)(drow0 + n) * K + k0 + 8 * c) = o; }
    LDS_WAIT(); asm volatile("" ::: "memory");
}
__device__ __forceinline__ void convert_ffn(Frame& F, const float* Wg, const float* Wu, const float* Wd, const float* gain, bf16* WGU, bf16* WD) {
    LAS float* scr = (LAS float*)(F.lds + F.wave * 16384);
    const int gw = F.vcu * NWAVES + F.wave, NGW = F.G * NWAVES;
    constexpr int I_GU = (NGU / 32) * (DM / 64), I_D = (DM / 32) * (DFF / 64);
    for (int it = gw; it < I_GU + I_D; it += NGW) {
        if (it < I_GU) { const int g = it % (NGU / 32), kb = it / (NGU / 32), tile = g >> 3, w = g & 7;
            tr_item(w < 4 ? Wg : Wu, DFF, DM, WGU, g * 32, tile * 128 + (w & 3) * 32 + (F.lane & 31), gain, scr, kb * 64, F.lane); }
        else { const int r = it - I_GU, g = r % (DM / 32), kb = r / (DM / 32);
            tr_item(Wd, DM, DFF, WD, g * 32, g * 32 + (F.lane & 31), nullptr, scr, kb * 64, F.lane); }
    }
}
__device__ __forceinline__ int win_src_col(int j) {
    const int t = j >> 8, c = j & 255;
    if (t < 16) return j;
    if (t < 18) return 4176 + (j - 4096);
    if (t < 20) return 4688 + (j - 4608);
    if (t < 24) return 5200 + (j - 5120);
    if (t < 28) return 6240 + (j - 6144);
    if (c < 64) return 4096 + c;
    if (c < 80) return 4160 + (c - 64);
    if (c < 96) return 6224 + (c - 80);
    return -1;
}
__device__ __forceinline__ void convert_mix(Frame& F, const float* Win, const float* Wout, const float* gain, bf16* WIN, bf16* WOUT) {
    LAS float* scr = (LAS float*)(F.lds + F.wave * 16384);
    const int gw = F.vcu * NWAVES + F.wave, NGW = F.G * NWAVES;
    constexpr int I_IN = (NPROJ / 32) * (DM / 64), I_OUT = (DM / 32) * (DM / 64);
    for (int it = gw; it < I_IN + I_OUT; it += NGW) {
        if (it < I_IN) { const int g = it % (NPROJ / 32), kb = it / (NPROJ / 32);
            tr_item(Win, 7264, DM, WIN, g * 32, win_src_col(g * 32 + (F.lane & 31)), gain, scr, kb * 64, F.lane); }
        else { const int r = it - I_IN, g = r % (DM / 32), kb = r / (DM / 32);
            tr_item(Wout, DM, DM, WOUT, g * 32, g * 32 + (F.lane & 31), nullptr, scr, kb * 64, F.lane); }
    }
}

__device__ __forceinline__ void p0_rows(Frame& F, const float* X, const float* META) {
    const int gw = F.vcu * NWAVES + F.wave, NGW = F.G * NWAVES;
    bf16* AB = (bf16*)(F.ws + WS_AB); float* rstd = (float*)(F.ws + WS_RSTD1);
    for (int row = gw; row < RP; row += NGW) {
        GAS v2u* o = (GAS v2u*)(AB + (size_t)row * DM) + F.lane;
        if (row < R + NMETA) {
            const float* xr = row < R ? X + (size_t)row * DM : META + (size_t)(row - R) * DM;
            const GAS f32x4* xp = (const GAS f32x4*)xr + F.lane;
            f32x4 v[8]; float ss = 0.f;
#pragma unroll
            for (int j = 0; j < 8; ++j) { v[j] = xp[64 * j]; ss += (v[j].x * v[j].x + v[j].y * v[j].y) + (v[j].z * v[j].z + v[j].w * v[j].w); }
            ss = wave_sum(ss);
#pragma unroll
            for (int j = 0; j < 8; ++j) o[64 * j] = (v2u){pk2(v[j].x, v[j].y), pk2(v[j].z, v[j].w)};
            if (F.lane == 0) rstd[row] = 1.0f / sqrtf(ss * (1.0f / DM) + EPS);
        } else {
#pragma unroll
            for (int j = 0; j < 8; ++j) o[64 * j] = (v2u){0u, 0u};
            if (F.lane == 0) rstd[row] = 0.f;
        }
    }
}
template <int MODE>
__device__ __forceinline__ void norm_rows(Frame& F, const float* g, float* rstd_out, const float* X, const float* META) {
    const int gw = F.vcu * NWAVES + F.wave, NGW = F.G * NWAVES;
    bf16* AB = (bf16*)(F.ws + WS_AB); const bf16* FB = (const bf16*)(F.ws + WS_F);
    const int nrows = (MODE == 0) ? RP : R;
    f32x4 gv[8];
#pragma unroll
    for (int j = 0; j < 8; ++j) gv[j] = ((const GAS f32x4*)g)[64 * j + F.lane];
    for (int row = gw; row < nrows; row += NGW) {
        if (MODE == 0 && row >= R + NMETA) { if (F.lane == 0) rstd_out[row] = 0.f; continue; }
        const GAS v2u* fp = (const GAS v2u*)(FB + (size_t)row * DM) + F.lane;
        GAS v2u* ab = (GAS v2u*)(AB + (size_t)row * DM) + F.lane;
        f32x4 f[8], h[8]; float ss = 0.f;
#pragma unroll
        for (int j = 0; j < 8; ++j) { const v2u w = fp[64 * j]; f[j] = (f32x4){bflo(w.x), bfhi(w.x), bflo(w.y), bfhi(w.y)};
            ss += (f[j].x * f[j].x + f[j].y * f[j].y) + (f[j].z * f[j].z + f[j].w * f[j].w); }
        if (MODE == 0) {
            const float* xr = row < R ? X + (size_t)row * DM : META + (size_t)(row - R) * DM;
            const GAS f32x4* xp = (const GAS f32x4*)xr + F.lane;
#pragma unroll
            for (int j = 0; j < 8; ++j) h[j] = xp[64 * j];
        } else {
#pragma unroll
            for (int j = 0; j < 8; ++j) { const v2u w = ab[64 * j]; h[j] = (f32x4){bflo(w.x), bfhi(w.x), bflo(w.y), bfhi(w.y)}; }
        }
        ss = wave_sum(ss);
        const float rf = (MODE == 1 ? 1.0f : 0.5f) / sqrtf(ss * (1.0f / DM) + EPS);
        float s2 = 0.f;
#pragma unroll
        for (int j = 0; j < 8; ++j) { h[j] = h[j] + f[j] * gv[j] * rf; s2 += (h[j].x * h[j].x + h[j].y * h[j].y) + (h[j].z * h[j].z + h[j].w * h[j].w); }
        if (MODE == 2) {
            GAS f32x4* op = (GAS f32x4*)(F.out + (size_t)row * DM) + F.lane;
#pragma unroll
            for (int j = 0; j < 8; ++j) op[64 * j] = h[j];
        } else {
            s2 = wave_sum(s2);
#pragma unroll
            for (int j = 0; j < 8; ++j) ab[64 * j] = (v2u){pk2(h[j].x, h[j].y), pk2(h[j].z, h[j].w)};
            if (F.lane == 0) rstd_out[row] = 1.0f / sqrtf(s2 * (1.0f / DM) + EPS);
        }
    }
}

__device__ __forceinline__ void zero_pads(Frame& F) {
    const int gt = F.vcu * (NWAVES * 64) + F.tid, NG = F.G * NWAVES * 64;
    bf16* Kh = (bf16*)(F.ws + WS_KH); bf16* Vh = (bf16*)(F.ws + WS_VH); bf16* IK = (bf16*)(F.ws + WS_IK);
    const v4u z = {0u, 0u, 0u, 0u};
    for (int i = gt; i < 2 * 16 * 768 + 2 * 384; i += NG) {
        if (i < 2 * 16 * 768) { const int which = i / (16 * 768), r = i % (16 * 768), bh = r / 768, o = r % 768;
            *(GAS v4u*)((which ? Vh : Kh) + ((size_t)bh * TKV + 8208) * 128 + o * 8) = z; }
        else { const int r = i - 2 * 16 * 768, b = r / 384, o = r % 384; *(GAS v4u*)(IK + ((size_t)b * TKV + 8208) * 64 + o * 8) = z; }
    }
}

__device__ __forceinline__ unsigned row_or16(unsigned v) {
    v |= (unsigned)__builtin_amdgcn_update_dpp(0, (int)v, 0xB1, 0xf, 0xf, false);
    v |= (unsigned)__builtin_amdgcn_update_dpp(0, (int)v, 0x4E, 0xf, 0xf, false);
    v |= (unsigned)__builtin_amdgcn_update_dpp(0, (int)v, 0x141, 0xf, 0xf, false);
    v |= (unsigned)__builtin_amdgcn_update_dpp(0, (int)v, 0x140, 0xf, 0xf, false);
    return v;
}
__device__ __forceinline__ void p5_item(Frame& F, int b, int t) {
    const int lane = F.lane, wid = F.wave, r32 = lane & 31, hi = lane >> 5;
    const GAS bf16* IQ = (const GAS bf16*)(F.ws + WS_IQ); const GAS bf16* IK = (const GAS bf16*)(F.ws + WS_IK); const GAS float* IW = (const GAS float*)(F.ws + WS_IW);
    GAS u64* MASK = (GAS u64*)(F.ws + WS_MASK);
    LAS unsigned short* S16 = (LAS unsigned short*)F.lds;
    constexpr int SROW = 8320;
    const int s0 = 8 * t, qb = s0 >> 8, nwords = 4 * qb + 5, nd = (nwords + 1) >> 1;
    const int kmax = 16 + s0 + 7, nkt = (kmax >> 5) + 1;
    {
        bf16x8 Af[4][4];
        LAS float* WL = (LAS float*)(F.lds + 8 * SROW * 2);
        if (F.tid < 128) WL[F.tid] = IW[((size_t)(b * SEQ + s0)) * 16 + F.tid];
        {
            const int qo = (r32 >> 2) & 1, h = (r32 & 3) + 4 * (r32 >> 3);
#pragma unroll
            for (int rb = 0; rb < 4; ++rb) {
                const GAS bf16* qp = IQ + ((size_t)(b * SEQ + s0 + 2 * rb + qo)) * 1024 + h * 64 + 8 * hi;
#pragma unroll
                for (int ks = 0; ks < 4; ++ks) Af[rb][ks] = *(const GAS bf16x8*)(qp + ks * 16);
            }
        }
        __syncthreads();
        const GAS char* kbase = (const GAS char*)(IK + (size_t)b * TKV * 64);
        const unsigned koff = (unsigned)((r32 * 64 + 8 * hi) * 2);
        bf16x8 Bn[4];
        if (wid < nkt) {
#pragma unroll
            for (int ks = 0; ks < 4; ++ks) Bn[ks] = *(const GAS bf16x8*)(kbase + (koff + (unsigned)(wid * 4096 + ks * 32)));
        }
        for (int kt = wid; kt < nkt; kt += 8) {
            bf16x8 Bf[4];
#pragma unroll
            for (int ks = 0; ks < 4; ++ks) Bf[ks] = Bn[ks];
            if (kt + 8 < nkt) {
#pragma unroll
                for (int ks = 0; ks < 4; ++ks) Bn[ks] = *(const GAS bf16x8*)(kbase + (koff + (unsigned)((kt + 8) * 4096 + ks * 32)));
            }
            const int key = kt * 32 + r32;
            int wlo = hi * 16; asm volatile("" : "+v"(wlo));
#pragma unroll
            for (int rb = 0; rb < 4; ++rb) {
                const LAS f32x4* wl = (const LAS f32x4*)(WL + wlo + 32 * rb);
                const f32x4 w0 = wl[0], w1 = wl[1], w2 = wl[2], w3 = wl[3];
                const float wv[16] = {w0.x, w0.y, w0.z, w0.w, w1.x, w1.y, w1.z, w1.w, w2.x, w2.y, w2.z, w2.w, w3.x, w3.y, w3.z, w3.w};
                f32x16 acc = {};
#pragma unroll
                for (int ks = 0; ks < 4; ++ks) acc = __builtin_amdgcn_mfma_f32_32x32x16_bf16(Af[rb][ks], Bf[ks], acc, 0, 0, 0);
                float sc = 0.f;
#pragma unroll
                for (int r = 0; r < 16; ++r) { const float a_ = acc[r]; const int ai_ = __float_as_int(a_); sc = fmaf(__int_as_float(ai_ > 0 ? ai_ : 0), wv[r], sc); }
                sc = fminf(fmaxf(sc, -60000.f), 60000.f);
                const _Float16 hf = (_Float16)sc;
                const unsigned hb = (unsigned)__builtin_bit_cast(unsigned short, hf);
                unsigned sk = (hb & 0x8000u) ? (~hb & 0xffffu) : (hb | 0x8000u);
                if (key > 16 + s0 + 2 * rb + hi) sk = 0x03ffu;
                S16[(2 * rb + hi) * SROW + key] = (unsigned short)sk;
            }
        }
    }
    { const int lo8 = nkt * 4, n8 = SROW / 8 - lo8;
      const v4u fill = {0x03ff03ffu, 0x03ff03ffu, 0x03ff03ffu, 0x03ff03ffu};
      for (int i = F.tid; i < 8 * n8; i += NWAVES * 64) { const int q = i / n8, k8 = i - q * n8; *(LAS v4u*)(S16 + q * SROW + 8 * (lo8 + k8)) = fill; } }
    __syncthreads();
    {
        typedef unsigned short u16x2 __attribute__((ext_vector_type(2)));
        constexpr int NDMAX = 65;
        const LAS unsigned* srow = (const LAS unsigned*)(S16 + wid * SROW);
        unsigned d[NDMAX];
#pragma unroll
        for (int j = 0; j < NDMAX; ++j) d[j] = srow[j * 64 + lane];
        const u16x2 one2 = {1, 1};
#define CNT_GT(acc2, c16) do { const u16x2 c2_ = {(unsigned short)(c16), (unsigned short)(c16)}; _Pragma("unroll") for (int jc = 0; jc < NDMAX; jc += 8) { if (jc < nd) { \
            _Pragma("unroll") for (int j = jc; j < jc + 8 && j < NDMAX; ++j) acc2 += __builtin_elementwise_min(__builtin_elementwise_sub_sat(__builtin_bit_cast(u16x2, d[j]), c2_), one2); } } } while (0)
        unsigned thr = 0u;
        for (int bit = 15; bit >= 0; --bit) {
            const unsigned cand = thr | (1u << bit); u16x2 c2 = {0, 0};
            CNT_GT(c2, cand - 1u);
            const unsigned cw = __builtin_bit_cast(unsigned, c2);
            const unsigned cnt = wave_sum_u((cw & 0xffffu) + (cw >> 16));
            if (cnt >= 256u) thr = cand;
        }
        if (thr < 0x0400u) thr = 0x0400u;
        u16x2 g2 = {0, 0}, e2 = {0, 0};
        CNT_GT(g2, thr); CNT_GT(e2, thr - 1u);
        const unsigned gw = __builtin_bit_cast(unsigned, g2), ew = __builtin_bit_cast(unsigned, e2);
        const unsigned cgt = wave_sum_u((gw & 0xffffu) + (gw >> 16)), cge = wave_sum_u((ew & 0xffffu) + (ew >> 16));
#undef CNT_GT
        const int need = 256 - (int)cgt;
        GAS unsigned short* mout16 = (GAS unsigned short*)(MASK + ((size_t)(b * SEQ + s0 + wid)) * 130);
        if (cge <= 256u) {
            const int nw32 = 2 * nwords, g = lane >> 4, sh = 2 * (lane & 15); const bool st_lane = (lane & 15) == 0;
            GAS unsigned short* mlane = mout16 + (4 * (g >> 1) + (g & 1));
            const u16x2 t2 = {(unsigned short)(thr - 1u), (unsigned short)(thr - 1u)};
#pragma unroll
            for (int j = 0; j < NDMAX; ++j) {
                if (4 * j < nw32) {
                    const unsigned sw = __builtin_bit_cast(unsigned, __builtin_elementwise_min(__builtin_elementwise_sub_sat(__builtin_bit_cast(u16x2, d[j]), t2), one2));
                    const unsigned v = row_or16(((sw & 1u) | ((sw >> 15) & 2u)) << sh);
                    if (st_lane) { const unsigned u = v >> 4;
                        const unsigned e0 = (v & 0xFu) | ((v >> 4) & 0xF0u) | ((v >> 8) & 0xF00u) | ((v >> 12) & 0xF000u);
                        const unsigned e1 = (u & 0xFu) | ((u >> 4) & 0xF0u) | ((u >> 8) & 0xF00u) | ((u >> 12) & 0xF000u);
                        mlane[8 * j] = (unsigned short)e0; mlane[8 * j + 2] = (unsigned short)e1; }
                }
            }
        } else {
            const LAS unsigned short* s16 = S16 + wid * SROW;
            int tie_seen = 0;
            for (int jj = 0; jj < nwords; ++jj) {
                const unsigned k = s16[jj * 64 + lane];
                const bool gt = k > thr, eq = k == thr;
                const u64 em = __ballot(eq);
                const int rank = tie_seen + (int)__builtin_amdgcn_mbcnt_hi((unsigned)(em >> 32), __builtin_amdgcn_mbcnt_lo((unsigned)em, 0u));
                const u64 w = __ballot(gt || (eq && rank < need));
                tie_seen += __popcll(em);
                const unsigned vl = (unsigned)w, vh = (unsigned)(w >> 32), ul = vl >> 4, uh = vh >> 4;
                const unsigned a0 = (vl & 0xFu) | ((vl >> 4) & 0xF0u) | ((vl >> 8) & 0xF00u) | ((vl >> 12) & 0xF000u), a1 = (ul & 0xFu) | ((ul >> 4) & 0xF0u) | ((ul >> 8) & 0xF00u) | ((ul >> 12) & 0xF000u);
                const unsigned b0 = (vh & 0xFu) | ((vh >> 4) & 0xF0u) | ((vh >> 8) & 0xF00u) | ((vh >> 12) & 0xF000u), b1 = (uh & 0xFu) | ((uh >> 4) & 0xF0u) | ((uh >> 8) & 0xF00u) | ((uh >> 12) & 0xF000u);
                if (lane == 0) { ((GAS unsigned*)mout16)[2 * jj] = a0 | (b0 << 16); ((GAS unsigned*)mout16)[2 * jj + 1] = a1 | (b1 << 16); }
            }
        }
    }
    __syncthreads();
}

template <int KSTEPS>
__device__ __forceinline__ void mma_ll(f32x16& acc, const LAS bf16* A, int sa, const LAS bf16* B, int sb, int r32, int hi) {
#pragma unroll
    for (int ks = 0; ks < KSTEPS; ++ks) {
        const bf16x8 a = *(const LAS bf16x8*)(A + r32 * sa + ks * 16 + 8 * hi), bb = *(const LAS bf16x8*)(B + r32 * sb + ks * 16 + 8 * hi);
        acc = __builtin_amdgcn_mfma_f32_32x32x16_bf16(a, bb, acc, 0, 0, 0);
    }
}
__device__ __forceinline__ float log_sigmoid_f(float z) { return fminf(z, 0.f) - __logf(1.0f + __expf(-fabsf(z))); }
__device__ __forceinline__ void gla_bcum(Frame& F, LAS float* BC, LAS float* GT, int b, int h, int n, const float* Wg, const float* bg) {
    const GAS float* GLOW = (const GAS float*)(F.ws + WS_GLOW);
    const int k = F.tid & 127, ig = __builtin_amdgcn_readfirstlane(F.tid >> 7);
    float wc[16];
#pragma unroll
    for (int r = 0; r < 16; ++r) wc[r] = Wg[r * 512 + h * 128 + k];
    const float bk = bg[h * 128 + k];
    float run = 0.f, pre[16];
#pragma unroll
    for (int ii = 0; ii < 16; ++ii) {
        const int i = 16 * ig + ii, pp = 64 * n + i; float lg = 0.f;
        if (!(n == 0 && i < 48)) {
            const GAS f32x4* gl = (const GAS f32x4*)(GLOW + ((size_t)b * TKV + pp) * 16); float z = bk;
#pragma unroll
            for (int r4 = 0; r4 < 4; ++r4) { const f32x4 g4 = gl[r4];
                z = fmaf(g4.x, wc[4 * r4 + 0], z); z = fmaf(g4.y, wc[4 * r4 + 1], z); z = fmaf(g4.z, wc[4 * r4 + 2], z); z = fmaf(g4.w, wc[4 * r4 + 3], z); }
            lg = log_sigmoid_f(z) * (1.0f / 16.0f);
        }
        run += lg; pre[ii] = run;
    }
    GT[ig * 128 + k] = run;
    __syncthreads();
    float off = 0.f;
#pragma unroll
    for (int gq = 0; gq < 3; ++gq) off += (gq < ig) ? GT[gq * 128 + k] : 0.f;
#pragma unroll
    for (int ii = 0; ii < 16; ++ii) BC[(16 * ig + ii) * 128 + k] = pre[ii] + off;
    __syncthreads();
}
__device__ __forceinline__ void gla_load_vt(Frame& F, LAS bf16* VT, int b, int h, int n) {
    const GAS bf16* GV = (const GAS bf16*)(F.ws + WS_GV);
    const int v0 = 8 * (F.tid & 31);
#pragma unroll
    for (int pass = 0; pass < 4; ++pass) {
        const int i = (F.tid >> 5) + 16 * pass, pp = 64 * n + i;
        v4u raw = {0u, 0u, 0u, 0u};
        if (!(n == 0 && i < 48)) raw = *(const GAS v4u*)(GV + ((size_t)b * TKV + pp) * 1024 + h * 256 + v0);
        VT[(v0 + 0) * 72 + i] = (bf16)(raw.x & 0xffffu); VT[(v0 + 1) * 72 + i] = (bf16)(raw.x >> 16);
        VT[(v0 + 2) * 72 + i] = (bf16)(raw.y & 0xffffu); VT[(v0 + 3) * 72 + i] = (bf16)(raw.y >> 16);
        VT[(v0 + 4) * 72 + i] = (bf16)(raw.z & 0xffffu); VT[(v0 + 5) * 72 + i] = (bf16)(raw.z >> 16);
        VT[(v0 + 6) * 72 + i] = (bf16)(raw.w & 0xffffu); VT[(v0 + 7) * 72 + i] = (bf16)(raw.w >> 16);
    }
}
__device__ __forceinline__ void g1_unit(Frame& F, int b, int h, int n, const float* Wg, const float* bg) {
    const int lane = F.lane, wid = F.wave, r32 = lane & 31, hi = lane >> 5, tid = F.tid;
    LAS float* BC = (LAS float*)F.lds; LAS bf16* KDT = (LAS bf16*)(F.lds + 32768); LAS bf16* VT = (LAS bf16*)(F.lds + 51200);
    const GAS bf16* GK = (const GAS bf16*)(F.ws + WS_GK); GAS bf16* ST = (GAS bf16*)(F.ws + WS_ST); GAS float* DEC = (GAS float*)(F.ws + WS_DEC);
    gla_bcum(F, BC, (LAS float*)(F.lds + 131072), b, h, n, Wg, bg);
    { const int k0 = 8 * (tid & 15);
#pragma unroll
      for (int pass = 0; pass < 2; ++pass) {
        const int i = (tid >> 4) + 32 * pass, pp = 64 * n + i;
        v4u raw = {0u, 0u, 0u, 0u};
        if (!(n == 0 && i < 48)) raw = *(const GAS v4u*)(GK + ((size_t)b * TKV + pp) * 512 + h * 128 + k0);
        const unsigned rw[4] = {raw.x, raw.y, raw.z, raw.w};
#pragma unroll
        for (int j = 0; j < 8; ++j) { const float kv = (j & 1) ? bfhi(rw[j >> 1]) : bflo(rw[j >> 1]);
            const float d = __expf(BC[63 * 128 + k0 + j] - BC[i * 128 + k0 + j]);
            KDT[(k0 + j) * 72 + i] = (bf16)f2bf(kv * d); }
      } }
    gla_load_vt(F, VT, b, h, n);
    __syncthreads();
    GAS bf16* dst = ST + ((size_t)((b * 4 + h) * 128 + n) * 256) * 128;
#pragma unroll
    for (int cb = 0; cb < 4; ++cb) {
        f32x16 acc = {};
        mma_ll<4>(acc, VT + (32 * wid) * 72, 72, KDT + (32 * cb) * 72, 72, r32, hi);
#pragma unroll
        for (int r = 0; r < 16; ++r) { const int dv = 32 * wid + (r & 3) + 8 * (r >> 2) + 4 * hi; const float v = acc[r], vn = __shfl_xor(v, 1);
            if ((r32 & 1) == 0) *(GAS unsigned*)(dst + (size_t)dv * 128 + 32 * cb + r32) = pk2(v, vn); }
    }
    if (tid < 128) DEC[(size_t)((b * 4 + h) * 128 + n) * 128 + tid] = __expf(BC[63 * 128 + tid]);
    __syncthreads();
}
__device__ __forceinline__ void g2_scan(Frame& F) {
    GAS bf16* ST = (GAS bf16*)(F.ws + WS_ST); const GAS float* DEC = (const GAS float*)(F.ws + WS_DEC);
    const int NG = F.G * NWAVES * 64;
    for (int e = F.vcu * (NWAVES * 64) + F.tid; e < 8 * 16384; e += NG) {
        const int bh = e >> 14, rem = e & 16383, v = rem >> 6, k = (rem & 63) * 2;
        GAS unsigned* p = (GAS unsigned*)(ST + ((size_t)bh * 128 * 256 + v) * 128 + k);
        const GAS float* d = DEC + (size_t)bh * 128 * 128 + k;
        float s0 = 0.f, s1 = 0.f;
        for (int n = 0; n < 128; n += 8) {
            unsigned w[8]; float d0[8], d1[8];
#pragma unroll
            for (int u = 0; u < 8; ++u) { w[u] = p[(size_t)(n + u) * 16384]; d0[u] = d[(n + u) * 128]; d1[u] = d[(n + u) * 128 + 1]; }
#pragma unroll
            for (int u = 0; u < 8; ++u) { s0 = fmaf(s0, d0[u], bflo(w[u])); s1 = fmaf(s1, d1[u], bfhi(w[u])); p[(size_t)(n + u) * 16384] = pk2(s0, s1); }
        }
    }
}
__device__ __forceinline__ void g3_unit(Frame& F, int b, int h, int c, const float* Wg, const float* bg, const float* ggla) {
    const int lane = F.lane, wid = F.wave, r32 = lane & 31, hi = lane >> 5, tid = F.tid;
    LAS float* BC = (LAS float*)F.lds; LAS bf16* Q1 = (LAS bf16*)(F.lds + 32768); LAS bf16* Q2 = (LAS bf16*)(F.lds + 50176); LAS bf16* KD = (LAS bf16*)(F.lds + 67584);
    LAS bf16* VT = (LAS bf16*)(F.lds + 84992); LAS bf16* AT = (LAS bf16*)(F.lds + 121856); LAS float* OS = (LAS float*)F.lds;
    const GAS bf16* GQ = (const GAS bf16*)(F.ws + WS_GQ); const GAS bf16* GK = (const GAS bf16*)(F.ws + WS_GK); const GAS bf16* GO = (const GAS bf16*)(F.ws + WS_GO);
    const GAS bf16* ST = (const GAS bf16*)(F.ws + WS_ST); GAS bf16* MIXA = (GAS bf16*)(F.ws + WS_MIXA);
    gla_bcum(F, BC, (LAS float*)(F.lds + 131072), b, h, c, Wg, bg);
    { const int k0 = 8 * (tid & 15);
#pragma unroll
      for (int pass = 0; pass < 2; ++pass) {
        const int i = (tid >> 4) + 32 * pass, pp = 64 * c + i;
        const v4u rq = *(const GAS v4u*)(GQ + ((size_t)b * TKV + pp) * 512 + h * 128 + k0);
        const v4u rk = *(const GAS v4u*)(GK + ((size_t)b * TKV + pp) * 512 + h * 128 + k0);
        const unsigned qw[4] = {rq.x, rq.y, rq.z, rq.w}, kw[4] = {rk.x, rk.y, rk.z, rk.w};
        float q1[8], q2[8], kd[8];
#pragma unroll
        for (int j = 0; j < 8; ++j) { const float qv = (j & 1) ? bfhi(qw[j >> 1]) : bflo(qw[j >> 1]), kv = (j & 1) ? bfhi(kw[j >> 1]) : bflo(kw[j >> 1]);
            const float bc = BC[i * 128 + k0 + j], bl = BC[63 * 128 + k0 + j];
            q1[j] = qv * __expf(bc); q2[j] = qv * __expf(bc - bl); kd[j] = kv * __expf(bl - bc); }
        *(LAS v4u*)(Q1 + i * 136 + k0) = (v4u){pk2(q1[0], q1[1]), pk2(q1[2], q1[3]), pk2(q1[4], q1[5]), pk2(q1[6], q1[7])};
        *(LAS v4u*)(Q2 + i * 136 + k0) = (v4u){pk2(q2[0], q2[1]), pk2(q2[2], q2[3]), pk2(q2[4], q2[5]), pk2(q2[6], q2[7])};
        *(LAS v4u*)(KD + i * 136 + k0) = (v4u){pk2(kd[0], kd[1]), pk2(kd[2], kd[3]), pk2(kd[4], kd[5]), pk2(kd[6], kd[7])};
      } }
    gla_load_vt(F, VT, b, h, c);
    __syncthreads();
    const int rbI = wid & 1, cbV = (wid >> 1) * 2;
    f32x16 acc[2] = {};
    {
        const GAS bf16* sp = ST + ((size_t)((b * 4 + h) * 128 + (c - 1)) * 256) * 128;
#pragma unroll
        for (int ks = 0; ks < 8; ++ks) {
            const bf16x8 a = *(const LAS bf16x8*)(Q1 + (32 * rbI + r32) * 136 + ks * 16 + 8 * hi);
#pragma unroll
            for (int t = 0; t < 2; ++t) { const bf16x8 bb = *(const GAS bf16x8*)(sp + (size_t)(32 * (cbV + t) + r32) * 128 + ks * 16 + 8 * hi);
                acc[t] = __builtin_amdgcn_mfma_f32_32x32x16_bf16(a, bb, acc[t], 0, 0, 0); }
        }
    }
    if (wid < 4) {
        const int ib = wid & 1, jb = wid >> 1;
        f32x16 at = {};
        mma_ll<8>(at, Q2 + (32 * ib) * 136, 136, KD + (32 * jb) * 136, 136, r32, hi);
#pragma unroll
        for (int r = 0; r < 16; ++r) { const int i = 32 * ib + (r & 3) + 8 * (r >> 2) + 4 * hi, j = 32 * jb + r32;
            AT[i * 72 + j] = (bf16)f2bf(j <= i ? at[r] : 0.f); }
    }
    __syncthreads();
#pragma unroll
    for (int t = 0; t < 2; ++t) mma_ll<4>(acc[t], AT + (32 * rbI) * 72, 72, VT + (32 * (cbV + t)) * 72, 72, r32, hi);
    __syncthreads();
#pragma unroll
    for (int t = 0; t < 2; ++t)
#pragma unroll
        for (int r = 0; r < 16; ++r) OS[(32 * rbI + (r & 3) + 8 * (r >> 2) + 4 * hi) * 260 + 32 * (cbV + t) + r32] = acc[t][r];
    __syncthreads();
    {
        const int i = tid >> 3, seg = tid & 7; const LAS float* orow = OS + i * 260 + 32 * seg;
        float ss = 0.f; f32x4 ov[8];
#pragma unroll
        for (int q = 0; q < 8; ++q) { ov[q] = *(const LAS f32x4*)(orow + 4 * q); ss += (ov[q].x * ov[q].x + ov[q].y * ov[q].y) + (ov[q].z * ov[q].z + ov[q].w * ov[q].w); }
        ss += __shfl_xor(ss, 1); ss += __shfl_xor(ss, 2); ss += __shfl_xor(ss, 4);
        const float rs = 1.0f / sqrtf(ss * (1.0f / 256.0f) + EPS);
        const size_t row = (size_t)b * SEQ + 64 * (c - 1) + i;
        const float* gn = ggla + 32 * seg;
        const GAS bf16* gp = GO + row * 1024 + h * 256 + 32 * seg;
        GAS bf16* op = MIXA + row * 2048 + 1024 + h * 256 + 32 * seg;
#pragma unroll
        for (int q2 = 0; q2 < 4; ++q2) {
            const v4u gw = *(const GAS v4u*)(gp + 8 * q2);
            const f32x4 g0 = *(const f32x4*)(gn + 8 * q2), g1 = *(const f32x4*)(gn + 8 * q2 + 4);
            const f32x4 a = ov[2 * q2], bq = ov[2 * q2 + 1];
            float y[8];
            y[0] = a.x * rs * g0.x * pg8::silu_f(bflo(gw.x)); y[1] = a.y * rs * g0.y * pg8::silu_f(bfhi(gw.x));
            y[2] = a.z * rs * g0.z * pg8::silu_f(bflo(gw.y)); y[3] = a.w * rs * g0.w * pg8::silu_f(bfhi(gw.y));
            y[4] = bq.x * rs * g1.x * pg8::silu_f(bflo(gw.z)); y[5] = bq.y * rs * g1.y * pg8::silu_f(bfhi(gw.z));
            y[6] = bq.z * rs * g1.z * pg8::silu_f(bflo(gw.w)); y[7] = bq.w * rs * g1.w * pg8::silu_f(bfhi(gw.w));
            *(GAS v4u*)(op + 8 * q2) = (v4u){pk2(y[0], y[1]), pk2(y[2], y[3]), pk2(y[4], y[5]), pk2(y[6], y[7])};
        }
    }
    __syncthreads();
}

__device__ __forceinline__ att::BlockRef att_ref(Frame& F, int bh, int qb) {
    const int b = bh >> 3, h = bh & 7; att::BlockRef r;
    r.Q = (const bf16*)(F.ws + WS_QH) + ((size_t)bh * SEQ + (size_t)qb * 256) * 128;
    r.K = (const bf16*)(F.ws + WS_KH) + (size_t)bh * TKV * 128; r.V = (const bf16*)(F.ws + WS_VH) + (size_t)bh * TKV * 128;
    r.O = (bf16*)(F.ws + WS_MIXA) + ((size_t)b * SEQ + (size_t)qb * 256) * 2048 + h * 128;
    r.M = (const u64*)(F.ws + WS_MASK) + ((size_t)b * SEQ + (size_t)qb * 256) * 130;
    r.NT = 4 * qb + 5;
    return r;
}
__device__ __forceinline__ void p7_attention(Frame& F) {
    constexpr int total = 256;
    int L = F.vcu; if (L >= total) return;
    int pass = 0;
    att::BlockRef cur = att_ref(F, L >> 4, L & 15);
    att::Seam S;
    att::att_prime(cur, (char*)F.ldsg, S);
    for (;;) {
        const bool more_pass = pass == 0, more_item = L + F.G < total, last = !more_pass && !more_item;
        int passn = pass + 1, Ln = L;
        if (!more_pass) { passn = 0; Ln = more_item ? L + F.G : L; }
        const att::BlockRef nxt = last ? cur : att_ref(F, Ln >> 4, passn ? 31 - (Ln & 15) : (Ln & 15));
        att::att_block(cur, nxt, (char*)F.ldsg, S);
        if (last) break;
        cur = nxt; pass = passn; L = Ln;
    }
}

struct Args { const float* in[19]; float* out; unsigned char* ws; int ph_lo, ph_hi; };
#ifndef PG8_SP2
#define PG8_SP2 true
#endif
#ifndef PG8_ALIGN
#define PG8_ALIGN true
#endif
__global__ void __launch_bounds__(NWAVES * 64, 2) hymba_fwd(Args args) {
    extern __shared__ __attribute__((aligned(16))) unsigned char lds[];
    Frame F;
    F.lds = (LAS unsigned char*)lds; F.ldsg = lds;
    F.MISC = (volatile LAS unsigned*)(F.lds + MISC_OFF);
    F.tid = threadIdx.x; F.lane = F.tid & 63; F.wave = __builtin_amdgcn_readfirstlane(F.tid >> 6);
    F.G = gridDim.x; { const int bx = blockIdx.x; F.vcu = (F.G % 8 == 0) ? (bx % 8) * (F.G / 8) + bx / 8 : bx; }
    F.ws = args.ws; F.ctl = (unsigned*)(args.ws + WS_CTL); F.out = args.out;
    for (int u = F.tid; u < (LDS_BYTES - MISC_OFF) / 4; u += NWAVES * 64) ((LAS unsigned*)(F.lds + MISC_OFF))[u] = 0u;
    __syncthreads();
    XcdBarrier bar; bar.bar = F.ctl + CW_BAR; bar.x = 0; bar.st = nullptr;
    if (!MK_PER_PHASE) bar = xcd_barrier_post(F.ctl + CW_BAR, F.MISC + 8);
    const int lo = args.ph_lo, hi = args.ph_hi;
#define PHASE_BEGIN() do { int t_ = threadIdx.x; asm volatile("" : "+v"(t_)); F.tid = t_; F.lane = t_ & 63; F.wave = __builtin_amdgcn_readfirstlane(t_ >> 6); } while (0)
#ifndef PH_MASK
#define PH_MASK 0x1fff
#endif
#define IN(k) ((((PH_MASK) >> (k)) & 1) && lo <= (k) && (k) < hi)
#define SEAM(k) do { if (!MK_PER_PHASE && IN((k) + 1)) xcd_barrier(bar); } while (0)
#ifndef PH_DUP
#define PH_DUP 0
#endif
#define AB ((bf16*)(F.ws + WS_AB))
#define ACT ((bf16*)(F.ws + WS_ACT))
#define FB ((bf16*)(F.ws + WS_F))
#define WGU ((bf16*)(F.ws + WS_WGU))
#define WD ((bf16*)(F.ws + WS_WD))
#define WIN ((bf16*)(F.ws + WS_WIN))
#define WOUT ((bf16*)(F.ws + WS_WOUT))
#define rstd1 ((float*)(F.ws + WS_RSTD1))
#define rstd2 ((float*)(F.ws + WS_RSTD2))
#define rstd3 ((float*)(F.ws + WS_RSTD3))

    #define BODY0 do { convert_ffn(F, args.in[I_W1G], args.in[I_W1U], args.in[I_W1D], args.in[I_G1PRE], WGU, WD); p0_rows(F, args.in[I_X], args.in[I_META]); } while (0)
    if (IN(0)) { PHASE_BEGIN();
#if (PH_DUP >> 0) & 1
        BODY0; xcd_barrier(bar);
#endif
        BODY0; SEAM(0); }
    if (IN(1)) { PHASE_BEGIN();
        pg8::Gemm g{AB, WGU, RP, NGU, DM}; pg8::StaticOrder S; S.init(RP, NGU, F.G, (int)blockIdx.x);
        pg8::EpiSwiGLU E{ACT, DFF, rstd1};
#if (PH_DUP >> 1) & 1
        pg8::gemm_phase<pg8::EpiSwiGLU, pg8::StaticOrder, PG8_ALIGN, PG8_SP2>(F.lds, g, S, E); xcd_barrier(bar);
#endif
        pg8::gemm_phase<pg8::EpiSwiGLU, pg8::StaticOrder, PG8_ALIGN, PG8_SP2>(F.lds, g, S, E);
        SEAM(1);
    }
    if (IN(2)) { PHASE_BEGIN();
        pg8::Gemm g{ACT, WD, RP, DM, DFF}; pg8::StaticOrder S; S.init(RP, DM, F.G, (int)blockIdx.x);
        pg8::EpiStoreBf16 E{FB, DM};
        pg8::gemm_phase<pg8::EpiStoreBf16, pg8::StaticOrder, PG8_ALIGN, PG8_SP2>(F.lds, g, S, E);
        SEAM(2);
    }
    #define BODY3 do { norm_rows<0>(F, args.in[I_G1POST], rstd2, args.in[I_X], args.in[I_META]); convert_mix(F, args.in[I_WIN], args.in[I_WOUT], args.in[I_GMIX], WIN, WOUT); } while (0)
    if (IN(3)) { PHASE_BEGIN();
#if (PH_DUP >> 3) & 1
        BODY3; xcd_barrier(bar);
#endif
        BODY3; SEAM(3); }
    if (IN(4)) { PHASE_BEGIN();
        zero_pads(F);
        pg8::Gemm g{AB, WIN, RP, NPROJ, DM}; pg8::StaticOrder S; S.init(RP, NPROJ, F.G, (int)blockIdx.x);
        pg8::EpiProj E{F.ws, WS_RSTD2, WS_QH, WS_KH, WS_VH, WS_IQ, WS_GQ, WS_GK, WS_GV, WS_GO, WS_IK, WS_IW, WS_GLOW};
        pg8::gemm_phase<pg8::EpiProj, pg8::StaticOrder, PG8_ALIGN, PG8_SP2>(F.lds, g, S, E);
        SEAM(4);
    }
#define BODY5A do { for (int v = F.vcu; v < 256; v += F.G) \
            for (int bq = 0; bq < 8; ++bq) { const int b = bq >> 2, q = bq & 3; const int t = q == 0 ? v : (q == 1 ? 511 - v : (q == 2 ? 512 + v : 1023 - v)); p5_item(F, b, t); } } while (0)
#define BODY5B do { PHASE_BEGIN(); for (int u = F.vcu; u < 1024; u += F.G) g1_unit(F, u >> 9, (u >> 7) & 3, u & 127, args.in[I_WGATE], args.in[I_BGATE]); } while (0)
    if (IN(5)) { PHASE_BEGIN();
#if (PH_DUP >> 5) & 1
        BODY5A; xcd_barrier(bar);
#endif
#if (PH_DUP >> 13) & 1
        BODY5B; xcd_barrier(bar);
#endif
        BODY5A; BODY5B;
        SEAM(5);
    }
    if (IN(6)) { PHASE_BEGIN(); g2_scan(F); SEAM(6); }
#define BODY7A do { p7_attention(F); } while (0)
#define BODY7B do { PHASE_BEGIN(); for (int u = F.vcu; u < 1024; u += F.G) g3_unit(F, u >> 9, (u >> 7) & 3, (u & 127) + 1, args.in[I_WGATE], args.in[I_BGATE], args.in[I_GGLA]); } while (0)
    if (IN(7)) { PHASE_BEGIN();
#if (PH_DUP >> 7) & 1
        BODY7A; xcd_barrier(bar);
#endif
#if (PH_DUP >> 14) & 1
        BODY7B; xcd_barrier(bar);
#endif
#ifndef SKIP_ATT
        BODY7A;
#endif
#ifndef SKIP_G3
        BODY7B;
#endif
        SEAM(7);
    }
    if (IN(8)) { PHASE_BEGIN();
        pg8::Gemm g{(const bf16*)(F.ws + WS_MIXA), WOUT, R, DM, DM}; pg8::StaticOrder S; S.init(R, DM, F.G, (int)blockIdx.x);
        pg8::EpiStoreBf16 E{FB, DM};
        pg8::gemm_phase<pg8::EpiStoreBf16, pg8::StaticOrder, PG8_ALIGN, PG8_SP2>(F.lds, g, S, E);
        SEAM(8);
    }
    if (IN(9)) { PHASE_BEGIN(); norm_rows<1>(F, args.in[I_GMIXPOST], rstd3, nullptr, nullptr); convert_ffn(F, args.in[I_W2G], args.in[I_W2U], args.in[I_W2D], args.in[I_G2PRE], WGU, WD); SEAM(9); }
    if (IN(10)) { PHASE_BEGIN();
        pg8::Gemm g{AB, WGU, R, NGU, DM}; pg8::StaticOrder S; S.init(R, NGU, F.G, (int)blockIdx.x);
        pg8::EpiSwiGLU E{ACT, DFF, rstd3};
        pg8::gemm_phase<pg8::EpiSwiGLU, pg8::StaticOrder, PG8_ALIGN, PG8_SP2>(F.lds, g, S, E);
        SEAM(10);
    }
    if (IN(11)) { PHASE_BEGIN();
        pg8::Gemm g{ACT, WD, R, DM, DFF}; pg8::StaticOrder S; S.init(R, DM, F.G, (int)blockIdx.x);
        pg8::EpiStoreBf16 E{FB, DM};
        pg8::gemm_phase<pg8::EpiStoreBf16, pg8::StaticOrder, PG8_ALIGN, PG8_SP2>(F.lds, g, S, E);
        SEAM(11);
    }
    if (IN(12)) { PHASE_BEGIN(); norm_rows<2>(F, args.in[I_G2POST], nullptr, nullptr, nullptr); }
#undef IN
#undef SEAM
#undef AB
#undef ACT
#undef FB
#undef WGU
#undef WD
#undef WIN
#undef WOUT
#undef rstd1
#undef rstd2
#undef rstd3
}

extern "C" void kernel_launch(void* const* d_in, const int* in_sizes, int n_in, void* d_out, int out_size, void* d_ws, size_t ws_size, hipStream_t stream) {
    static int grid = 0;
    if (grid == 0) {
        if (n_in != 19 || in_sizes[0] != R * DM || out_size != R * DM || ws_size < WS_END) {
            fprintf(stderr, "kernel_launch: unexpected shapes (n_in %d, in0 %d, out %d, ws %zu; need ws >= %zu); nothing launched\n", n_in, n_in > 0 ? in_sizes[0] : -1, out_size, ws_size, (size_t)WS_END); grid = -1; return; }
        int dev = 0, cus = 0, per_cu = 0;
        if (hipGetDevice(&dev) != hipSuccess || hipDeviceGetAttribute(&cus, hipDeviceAttributeMultiprocessorCount, dev) != hipSuccess) { grid = -1; return; }
        if (hipFuncSetAttribute((const void*)hymba_fwd, hipFuncAttributeMaxDynamicSharedMemorySize, LDS_BYTES) != hipSuccess) { fprintf(stderr, "kernel_launch: hipFuncSetAttribute failed\n"); grid = -1; return; }
        if (hipOccupancyMaxActiveBlocksPerMultiprocessor(&per_cu, (const void*)hymba_fwd, NWAVES * 64, LDS_BYTES) != hipSuccess || per_cu < 1)
            fprintf(stderr, "kernel_launch: note: occupancy query reports %d workgroups per CU\n", per_cu);
        (void)hipGetLastError();
        grid = cus;
    }
    if (grid < 0) return;
    if (hipMemsetAsync((char*)d_ws + WS_CTL, 0, CTL_ZERO_BYTES, stream) != hipSuccess) return;
    Args a{};
    for (int i = 0; i < 19; ++i) a.in[i] = (const float*)d_in[i];
    a.out = (float*)d_out; a.ws = (unsigned char*)d_ws;
#if MK_PER_PHASE
    for (int p = 0; p < N_PHASES; ++p) { a.ph_lo = p; a.ph_hi = p + 1; hipLaunchKernelGGL(hymba_fwd, dim3(grid), dim3(NWAVES * 64), LDS_BYTES, stream, a); }
#else
    a.ph_lo = 0; a.ph_hi = N_PHASES;
    hipLaunchKernelGGL(hymba_fwd, dim3(grid), dim3(NWAVES * 64), LDS_BYTES, stream, a);
#endif
    const hipError_t le = hipPeekAtLastError();
    if (le != hipSuccess) fprintf(stderr, "kernel_launch: launch failed: %s\n", hipGetErrorName(le));
}
```

```cpp
#include <hip/hip_runtime.h>
#include <cstdio>
#include <cstdint>
#define MK_PER_PHASE 0
namespace pg8 {
#define PG8_LAS __attribute__((address_space(3)))
typedef unsigned short bf16_t;
typedef short bf16x8 __attribute__((ext_vector_type(8)));
typedef float f32x4 __attribute__((ext_vector_type(4)));
typedef unsigned u32x4 __attribute__((ext_vector_type(4)));
constexpr int BM = 256, BK = 64, HALF = 128, HTB = HALF * BK * 2  , STAGE_BYTES = 8 * HTB, NXCD = 8, WGM = 8;

__host__ __device__ __forceinline__ int lds_byte(int r, int c) { const int st = (r >> 4) * 2 + (c >> 5), rr = r & 15, cc = c & 31, ob = rr * 64 + cc * 2; return st * 1024 + (ob ^ (((ob >> 9) & 1) << 5)); }
__host__ __device__ __forceinline__ void stage_rc(int b, int& R, int& C) { const int st = b / 1024, sb = b % 1024, swz = sb ^ (((sb >> 9) & 1) << 5); R = (st >> 1) * 16 + swz / 64; C = (st & 1) * 32 + (swz % 64) / 2; }
__host__ __device__ __forceinline__ int perm32(int rho) { const int n = rho >> 4, i = rho & 15; return 8 * (i >> 2) + 4 * n + (i & 3); }

struct Unit { int pm, pn; };
struct Gemm { const bf16_t* A; const bf16_t* Bt; int M, N, K; };

struct StaticOrder {
    int nM, nN, nwg, G, c;
    __host__ __device__ void init(int M, int N, int G_, int c_) { nM = M / BM; nN = N / BM; nwg = nM * nN; G = G_; c = c_; }
    __host__ __device__ bool next(int i, Unit& u) const {
        const long L = (long)i * G + c; if (L >= nwg) return false;
        int wgid = (int)L; { const int q = nwg / NXCD, r = nwg % NXCD, xcd = wgid % NXCD, off = wgid / NXCD; wgid = (xcd < r ? xcd * (q + 1) : r * (q + 1) + (xcd - r) * q) + off; }
        const int nig = WGM * nN, gid = wgid / nig, fm = gid * WGM, gsz = (nM - fm) < WGM ? (nM - fm) : WGM;
        u.pm = fm + ((wgid % nig) % gsz); u.pn = (wgid % nig) / gsz; return true;
    }
    __device__ __forceinline__ void a_ready(const Unit&) const {}
    __device__ __forceinline__ void done(const Unit&) const {}
};

__device__ __forceinline__ unsigned cvt_pk_bf16(float lo, float hi) { unsigned r; asm volatile("v_cvt_pk_bf16_f32 %0, %1, %2" : "=v"(r) : "v"(lo), "v"(hi)); return r; }
typedef float f32x2 __attribute__((ext_vector_type(2)));

__device__ __forceinline__ void st8bf(bf16_t* p, const f32x4 v0, const f32x4 v1) {
    u32x4 w; w.x = cvt_pk_bf16(v0[0], v0[1]); w.y = cvt_pk_bf16(v0[2], v0[3]); w.z = cvt_pk_bf16(v1[0], v1[1]); w.w = cvt_pk_bf16(v1[2], v1[3]);
    *(u32x4*)p = w;
}
__device__ __forceinline__ float silu_f(float x) { return x * __builtin_amdgcn_rcpf(1.0f + __builtin_amdgcn_exp2f(-1.4426950408889634f * x)); }

struct EpiStoreBf16 {
    static constexpr bool PERM = true, AFTER_DRAIN = false;
    bf16_t* O; int ldc;
    __device__ __forceinline__ void operator()(const f32x4 (&acc)[2][2][4][2], const Unit& u, int wr, int wc, int fr, int fq) const {
        const int row0 = u.pm * BM + wr * 64 + fr, col0 = u.pn * BM + wc * 32 + 8 * fq;
#pragma unroll
        for (int ai = 0; ai < 2; ++ai)
#pragma unroll
            for (int m = 0; m < 4; ++m) { bf16_t* rowp = O + (size_t)(row0 + ai * HALF + m * 16) * ldc + col0;
#pragma unroll
                for (int bj = 0; bj < 2; ++bj) st8bf(rowp + bj * HALF, acc[ai][bj][m][0], acc[ai][bj][m][1]); }
    }
};
struct EpiSwiGLU {
    static constexpr bool PERM = true, AFTER_DRAIN = false;
    bf16_t* O; int ldc; const float* rstd;
    __device__ __forceinline__ void operator()(const f32x4 (&acc)[2][2][4][2], const Unit& u, int wr, int wc, int fr, int fq) const {
        const int row0 = u.pm * BM + wr * 64 + fr, col0 = u.pn * HALF + wc * 32 + 8 * fq;
#pragma unroll
        for (int ai = 0; ai < 2; ++ai)
#pragma unroll
            for (int m = 0; m < 4; ++m) { const int row = row0 + ai * HALF + m * 16; const float rs = rstd[row];
                f32x4 o0, o1;
#pragma unroll
                for (int j = 0; j < 4; ++j) { o0[j] = silu_f(acc[ai][0][m][0][j] * rs) * (acc[ai][1][m][0][j] * rs); o1[j] = silu_f(acc[ai][0][m][1][j] * rs) * (acc[ai][1][m][1][j] * rs); }
                st8bf(O + (size_t)row * ldc + col0, o0, o1); }
    }
};
struct EpiProj {
    static constexpr bool PERM = true, AFTER_DRAIN = false;
    static constexpr int TKV = 8256;
    unsigned char* ws; size_t o_rstd, o_qh, o_kh, o_vh, o_iq, o_gq, o_gk, o_gv, o_go, o_ik, o_iw, o_glow;
    __device__ __forceinline__ void operator()(const f32x4 (&acc)[2][2][4][2], const Unit& u, int wr, int wc, int fr, int fq) const {
        const float* rstd = (const float*)(ws + o_rstd);
        bf16_t* Qh = (bf16_t*)(ws + o_qh); bf16_t* Kh = (bf16_t*)(ws + o_kh); bf16_t* Vh = (bf16_t*)(ws + o_vh); bf16_t* IQ = (bf16_t*)(ws + o_iq); bf16_t* GQ = (bf16_t*)(ws + o_gq);
        bf16_t* GK = (bf16_t*)(ws + o_gk); bf16_t* GV = (bf16_t*)(ws + o_gv); bf16_t* GO = (bf16_t*)(ws + o_go); bf16_t* IK = (bf16_t*)(ws + o_ik); float* IW = (float*)(ws + o_iw); float* GLOW = (float*)(ws + o_glow);
        const int pn = u.pn;
        const int row0 = u.pm * BM + wr * 64 + fr;
#pragma unroll
        for (int ai = 0; ai < 2; ++ai)
#pragma unroll
            for (int m = 0; m < 4; ++m) {
                const int row = row0 + ai * HALF + m * 16; const float rs = rstd[row];
                const bool mainr = row < 16384, metar = (row >= 16384) && (row < 16400);
                const int b = row >> 13, s = row & 8191, mi = row - 16384;
#pragma unroll
                for (int bj = 0; bj < 2; ++bj) {
                    const int col = bj * HALF + wc * 32 + 8 * fq;
                    f32x4 v0 = acc[ai][bj][m][0] * rs, v1 = acc[ai][bj][m][1] * rs;
                    if (pn < 4) {
                        if (mainr) { const int h = pn * 2 + (col >> 7), d = col & 127; st8bf(Qh + ((size_t)(b * 8 + h) * 8192 + s) * 128 + d, v0, v1); }
                    } else if (pn < 12) {
                        bf16_t* base = pn < 8 ? Kh : Vh; const int h = (pn & 3) * 2 + (col >> 7), d = col & 127;
                        if (mainr) st8bf(base + ((size_t)(b * 8 + h) * TKV + 16 + s) * 128 + d, v0, v1);
                        else if (metar) { st8bf(base + ((size_t)h * TKV + mi) * 128 + d, v0, v1); st8bf(base + ((size_t)(8 + h) * TKV + mi) * 128 + d, v0, v1); }
                    } else if (pn < 16) {
                        if (mainr) st8bf(IQ + (size_t)row * 1024 + (pn - 12) * 256 + col, v0 * 0.125f, v1 * 0.125f);
                    } else if (pn < 18) {
                        if (mainr) st8bf(GQ + ((size_t)b * TKV + 64 + s) * 512 + (pn - 16) * 256 + col, v0 * 0.08838834764831845f, v1 * 0.08838834764831845f);
                    } else if (pn < 20) {
                        const int c = (pn - 18) * 256 + col;
                        if (mainr) st8bf(GK + ((size_t)b * TKV + 64 + s) * 512 + c, v0, v1);
                        else if (metar) { st8bf(GK + ((size_t)48 + mi) * 512 + c, v0, v1); st8bf(GK + ((size_t)TKV + 48 + mi) * 512 + c, v0, v1); }
                    } else if (pn < 24) {
                        const int c = (pn - 20) * 256 + col;
                        if (mainr) st8bf(GV + ((size_t)b * TKV + 64 + s) * 1024 + c, v0, v1);
                        else if (metar) { st8bf(GV + ((size_t)48 + mi) * 1024 + c, v0, v1); st8bf(GV + ((size_t)TKV + 48 + mi) * 1024 + c, v0, v1); }
                    } else if (pn < 28) {
                        if (mainr) st8bf(GO + (size_t)row * 1024 + (pn - 24) * 256 + col, v0, v1);
                    } else {
                        if (col < 64) {
                            const int ch = col >> 3, fo = (ch >> 1) * 512 + (ch & 1) * 256;
                            if (mainr) { const int pos = 16 + s; st8bf(IK + (size_t)b * TKV * 64 + (size_t)(pos >> 5) * 2048 + fo + (pos & 31) * 8, v0, v1); }
                            else if (metar) { st8bf(IK + fo + mi * 8, v0, v1); st8bf(IK + (size_t)TKV * 64 + fo + mi * 8, v0, v1); }
                        } else if (col < 80) {
                            if (mainr) { float* p = IW + (size_t)row * 16 + (col - 64); *(f32x4*)p = v0 * 0.25f; *(f32x4*)(p + 4) = v1 * 0.25f; }
                        } else if (col < 96) {
                            const int c = col - 80;
                            if (mainr) { float* p = GLOW + ((size_t)b * TKV + 64 + s) * 16 + c; *(f32x4*)p = v0; *(f32x4*)(p + 4) = v1; }
                            else if (metar) { float* p = GLOW + ((size_t)48 + mi) * 16 + c; *(f32x4*)p = v0; *(f32x4*)(p + 4) = v1;
                                              float* p2 = GLOW + ((size_t)TKV + 48 + mi) * 16 + c; *(f32x4*)p2 = v0; *(f32x4*)(p2 + 4) = v1; }
                        }
                    }
                }
            }
    }
};
template <class Epi, class Sched, bool ALIGN_EPI = false, bool SP2 = false>
__device__ __forceinline__ void gemm_phase(PG8_LAS unsigned char* lds, const Gemm g, const Sched& S, const Epi& E) {
    const int tid = threadIdx.x, wid = __builtin_amdgcn_readfirstlane(tid >> 6), lane = tid & 63, wr = wid >> 2, wc = wid & 3, fr = lane & 15, fq = lane >> 4;
    const int K = g.K, nt = K / BK;
    unsigned voffA[2], voffB[2];
#pragma unroll
    for (int i = 0; i < 2; ++i) { int R, C; stage_rc(tid * 16 + i * 8192, R, C); const int Rb = Epi::PERM ? ((R & ~31) + perm32(R & 31)) : R;
        voffA[i] = (unsigned)(R * K + C) * 2u; voffB[i] = (unsigned)(Rb * K + C) * 2u; }
    const size_t kstep = (size_t)(BK * 2);
    const size_t hstep = (size_t)HALF * K * 2;
    const size_t tstep = 2 * hstep;
    const unsigned ldsw = (unsigned)wid * 1024u;
    const int aoff = lds_byte(wr * 64 + fr, fq * 8), boff = lds_byte(wc * 32 + fr, fq * 8);
#define PG8_SA(b, h) (((b) * 2 + (h)) * HTB)
#define PG8_SB(b, h) ((4 + (b) * 2 + (h)) * HTB)
#define PG8_STAGE(bufoff, gbase, voff) do { _Pragma("unroll") for (int _i = 0; _i < 2; ++_i) \
        __builtin_amdgcn_global_load_lds((const unsigned*)((const char*)(gbase) + (voff)[_i]), (PG8_LAS unsigned*)(lds + (bufoff) + ldsw + _i * 8192), 16, 0, 0); } while (0)
#define PG8_LDA(dst, b, h) do { _Pragma("unroll") for (int m = 0; m < 4; ++m) _Pragma("unroll") for (int k = 0; k < 2; ++k) dst[m][k] = *(const PG8_LAS bf16x8*)(lds + PG8_SA(b, h) + aoff + m * 2048 + k * 1024); } while (0)
#define PG8_LDB(dst, b, h) do { _Pragma("unroll") for (int n = 0; n < 2; ++n) _Pragma("unroll") for (int k = 0; k < 2; ++k) dst[n][k] = *(const PG8_LAS bf16x8*)(lds + PG8_SB(b, h) + boff + n * 2048 + k * 1024); } while (0)
#define PG8_MMA(ai, bj, At, Bt) do { __builtin_amdgcn_s_setprio(1); _Pragma("unroll") for (int m = 0; m < 4; ++m) _Pragma("unroll") for (int n = 0; n < 2; ++n) _Pragma("unroll") for (int k = 0; k < 2; ++k) \
        acc[ai][bj][m][n] = __builtin_amdgcn_mfma_f32_16x16x32_bf16(Bt[n][k], At[m][k], acc[ai][bj][m][n], 0, 0, 0); __builtin_amdgcn_s_setprio(0); } while (0)
#define PG8_WAIT_V(n) asm volatile("s_waitcnt vmcnt(" #n ")" ::: "memory")
#define PG8_WAIT_L(n) asm volatile("s_waitcnt lgkmcnt(" #n ")" ::: "memory")
#define PG8_BAR __builtin_amdgcn_s_barrier()
#define PG8_SCHED __builtin_amdgcn_sched_barrier(0)
    Unit cur, nxt; int ui = 0;
    if (!S.next(0, cur)) return;
    f32x4 acc[2][2][4][2];
#pragma unroll
    for (int a = 0; a < 2; ++a)
#pragma unroll
        for (int b = 0; b < 2; ++b)
#pragma unroll
            for (int m = 0; m < 4; ++m)
#pragma unroll
                for (int n = 0; n < 2; ++n) acc[a][b][m][n] = (f32x4){0.f, 0.f, 0.f, 0.f};
    bf16x8 At[4][2], B0[2][2], B1[2][2];
    const char* cA = (const char*)g.A + (size_t)cur.pm * tstep; const char* cB = (const char*)g.Bt + (size_t)cur.pn * tstep;
    S.a_ready(cur);
    if constexpr (SP2) {
        PG8_STAGE(PG8_SB(0, 0), cB, voffB); PG8_STAGE(PG8_SB(0, 1), cB + hstep, voffB); PG8_STAGE(PG8_SA(0, 0), cA, voffA); PG8_STAGE(PG8_SA(0, 1), cA + hstep, voffA);
        if (wr == 1) PG8_BAR;
        PG8_WAIT_V(2); PG8_BAR;
        PG8_STAGE(PG8_SB(1, 0), cB + kstep, voffB); PG8_STAGE(PG8_SA(1, 0), cA + kstep, voffA); PG8_STAGE(PG8_SB(1, 1), cB + hstep + kstep, voffB);
        PG8_WAIT_V(6); PG8_BAR;
    } else {
        PG8_STAGE(PG8_SB(0, 0), cB, voffB); PG8_STAGE(PG8_SA(0, 0), cA, voffA); PG8_STAGE(PG8_SB(0, 1), cB + hstep, voffB); PG8_STAGE(PG8_SA(0, 1), cA + hstep, voffA);
        if (wr == 1) PG8_BAR;
        PG8_WAIT_V(4); PG8_BAR;
        PG8_STAGE(PG8_SB(1, 0), cB + kstep, voffB); PG8_STAGE(PG8_SA(1, 0), cA + kstep, voffA); PG8_STAGE(PG8_SB(1, 1), cB + hstep + kstep, voffB);
        PG8_WAIT_V(6); PG8_BAR;
    }
    for (;;) {
        const bool has_next = S.next(ui + 1, nxt);
        const char* nA = has_next ? (const char*)g.A + (size_t)nxt.pm * tstep : cA; const char* nB = has_next ? (const char*)g.Bt + (size_t)nxt.pn * tstep : cB;
        for (int t = 0; t < nt; t += 2) {
            const bool last = (t == nt - 2);
            const char* a1 = cA + (size_t)(t + 1) * kstep;
            const char* a2 = last ? nA : cA + (size_t)(t + 2) * kstep; const char* b2 = last ? nB : cB + (size_t)(t + 2) * kstep;
            const char* a3 = a2 + kstep; const char* b3 = b2 + kstep;
            if (last && has_next) S.a_ready(nxt);
            if constexpr (SP2) {
            PG8_LDB(B0, 0, 0); PG8_LDB(B1, 0, 1); PG8_SCHED; PG8_LDA(At, 0, 0); PG8_STAGE(PG8_SA(1, 1), a1 + hstep, voffA);
            PG8_WAIT_V(8); PG8_WAIT_L(0); PG8_BAR; PG8_MMA(0, 0, At, B0); PG8_MMA(0, 1, At, B1); PG8_BAR; PG8_SCHED;
            PG8_LDA(At, 0, 1); PG8_STAGE(PG8_SB(0, 0), b2, voffB); PG8_STAGE(PG8_SB(0, 1), b2 + hstep, voffB); PG8_STAGE(PG8_SA(0, 0), a2, voffA);
            PG8_WAIT_V(8); PG8_WAIT_L(0); PG8_BAR; PG8_MMA(1, 0, At, B0); PG8_MMA(1, 1, At, B1); PG8_BAR; PG8_SCHED;
            PG8_LDB(B0, 1, 0); PG8_LDB(B1, 1, 1); PG8_SCHED; PG8_LDA(At, 1, 0); PG8_STAGE(PG8_SA(0, 1), a2 + hstep, voffA);
            PG8_WAIT_V(8); PG8_WAIT_L(0); PG8_BAR; PG8_MMA(0, 0, At, B0); PG8_MMA(0, 1, At, B1); PG8_BAR; PG8_SCHED;
            PG8_LDA(At, 1, 1); PG8_STAGE(PG8_SB(1, 0), b3, voffB); PG8_STAGE(PG8_SB(1, 1), b3 + hstep, voffB); PG8_STAGE(PG8_SA(1, 0), a3, voffA);
            PG8_WAIT_V(8); PG8_WAIT_L(0); PG8_BAR; PG8_MMA(1, 0, At, B0); PG8_MMA(1, 1, At, B1); PG8_BAR; PG8_SCHED;
            } else {
            PG8_LDB(B0, 0, 0); PG8_SCHED; PG8_LDA(At, 0, 0); PG8_STAGE(PG8_SA(1, 1), a1 + hstep, voffA);
            PG8_WAIT_L(8); PG8_BAR; PG8_WAIT_L(0); PG8_MMA(0, 0, At, B0); PG8_BAR; PG8_SCHED;
            PG8_LDB(B1, 0, 1); PG8_STAGE(PG8_SB(0, 0), b2, voffB);
            PG8_BAR; PG8_WAIT_L(0); PG8_MMA(0, 1, At, B1); PG8_BAR;
            PG8_LDA(At, 0, 1); PG8_STAGE(PG8_SA(0, 0), a2, voffA);
            PG8_BAR; PG8_WAIT_L(0); PG8_MMA(1, 0, At, B0); PG8_BAR; PG8_SCHED;
            PG8_STAGE(PG8_SB(0, 1), b2 + hstep, voffB);
            PG8_WAIT_V(6); PG8_BAR; PG8_MMA(1, 1, At, B1); PG8_BAR;
            PG8_LDB(B0, 1, 0); PG8_SCHED; PG8_LDA(At, 1, 0); PG8_STAGE(PG8_SA(0, 1), a2 + hstep, voffA);
            PG8_WAIT_L(8); PG8_BAR; PG8_WAIT_L(0); PG8_MMA(0, 0, At, B0); PG8_BAR; PG8_SCHED;
            PG8_LDB(B1, 1, 1); PG8_STAGE(PG8_SB(1, 0), b3, voffB);
            PG8_BAR; PG8_WAIT_L(0); PG8_MMA(0, 1, At, B1); PG8_BAR;
            PG8_LDA(At, 1, 1); PG8_STAGE(PG8_SA(1, 0), a3, voffA);
            PG8_BAR; PG8_WAIT_L(0); PG8_MMA(1, 0, At, B0); PG8_BAR; PG8_SCHED;
            PG8_STAGE(PG8_SB(1, 1), b3 + hstep, voffB);
            PG8_WAIT_V(6); PG8_BAR; PG8_MMA(1, 1, At, B1); PG8_BAR;
            }
        }
        if constexpr (ALIGN_EPI) { if (wr == 0) PG8_BAR; }
        if constexpr (!Epi::AFTER_DRAIN) { E(acc, cur, wr, wc, fr, fq); S.done(cur); }
        if (!has_next) break;
#pragma unroll
        for (int a = 0; a < 2; ++a)
#pragma unroll
            for (int b = 0; b < 2; ++b)
#pragma unroll
                for (int m = 0; m < 4; ++m)
#pragma unroll
                    for (int n = 0; n < 2; ++n) acc[a][b][m][n] = (f32x4){0.f, 0.f, 0.f, 0.f};
        cur = nxt; cA = nA; cB = nB; ++ui;
        if constexpr (ALIGN_EPI) { if (wr == 1) PG8_BAR; }
    }
    PG8_WAIT_V(0);
    if constexpr (!ALIGN_EPI) { if (wr == 0) PG8_BAR; }
    PG8_BAR;
    if constexpr (Epi::AFTER_DRAIN) { E.fused(acc, cur, wr, wc, fr, fq, lds, wid, lane); S.done(cur); }
#undef PG8_SA
#undef PG8_SB
#undef PG8_STAGE
#undef PG8_LDA
#undef PG8_LDB
#undef PG8_MMA
#undef PG8_WAIT_V
#undef PG8_WAIT_L
#undef PG8_BAR
#undef PG8_SCHED
}
}

namespace att {
typedef unsigned short bf16;
typedef short bf16x8 __attribute__((ext_vector_type(8)));
typedef short s16x4 __attribute__((ext_vector_type(4)));
typedef float f32x16 __attribute__((ext_vector_type(16)));
typedef float f32x4 __attribute__((ext_vector_type(4)));
typedef unsigned u32x4 __attribute__((ext_vector_type(4)));
typedef unsigned long long u64;
constexpr int HD = 128, NW = 8, QBLK = 32, KVBLK = 64, QB = NW * QBLK;
constexpr int SHM_V = KVBLK * HD * 2, SHM_K = KVBLK * HD * 2;
constexpr int ATT_LDS_BYTES = 2 * SHM_V + 2 * SHM_K + NW * 64 * 4;
constexpr float SCALE = 0.08838834764831845f;
constexpr float THR = 8.f;
constexpr int OSTR = 2048;
constexpr int MWORDS = 130;

#define KSWZ(row, colB) ((row) * 256 + ((colB) ^ (((row) & 7) << 4)))
#define SBAR() __builtin_amdgcn_sched_barrier(0)
__device__ __forceinline__ int v_st(int k, int c) { const int kk = (k & ~0xC) | ((k & 4) << 1) | ((k & 8) >> 1); return ((kk >> 3) * 4 + (c >> 5)) * 512 + ((kk & 7) * 32 + (c & 31)) * 2; }
__device__ __forceinline__ int v_rd_base(int lane) { return ((lane & 3) << 3) | (((lane >> 2) & 3) << 6) | (((lane >> 4) & 1) << 5) | (((lane >> 5) & 1) << 8); }
constexpr int v_rd_off(int d0, int ks, int half) { return d0 * 512 + ks * 4096 + half * 2048; }
__device__ __forceinline__ int crow(int r, int hi) { return (r & 3) + 8 * (r >> 2) + 4 * hi; }
__device__ __forceinline__ unsigned cvtpk(float lo, float hi) {
    unsigned r; asm volatile("v_cvt_pk_bf16_f32 %0, %1, %2" : "=v"(r) : "v"(lo), "v"(hi)); return r;
}
__device__ __forceinline__ bf16x8 load8(const bf16* p) { return *reinterpret_cast<const bf16x8*>(p); }
__device__ __forceinline__ void mask_bits(f32x16& p0, f32x16& p1, unsigned mw) {
    const float NEG = -__builtin_inff();
#pragma unroll
    for (int r = 0; r < 16; ++r) {
        if (!((mw >> r) & 1u)) p0[r] = NEG;
        if (!((mw >> (16 + r)) & 1u)) p1[r] = NEG;
    }
}
__device__ __forceinline__ void partialSM(f32x16& p0, f32x16& p1, float& m_reg, float& mn, float& alpha) {
    float pmax = p0[0]; for (int r = 1; r < 16; ++r) pmax = fmaxf(pmax, p0[r]); for (int r = 0; r < 16; ++r) pmax = fmaxf(pmax, p1[r]);
    { auto rr = __builtin_amdgcn_permlane32_swap(__float_as_uint(pmax), __float_as_uint(pmax), false, false);
      pmax = fmaxf(__uint_as_float(rr[0]), __uint_as_float(rr[1])); }
    constexpr float C2 = 1.4426950408889634f * SCALE;
    if (__builtin_expect(__all((pmax - m_reg) * SCALE <= THR), 1)) { mn = m_reg; alpha = 1.f; }
    else { mn = fmaxf(m_reg, pmax); alpha = __builtin_amdgcn_exp2f((m_reg - mn) * C2); m_reg = mn; }
    const float mnL = -mn * C2;
    for (int r = 0; r < 16; ++r) p0[r] = fmaf(p0[r], C2, mnL); for (int r = 0; r < 16; ++r) p1[r] = fmaf(p1[r], C2, mnL);
    for (int r = 0; r < 16; ++r) p0[r] = __builtin_amdgcn_exp2f(p0[r]);
}
__device__ __forceinline__ void finishSM(f32x16& p0, f32x16& p1, float alpha, float& l_reg, bf16x8& pa0, bf16x8& pa1, bf16x8& pa2, bf16x8& pa3) {
    for (int r = 0; r < 16; ++r) p1[r] = __builtin_amdgcn_exp2f(p1[r]);
    float ps = 0; for (int r = 0; r < 16; ++r) ps += p0[r]; for (int r = 0; r < 16; ++r) ps += p1[r];
    { auto rr = __builtin_amdgcn_permlane32_swap(__float_as_uint(ps), __float_as_uint(ps), false, false);
      ps = __uint_as_float(rr[0]) + __uint_as_float(rr[1]); }
    l_reg = l_reg * alpha + ps;
#define PK4(P, B_, OUT) do { unsigned a0 = cvtpk(P[B_+0], P[B_+1]), a1 = cvtpk(P[B_+2], P[B_+3]);                          \
        unsigned b0 = cvtpk(P[B_+4], P[B_+5]), b1 = cvtpk(P[B_+6], P[B_+7]);                                             \
        auto r0 = __builtin_amdgcn_permlane32_swap(a0, b0, false, false); auto r1 = __builtin_amdgcn_permlane32_swap(a1, b1, false, false); \
        u32x4 w = {r0[0], r1[0], r0[1], r1[1]}; OUT = *reinterpret_cast<bf16x8*>(&w); } while (0)
    PK4(p0, 0, pa0); PK4(p0, 8, pa1); PK4(p1, 0, pa2); PK4(p1, 8, pa3);
#undef PK4
}
template <int KB>
__device__ __forceinline__ void qkt(f32x16& p0, f32x16& p1, const char* K_lds, int r32, int hi, const bf16x8* qr) {
    p0 = f32x16{}; p1 = f32x16{};
    const char* kb[4];
#pragma unroll
    for (int dd = 0; dd < 4; ++dd) kb[dd] = K_lds + KB * SHM_K + KSWZ(r32, (dd * 16 + hi * 8) * 2);
#pragma unroll
    for (int d0 = 0; d0 < 8; ++d0) { const char* a = kb[d0 & 3] + (d0 >> 2) * 128;
        bf16x8 b0 = *reinterpret_cast<const bf16x8*>(a);
        bf16x8 b1 = *reinterpret_cast<const bf16x8*>(a + 32 * 256);
        p0 = __builtin_amdgcn_mfma_f32_32x32x16_bf16(b0, qr[d0], p0, 0, 0, 0);
        p1 = __builtin_amdgcn_mfma_f32_32x32x16_bf16(b1, qr[d0], p1, 0, 0, 0); }
}
template <int VB>
__device__ __forceinline__ void pv_tile(f32x16* o, int vb0, bf16x8 pa0, bf16x8 pa1, bf16x8 pa2, bf16x8 pa3) {
#define TRRD(dst, off) asm volatile("ds_read_b64_tr_b16 %0, %1 offset:%2" : "=&v"(dst) : "v"(vb0), "i"(off) : "memory")
#define PV_D0(d0) do { s16x4 l0, l1, l2, l3, h0, h1, h2, h3; constexpr int b_ = VB * SHM_V + v_rd_off(d0, 0, 0);     \
        TRRD(l0, b_); TRRD(h0, b_ + 2048); TRRD(l1, b_ + 4096); TRRD(h1, b_ + 6144); TRRD(l2, b_ + 8192); TRRD(h2, b_ + 10240); TRRD(l3, b_ + 12288); TRRD(h3, b_ + 14336); \
        asm volatile("s_waitcnt lgkmcnt(0)" ::: "memory"); SBAR();             \
        o[d0] = __builtin_amdgcn_mfma_f32_32x32x16_bf16(pa0, (bf16x8){l0[0], l0[1], l0[2], l0[3], h0[0], h0[1], h0[2], h0[3]}, o[d0], 0, 0, 0);   \
        o[d0] = __builtin_amdgcn_mfma_f32_32x32x16_bf16(pa1, (bf16x8){l1[0], l1[1], l1[2], l1[3], h1[0], h1[1], h1[2], h1[3]}, o[d0], 0, 0, 0);   \
        o[d0] = __builtin_amdgcn_mfma_f32_32x32x16_bf16(pa2, (bf16x8){l2[0], l2[1], l2[2], l2[3], h2[0], h2[1], h2[2], h2[3]}, o[d0], 0, 0, 0);   \
        o[d0] = __builtin_amdgcn_mfma_f32_32x32x16_bf16(pa3, (bf16x8){l3[0], l3[1], l3[2], l3[3], h3[0], h3[1], h3[2], h3[3]}, o[d0], 0, 0, 0); } while (0)
    PV_D0(0); PV_D0(1); PV_D0(2); PV_D0(3);
#undef PV_D0
#undef TRRD
}

struct BlockRef { const bf16* Q; const bf16* K; const bf16* V; bf16* O; const u64* M; int NT; };
struct Seam { bf16x8 qr[8]; bf16x8 st_v0, st_v1, st_k0, st_k1; };
#define VMW() asm volatile("s_waitcnt vmcnt(0)" ::: "memory")
#define VMWN(n) asm volatile("s_waitcnt vmcnt(%0)" :: "i"(n) : "memory")
#define SLOAD_H(Kp, Vp, k0) do { int t_ = tid; asm volatile("" : "+v"(t_)); const unsigned go_ = (unsigned)((k0) * (HD * 2)) + (unsigned)t_ * 16u;               \
                         S.st_v0 = load8((const bf16*)((const char*)(Vp) + go_)); S.st_v1 = load8((const bf16*)((const char*)(Vp) + (go_ + 8192u)));              \
                         S.st_k0 = load8((const bf16*)((const char*)(Kp) + go_)); S.st_k1 = load8((const bf16*)((const char*)(Kp) + (go_ + 8192u))); } while (0)
#define SWRITE_HK(bf) do { int t_ = tid; asm volatile("" : "+v"(t_)); const int sr_ = t_ >> 4, sc_ = (t_ & 15) * 8, kws_ = KSWZ(sr_, sc_ * 2);                      \
                         *(bf16x8*)(K_lds + (bf) * SHM_K + kws_) = S.st_k0; *(bf16x8*)(K_lds + (bf) * SHM_K + kws_ + 32 * 256) = S.st_k1; } while (0)
#define SWRITE_HV(bf) do { int t_ = tid; asm volatile("" : "+v"(t_)); const int sr_ = t_ >> 4, sc_ = (t_ & 15) * 8, vs_ = v_st(sr_, sc_);                            \
                         *(bf16x8*)(V_lds + (bf) * SHM_V + vs_) = S.st_v0; *(bf16x8*)(V_lds + (bf) * SHM_V + vs_ + 8192) = S.st_v1; } while (0)
#define SWRITE_H(bf) do { SWRITE_HV(bf); SWRITE_HK(bf); } while (0)
__device__ __forceinline__ void att_prime(const BlockRef& cur, char* lds, Seam& S) {
    const int tid = threadIdx.x, wid = __builtin_amdgcn_readfirstlane(tid >> 6), lane = tid & 63, r32 = lane & 31, hi = lane >> 5;
    char* K_lds = lds + 2 * SHM_V;
#pragma unroll
    for (int d0 = 0; d0 < 8; ++d0) S.qr[d0] = load8((const bf16*)((const char*)cur.Q + (unsigned)(((wid * QBLK + r32) * HD + hi * 8) * 2 + d0 * 32)));
    SLOAD_H(cur.K, cur.V, 0); VMW(); SWRITE_HK(0);
    __syncthreads();
}
__device__ __forceinline__ void att_block(const BlockRef& cur, const BlockRef& nxt, char* lds, Seam& S) {
    const int tid = threadIdx.x, wid = __builtin_amdgcn_readfirstlane(tid >> 6), lane = tid & 63, r32 = lane & 31, hi = lane >> 5;
    const int NT = cur.NT;
    char* V_lds = lds; char* K_lds = lds + 2 * SHM_V;
    float* ws = (float*)(lds + 2 * SHM_V + 2 * SHM_K) + wid * 64; float* li_l = ws, * al_l = ws + 32;
    float m_reg = -1e30f, l_reg = 0; f32x16 o[4] = {};
    const int vb0 = (int)(uintptr_t)V_lds + v_rd_base(lane);
    const bf16* Kh = cur.K; const bf16* Vh = cur.V;
    const char* Mb = (const char*)cur.M; const unsigned moff = (unsigned)((wid * QBLK + r32) * (MWORDS * 8) + hi * 4);
#define MLOAD(t) (*(const unsigned*)(Mb + (moff + (unsigned)(t) * 8u)))
    unsigned mwA = MLOAD(0), mwB = 0u;
#define RESC(a) do { if (__any((a) < 1.f)) { if (hi == 0) al_l[r32] = (a); asm volatile("s_waitcnt lgkmcnt(0)" ::: "memory");              \
                     for (int d_ = 0; d_ < 4; ++d_) for (int r = 0; r < 16; ++r) o[d_][r] *= al_l[crow(r, hi)]; } } while (0)
#define KBASE(t) ((t) * KVBLK)
    constexpr int NQL = 8;
#define SEAM_K0() do { VMWN(NQL); SWRITE_HK(0); SBAR(); } while (0)
    f32x16 pA0, pA1, pB0, pB1; float mnA, mnB, alA, alB; bf16x8 pa0, pa1, pa2, pa3;
    SWRITE_HV(0); SBAR();
    if (NT > 1) { SLOAD_H(Kh, Vh, KBASE(1)); }
    SBAR(); qkt<0>(pA0, pA1, K_lds, r32, hi, S.qr);
    mask_bits(pA0, pA1, mwA); partialSM(pA0, pA1, m_reg, mnA, alA);
    if (NT > 1) { VMW(); SWRITE_H(1); }
    __syncthreads();
#define HALF_STEP(PX0, PX1, mnX, alX, PY0, PY1, alY, t, KB, VB, SB, MWX, MWY) do {                                             \
        MWX = MLOAD(t);                                                                                                       \
        SBAR(); qkt<KB>(PX0, PX1, K_lds, r32, hi, S.qr);                                                                      \
        finishSM(PY0, PY1, alY, l_reg, pa0, pa1, pa2, pa3); SBAR();                                                           \
        if ((t) + 1 < NT) { SLOAD_H(Kh, Vh, KBASE((t) + 1)); SBAR(); }                                                        \
        pv_tile<VB>(o, vb0, pa0, pa1, pa2, pa3); mask_bits(PX0, PX1, MWX); partialSM(PX0, PX1, m_reg, mnX, alX);          \
        __syncthreads();                                                                                                      \
        if ((t) + 1 < NT) { VMW(); SWRITE_H(SB); }                                                                            \
        RESC(alX); __syncthreads(); } while (0)
    for (int t = 1; t + 1 < NT; t += 2) {
        HALF_STEP(pB0, pB1, mnB, alB, pA0, pA1, alA, t, 1, 0, 0, mwB, mwA);
        HALF_STEP(pA0, pA1, mnA, alA, pB0, pB1, alB, t + 1, 0, 1, 1, mwA, mwB);
    }
    const bool even = (NT & 1) == 0;
    if (even) { mwB = MLOAD(NT - 1); SBAR(); qkt<1>(pB0, pB1, K_lds, r32, hi, S.qr); SBAR(); }
    SLOAD_H(nxt.K, nxt.V, 0); SBAR();
#pragma unroll
    for (int d0 = 0; d0 < 8; ++d0) S.qr[d0] = load8((const bf16*)((const char*)nxt.Q + (unsigned)(((wid * QBLK + r32) * HD + hi * 8) * 2 + d0 * 32)));
    SBAR();
    finishSM(pA0, pA1, alA, l_reg, pa0, pa1, pa2, pa3); SBAR();
    pv_tile<0>(o, vb0, pa0, pa1, pa2, pa3);
    if (even) { mask_bits(pB0, pB1, mwB); partialSM(pB0, pB1, m_reg, mnB, alB); __syncthreads(); RESC(alB);
        finishSM(pB0, pB1, alB, l_reg, pa0, pa1, pa2, pa3); SBAR(); pv_tile<1>(o, vb0, pa0, pa1, pa2, pa3); }
    SBAR(); SEAM_K0();
    if (hi == 0) li_l[r32] = l_reg; asm volatile("s_waitcnt lgkmcnt(0)" ::: "memory");
    float rli[16];
#pragma unroll
    for (int r = 0; r < 16; ++r) rli[r] = __builtin_amdgcn_rcpf(li_l[crow(r, hi)]);
    char* Owb = (char*)(cur.O + (size_t)(wid * QBLK) * OSTR);
    int hi_e = hi, r32_e = r32; asm volatile("" : "+v"(hi_e), "+v"(r32_e));
    const unsigned lane_off = (unsigned)(4 * hi_e * OSTR + r32_e) * 2u;
#pragma unroll
    for (int r = 0; r < 16; ++r) { constexpr int dummy = 0; (void)dummy; const unsigned rowb = (unsigned)(((r & 3) + 8 * (r >> 2)) * OSTR * 2);
#pragma unroll
        for (int d0 = 0; d0 < 4; ++d0) { const float v = o[d0][r] * rli[r];
            const float vn = __shfl_xor(v, 1);
            if ((r32 & 1) == 0) *(unsigned*)(Owb + rowb + d0 * 64 + lane_off) = cvtpk(v, vn); } }
    __syncthreads();
#undef RESC
#undef KBASE
#undef SEAM_K0
#undef HALF_STEP
#undef MLOAD
}
#undef VMW
#undef VMWN
#undef SLOAD_H
#undef SWRITE_HK
#undef SWRITE_HV
#undef SWRITE_H
#undef KSWZ
#undef SBAR
}

constexpr int NWAVES = 8;
#ifndef MK_PER_PHASE
#define MK_PER_PHASE 0
#endif
constexpr int N_PHASES = 13;

constexpr int DM = 2048, SEQ = 8192, NBATCH = 2, NMETA = 16, DFF = 5632;
constexpr int R = NBATCH * SEQ;
constexpr int RP = 16640;
constexpr int TKV = 8256;
constexpr int NPROJ = 7424;
constexpr int NGU = 2 * DFF;
constexpr float EPS = 1e-6f;

constexpr size_t MiB = 1u << 20;
constexpr size_t WS_CTL = 0, CTL_ZERO_BYTES = 1 * MiB;
constexpr size_t WS_AB = 1 * MiB;
constexpr size_t WS_WB = 66 * MiB;
constexpr size_t WS_WGU = WS_WB, WS_WD = WS_WB + 44 * MiB, WS_WIN = WS_WB, WS_WOUT = WS_WB + 29 * MiB, WS_MASK = WS_WB + 40 * MiB;
constexpr size_t WS_SMALL = 132 * MiB;
constexpr size_t WS_RSTD1 = WS_SMALL, WS_RSTD2 = WS_SMALL + 128 * 1024, WS_RSTD3 = WS_SMALL + 256 * 1024, WS_DEC = WS_SMALL + 384 * 1024;
constexpr size_t WS_ACT = 133 * MiB;
constexpr size_t WS_F = 312 * MiB;
constexpr size_t WS_MIXA = 133 * MiB;
constexpr size_t WS_QH = 197 * MiB;
constexpr size_t WS_KH = 229 * MiB, WS_VH = 262 * MiB;
constexpr size_t WS_IQ = 295 * MiB;
constexpr size_t WS_GQ = 327 * MiB, WS_GK = 344 * MiB;
constexpr size_t WS_GV = 361 * MiB;
constexpr size_t WS_GO = 394 * MiB;
constexpr size_t WS_IK = 426 * MiB;
constexpr size_t WS_IW = 429 * MiB;
constexpr size_t WS_GLOW = 430 * MiB;
constexpr size_t WS_ST = 432 * MiB;
constexpr size_t WS_END = 496 * MiB;
constexpr int CW_BAR = 4096;

constexpr int SCR_BYTES = 147456;
constexpr int MISC_OFF = SCR_BYTES;
constexpr int LDS_BYTES = SCR_BYTES + 2048;

#define GAS __attribute__((address_space(1)))
#define LAS __attribute__((address_space(3)))
typedef unsigned short bf16;
typedef unsigned v4u __attribute__((ext_vector_type(4)));
typedef unsigned v2u __attribute__((ext_vector_type(2)));
typedef float f32x4 __attribute__((ext_vector_type(4)));
typedef float f32x16 __attribute__((ext_vector_type(16)));
typedef short bf16x8 __attribute__((ext_vector_type(8)));
typedef unsigned long long u64;
typedef GAS unsigned gu32;
#define RLX_AGENT __ATOMIC_RELAXED, __HIP_MEMORY_SCOPE_AGENT
#define LDS_WAIT() asm volatile("s_waitcnt lgkmcnt(0)" ::: "memory")
#define VM_WAIT() asm volatile("s_waitcnt vmcnt(0)" ::: "memory")
__device__ __forceinline__ unsigned f2bf(float f) { unsigned u = __builtin_bit_cast(unsigned, f); return (u + 0x7fffu + ((u >> 16) & 1u)) >> 16; }
__device__ __forceinline__ unsigned pk2(float lo, float hi) { return f2bf(lo) | (f2bf(hi) << 16); }
__device__ __forceinline__ float bf2f(unsigned short b) { return __builtin_bit_cast(float, (unsigned)b << 16); }
__device__ __forceinline__ float bflo(unsigned w) { return __builtin_bit_cast(float, w << 16); }
__device__ __forceinline__ float bfhi(unsigned w) { return __builtin_bit_cast(float, w & 0xffff0000u); }
#define XB_TMO      128
#define XB_XCNT(j)  (256  + 64 * (j))
#define XB_XSUB(j)  (1280 + 64 * (j))
#define XB_XGEN(j)  (2304 + 64 * (j))
#define XB_TOP      3328
#define XB_TOPGEN   3392
#define XCD_BAR_WORDS 3456
#define XB_SPIN_CAP (1u << 22)

__device__ __forceinline__ unsigned xb_ld(unsigned* p)              { return __hip_atomic_load(p, __ATOMIC_RELAXED, __HIP_MEMORY_SCOPE_AGENT); }
__device__ __forceinline__ unsigned xb_add(unsigned* p, unsigned v) { return __hip_atomic_fetch_add(p, v, __ATOMIC_RELAXED, __HIP_MEMORY_SCOPE_AGENT); }
__device__ __forceinline__ unsigned xb_xcc_id() { return (unsigned)__builtin_amdgcn_s_getreg((3 << 11) | 20) & 0xFu; }
#define XB_SPIN(cond, bar) do { unsigned _sp = 0; while (cond) { __builtin_amdgcn_s_sleep(1); \
    if ((++_sp & 255u) == 0u) { if (xb_ld(&(bar)[XB_TMO])) break; if (_sp > XB_SPIN_CAP) { atomicAdd(&(bar)[XB_TMO], 1u); break; } } } } while (0)

struct XcdBarrier {
    unsigned* bar; unsigned x;
    volatile LAS unsigned* st;
};

__device__ __forceinline__ XcdBarrier xcd_barrier_post(unsigned* bar, volatile LAS unsigned* st) {
    XcdBarrier b; b.bar = bar; b.x = xb_xcc_id(); b.st = st;
    if (threadIdx.x == 0) (void)xb_add(&bar[XB_XCNT(b.x)], 1u);
    return b;
}
__device__ __forceinline__ void xcd_barrier_complete(unsigned* bar, unsigned x, unsigned& nloc, unsigned& nx) {
    const unsigned G = gridDim.x * gridDim.y * gridDim.z;
    unsigned sum, cnt, mine, sp = 0u;
    for (;;) {
        sum = 0u; cnt = 0u; mine = 0u;
#pragma unroll
        for (unsigned j = 0; j < 16; ++j) { const unsigned c = xb_ld(&bar[XB_XCNT(j)]); sum += c; cnt += (c > 0u) ? 1u : 0u; mine = (j == x) ? c : mine; }
        if (sum == G) break;
        __builtin_amdgcn_s_sleep(1);
        if ((++sp & 255u) == 0u) { if (xb_ld(&bar[XB_TMO])) break; if (sp > XB_SPIN_CAP) { atomicAdd(&bar[XB_TMO], 1u); break; } }
    }
    nloc = mine > 0u ? mine : 1u; nx = cnt > 0u ? cnt : 1u;
}

__device__ __forceinline__ void xcd_barrier(const XcdBarrier& b) {
    asm volatile("s_waitcnt vmcnt(0)" ::: "memory");
    __syncthreads();
    if (threadIdx.x == 0) {
        unsigned* bar = b.bar;
        __builtin_amdgcn_s_waitcnt(0);
        unsigned nloc = b.st[0], nx = b.st[1];
        if (nloc == 0u) { xcd_barrier_complete(bar, b.x, nloc, nx); b.st[0] = nloc; b.st[1] = nx; }
        const unsigned old = xb_add(&bar[XB_XSUB(b.x)], 1u);
        const unsigned gen = old / nloc;
        if (old + 1u == (gen + 1u) * nloc) {
            __builtin_amdgcn_fence(__ATOMIC_RELEASE, "agent");
            asm volatile("s_waitcnt vmcnt(0)" ::: "memory");
            const unsigned og = xb_add(&bar[XB_TOP], 1u);
            const unsigned tg = og / nx;
            if (og + 1u == (tg + 1u) * nx) xb_add(&bar[XB_TOPGEN], 1u);
            else XB_SPIN(xb_ld(&bar[XB_TOPGEN]) == tg, bar);
            __builtin_amdgcn_fence(__ATOMIC_ACQUIRE, "agent");
            xb_add(&bar[XB_XGEN(b.x)], 1u);
            asm volatile("s_waitcnt vmcnt(0)" ::: "memory");
        } else {
            XB_SPIN(xb_ld(&bar[XB_XGEN(b.x)]) == gen, bar);
            __builtin_amdgcn_fence(__ATOMIC_ACQUIRE, "agent");
            asm volatile("s_waitcnt vmcnt(0)" ::: "memory");
        }
    }
    __syncthreads();
}

struct Frame {
    LAS unsigned char* lds;
    unsigned char* ldsg;
    volatile LAS unsigned* MISC;
    unsigned* ctl;
    int tid, lane, wave, vcu, G;
    float* out; unsigned char* ws;
};
enum { I_X = 0, I_META, I_G1PRE, I_W1G, I_W1U, I_W1D, I_G1POST, I_GMIX, I_WIN, I_WGATE, I_BGATE, I_GGLA, I_WOUT, I_GMIXPOST, I_G2PRE, I_W2G, I_W2U, I_W2D, I_G2POST };
#ifndef PROBE_K
#define PROBE_K (-1)
#endif
#ifndef PROBE_BLOCK
#define PROBE_BLOCK 37
#endif
#ifndef PROBE_AMP
#define PROBE_AMP 4
#endif
#define TIC(k) do { if (PROBE_K == (k) && blockIdx.x == PROBE_BLOCK && threadIdx.x == 0) { const unsigned long long t_ = __builtin_amdgcn_s_memrealtime(); F.MISC[20] = (unsigned)t_; F.MISC[21] = (unsigned)(t_ >> 32); } } while (0)
#define TOC(k) do { if (PROBE_K == (k) && blockIdx.x == PROBE_BLOCK && threadIdx.x == 0) { const unsigned long long t0_ = ((unsigned long long)F.MISC[21] << 32) | F.MISC[20]; \
        const unsigned long long a_ = (((unsigned long long)F.MISC[23] << 32) | F.MISC[22]) + (__builtin_amdgcn_s_memrealtime() - t0_); F.MISC[22] = (unsigned)a_; F.MISC[23] = (unsigned)(a_ >> 32); } } while (0)
#define PROBE_SPIN() do { if (PROBE_K >= 0 && blockIdx.x == PROBE_BLOCK && threadIdx.x == 0) { const unsigned long long a_ = (((unsigned long long)F.MISC[23] << 32) | F.MISC[22]) * PROBE_AMP; \
        const unsigned long long s_ = __builtin_amdgcn_s_memrealtime(); while (__builtin_amdgcn_s_memrealtime() - s_ < a_) __builtin_amdgcn_s_sleep(8); } } while (0)

__device__ __forceinline__ float wave_sum(float v) {
#pragma unroll
    for (int o = 1; o < 64; o <<= 1) v += __shfl_xor(v, o);
    return v;
}
__device__ __forceinline__ unsigned wave_sum_u(unsigned v) {
    v += (unsigned)__builtin_amdgcn_update_dpp(0, (int)v, 0xB1, 0xf, 0xf, false);
    v += (unsigned)__builtin_amdgcn_update_dpp(0, (int)v, 0x4E, 0xf, 0xf, false);
    v += (unsigned)__builtin_amdgcn_update_dpp(0, (int)v, 0x141, 0xf, 0xf, false);
    v += (unsigned)__builtin_amdgcn_update_dpp(0, (int)v, 0x140, 0xf, 0xf, false);
    return (unsigned)__builtin_amdgcn_readlane((int)v, 0) + (unsigned)__builtin_amdgcn_readlane((int)v, 16) + (unsigned)__builtin_amdgcn_readlane((int)v, 32) + (unsigned)__builtin_amdgcn_readlane((int)v, 48);
}

__device__ __forceinline__ void tr_item(const float* W, int N, int K, bf16* WT, int drow0, int scol, const float* gain, LAS float* scr, int k0, int lane) {
#pragma unroll 8
    for (int i = 0; i < 32; ++i) { const int kk = 2 * i + (lane >> 5); float v = 0.f;
        if (scol >= 0) v = W[(size_t)(k0 + kk) * N + scol];
        if (gain) v *= gain[k0 + kk];
        scr[kk * 33 + (lane & 31)] = v; }
    LDS_WAIT(); asm volatile("" ::: "memory");
    const int c = lane & 7;
#pragma unroll
    for (int j = 0; j < 4; ++j) { const int n = (lane >> 3) + 8 * j; const LAS float* s = scr + (8 * c) * 33 + n;
        v4u o; o.x = pk2(s[0 * 33], s[1 * 33]); o.y = pk2(s[2 * 33], s[3 * 33]); o.z = pk2(s[4 * 33], s[5 * 33]); o.w = pk2(s[6 * 33], s[7 * 33]);
        *(GAS v4u*)(WT + (size_t)(drow0 + n) * K + k0 + 8 * c) = o; }
    LDS_WAIT(); asm volatile("" ::: "memory");
}
__device__ __forceinline__ void convert_ffn(Frame& F, const float* Wg, const float* Wu, const float* Wd, const float* gain, bf16* WGU, bf16* WD) {
    LAS float* scr = (LAS float*)(F.lds + F.wave * 16384);
    const int gw = F.vcu * NWAVES + F.wave, NGW = F.G * NWAVES;
    constexpr int I_GU = (NGU / 32) * (DM / 64), I_D = (DM / 32) * (DFF / 64);
    for (int it = gw; it < I_GU + I_D; it += NGW) {
        if (it < I_GU) { const int g = it % (NGU / 32), kb = it / (NGU / 32), tile = g >> 3, w = g & 7;
            tr_item(w < 4 ? Wg : Wu, DFF, DM, WGU, g * 32, tile * 128 + (w & 3) * 32 + (F.lane & 31), gain, scr, kb * 64, F.lane); }
        else { const int r = it - I_GU, g = r % (DM / 32), kb = r / (DM / 32);
            tr_item(Wd, DM, DFF, WD, g * 32, g * 32 + (F.lane & 31), nullptr, scr, kb * 64, F.lane); }
    }
}
__device__ __forceinline__ int win_src_col(int j) {
    const int t = j >> 8, c = j & 255;
    if (t < 16) return j;
    if (t < 18) return 4176 + (j - 4096);
    if (t < 20) return 4688 + (j - 4608);
    if (t < 24) return 5200 + (j - 5120);
    if (t < 28) return 6240 + (j - 6144);
    if (c < 64) return 4096 + c;
    if (c < 80) return 4160 + (c - 64);
    if (c < 96) return 6224 + (c - 80);
    return -1;
}
__device__ __forceinline__ void convert_mix(Frame& F, const float* Win, const float* Wout, const float* gain, bf16* WIN, bf16* WOUT) {
    LAS float* scr = (LAS float*)(F.lds + F.wave * 16384);
    const int gw = F.vcu * NWAVES + F.wave, NGW = F.G * NWAVES;
    constexpr int I_IN = (NPROJ / 32) * (DM / 64), I_OUT = (DM / 32) * (DM / 64);
    for (int it = gw; it < I_IN + I_OUT; it += NGW) {
        if (it < I_IN) { const int g = it % (NPROJ / 32), kb = it / (NPROJ / 32);
            tr_item(Win, 7264, DM, WIN, g * 32, win_src_col(g * 32 + (F.lane & 31)), gain, scr, kb * 64, F.lane); }
        else { const int r = it - I_IN, g = r % (DM / 32), kb = r / (DM / 32);
            tr_item(Wout, DM, DM, WOUT, g * 32, g * 32 + (F.lane & 31), nullptr, scr, kb * 64, F.lane); }
    }
}

__device__ __forceinline__ void p0_rows(Frame& F, const float* X, const float* META) {
    const int gw = F.vcu * NWAVES + F.wave, NGW = F.G * NWAVES;
    bf16* AB = (bf16*)(F.ws + WS_AB); float* rstd = (float*)(F.ws + WS_RSTD1);
    for (int row = gw; row < RP; row += NGW) {
        GAS v2u* o = (GAS v2u*)(AB + (size_t)row * DM) + F.lane;
        if (row < R + NMETA) {
            const float* xr = row < R ? X + (size_t)row * DM : META + (size_t)(row - R) * DM;
            const GAS f32x4* xp = (const GAS f32x4*)xr + F.lane;
            f32x4 v[8]; float ss = 0.f;
#pragma unroll
            for (int j = 0; j < 8; ++j) { v[j] = xp[64 * j]; ss += (v[j].x * v[j].x + v[j].y * v[j].y) + (v[j].z * v[j].z + v[j].w * v[j].w); }
            ss = wave_sum(ss);
#pragma unroll
            for (int j = 0; j < 8; ++j) o[64 * j] = (v2u){pk2(v[j].x, v[j].y), pk2(v[j].z, v[j].w)};
            if (F.lane == 0) rstd[row] = 1.0f / sqrtf(ss * (1.0f / DM) + EPS);
        } else {
#pragma unroll
            for (int j = 0; j < 8; ++j) o[64 * j] = (v2u){0u, 0u};
            if (F.lane == 0) rstd[row] = 0.f;
        }
    }
}
template <int MODE>
__device__ __forceinline__ void norm_rows(Frame& F, const float* g, float* rstd_out, const float* X, const float* META) {
    const int gw = F.vcu * NWAVES + F.wave, NGW = F.G * NWAVES;
    bf16* AB = (bf16*)(F.ws + WS_AB); const bf16* FB = (const bf16*)(F.ws + WS_F);
    const int nrows = (MODE == 0) ? RP : R;
    f32x4 gv[8];
#pragma unroll
    for (int j = 0; j < 8; ++j) gv[j] = ((const GAS f32x4*)g)[64 * j + F.lane];
    for (int row = gw; row < nrows; row += NGW) {
        if (MODE == 0 && row >= R + NMETA) { if (F.lane == 0) rstd_out[row] = 0.f; continue; }
        const GAS v2u* fp = (const GAS v2u*)(FB + (size_t)row * DM) + F.lane;
        GAS v2u* ab = (GAS v2u*)(AB + (size_t)row * DM) + F.lane;
        f32x4 f[8], h[8]; float ss = 0.f;
#pragma unroll
        for (int j = 0; j < 8; ++j) { const v2u w = fp[64 * j]; f[j] = (f32x4){bflo(w.x), bfhi(w.x), bflo(w.y), bfhi(w.y)};
            ss += (f[j].x * f[j].x + f[j].y * f[j].y) + (f[j].z * f[j].z + f[j].w * f[j].w); }
        if (MODE == 0) {
            const float* xr = row < R ? X + (size_t)row * DM : META + (size_t)(row - R) * DM;
            const GAS f32x4* xp = (const GAS f32x4*)xr + F.lane;
#pragma unroll
            for (int j = 0; j < 8; ++j) h[j] = xp[64 * j];
        } else {
#pragma unroll
            for (int j = 0; j < 8; ++j) { const v2u w = ab[64 * j]; h[j] = (f32x4){bflo(w.x), bfhi(w.x), bflo(w.y), bfhi(w.y)}; }
        }
        ss = wave_sum(ss);
        const float rf = (MODE == 1 ? 1.0f : 0.5f) / sqrtf(ss * (1.0f / DM) + EPS);
        float s2 = 0.f;
#pragma unroll
        for (int j = 0; j < 8; ++j) { h[j] = h[j] + f[j] * gv[j] * rf; s2 += (h[j].x * h[j].x + h[j].y * h[j].y) + (h[j].z * h[j].z + h[j].w * h[j].w); }
        if (MODE == 2) {
            GAS f32x4* op = (GAS f32x4*)(F.out + (size_t)row * DM) + F.lane;
#pragma unroll
            for (int j = 0; j < 8; ++j) op[64 * j] = h[j];
        } else {
            s2 = wave_sum(s2);
#pragma unroll
            for (int j = 0; j < 8; ++j) ab[64 * j] = (v2u){pk2(h[j].x, h[j].y), pk2(h[j].z, h[j].w)};
            if (F.lane == 0) rstd_out[row] = 1.0f / sqrtf(s2 * (1.0f / DM) + EPS);
        }
    }
}

__device__ __forceinline__ void zero_pads(Frame& F) {
    const int gt = F.vcu * (NWAVES * 64) + F.tid, NG = F.G * NWAVES * 64;
    bf16* Kh = (bf16*)(F.ws + WS_KH); bf16* Vh = (bf16*)(F.ws + WS_VH); bf16* IK = (bf16*)(F.ws + WS_IK);
    const v4u z = {0u, 0u, 0u, 0u};
    for (int i = gt; i < 2 * 16 * 768 + 2 * 384; i += NG) {
        if (i < 2 * 16 * 768) { const int which = i / (16 * 768), r = i % (16 * 768), bh = r / 768, o = r % 768;
            *(GAS v4u*)((which ? Vh : Kh) + ((size_t)bh * TKV + 8208) * 128 + o * 8) = z; }
        else { const int r = i - 2 * 16 * 768, b = r / 384, o = r % 384, pos = 8208 + (o >> 3), ch = o & 7;
               *(GAS v4u*)(IK + (size_t)b * TKV * 64 + (size_t)(pos >> 5) * 2048 + (ch >> 1) * 512 + (ch & 1) * 256 + (pos & 31) * 8) = z; }
    }
}

__device__ __forceinline__ unsigned row_or16(unsigned v) {
    v |= (unsigned)__builtin_amdgcn_update_dpp(0, (int)v, 0xB1, 0xf, 0xf, false);
    v |= (unsigned)__builtin_amdgcn_update_dpp(0, (int)v, 0x4E, 0xf, 0xf, false);
    v |= (unsigned)__builtin_amdgcn_update_dpp(0, (int)v, 0x141, 0xf, 0xf, false);
    v |= (unsigned)__builtin_amdgcn_update_dpp(0, (int)v, 0x140, 0xf, 0xf, false);
    return v;
}
#ifndef P5_REP_SCORE
#define P5_REP_SCORE 1
#endif
#ifndef P5_REP_SEL
#define P5_REP_SEL 1
#endif
#ifndef P5_REP_MMA
#define P5_REP_MMA 1
#endif
#ifndef P5_REP_SCV
#define P5_REP_SCV 1
#endif
#ifndef P5_REP_BIS
#define P5_REP_BIS 1
#endif
#ifndef P5_REP_EMIT
#define P5_REP_EMIT 1
#endif
__device__ __forceinline__ void p5_item(Frame& F, int b, int t) {
    const int lane = F.lane, wid = F.wave, r32 = lane & 31, hi = lane >> 5;
    const GAS bf16* IQ = (const GAS bf16*)(F.ws + WS_IQ); const GAS bf16* IK = (const GAS bf16*)(F.ws + WS_IK); const GAS float* IW = (const GAS float*)(F.ws + WS_IW);
    GAS u64* MASK = (GAS u64*)(F.ws + WS_MASK);
    LAS unsigned short* S16 = (LAS unsigned short*)F.lds;
    constexpr int SROWD = 129 * 33, SROWH = 2 * SROWD;
    const int s0 = 8 * t, qb = s0 >> 8, nwords = 4 * qb + 5;
    const int kmax = 16 + s0 + 7, nkt = (kmax >> 5) + 1;
    TIC(0); TIC(1);
    {
        bf16x8 Af[4][4];
        LAS float* WL = (LAS float*)(F.lds + 8 * SROWH * 2);
        if (F.tid < 128) WL[F.tid] = IW[((size_t)(b * SEQ + s0)) * 16 + F.tid];
        {
            const int qo = (r32 >> 2) & 1, h = (r32 & 3) + 4 * (r32 >> 3);
#pragma unroll
            for (int rb = 0; rb < 4; ++rb) {
                const GAS bf16* qp = IQ + ((size_t)(b * SEQ + s0 + 2 * rb + qo)) * 1024 + h * 64 + 8 * hi;
#pragma unroll
                for (int ks = 0; ks < 4; ++ks) Af[rb][ks] = *(const GAS bf16x8*)(qp + ks * 16);
            }
        }
        __syncthreads();
        float wv[4][16];
#pragma unroll
        for (int rb = 0; rb < 4; ++rb) { const LAS f32x4* wl = (const LAS f32x4*)(WL + hi * 16 + 32 * rb);
#pragma unroll
            for (int r4 = 0; r4 < 4; ++r4) { const f32x4 w4 = wl[r4]; wv[rb][4 * r4] = w4.x; wv[rb][4 * r4 + 1] = w4.y; wv[rb][4 * r4 + 2] = w4.z; wv[rb][4 * r4 + 3] = w4.w; } }
        TOC(1); TIC(2);
        const GAS char* kbase = (const GAS char*)(IK + (size_t)b * TKV * 64);
        const unsigned koff = (unsigned)(lane * 16);
        bf16x8 Bn[4];
        for (int rep_ = 0; rep_ < P5_REP_SCORE; ++rep_) {
        if (wid < nkt) {
#pragma unroll
            for (int ks = 0; ks < 4; ++ks) Bn[ks] = *(const GAS bf16x8*)(kbase + (koff + (unsigned)(wid * 4096 + ks * 1024)));
        }
        for (int kt = wid; kt < nkt; kt += 8) {
            bf16x8 Bf[4];
#pragma unroll
            for (int ks = 0; ks < 4; ++ks) Bf[ks] = Bn[ks];
            if (kt + 8 < nkt) {
#pragma unroll
                for (int ks = 0; ks < 4; ++ks) Bn[ks] = *(const GAS bf16x8*)(kbase + (koff + (unsigned)((kt + 8) * 4096 + ks * 1024)));
            }
            const int key = kt * 32 + r32;
            f32x16 acc[4];
#pragma unroll
            for (int m_ = 0; m_ < P5_REP_MMA; ++m_) {
#pragma unroll
            for (int rb = 0; rb < 4; ++rb) acc[rb] = (f32x16){};
#pragma unroll
            for (int ks = 0; ks < 4; ++ks)
#pragma unroll
                for (int rb = 0; rb < 4; ++rb) acc[rb] = __builtin_amdgcn_mfma_f32_32x32x16_bf16(Af[rb][ks], Bf[ks], acc[rb], 0, 0, 0);
            if (m_ + 1 < P5_REP_MMA) asm volatile("" : "+v"(acc[0]), "+v"(acc[1]), "+v"(acc[2]), "+v"(acc[3]));
            }
#pragma unroll
            for (int v_ = 0; v_ < P5_REP_SCV; ++v_)
#pragma unroll
            for (int rb = 0; rb < 4; ++rb) {
                if (P5_REP_SCV > 1) asm volatile("" : "+v"(acc[rb]));
                float sc0 = 0.f, sc1 = 0.f;
#pragma unroll
                for (int r = 0; r < 16; r += 2) {
                    { const float a_ = acc[rb][r]; const int ai_ = __float_as_int(a_); sc0 = fmaf(__int_as_float(ai_ > 0 ? ai_ : 0), wv[rb][r], sc0); }
                    { const float a_ = acc[rb][r + 1]; const int ai_ = __float_as_int(a_); sc1 = fmaf(__int_as_float(ai_ > 0 ? ai_ : 0), wv[rb][r + 1], sc1); }
                }
                float sc = sc0 + sc1;
                sc = fminf(fmaxf(sc, -60000.f), 60000.f);
                const _Float16 hf = (_Float16)sc;
                const unsigned hb = (unsigned)__builtin_bit_cast(unsigned short, hf);
                unsigned sk = (hb & 0x8000u) ? (~hb & 0xffffu) : (hb | 0x8000u);
                sk = (sk >> 1) | 0x8000u;
                if (key > 16 + s0 + 2 * rb + hi) sk = 0x81ffu;
                S16[(2 * rb + hi) * SROWH + (key >> 6) * 66 + (key & 63)] = (unsigned short)sk;
            }
        }
        }
    }
    TOC(2); TIC(3);
    {
        LAS unsigned* row = (LAS unsigned*)(S16 + wid * SROWH);
        for (int k2 = nkt * 16 + lane; k2 < 4128; k2 += 64) row[(k2 >> 5) * 33 + (k2 & 31)] = 0x81ff81ffu;
    }
    asm volatile("s_waitcnt lgkmcnt(0)" ::: "memory"); __builtin_amdgcn_s_barrier(); asm volatile("" ::: "memory");
    TOC(3); TIC(4);
    {
        const LAS unsigned* srow = (const LAS unsigned*)(S16 + wid * SROWH);
        const bool second = nwords > 64, last = nwords > 128;
        unsigned d[64];
#pragma unroll
        for (int i = 0; i < 32; ++i) d[i] = srow[lane * 33 + i];
#pragma unroll
        for (int i = 0; i < 32; ++i) { const unsigned x = srow[(lane + 64) * 33 + i]; d[32 + i] = second ? x : 0x81ff81ffu; }
        unsigned d128 = 0x81ff81ffu;
        if (last) d128 = 0x81ff0000u | (unsigned)(S16 + wid * SROWH)[128 * 66 + lane];
#define CNT_GE(cnt_, c15) do { const unsigned C_ = (unsigned)(c15) * 0x10001u; \
            _Pragma("unroll") for (int i = 0; i < 32; ++i) cnt_ += (unsigned)__builtin_popcount((d[i] - C_) & 0x80008000u); \
            if (second) { _Pragma("unroll") for (int i = 32; i < 64; ++i) cnt_ += (unsigned)__builtin_popcount((d[i] - C_) & 0x80008000u); \
                cnt_ += (unsigned)__builtin_popcount((d128 - C_) & 0x80008000u); } } while (0)
        unsigned thr = 0u;
        for (int bit = 14; bit >= 0; --bit) {
            const unsigned cand = thr | (1u << bit); unsigned c = 0u;
            CNT_GE(c, cand);
            if (wave_sum_u(c) >= 256u) thr = cand;
        }
        TOC(4); TIC(5);
        if (thr < 0x0200u) thr = 0x0200u;
        unsigned cg = 0u, ce = 0u;
        CNT_GE(cg, thr + 1u); CNT_GE(ce, thr);
        const unsigned cgt = wave_sum_u(cg), cge = wave_sum_u(ce);
#undef CNT_GE
        const int need = 256 - (int)cgt;
        GAS unsigned* mrow = (GAS unsigned*)(MASK + ((size_t)(b * SEQ + s0 + wid)) * 130);
        if (cge <= 256u) {
            const unsigned T_ = thr * 0x10001u;
#pragma unroll
            for (int tt = 0; tt < 2; ++tt) {
                if (tt == 0 || second) {
                    unsigned w0 = 0u, w1 = 0u;
#pragma unroll
                    for (int i = 0; i < 32; ++i) {
                        const unsigned sw = d[32 * tt + i] - T_;
                        const unsigned b2 = ((sw >> 15) & 1u) | ((sw >> 30) & 2u);
                        constexpr int dummy_ = 0; (void)dummy_;
                        const int pos = 16 * (i >> 4) + 2 * (i & 1) + 4 * ((i & 15) >> 2);
                        if (((i & 15) >> 1) & 1) w1 |= b2 << pos; else w0 |= b2 << pos;
                    }
                    *(GAS v2u*)(mrow + 2 * (64 * tt + lane)) = (v2u){w0, w1};
                }
            }
            if (last) {
                const u64 w = __ballot((((d128 - T_) >> 15) & 1u) != 0u);
                const unsigned vl = (unsigned)w, vh = (unsigned)(w >> 32), ul = vl >> 4, uh = vh >> 4;
                const unsigned a0 = (vl & 0xFu) | ((vl >> 4) & 0xF0u) | ((vl >> 8) & 0xF00u) | ((vl >> 12) & 0xF000u), a1 = (ul & 0xFu) | ((ul >> 4) & 0xF0u) | ((ul >> 8) & 0xF00u) | ((ul >> 12) & 0xF000u);
                const unsigned b0 = (vh & 0xFu) | ((vh >> 4) & 0xF0u) | ((vh >> 8) & 0xF00u) | ((vh >> 12) & 0xF000u), b1 = (uh & 0xFu) | ((uh >> 4) & 0xF0u) | ((uh >> 8) & 0xF00u) | ((uh >> 12) & 0xF000u);
                if (lane == 0) { mrow[256] = a0 | (b0 << 16); mrow[257] = a1 | (b1 << 16); }
            }
        } else {
            const unsigned T_ = thr * 0x10001u, T1_ = (thr + 1u) * 0x10001u;
            unsigned e1 = 0u, e2 = 0u;
#pragma unroll
            for (int i = 0; i < 32; ++i) e1 += (unsigned)__builtin_popcount((d[i] - T_) & 0x80008000u) - (unsigned)__builtin_popcount((d[i] - T1_) & 0x80008000u);
#pragma unroll
            for (int i = 32; i < 64; ++i) e2 += (unsigned)__builtin_popcount((d[i] - T_) & 0x80008000u) - (unsigned)__builtin_popcount((d[i] - T1_) & 0x80008000u);
            int base1 = 0, base2 = 0, tot1 = 0, tot2 = 0;
#pragma unroll
            for (int bt = 0; bt < 7; ++bt) {
                const u64 m1 = __ballot(((e1 >> bt) & 1u) != 0u), m2 = __ballot(((e2 >> bt) & 1u) != 0u);
                base1 += (int)__builtin_amdgcn_mbcnt_hi((unsigned)(m1 >> 32), __builtin_amdgcn_mbcnt_lo((unsigned)m1, 0u)) << bt; tot1 += __popcll(m1) << bt;
                base2 += (int)__builtin_amdgcn_mbcnt_hi((unsigned)(m2 >> 32), __builtin_amdgcn_mbcnt_lo((unsigned)m2, 0u)) << bt; tot2 += __popcll(m2) << bt;
            }
#pragma unroll
            for (int tt = 0; tt < 2; ++tt) {
                if (tt == 0 || second) {
                    int quota = need - (tt == 0 ? base1 : tot1 + base2);
                    unsigned w0 = 0u, w1 = 0u;
#pragma unroll
                    for (int i = 0; i < 32; ++i) {
                        const unsigned sw = d[32 * tt + i] - T_, sg = d[32 * tt + i] - T1_;
                        const unsigned ge_lo = (sw >> 15) & 1u, ge_hi = (sw >> 31) & 1u, gt_lo = (sg >> 15) & 1u, gt_hi = (sg >> 31) & 1u;
                        const unsigned eq_lo = ge_lo ^ gt_lo, eq_hi = ge_hi ^ gt_hi;
                        const unsigned s_lo = gt_lo | (eq_lo & (quota > 0 ? 1u : 0u)); quota -= (int)eq_lo;
                        const unsigned s_hi = gt_hi | (eq_hi & (quota > 0 ? 1u : 0u)); quota -= (int)eq_hi;
                        const unsigned b2 = s_lo | (s_hi << 1);
                        const int pos = 16 * (i >> 4) + 2 * (i & 1) + 4 * ((i & 15) >> 2);
                        if (((i & 15) >> 1) & 1) w1 |= b2 << pos; else w0 |= b2 << pos;
                    }
                    *(GAS v2u*)(mrow + 2 * (64 * tt + lane)) = (v2u){w0, w1};
                }
            }
            if (last) {
                const unsigned k128 = d128 & 0x7fffu;
                const u64 em = __ballot(k128 == thr);
                const int rank = tot1 + tot2 + (int)__builtin_amdgcn_mbcnt_hi((unsigned)(em >> 32), __builtin_amdgcn_mbcnt_lo((unsigned)em, 0u));
                const u64 w = __ballot(k128 > thr || (k128 == thr && rank < need));
                const unsigned vl = (unsigned)w, vh = (unsigned)(w >> 32), ul = vl >> 4, uh = vh >> 4;
                const unsigned a0 = (vl & 0xFu) | ((vl >> 4) & 0xF0u) | ((vl >> 8) & 0xF00u) | ((vl >> 12) & 0xF000u), a1 = (ul & 0xFu) | ((ul >> 4) & 0xF0u) | ((ul >> 8) & 0xF00u) | ((ul >> 12) & 0xF000u);
                const unsigned b0 = (vh & 0xFu) | ((vh >> 4) & 0xF0u) | ((vh >> 8) & 0xF00u) | ((vh >> 12) & 0xF000u), b1 = (uh & 0xFu) | ((uh >> 4) & 0xF0u) | ((uh >> 8) & 0xF00u) | ((uh >> 12) & 0xF000u);
                if (lane == 0) { mrow[256] = a0 | (b0 << 16); mrow[257] = a1 | (b1 << 16); }
            }
        }
    }
    asm volatile("s_waitcnt lgkmcnt(0)" ::: "memory"); __builtin_amdgcn_s_barrier(); asm volatile("" ::: "memory");
    TOC(5); TOC(0);
}

template <int KSTEPS>
__device__ __forceinline__ void mma_ll(f32x16& acc, const LAS bf16* A, int sa, const LAS bf16* B, int sb, int r32, int hi) {
#pragma unroll
    for (int ks = 0; ks < KSTEPS; ++ks) {
        const bf16x8 a = *(const LAS bf16x8*)(A + r32 * sa + ks * 16 + 8 * hi), bb = *(const LAS bf16x8*)(B + r32 * sb + ks * 16 + 8 * hi);
        acc = __builtin_amdgcn_mfma_f32_32x32x16_bf16(a, bb, acc, 0, 0, 0);
    }
}
__device__ __forceinline__ float log_sigmoid_f(float z) { return fminf(z, 0.f) - __logf(1.0f + __expf(-fabsf(z))); }
__device__ __forceinline__ void gla_bcum(Frame& F, LAS float* BC, LAS float* GT, int b, int h, int n, const float* Wg, const float* bg) {
    const GAS float* GLOW = (const GAS float*)(F.ws + WS_GLOW);
    const int k = F.tid & 127, ig = __builtin_amdgcn_readfirstlane(F.tid >> 7);
    float wc[16];
#pragma unroll
    for (int r = 0; r < 16; ++r) wc[r] = Wg[r * 512 + h * 128 + k];
    const float bk = bg[h * 128 + k];
    float run = 0.f, pre[16];
#pragma unroll
    for (int ii = 0; ii < 16; ++ii) {
        const int i = 16 * ig + ii, pp = 64 * n + i; float lg = 0.f;
        if (!(n == 0 && i < 48)) {
            const GAS f32x4* gl = (const GAS f32x4*)(GLOW + ((size_t)b * TKV + pp) * 16); float z = bk;
#pragma unroll
            for (int r4 = 0; r4 < 4; ++r4) { const f32x4 g4 = gl[r4];
                z = fmaf(g4.x, wc[4 * r4 + 0], z); z = fmaf(g4.y, wc[4 * r4 + 1], z); z = fmaf(g4.z, wc[4 * r4 + 2], z); z = fmaf(g4.w, wc[4 * r4 + 3], z); }
            lg = log_sigmoid_f(z) * (1.0f / 16.0f);
        }
        run += lg; pre[ii] = run;
    }
    GT[ig * 128 + k] = run;
    __syncthreads();
    float off = 0.f;
#pragma unroll
    for (int gq = 0; gq < 3; ++gq) off += (gq < ig) ? GT[gq * 128 + k] : 0.f;
#pragma unroll
    for (int ii = 0; ii < 16; ++ii) BC[(16 * ig + ii) * 128 + k] = pre[ii] + off;
    __syncthreads();
}
__device__ __forceinline__ void gla_load_vt(Frame& F, LAS bf16* VT, int b, int h, int n) {
    const GAS bf16* GV = (const GAS bf16*)(F.ws + WS_GV);
    const int v0 = 8 * (F.tid & 31);
#pragma unroll
    for (int pass = 0; pass < 4; ++pass) {
        const int i = (F.tid >> 5) + 16 * pass, pp = 64 * n + i;
        v4u raw = {0u, 0u, 0u, 0u};
        if (!(n == 0 && i < 48)) raw = *(const GAS v4u*)(GV + ((size_t)b * TKV + pp) * 1024 + h * 256 + v0);
        VT[(v0 + 0) * 72 + i] = (bf16)(raw.x & 0xffffu); VT[(v0 + 1) * 72 + i] = (bf16)(raw.x >> 16);
        VT[(v0 + 2) * 72 + i] = (bf16)(raw.y & 0xffffu); VT[(v0 + 3) * 72 + i] = (bf16)(raw.y >> 16);
        VT[(v0 + 4) * 72 + i] = (bf16)(raw.z & 0xffffu); VT[(v0 + 5) * 72 + i] = (bf16)(raw.z >> 16);
        VT[(v0 + 6) * 72 + i] = (bf16)(raw.w & 0xffffu); VT[(v0 + 7) * 72 + i] = (bf16)(raw.w >> 16);
    }
}
__device__ __forceinline__ void g1_unit(Frame& F, int b, int h, int n, const float* Wg, const float* bg) {
    const int lane = F.lane, wid = F.wave, r32 = lane & 31, hi = lane >> 5, tid = F.tid;
    LAS float* BC = (LAS float*)F.lds; LAS bf16* KDT = (LAS bf16*)(F.lds + 32768); LAS bf16* VT = (LAS bf16*)(F.lds + 51200);
    const GAS bf16* GK = (const GAS bf16*)(F.ws + WS_GK); GAS bf16* ST = (GAS bf16*)(F.ws + WS_ST); GAS float* DEC = (GAS float*)(F.ws + WS_DEC);
    gla_bcum(F, BC, (LAS float*)(F.lds + 131072), b, h, n, Wg, bg);
    { const int k0 = 8 * (tid & 15);
#pragma unroll
      for (int pass = 0; pass < 2; ++pass) {
        const int i = (tid >> 4) + 32 * pass, pp = 64 * n + i;
        v4u raw = {0u, 0u, 0u, 0u};
        if (!(n == 0 && i < 48)) raw = *(const GAS v4u*)(GK + ((size_t)b * TKV + pp) * 512 + h * 128 + k0);
        const unsigned rw[4] = {raw.x, raw.y, raw.z, raw.w};
#pragma unroll
        for (int j = 0; j < 8; ++j) { const float kv = (j & 1) ? bfhi(rw[j >> 1]) : bflo(rw[j >> 1]);
            const float d = __expf(BC[63 * 128 + k0 + j] - BC[i * 128 + k0 + j]);
            KDT[(k0 + j) * 72 + i] = (bf16)f2bf(kv * d); }
      } }
    gla_load_vt(F, VT, b, h, n);
    __syncthreads();
    GAS bf16* dst = ST + ((size_t)((b * 4 + h) * 128 + n) * 256) * 128;
    const float declast = (tid < 128) ? __expf(BC[63 * 128 + tid]) : 0.f;
    f32x16 acc[4];
#pragma unroll
    for (int cb = 0; cb < 4; ++cb) { acc[cb] = (f32x16){}; mma_ll<4>(acc[cb], VT + (32 * wid) * 72, 72, KDT + (32 * cb) * 72, 72, r32, hi); }
    __syncthreads();
    {   LAS bf16* LT = (LAS bf16*)F.lds;
#pragma unroll
        for (int cb = 0; cb < 4; ++cb)
#pragma unroll
            for (int r = 0; r < 16; ++r) LT[(32 * wid + (r & 3) + 8 * (r >> 2) + 4 * hi) * 128 + 32 * cb + r32] = (bf16)f2bf(acc[cb][r]);
        __syncthreads();
        const LAS v4u* src = (const LAS v4u*)F.lds; GAS v4u* d4 = (GAS v4u*)dst;
#pragma unroll
        for (int q = 0; q < 8; ++q) d4[q * 512 + tid] = src[q * 512 + tid];
    }
    if (tid < 128) DEC[(size_t)((b * 4 + h) * 128 + n) * 128 + tid] = declast;
    __syncthreads();
}
__device__ __forceinline__ void g2_scan(Frame& F) {
    GAS bf16* ST = (GAS bf16*)(F.ws + WS_ST); const GAS float* DEC = (const GAS float*)(F.ws + WS_DEC);
    const int NG = F.G * NWAVES * 64;
    for (int e = F.vcu * (NWAVES * 64) + F.tid; e < 8 * 16384; e += NG) {
        const int bh = e >> 14, rem = e & 16383, v = rem >> 6, k = (rem & 63) * 2;
        GAS unsigned* p = (GAS unsigned*)(ST + ((size_t)bh * 128 * 256 + v) * 128 + k);
        const GAS float* d = DEC + (size_t)bh * 128 * 128 + k;
        float s0 = 0.f, s1 = 0.f;
        for (int n = 0; n < 128; n += 8) {
            unsigned w[8]; float d0[8], d1[8];
#pragma unroll
            for (int u = 0; u < 8; ++u) { w[u] = p[(size_t)(n + u) * 16384]; d0[u] = d[(n + u) * 128]; d1[u] = d[(n + u) * 128 + 1]; }
#pragma unroll
            for (int u = 0; u < 8; ++u) { s0 = fmaf(s0, d0[u], bflo(w[u])); s1 = fmaf(s1, d1[u], bfhi(w[u])); p[(size_t)(n + u) * 16384] = pk2(s0, s1); }
        }
    }
}
__device__ __forceinline__ void g3_unit(Frame& F, int b, int h, int c, const float* Wg, const float* bg, const float* ggla) {
    const int lane = F.lane, wid = F.wave, r32 = lane & 31, hi = lane >> 5, tid = F.tid;
    LAS float* BC = (LAS float*)F.lds; LAS bf16* Q1 = (LAS bf16*)(F.lds + 32768); LAS bf16* Q2 = (LAS bf16*)(F.lds + 50176); LAS bf16* KD = (LAS bf16*)(F.lds + 67584);
    LAS bf16* VT = (LAS bf16*)(F.lds + 84992); LAS bf16* AT = (LAS bf16*)(F.lds + 121856); LAS float* OS = (LAS float*)F.lds;
    const GAS bf16* GQ = (const GAS bf16*)(F.ws + WS_GQ); const GAS bf16* GK = (const GAS bf16*)(F.ws + WS_GK); const GAS bf16* GO = (const GAS bf16*)(F.ws + WS_GO);
    const GAS bf16* ST = (const GAS bf16*)(F.ws + WS_ST); GAS bf16* MIXA = (GAS bf16*)(F.ws + WS_MIXA);
    gla_bcum(F, BC, (LAS float*)(F.lds + 131072), b, h, c, Wg, bg);
    { const int k0 = 8 * (tid & 15);
#pragma unroll
      for (int pass = 0; pass < 2; ++pass) {
        const int i = (tid >> 4) + 32 * pass, pp = 64 * c + i;
        const v4u rq = *(const GAS v4u*)(GQ + ((size_t)b * TKV + pp) * 512 + h * 128 + k0);
        const v4u rk = *(const GAS v4u*)(GK + ((size_t)b * TKV + pp) * 512 + h * 128 + k0);
        const unsigned qw[4] = {rq.x, rq.y, rq.z, rq.w}, kw[4] = {rk.x, rk.y, rk.z, rk.w};
        float q1[8], q2[8], kd[8];
#pragma unroll
        for (int j = 0; j < 8; ++j) { const float qv = (j & 1) ? bfhi(qw[j >> 1]) : bflo(qw[j >> 1]), kv = (j & 1) ? bfhi(kw[j >> 1]) : bflo(kw[j >> 1]);
            const float bc = BC[i * 128 + k0 + j], bl = BC[63 * 128 + k0 + j];
            q1[j] = qv * __expf(bc); q2[j] = qv * __expf(bc - bl); kd[j] = kv * __expf(bl - bc); }
        *(LAS v4u*)(Q1 + i * 136 + k0) = (v4u){pk2(q1[0], q1[1]), pk2(q1[2], q1[3]), pk2(q1[4], q1[5]), pk2(q1[6], q1[7])};
        *(LAS v4u*)(Q2 + i * 136 + k0) = (v4u){pk2(q2[0], q2[1]), pk2(q2[2], q2[3]), pk2(q2[4], q2[5]), pk2(q2[6], q2[7])};
        *(LAS v4u*)(KD + i * 136 + k0) = (v4u){pk2(kd[0], kd[1]), pk2(kd[2], kd[3]), pk2(kd[4], kd[5]), pk2(kd[6], kd[7])};
      } }
    gla_load_vt(F, VT, b, h, c);
    __syncthreads();
    const int rbI = wid & 1, cbV = (wid >> 1) * 2;
    f32x16 acc[2] = {};
    {
        const GAS bf16* sp = ST + ((size_t)((b * 4 + h) * 128 + (c - 1)) * 256) * 128;
#pragma unroll
        for (int ks = 0; ks < 8; ++ks) {
            const bf16x8 a = *(const LAS bf16x8*)(Q1 + (32 * rbI + r32) * 136 + ks * 16 + 8 * hi);
#pragma unroll
            for (int t = 0; t < 2; ++t) { const bf16x8 bb = *(const GAS bf16x8*)(sp + (size_t)(32 * (cbV + t) + r32) * 128 + ks * 16 + 8 * hi);
                acc[t] = __builtin_amdgcn_mfma_f32_32x32x16_bf16(a, bb, acc[t], 0, 0, 0); }
        }
    }
    if (wid < 4) {
        const int ib = wid & 1, jb = wid >> 1;
        f32x16 at = {};
        mma_ll<8>(at, Q2 + (32 * ib) * 136, 136, KD + (32 * jb) * 136, 136, r32, hi);
#pragma unroll
        for (int r = 0; r < 16; ++r) { const int i = 32 * ib + (r & 3) + 8 * (r >> 2) + 4 * hi, j = 32 * jb + r32;
            AT[i * 72 + j] = (bf16)f2bf(j <= i ? at[r] : 0.f); }
    }
    __syncthreads();
#pragma unroll
    for (int t = 0; t < 2; ++t) mma_ll<4>(acc[t], AT + (32 * rbI) * 72, 72, VT + (32 * (cbV + t)) * 72, 72, r32, hi);
    __syncthreads();
#pragma unroll
    for (int t = 0; t < 2; ++t)
#pragma unroll
        for (int r = 0; r < 16; ++r) OS[(32 * rbI + (r & 3) + 8 * (r >> 2) + 4 * hi) * 260 + 32 * (cbV + t) + r32] = acc[t][r];
    __syncthreads();
    {
        const int i = tid >> 3, seg = tid & 7; const LAS float* orow = OS + i * 260 + 32 * seg;
        float ss = 0.f; f32x4 ov[8];
#pragma unroll
        for (int q = 0; q < 8; ++q) { ov[q] = *(const LAS f32x4*)(orow + 4 * q); ss += (ov[q].x * ov[q].x + ov[q].y * ov[q].y) + (ov[q].z * ov[q].z + ov[q].w * ov[q].w); }
        ss += __shfl_xor(ss, 1); ss += __shfl_xor(ss, 2); ss += __shfl_xor(ss, 4);
        const float rs = 1.0f / sqrtf(ss * (1.0f / 256.0f) + EPS);
        const size_t row = (size_t)b * SEQ + 64 * (c - 1) + i;
        const float* gn = ggla + 32 * seg;
        const GAS bf16* gp = GO + row * 1024 + h * 256 + 32 * seg;
        GAS bf16* op = MIXA + row * 2048 + 1024 + h * 256 + 32 * seg;
#pragma unroll
        for (int q2 = 0; q2 < 4; ++q2) {
            const v4u gw = *(const GAS v4u*)(gp + 8 * q2);
            const f32x4 g0 = *(const f32x4*)(gn + 8 * q2), g1 = *(const f32x4*)(gn + 8 * q2 + 4);
            const f32x4 a = ov[2 * q2], bq = ov[2 * q2 + 1];
            float y[8];
            y[0] = a.x * rs * g0.x * pg8::silu_f(bflo(gw.x)); y[1] = a.y * rs * g0.y * pg8::silu_f(bfhi(gw.x));
            y[2] = a.z * rs * g0.z * pg8::silu_f(bflo(gw.y)); y[3] = a.w * rs * g0.w * pg8::silu_f(bfhi(gw.y));
            y[4] = bq.x * rs * g1.x * pg8::silu_f(bflo(gw.z)); y[5] = bq.y * rs * g1.y * pg8::silu_f(bfhi(gw.z));
            y[6] = bq.z * rs * g1.z * pg8::silu_f(bflo(gw.w)); y[7] = bq.w * rs * g1.w * pg8::silu_f(bfhi(gw.w));
            *(GAS v4u*)(op + 8 * q2) = (v4u){pk2(y[0], y[1]), pk2(y[2], y[3]), pk2(y[4], y[5]), pk2(y[6], y[7])};
        }
    }
    __syncthreads();
}

__device__ __forceinline__ att::BlockRef att_ref(Frame& F, int bh, int qb) {
    const int b = bh >> 3, h = bh & 7; att::BlockRef r;
    r.Q = (const bf16*)(F.ws + WS_QH) + ((size_t)bh * SEQ + (size_t)qb * 256) * 128;
    r.K = (const bf16*)(F.ws + WS_KH) + (size_t)bh * TKV * 128; r.V = (const bf16*)(F.ws + WS_VH) + (size_t)bh * TKV * 128;
    r.O = (bf16*)(F.ws + WS_MIXA) + ((size_t)b * SEQ + (size_t)qb * 256) * 2048 + h * 128;
    r.M = (const u64*)(F.ws + WS_MASK) + ((size_t)b * SEQ + (size_t)qb * 256) * 130;
    r.NT = 4 * qb + 5;
    return r;
}
__device__ __forceinline__ void p7_attention(Frame& F) {
    constexpr int total = 256;
    int L = F.vcu; if (L >= total) return;
    int pass = 0;
    att::BlockRef cur = att_ref(F, L >> 4, L & 15);
    att::Seam S;
    att::att_prime(cur, (char*)F.ldsg, S);
    for (;;) {
        const bool more_pass = pass == 0, more_item = L + F.G < total, last = !more_pass && !more_item;
        int passn = pass + 1, Ln = L;
        if (!more_pass) { passn = 0; Ln = more_item ? L + F.G : L; }
        const att::BlockRef nxt = last ? cur : att_ref(F, Ln >> 4, passn ? 31 - (Ln & 15) : (Ln & 15));
        att::att_block(cur, nxt, (char*)F.ldsg, S);
        if (last) break;
        cur = nxt; pass = passn; L = Ln;
    }
}

struct Args { const float* in[19]; float* out; unsigned char* ws; int ph_lo, ph_hi; };
#ifndef PG8_SP2
#define PG8_SP2 true
#endif
#ifndef PG8_ALIGN
#define PG8_ALIGN true
#endif
__global__ void __launch_bounds__(NWAVES * 64, 2) hymba_fwd(Args args) {
    extern __shared__ __attribute__((aligned(16))) unsigned char lds[];
    Frame F;
    F.lds = (LAS unsigned char*)lds; F.ldsg = lds;
    F.MISC = (volatile LAS unsigned*)(F.lds + MISC_OFF);
    F.tid = threadIdx.x; F.lane = F.tid & 63; F.wave = __builtin_amdgcn_readfirstlane(F.tid >> 6);
    F.G = gridDim.x; { const int bx = blockIdx.x; F.vcu = (F.G % 8 == 0) ? (bx % 8) * (F.G / 8) + bx / 8 : bx; }
    F.ws = args.ws; F.ctl = (unsigned*)(args.ws + WS_CTL); F.out = args.out;
    for (int u = F.tid; u < (LDS_BYTES - MISC_OFF) / 4; u += NWAVES * 64) ((LAS unsigned*)(F.lds + MISC_OFF))[u] = 0u;
    __syncthreads();
    XcdBarrier bar; bar.bar = F.ctl + CW_BAR; bar.x = 0; bar.st = nullptr;
    if (!MK_PER_PHASE) bar = xcd_barrier_post(F.ctl + CW_BAR, F.MISC + 8);
    const int lo = args.ph_lo, hi = args.ph_hi;
#define PHASE_BEGIN() do { int t_ = threadIdx.x; asm volatile("" : "+v"(t_)); F.tid = t_; F.lane = t_ & 63; F.wave = __builtin_amdgcn_readfirstlane(t_ >> 6); } while (0)
#ifndef PH_MASK
#define PH_MASK 0x1fff
#endif
#define IN(k) ((((PH_MASK) >> (k)) & 1) && lo <= (k) && (k) < hi)
#define SEAM(k) do { if (!MK_PER_PHASE && IN((k) + 1)) xcd_barrier(bar); } while (0)
#ifndef PH_DUP
#define PH_DUP 0
#endif
#define AB ((bf16*)(F.ws + WS_AB))
#define ACT ((bf16*)(F.ws + WS_ACT))
#define FB ((bf16*)(F.ws + WS_F))
#define WGU ((bf16*)(F.ws + WS_WGU))
#define WD ((bf16*)(F.ws + WS_WD))
#define WIN ((bf16*)(F.ws + WS_WIN))
#define WOUT ((bf16*)(F.ws + WS_WOUT))
#define rstd1 ((float*)(F.ws + WS_RSTD1))
#define rstd2 ((float*)(F.ws + WS_RSTD2))
#define rstd3 ((float*)(F.ws + WS_RSTD3))

    #define BODY0 do { convert_ffn(F, args.in[I_W1G], args.in[I_W1U], args.in[I_W1D], args.in[I_G1PRE], WGU, WD); p0_rows(F, args.in[I_X], args.in[I_META]); } while (0)
    if (IN(0)) { PHASE_BEGIN();
#if (PH_DUP >> 0) & 1
        BODY0; xcd_barrier(bar);
#endif
        BODY0; SEAM(0); }
    if (IN(1)) { PHASE_BEGIN();
        pg8::Gemm g{AB, WGU, RP, NGU, DM}; pg8::StaticOrder S; S.init(RP, NGU, F.G, (int)blockIdx.x);
        pg8::EpiSwiGLU E{ACT, DFF, rstd1};
#if (PH_DUP >> 1) & 1
        pg8::gemm_phase<pg8::EpiSwiGLU, pg8::StaticOrder, PG8_ALIGN, PG8_SP2>(F.lds, g, S, E); xcd_barrier(bar);
#endif
        pg8::gemm_phase<pg8::EpiSwiGLU, pg8::StaticOrder, PG8_ALIGN, PG8_SP2>(F.lds, g, S, E);
        SEAM(1);
    }
    if (IN(2)) { PHASE_BEGIN();
        pg8::Gemm g{ACT, WD, RP, DM, DFF}; pg8::StaticOrder S; S.init(RP, DM, F.G, (int)blockIdx.x);
        pg8::EpiStoreBf16 E{FB, DM};
        pg8::gemm_phase<pg8::EpiStoreBf16, pg8::StaticOrder, PG8_ALIGN, PG8_SP2>(F.lds, g, S, E);
        SEAM(2);
    }
    #define BODY3 do { norm_rows<0>(F, args.in[I_G1POST], rstd2, args.in[I_X], args.in[I_META]); convert_mix(F, args.in[I_WIN], args.in[I_WOUT], args.in[I_GMIX], WIN, WOUT); } while (0)
    if (IN(3)) { PHASE_BEGIN();
#if (PH_DUP >> 3) & 1
        BODY3; xcd_barrier(bar);
#endif
        BODY3; SEAM(3); }
    if (IN(4)) { PHASE_BEGIN();
        zero_pads(F);
        pg8::Gemm g{AB, WIN, RP, NPROJ, DM}; pg8::StaticOrder S; S.init(RP, NPROJ, F.G, (int)blockIdx.x);
        pg8::EpiProj E{F.ws, WS_RSTD2, WS_QH, WS_KH, WS_VH, WS_IQ, WS_GQ, WS_GK, WS_GV, WS_GO, WS_IK, WS_IW, WS_GLOW};
        pg8::gemm_phase<pg8::EpiProj, pg8::StaticOrder, PG8_ALIGN, PG8_SP2>(F.lds, g, S, E);
        SEAM(4);
    }
#define BODY5A do { for (int v = F.vcu; v < 256; v += F.G) \
            for (int bq = 0; bq < 8; ++bq) { const int b = bq >> 2, q = bq & 3; const int t = q == 0 ? v : (q == 1 ? 511 - v : (q == 2 ? 512 + v : 1023 - v)); p5_item(F, b, t); } } while (0)
#define BODY5B do { PHASE_BEGIN(); for (int u = F.vcu; u < 1024; u += F.G) g1_unit(F, u >> 9, (u >> 7) & 3, u & 127, args.in[I_WGATE], args.in[I_BGATE]); } while (0)
    if (IN(5)) { PHASE_BEGIN();
#if (PH_DUP >> 5) & 1
        BODY5A; xcd_barrier(bar);
#endif
#if (PH_DUP >> 13) & 1
        BODY5B; xcd_barrier(bar);
#endif
        BODY5A; BODY5B;
        SEAM(5);
    }
    if (IN(6)) { PHASE_BEGIN(); g2_scan(F); SEAM(6); }
#define BODY7A do { p7_attention(F); } while (0)
#define BODY7B do { PHASE_BEGIN(); for (int u = F.vcu; u < 1024; u += F.G) g3_unit(F, u >> 9, (u >> 7) & 3, (u & 127) + 1, args.in[I_WGATE], args.in[I_BGATE], args.in[I_GGLA]); } while (0)
    if (IN(7)) { PHASE_BEGIN();
#if (PH_DUP >> 7) & 1
        BODY7A; xcd_barrier(bar);
#endif
#if (PH_DUP >> 14) & 1
        BODY7B; xcd_barrier(bar);
#endif
#ifndef SKIP_ATT
        BODY7A;
#endif
#ifndef SKIP_G3
        BODY7B;
#endif
        SEAM(7);
    }
    if (IN(8)) { PHASE_BEGIN();
        pg8::Gemm g{(const bf16*)(F.ws + WS_MIXA), WOUT, R, DM, DM}; pg8::StaticOrder S; S.init(R, DM, F.G, (int)blockIdx.x);
        pg8::EpiStoreBf16 E{FB, DM};
        pg8::gemm_phase<pg8::EpiStoreBf16, pg8::StaticOrder, PG8_ALIGN, PG8_SP2>(F.lds, g, S, E);
        SEAM(8);
    }
    if (IN(9)) { PHASE_BEGIN(); norm_rows<1>(F, args.in[I_GMIXPOST], rstd3, nullptr, nullptr); convert_ffn(F, args.in[I_W2G], args.in[I_W2U], args.in[I_W2D], args.in[I_G2PRE], WGU, WD); SEAM(9); }
    if (IN(10)) { PHASE_BEGIN();
        pg8::Gemm g{AB, WGU, R, NGU, DM}; pg8::StaticOrder S; S.init(R, NGU, F.G, (int)blockIdx.x);
        pg8::EpiSwiGLU E{ACT, DFF, rstd3};
        pg8::gemm_phase<pg8::EpiSwiGLU, pg8::StaticOrder, PG8_ALIGN, PG8_SP2>(F.lds, g, S, E);
        SEAM(10);
    }
    if (IN(11)) { PHASE_BEGIN();
        pg8::Gemm g{ACT, WD, R, DM, DFF}; pg8::StaticOrder S; S.init(R, DM, F.G, (int)blockIdx.x);
        pg8::EpiStoreBf16 E{FB, DM};
        pg8::gemm_phase<pg8::EpiStoreBf16, pg8::StaticOrder, PG8_ALIGN, PG8_SP2>(F.lds, g, S, E);
        SEAM(11);
    }
    if (IN(12)) { PHASE_BEGIN(); norm_rows<2>(F, args.in[I_G2POST], nullptr, nullptr, nullptr); PROBE_SPIN(); }
#undef IN
#undef SEAM
#undef AB
#undef ACT
#undef FB
#undef WGU
#undef WD
#undef WIN
#undef WOUT
#undef rstd1
#undef rstd2
#undef rstd3
}

extern "C" void kernel_launch(void* const* d_in, const int* in_sizes, int n_in, void* d_out, int out_size, void* d_ws, size_t ws_size, hipStream_t stream) {
    static int grid = 0;
    if (grid == 0) {
        if (n_in != 19 || in_sizes[0] != R * DM || out_size != R * DM || ws_size < WS_END) {
            fprintf(stderr, "kernel_launch: unexpected shapes (n_in %d, in0 %d, out %d, ws %zu; need ws >= %zu); nothing launched\n", n_in, n_in > 0 ? in_sizes[0] : -1, out_size, ws_size, (size_t)WS_END); grid = -1; return; }
        int dev = 0, cus = 0, per_cu = 0;
        if (hipGetDevice(&dev) != hipSuccess || hipDeviceGetAttribute(&cus, hipDeviceAttributeMultiprocessorCount, dev) != hipSuccess) { grid = -1; return; }
        if (hipFuncSetAttribute((const void*)hymba_fwd, hipFuncAttributeMaxDynamicSharedMemorySize, LDS_BYTES) != hipSuccess) { fprintf(stderr, "kernel_launch: hipFuncSetAttribute failed\n"); grid = -1; return; }
        if (hipOccupancyMaxActiveBlocksPerMultiprocessor(&per_cu, (const void*)hymba_fwd, NWAVES * 64, LDS_BYTES) != hipSuccess || per_cu < 1)
            fprintf(stderr, "kernel_launch: note: occupancy query reports %d workgroups per CU\n", per_cu);
        (void)hipGetLastError();
        grid = cus;
    }
    if (grid < 0) return;
    if (hipMemsetAsync((char*)d_ws + WS_CTL, 0, CTL_ZERO_BYTES, stream) != hipSuccess) return;
    Args a{};
    for (int i = 0; i < 19; ++i) a.in[i] = (const float*)d_in[i];
    a.out = (float*)d_out; a.ws = (unsigned char*)d_ws;
#if MK_PER_PHASE
    for (int p = 0; p < N_PHASES; ++p) { a.ph_lo = p; a.ph_hi = p + 1; hipLaunchKernelGGL(hymba_fwd, dim3(grid), dim3(NWAVES * 64), LDS_BYTES, stream, a); }
#else
    a.ph_lo = 0; a.ph_hi = N_PHASES;
    hipLaunchKernelGGL(hymba_fwd, dim3(grid), dim3(NWAVES * 64), LDS_BYTES, stream, a);
#endif
    const hipError_t le = hipPeekAtLastError();
    if (le != hipSuccess) fprintf(stderr, "kernel_launch: launch failed: %s\n", hipGetErrorName(le));
}
```

```cpp
#include <hip/hip_runtime.h>
#include <cstdio>
#include <cstdint>
#define MK_PER_PHASE 0
namespace pg8 {
#define PG8_LAS __attribute__((address_space(3)))
typedef unsigned short bf16_t;
typedef short bf16x8 __attribute__((ext_vector_type(8)));
typedef float f32x4 __attribute__((ext_vector_type(4)));
typedef unsigned u32x4 __attribute__((ext_vector_type(4)));
constexpr int BM = 256, BK = 64, HALF = 128, HTB = HALF * BK * 2  , STAGE_BYTES = 8 * HTB, NXCD = 8, WGM = 8;

__host__ __device__ __forceinline__ int lds_byte(int r, int c) { const int st = (r >> 4) * 2 + (c >> 5), rr = r & 15, cc = c & 31, ob = rr * 64 + cc * 2; return st * 1024 + (ob ^ (((ob >> 9) & 1) << 5)); }
__host__ __device__ __forceinline__ void stage_rc(int b, int& R, int& C) { const int st = b / 1024, sb = b % 1024, swz = sb ^ (((sb >> 9) & 1) << 5); R = (st >> 1) * 16 + swz / 64; C = (st & 1) * 32 + (swz % 64) / 2; }
__host__ __device__ __forceinline__ int perm32(int rho) { const int n = rho >> 4, i = rho & 15; return 8 * (i >> 2) + 4 * n + (i & 3); }

struct Unit { int pm, pn; };
struct Gemm { const bf16_t* A; const bf16_t* Bt; int M, N, K; };

struct StaticOrder {
    int nM, nN, nwg, G, c;
    __host__ __device__ void init(int M, int N, int G_, int c_) { nM = M / BM; nN = N / BM; nwg = nM * nN; G = G_; c = c_; }
    __host__ __device__ bool next(int i, Unit& u) const {
        const long L = (long)i * G + c; if (L >= nwg) return false;
        int wgid = (int)L; { const int q = nwg / NXCD, r = nwg % NXCD, xcd = wgid % NXCD, off = wgid / NXCD; wgid = (xcd < r ? xcd * (q + 1) : r * (q + 1) + (xcd - r) * q) + off; }
        const int nig = WGM * nN, gid = wgid / nig, fm = gid * WGM, gsz = (nM - fm) < WGM ? (nM - fm) : WGM;
        u.pm = fm + ((wgid % nig) % gsz); u.pn = (wgid % nig) / gsz; return true;
    }
    __device__ __forceinline__ void a_ready(const Unit&) const {}
    __device__ __forceinline__ void done(const Unit&) const {}
};

__device__ __forceinline__ unsigned cvt_pk_bf16(float lo, float hi) { unsigned r; asm volatile("v_cvt_pk_bf16_f32 %0, %1, %2" : "=v"(r) : "v"(lo), "v"(hi)); return r; }
typedef float f32x2 __attribute__((ext_vector_type(2)));

__device__ __forceinline__ void st8bf(bf16_t* p, const f32x4 v0, const f32x4 v1) {
    u32x4 w; w.x = cvt_pk_bf16(v0[0], v0[1]); w.y = cvt_pk_bf16(v0[2], v0[3]); w.z = cvt_pk_bf16(v1[0], v1[1]); w.w = cvt_pk_bf16(v1[2], v1[3]);
    *(u32x4*)p = w;
}
__device__ __forceinline__ float silu_f(float x) { return x * __builtin_amdgcn_rcpf(1.0f + __builtin_amdgcn_exp2f(-1.4426950408889634f * x)); }

struct EpiStoreBf16 {
    static constexpr bool PERM = true, AFTER_DRAIN = false;
    bf16_t* O; int ldc;
    __device__ __forceinline__ void operator()(const f32x4 (&acc)[2][2][4][2], const Unit& u, int wr, int wc, int fr, int fq) const {
        const int row0 = u.pm * BM + wr * 64 + fr, col0 = u.pn * BM + wc * 32 + 8 * fq;
#pragma unroll
        for (int ai = 0; ai < 2; ++ai)
#pragma unroll
            for (int m = 0; m < 4; ++m) { bf16_t* rowp = O + (size_t)(row0 + ai * HALF + m * 16) * ldc + col0;
#pragma unroll
                for (int bj = 0; bj < 2; ++bj) st8bf(rowp + bj * HALF, acc[ai][bj][m][0], acc[ai][bj][m][1]); }
    }
};
struct EpiSwiGLU {
    static constexpr bool PERM = true, AFTER_DRAIN = false;
    bf16_t* O; int ldc; const float* rstd;
    __device__ __forceinline__ void operator()(const f32x4 (&acc)[2][2][4][2], const Unit& u, int wr, int wc, int fr, int fq) const {
        const int row0 = u.pm * BM + wr * 64 + fr, col0 = u.pn * HALF + wc * 32 + 8 * fq;
#pragma unroll
        for (int ai = 0; ai < 2; ++ai)
#pragma unroll
            for (int m = 0; m < 4; ++m) { const int row = row0 + ai * HALF + m * 16; const float rs = rstd[row];
                f32x4 o0, o1;
#pragma unroll
                for (int j = 0; j < 4; ++j) { o0[j] = silu_f(acc[ai][0][m][0][j] * rs) * (acc[ai][1][m][0][j] * rs); o1[j] = silu_f(acc[ai][0][m][1][j] * rs) * (acc[ai][1][m][1][j] * rs); }
                st8bf(O + (size_t)row * ldc + col0, o0, o1); }
    }
};
struct EpiProj {
    static constexpr bool PERM = true, AFTER_DRAIN = false;
    static constexpr int TKV = 8256;
    unsigned char* ws; size_t o_rstd, o_qh, o_kh, o_vh, o_iq, o_gq, o_gk, o_gv, o_go, o_ik, o_iw, o_glow;
    __device__ __forceinline__ void operator()(const f32x4 (&acc)[2][2][4][2], const Unit& u, int wr, int wc, int fr, int fq) const {
        const float* rstd = (const float*)(ws + o_rstd);
        bf16_t* Qh = (bf16_t*)(ws + o_qh); bf16_t* Kh = (bf16_t*)(ws + o_kh); bf16_t* Vh = (bf16_t*)(ws + o_vh); bf16_t* IQ = (bf16_t*)(ws + o_iq); bf16_t* GQ = (bf16_t*)(ws + o_gq);
        bf16_t* GK = (bf16_t*)(ws + o_gk); bf16_t* GV = (bf16_t*)(ws + o_gv); bf16_t* GO = (bf16_t*)(ws + o_go); bf16_t* IK = (bf16_t*)(ws + o_ik); float* IW = (float*)(ws + o_iw); float* GLOW = (float*)(ws + o_glow);
        const int pn = u.pn;
        const int row0 = u.pm * BM + wr * 64 + fr;
#pragma unroll
        for (int ai = 0; ai < 2; ++ai)
#pragma unroll
            for (int m = 0; m < 4; ++m) {
                const int row = row0 + ai * HALF + m * 16; const float rs = rstd[row];
                const bool mainr = row < 16384, metar = (row >= 16384) && (row < 16400);
                const int b = row >> 13, s = row & 8191, mi = row - 16384;
#pragma unroll
                for (int bj = 0; bj < 2; ++bj) {
                    const int col = bj * HALF + wc * 32 + 8 * fq;
                    f32x4 v0 = acc[ai][bj][m][0] * rs, v1 = acc[ai][bj][m][1] * rs;
                    if (pn < 4) {
                        if (mainr) { const int h = pn * 2 + (col >> 7), d = col & 127; st8bf(Qh + ((size_t)(b * 8 + h) * 8192 + s) * 128 + d, v0, v1); }
                    } else if (pn < 12) {
                        bf16_t* base = pn < 8 ? Kh : Vh; const int h = (pn & 3) * 2 + (col >> 7), d = col & 127;
                        if (mainr) st8bf(base + ((size_t)(b * 8 + h) * TKV + 16 + s) * 128 + d, v0, v1);
                        else if (metar) { st8bf(base + ((size_t)h * TKV + mi) * 128 + d, v0, v1); st8bf(base + ((size_t)(8 + h) * TKV + mi) * 128 + d, v0, v1); }
                    } else if (pn < 16) {
                        if (mainr) st8bf(IQ + (size_t)row * 1024 + (pn - 12) * 256 + col, v0 * 0.125f, v1 * 0.125f);
                    } else if (pn < 18) {
                        if (mainr) st8bf(GQ + ((size_t)b * TKV + 64 + s) * 512 + (pn - 16) * 256 + col, v0 * 0.08838834764831845f, v1 * 0.08838834764831845f);
                    } else if (pn < 20) {
                        const int c = (pn - 18) * 256 + col;
                        if (mainr) st8bf(GK + ((size_t)b * TKV + 64 + s) * 512 + c, v0, v1);
                        else if (metar) { st8bf(GK + ((size_t)48 + mi) * 512 + c, v0, v1); st8bf(GK + ((size_t)TKV + 48 + mi) * 512 + c, v0, v1); }
                    } else if (pn < 24) {
                        const int c = (pn - 20) * 256 + col;
                        if (mainr) st8bf(GV + ((size_t)b * TKV + 64 + s) * 1024 + c, v0, v1);
                        else if (metar) { st8bf(GV + ((size_t)48 + mi) * 1024 + c, v0, v1); st8bf(GV + ((size_t)TKV + 48 + mi) * 1024 + c, v0, v1); }
                    } else if (pn < 28) {
                        if (mainr) st8bf(GO + (size_t)row * 1024 + (pn - 24) * 256 + col, v0, v1);
                    } else {
                        if (col < 64) {
                            const int ch = col >> 3, fo = (ch >> 1) * 512 + (ch & 1) * 256;
                            if (mainr) { const int pos = 16 + s; st8bf(IK + (size_t)b * TKV * 64 + (size_t)(pos >> 5) * 2048 + fo + (pos & 31) * 8, v0, v1); }
                            else if (metar) { st8bf(IK + fo + mi * 8, v0, v1); st8bf(IK + (size_t)TKV * 64 + fo + mi * 8, v0, v1); }
                        } else if (col < 80) {
                            if (mainr) { float* p = IW + (size_t)row * 16 + (col - 64); *(f32x4*)p = v0 * 0.25f; *(f32x4*)(p + 4) = v1 * 0.25f; }
                        } else if (col < 96) {
                            const int c = col - 80;
                            if (mainr) { float* p = GLOW + ((size_t)b * TKV + 64 + s) * 16 + c; *(f32x4*)p = v0; *(f32x4*)(p + 4) = v1; }
                            else if (metar) { float* p = GLOW + ((size_t)48 + mi) * 16 + c; *(f32x4*)p = v0; *(f32x4*)(p + 4) = v1;
                                              float* p2 = GLOW + ((size_t)TKV + 48 + mi) * 16 + c; *(f32x4*)p2 = v0; *(f32x4*)(p2 + 4) = v1; }
                        }
                    }
                }
            }
    }
};
template <class Epi, class Sched, bool ALIGN_EPI = false, bool SP2 = false>
__device__ __forceinline__ void gemm_phase(PG8_LAS unsigned char* lds, const Gemm g, const Sched& S, const Epi& E) {
    const int tid = threadIdx.x, wid = __builtin_amdgcn_readfirstlane(tid >> 6), lane = tid & 63, wr = wid >> 2, wc = wid & 3, fr = lane & 15, fq = lane >> 4;
    const int K = g.K, nt = K / BK;
    unsigned voffA[2], voffB[2];
#pragma unroll
    for (int i = 0; i < 2; ++i) { int R, C; stage_rc(tid * 16 + i * 8192, R, C); const int Rb = Epi::PERM ? ((R & ~31) + perm32(R & 31)) : R;
        voffA[i] = (unsigned)(R * K + C) * 2u; voffB[i] = (unsigned)(Rb * K + C) * 2u; }
    const size_t kstep = (size_t)(BK * 2);
    const size_t hstep = (size_t)HALF * K * 2;
    const size_t tstep = 2 * hstep;
    const unsigned ldsw = (unsigned)wid * 1024u;
    const int aoff = lds_byte(wr * 64 + fr, fq * 8), boff = lds_byte(wc * 32 + fr, fq * 8);
#define PG8_SA(b, h) (((b) * 2 + (h)) * HTB)
#define PG8_SB(b, h) ((4 + (b) * 2 + (h)) * HTB)
#define PG8_STAGE(bufoff, gbase, voff) do { _Pragma("unroll") for (int _i = 0; _i < 2; ++_i) \
        __builtin_amdgcn_global_load_lds((const unsigned*)((const char*)(gbase) + (voff)[_i]), (PG8_LAS unsigned*)(lds + (bufoff) + ldsw + _i * 8192), 16, 0, 0); } while (0)
#define PG8_LDA(dst, b, h) do { _Pragma("unroll") for (int m = 0; m < 4; ++m) _Pragma("unroll") for (int k = 0; k < 2; ++k) dst[m][k] = *(const PG8_LAS bf16x8*)(lds + PG8_SA(b, h) + aoff + m * 2048 + k * 1024); } while (0)
#define PG8_LDB(dst, b, h) do { _Pragma("unroll") for (int n = 0; n < 2; ++n) _Pragma("unroll") for (int k = 0; k < 2; ++k) dst[n][k] = *(const PG8_LAS bf16x8*)(lds + PG8_SB(b, h) + boff + n * 2048 + k * 1024); } while (0)
#define PG8_MMA(ai, bj, At, Bt) do { __builtin_amdgcn_s_setprio(1); _Pragma("unroll") for (int m = 0; m < 4; ++m) _Pragma("unroll") for (int n = 0; n < 2; ++n) _Pragma("unroll") for (int k = 0; k < 2; ++k) \
        acc[ai][bj][m][n] = __builtin_amdgcn_mfma_f32_16x16x32_bf16(Bt[n][k], At[m][k], acc[ai][bj][m][n], 0, 0, 0); __builtin_amdgcn_s_setprio(0); } while (0)
#define PG8_WAIT_V(n) asm volatile("s_waitcnt vmcnt(" #n ")" ::: "memory")
#define PG8_WAIT_L(n) asm volatile("s_waitcnt lgkmcnt(" #n ")" ::: "memory")
#define PG8_BAR __builtin_amdgcn_s_barrier()
#define PG8_SCHED __builtin_amdgcn_sched_barrier(0)
    Unit cur, nxt; int ui = 0;
    if (!S.next(0, cur)) return;
    f32x4 acc[2][2][4][2];
#pragma unroll
    for (int a = 0; a < 2; ++a)
#pragma unroll
        for (int b = 0; b < 2; ++b)
#pragma unroll
            for (int m = 0; m < 4; ++m)
#pragma unroll
                for (int n = 0; n < 2; ++n) acc[a][b][m][n] = (f32x4){0.f, 0.f, 0.f, 0.f};
    bf16x8 At[4][2], B0[2][2], B1[2][2];
    const char* cA = (const char*)g.A + (size_t)cur.pm * tstep; const char* cB = (const char*)g.Bt + (size_t)cur.pn * tstep;
    S.a_ready(cur);
    if constexpr (SP2) {
        PG8_STAGE(PG8_SB(0, 0), cB, voffB); PG8_STAGE(PG8_SB(0, 1), cB + hstep, voffB); PG8_STAGE(PG8_SA(0, 0), cA, voffA); PG8_STAGE(PG8_SA(0, 1), cA + hstep, voffA);
        if (wr == 1) PG8_BAR;
        PG8_WAIT_V(2); PG8_BAR;
        PG8_STAGE(PG8_SB(1, 0), cB + kstep, voffB); PG8_STAGE(PG8_SA(1, 0), cA + kstep, voffA); PG8_STAGE(PG8_SB(1, 1), cB + hstep + kstep, voffB);
        PG8_WAIT_V(6); PG8_BAR;
    } else {
        PG8_STAGE(PG8_SB(0, 0), cB, voffB); PG8_STAGE(PG8_SA(0, 0), cA, voffA); PG8_STAGE(PG8_SB(0, 1), cB + hstep, voffB); PG8_STAGE(PG8_SA(0, 1), cA + hstep, voffA);
        if (wr == 1) PG8_BAR;
        PG8_WAIT_V(4); PG8_BAR;
        PG8_STAGE(PG8_SB(1, 0), cB + kstep, voffB); PG8_STAGE(PG8_SA(1, 0), cA + kstep, voffA); PG8_STAGE(PG8_SB(1, 1), cB + hstep + kstep, voffB);
        PG8_WAIT_V(6); PG8_BAR;
    }
    for (;;) {
        const bool has_next = S.next(ui + 1, nxt);
        const char* nA = has_next ? (const char*)g.A + (size_t)nxt.pm * tstep : cA; const char* nB = has_next ? (const char*)g.Bt + (size_t)nxt.pn * tstep : cB;
        for (int t = 0; t < nt; t += 2) {
            const bool last = (t == nt - 2);
            const char* a1 = cA + (size_t)(t + 1) * kstep;
            const char* a2 = last ? nA : cA + (size_t)(t + 2) * kstep; const char* b2 = last ? nB : cB + (size_t)(t + 2) * kstep;
            const char* a3 = a2 + kstep; const char* b3 = b2 + kstep;
            if (last && has_next) S.a_ready(nxt);
            if constexpr (SP2) {
            PG8_LDB(B0, 0, 0); PG8_LDB(B1, 0, 1); PG8_SCHED; PG8_LDA(At, 0, 0); PG8_STAGE(PG8_SA(1, 1), a1 + hstep, voffA);
            PG8_WAIT_V(8); PG8_WAIT_L(0); PG8_BAR; PG8_MMA(0, 0, At, B0); PG8_MMA(0, 1, At, B1); PG8_BAR; PG8_SCHED;
            PG8_LDA(At, 0, 1); PG8_STAGE(PG8_SB(0, 0), b2, voffB); PG8_STAGE(PG8_SB(0, 1), b2 + hstep, voffB); PG8_STAGE(PG8_SA(0, 0), a2, voffA);
            PG8_WAIT_V(8); PG8_WAIT_L(0); PG8_BAR; PG8_MMA(1, 0, At, B0); PG8_MMA(1, 1, At, B1); PG8_BAR; PG8_SCHED;
            PG8_LDB(B0, 1, 0); PG8_LDB(B1, 1, 1); PG8_SCHED; PG8_LDA(At, 1, 0); PG8_STAGE(PG8_SA(0, 1), a2 + hstep, voffA);
            PG8_WAIT_V(8); PG8_WAIT_L(0); PG8_BAR; PG8_MMA(0, 0, At, B0); PG8_MMA(0, 1, At, B1); PG8_BAR; PG8_SCHED;
            PG8_LDA(At, 1, 1); PG8_STAGE(PG8_SB(1, 0), b3, voffB); PG8_STAGE(PG8_SB(1, 1), b3 + hstep, voffB); PG8_STAGE(PG8_SA(1, 0), a3, voffA);
            PG8_WAIT_V(8); PG8_WAIT_L(0); PG8_BAR; PG8_MMA(1, 0, At, B0); PG8_MMA(1, 1, At, B1); PG8_BAR; PG8_SCHED;
            } else {
            PG8_LDB(B0, 0, 0); PG8_SCHED; PG8_LDA(At, 0, 0); PG8_STAGE(PG8_SA(1, 1), a1 + hstep, voffA);
            PG8_WAIT_L(8); PG8_BAR; PG8_WAIT_L(0); PG8_MMA(0, 0, At, B0); PG8_BAR; PG8_SCHED;
            PG8_LDB(B1, 0, 1); PG8_STAGE(PG8_SB(0, 0), b2, voffB);
            PG8_BAR; PG8_WAIT_L(0); PG8_MMA(0, 1, At, B1); PG8_BAR;
            PG8_LDA(At, 0, 1); PG8_STAGE(PG8_SA(0, 0), a2, voffA);
            PG8_BAR; PG8_WAIT_L(0); PG8_MMA(1, 0, At, B0); PG8_BAR; PG8_SCHED;
            PG8_STAGE(PG8_SB(0, 1), b2 + hstep, voffB);
            PG8_WAIT_V(6); PG8_BAR; PG8_MMA(1, 1, At, B1); PG8_BAR;
            PG8_LDB(B0, 1, 0); PG8_SCHED; PG8_LDA(At, 1, 0); PG8_STAGE(PG8_SA(0, 1), a2 + hstep, voffA);
            PG8_WAIT_L(8); PG8_BAR; PG8_WAIT_L(0); PG8_MMA(0, 0, At, B0); PG8_BAR; PG8_SCHED;
            PG8_LDB(B1, 1, 1); PG8_STAGE(PG8_SB(1, 0), b3, voffB);
            PG8_BAR; PG8_WAIT_L(0); PG8_MMA(0, 1, At, B1); PG8_BAR;
            PG8_LDA(At, 1, 1); PG8_STAGE(PG8_SA(1, 0), a3, voffA);
            PG8_BAR; PG8_WAIT_L(0); PG8_MMA(1, 0, At, B0); PG8_BAR; PG8_SCHED;
            PG8_STAGE(PG8_SB(1, 1), b3 + hstep, voffB);
            PG8_WAIT_V(6); PG8_BAR; PG8_MMA(1, 1, At, B1); PG8_BAR;
            }
        }
        if constexpr (ALIGN_EPI) { if (wr == 0) PG8_BAR; }
        if constexpr (!Epi::AFTER_DRAIN) { E(acc, cur, wr, wc, fr, fq); S.done(cur); }
        if (!has_next) break;
#pragma unroll
        for (int a = 0; a < 2; ++a)
#pragma unroll
            for (int b = 0; b < 2; ++b)
#pragma unroll
                for (int m = 0; m < 4; ++m)
#pragma unroll
                    for (int n = 0; n < 2; ++n) acc[a][b][m][n] = (f32x4){0.f, 0.f, 0.f, 0.f};
        cur = nxt; cA = nA; cB = nB; ++ui;
        if constexpr (ALIGN_EPI) { if (wr == 1) PG8_BAR; }
    }
    PG8_WAIT_V(0);
    if constexpr (!ALIGN_EPI) { if (wr == 0) PG8_BAR; }
    PG8_BAR;
    if constexpr (Epi::AFTER_DRAIN) { E.fused(acc, cur, wr, wc, fr, fq, lds, wid, lane); S.done(cur); }
#undef PG8_SA
#undef PG8_SB
#undef PG8_STAGE
#undef PG8_LDA
#undef PG8_LDB
#undef PG8_MMA
#undef PG8_WAIT_V
#undef PG8_WAIT_L
#undef PG8_BAR
#undef PG8_SCHED
}
}

namespace att {
typedef unsigned short bf16;
typedef short bf16x8 __attribute__((ext_vector_type(8)));
typedef short s16x4 __attribute__((ext_vector_type(4)));
typedef float f32x16 __attribute__((ext_vector_type(16)));
typedef float f32x4 __attribute__((ext_vector_type(4)));
typedef unsigned u32x4 __attribute__((ext_vector_type(4)));
typedef unsigned long long u64;
constexpr int HD = 128, NW = 8, QBLK = 32, KVBLK = 64, QB = NW * QBLK;
constexpr int SHM_V = KVBLK * HD * 2, SHM_K = KVBLK * HD * 2;
constexpr int ATT_LDS_BYTES = 2 * SHM_V + 2 * SHM_K + NW * 64 * 4;
constexpr float SCALE = 0.08838834764831845f;
constexpr float THR = 8.f;
constexpr int OSTR = 2048;
constexpr int MWORDS = 130;

#define KSWZ(row, colB) ((row) * 256 + ((colB) ^ (((row) & 7) << 4)))
#define SBAR() __builtin_amdgcn_sched_barrier(0)
__device__ __forceinline__ int v_st(int k, int c) { const int kk = (k & ~0xC) | ((k & 4) << 1) | ((k & 8) >> 1); return ((kk >> 3) * 4 + (c >> 5)) * 512 + ((kk & 7) * 32 + (c & 31)) * 2; }
__device__ __forceinline__ int v_rd_base(int lane) { return ((lane & 3) << 3) | (((lane >> 2) & 3) << 6) | (((lane >> 4) & 1) << 5) | (((lane >> 5) & 1) << 8); }
constexpr int v_rd_off(int d0, int ks, int half) { return d0 * 512 + ks * 4096 + half * 2048; }
__device__ __forceinline__ int crow(int r, int hi) { return (r & 3) + 8 * (r >> 2) + 4 * hi; }
__device__ __forceinline__ unsigned cvtpk(float lo, float hi) {
    unsigned r; asm volatile("v_cvt_pk_bf16_f32 %0, %1, %2" : "=v"(r) : "v"(lo), "v"(hi)); return r;
}
__device__ __forceinline__ bf16x8 load8(const bf16* p) { return *reinterpret_cast<const bf16x8*>(p); }
__device__ __forceinline__ void mask_bits(f32x16& p0, f32x16& p1, unsigned mw) {
    const float NEG = -__builtin_inff();
#pragma unroll
    for (int r = 0; r < 16; ++r) {
        if (!((mw >> r) & 1u)) p0[r] = NEG;
        if (!((mw >> (16 + r)) & 1u)) p1[r] = NEG;
    }
}
__device__ __forceinline__ void partialSM(f32x16& p0, f32x16& p1, float& m_reg, float& mn, float& alpha) {
    float pmax = p0[0]; for (int r = 1; r < 16; ++r) pmax = fmaxf(pmax, p0[r]); for (int r = 0; r < 16; ++r) pmax = fmaxf(pmax, p1[r]);
    { auto rr = __builtin_amdgcn_permlane32_swap(__float_as_uint(pmax), __float_as_uint(pmax), false, false);
      pmax = fmaxf(__uint_as_float(rr[0]), __uint_as_float(rr[1])); }
    constexpr float C2 = 1.4426950408889634f * SCALE;
    if (__builtin_expect(__all((pmax - m_reg) * SCALE <= THR), 1)) { mn = m_reg; alpha = 1.f; }
    else { mn = fmaxf(m_reg, pmax); alpha = __builtin_amdgcn_exp2f((m_reg - mn) * C2); m_reg = mn; }
    const float mnL = -mn * C2;
    for (int r = 0; r < 16; ++r) p0[r] = fmaf(p0[r], C2, mnL); for (int r = 0; r < 16; ++r) p1[r] = fmaf(p1[r], C2, mnL);
    for (int r = 0; r < 16; ++r) p0[r] = __builtin_amdgcn_exp2f(p0[r]);
}
__device__ __forceinline__ void finishSM(f32x16& p0, f32x16& p1, float alpha, float& l_reg, bf16x8& pa0, bf16x8& pa1, bf16x8& pa2, bf16x8& pa3) {
    for (int r = 0; r < 16; ++r) p1[r] = __builtin_amdgcn_exp2f(p1[r]);
    float ps = 0; for (int r = 0; r < 16; ++r) ps += p0[r]; for (int r = 0; r < 16; ++r) ps += p1[r];
    { auto rr = __builtin_amdgcn_permlane32_swap(__float_as_uint(ps), __float_as_uint(ps), false, false);
      ps = __uint_as_float(rr[0]) + __uint_as_float(rr[1]); }
    l_reg = l_reg * alpha + ps;
#define PK4(P, B_, OUT) do { unsigned a0 = cvtpk(P[B_+0], P[B_+1]), a1 = cvtpk(P[B_+2], P[B_+3]);                          \
        unsigned b0 = cvtpk(P[B_+4], P[B_+5]), b1 = cvtpk(P[B_+6], P[B_+7]);                                             \
        auto r0 = __builtin_amdgcn_permlane32_swap(a0, b0, false, false); auto r1 = __builtin_amdgcn_permlane32_swap(a1, b1, false, false); \
        u32x4 w = {r0[0], r1[0], r0[1], r1[1]}; OUT = *reinterpret_cast<bf16x8*>(&w); } while (0)
    PK4(p0, 0, pa0); PK4(p0, 8, pa1); PK4(p1, 0, pa2); PK4(p1, 8, pa3);
#undef PK4
}
template <int KB>
__device__ __forceinline__ void qkt(f32x16& p0, f32x16& p1, const char* K_lds, int r32, int hi, const bf16x8* qr) {
    p0 = f32x16{}; p1 = f32x16{};
    const char* kb[4];
#pragma unroll
    for (int dd = 0; dd < 4; ++dd) kb[dd] = K_lds + KB * SHM_K + KSWZ(r32, (dd * 16 + hi * 8) * 2);
#pragma unroll
    for (int d0 = 0; d0 < 8; ++d0) { const char* a = kb[d0 & 3] + (d0 >> 2) * 128;
        bf16x8 b0 = *reinterpret_cast<const bf16x8*>(a);
        bf16x8 b1 = *reinterpret_cast<const bf16x8*>(a + 32 * 256);
        p0 = __builtin_amdgcn_mfma_f32_32x32x16_bf16(b0, qr[d0], p0, 0, 0, 0);
        p1 = __builtin_amdgcn_mfma_f32_32x32x16_bf16(b1, qr[d0], p1, 0, 0, 0); }
}
template <int VB>
__device__ __forceinline__ void pv_tile(f32x16* o, int vb0, bf16x8 pa0, bf16x8 pa1, bf16x8 pa2, bf16x8 pa3) {
#define TRRD(dst, off) asm volatile("ds_read_b64_tr_b16 %0, %1 offset:%2" : "=&v"(dst) : "v"(vb0), "i"(off) : "memory")
#define PV_D0(d0) do { s16x4 l0, l1, l2, l3, h0, h1, h2, h3; constexpr int b_ = VB * SHM_V + v_rd_off(d0, 0, 0);     \
        TRRD(l0, b_); TRRD(h0, b_ + 2048); TRRD(l1, b_ + 4096); TRRD(h1, b_ + 6144); TRRD(l2, b_ + 8192); TRRD(h2, b_ + 10240); TRRD(l3, b_ + 12288); TRRD(h3, b_ + 14336); \
        asm volatile("s_waitcnt lgkmcnt(0)" ::: "memory"); SBAR();             \
        o[d0] = __builtin_amdgcn_mfma_f32_32x32x16_bf16(pa0, (bf16x8){l0[0], l0[1], l0[2], l0[3], h0[0], h0[1], h0[2], h0[3]}, o[d0], 0, 0, 0);   \
        o[d0] = __builtin_amdgcn_mfma_f32_32x32x16_bf16(pa1, (bf16x8){l1[0], l1[1], l1[2], l1[3], h1[0], h1[1], h1[2], h1[3]}, o[d0], 0, 0, 0);   \
        o[d0] = __builtin_amdgcn_mfma_f32_32x32x16_bf16(pa2, (bf16x8){l2[0], l2[1], l2[2], l2[3], h2[0], h2[1], h2[2], h2[3]}, o[d0], 0, 0, 0);   \
        o[d0] = __builtin_amdgcn_mfma_f32_32x32x16_bf16(pa3, (bf16x8){l3[0], l3[1], l3[2], l3[3], h3[0], h3[1], h3[2], h3[3]}, o[d0], 0, 0, 0); } while (0)
    PV_D0(0); PV_D0(1); PV_D0(2); PV_D0(3);
#undef PV_D0
#undef TRRD
}

struct BlockRef { const bf16* Q; const bf16* K; const bf16* V; bf16* O; const u64* M; int NT; };
struct Seam { bf16x8 qr[8]; bf16x8 st_v0, st_v1, st_k0, st_k1; };
#define VMW() asm volatile("s_waitcnt vmcnt(0)" ::: "memory")
#define VMWN(n) asm volatile("s_waitcnt vmcnt(%0)" :: "i"(n) : "memory")
#define SLOAD_H(Kp, Vp, k0) do { int t_ = tid; asm volatile("" : "+v"(t_)); const unsigned go_ = (unsigned)((k0) * (HD * 2)) + (unsigned)t_ * 16u;               \
                         S.st_v0 = load8((const bf16*)((const char*)(Vp) + go_)); S.st_v1 = load8((const bf16*)((const char*)(Vp) + (go_ + 8192u)));              \
                         S.st_k0 = load8((const bf16*)((const char*)(Kp) + go_)); S.st_k1 = load8((const bf16*)((const char*)(Kp) + (go_ + 8192u))); } while (0)
#define SWRITE_HK(bf) do { int t_ = tid; asm volatile("" : "+v"(t_)); const int sr_ = t_ >> 4, sc_ = (t_ & 15) * 8, kws_ = KSWZ(sr_, sc_ * 2);                      \
                         *(bf16x8*)(K_lds + (bf) * SHM_K + kws_) = S.st_k0; *(bf16x8*)(K_lds + (bf) * SHM_K + kws_ + 32 * 256) = S.st_k1; } while (0)
#define SWRITE_HV(bf) do { int t_ = tid; asm volatile("" : "+v"(t_)); const int sr_ = t_ >> 4, sc_ = (t_ & 15) * 8, vs_ = v_st(sr_, sc_);                            \
                         *(bf16x8*)(V_lds + (bf) * SHM_V + vs_) = S.st_v0; *(bf16x8*)(V_lds + (bf) * SHM_V + vs_ + 8192) = S.st_v1; } while (0)
#define SWRITE_H(bf) do { SWRITE_HV(bf); SWRITE_HK(bf); } while (0)
__device__ __forceinline__ void att_prime(const BlockRef& cur, char* lds, Seam& S) {
    const int tid = threadIdx.x, wid = __builtin_amdgcn_readfirstlane(tid >> 6), lane = tid & 63, r32 = lane & 31, hi = lane >> 5;
    char* K_lds = lds + 2 * SHM_V;
#pragma unroll
    for (int d0 = 0; d0 < 8; ++d0) S.qr[d0] = load8((const bf16*)((const char*)cur.Q + (unsigned)(((wid * QBLK + r32) * HD + hi * 8) * 2 + d0 * 32)));
    SLOAD_H(cur.K, cur.V, 0); VMW(); SWRITE_HK(0);
    __syncthreads();
}
__device__ __forceinline__ void att_block(const BlockRef& cur, const BlockRef& nxt, char* lds, Seam& S) {
    const int tid = threadIdx.x, wid = __builtin_amdgcn_readfirstlane(tid >> 6), lane = tid & 63, r32 = lane & 31, hi = lane >> 5;
    const int NT = cur.NT;
    char* V_lds = lds; char* K_lds = lds + 2 * SHM_V;
    float* ws = (float*)(lds + 2 * SHM_V + 2 * SHM_K) + wid * 64; float* li_l = ws, * al_l = ws + 32;
    float m_reg = -1e30f, l_reg = 0; f32x16 o[4] = {};
    const int vb0 = (int)(uintptr_t)V_lds + v_rd_base(lane);
    const bf16* Kh = cur.K; const bf16* Vh = cur.V;
    const char* Mb = (const char*)cur.M; const unsigned moff = (unsigned)((wid * QBLK + r32) * (MWORDS * 8) + hi * 4);
#define MLOAD(t) (*(const unsigned*)(Mb + (moff + (unsigned)(t) * 8u)))
    unsigned mwA = MLOAD(0), mwB = 0u;
#define RESC(a) do { if (__any((a) < 1.f)) { if (hi == 0) al_l[r32] = (a); asm volatile("s_waitcnt lgkmcnt(0)" ::: "memory");              \
                     for (int d_ = 0; d_ < 4; ++d_) for (int r = 0; r < 16; ++r) o[d_][r] *= al_l[crow(r, hi)]; } } while (0)
#define KBASE(t) ((t) * KVBLK)
    constexpr int NQL = 8;
#define SEAM_K0() do { VMWN(NQL); SWRITE_HK(0); SBAR(); } while (0)
    f32x16 pA0, pA1, pB0, pB1; float mnA, mnB, alA, alB; bf16x8 pa0, pa1, pa2, pa3;
    SWRITE_HV(0); SBAR();
    if (NT > 1) { SLOAD_H(Kh, Vh, KBASE(1)); }
    SBAR(); qkt<0>(pA0, pA1, K_lds, r32, hi, S.qr);
    mask_bits(pA0, pA1, mwA); partialSM(pA0, pA1, m_reg, mnA, alA);
    if (NT > 1) { VMW(); SWRITE_H(1); }
    __syncthreads();
#define HALF_STEP(PX0, PX1, mnX, alX, PY0, PY1, alY, t, KB, VB, SB, MWX, MWY) do {                                             \
        MWX = MLOAD(t);                                                                                                       \
        SBAR(); qkt<KB>(PX0, PX1, K_lds, r32, hi, S.qr);                                                                      \
        finishSM(PY0, PY1, alY, l_reg, pa0, pa1, pa2, pa3); SBAR();                                                           \
        if ((t) + 1 < NT) { SLOAD_H(Kh, Vh, KBASE((t) + 1)); SBAR(); }                                                        \
        pv_tile<VB>(o, vb0, pa0, pa1, pa2, pa3); mask_bits(PX0, PX1, MWX); partialSM(PX0, PX1, m_reg, mnX, alX);          \
        __syncthreads();                                                                                                      \
        if ((t) + 1 < NT) { VMW(); SWRITE_H(SB); }                                                                            \
        RESC(alX); __syncthreads(); } while (0)
    for (int t = 1; t + 1 < NT; t += 2) {
        HALF_STEP(pB0, pB1, mnB, alB, pA0, pA1, alA, t, 1, 0, 0, mwB, mwA);
        HALF_STEP(pA0, pA1, mnA, alA, pB0, pB1, alB, t + 1, 0, 1, 1, mwA, mwB);
    }
    const bool even = (NT & 1) == 0;
    if (even) { mwB = MLOAD(NT - 1); SBAR(); qkt<1>(pB0, pB1, K_lds, r32, hi, S.qr); SBAR(); }
    SLOAD_H(nxt.K, nxt.V, 0); SBAR();
#pragma unroll
    for (int d0 = 0; d0 < 8; ++d0) S.qr[d0] = load8((const bf16*)((const char*)nxt.Q + (unsigned)(((wid * QBLK + r32) * HD + hi * 8) * 2 + d0 * 32)));
    SBAR();
    finishSM(pA0, pA1, alA, l_reg, pa0, pa1, pa2, pa3); SBAR();
    pv_tile<0>(o, vb0, pa0, pa1, pa2, pa3);
    if (even) { mask_bits(pB0, pB1, mwB); partialSM(pB0, pB1, m_reg, mnB, alB); __syncthreads(); RESC(alB);
        finishSM(pB0, pB1, alB, l_reg, pa0, pa1, pa2, pa3); SBAR(); pv_tile<1>(o, vb0, pa0, pa1, pa2, pa3); }
    SBAR(); SEAM_K0();
    if (hi == 0) li_l[r32] = l_reg; asm volatile("s_waitcnt lgkmcnt(0)" ::: "memory");
    float rli[16];
#pragma unroll
    for (int r = 0; r < 16; ++r) rli[r] = __builtin_amdgcn_rcpf(li_l[crow(r, hi)]);
    char* Owb = (char*)(cur.O + (size_t)(wid * QBLK) * OSTR);
    int hi_e = hi, r32_e = r32; asm volatile("" : "+v"(hi_e), "+v"(r32_e));
    const unsigned lane_off = (unsigned)(4 * hi_e * OSTR + r32_e) * 2u;
#pragma unroll
    for (int r = 0; r < 16; ++r) { constexpr int dummy = 0; (void)dummy; const unsigned rowb = (unsigned)(((r & 3) + 8 * (r >> 2)) * OSTR * 2);
#pragma unroll
        for (int d0 = 0; d0 < 4; ++d0) { const float v = o[d0][r] * rli[r];
            const float vn = __shfl_xor(v, 1);
            if ((r32 & 1) == 0) *(unsigned*)(Owb + rowb + d0 * 64 + lane_off) = cvtpk(v, vn); } }
    __syncthreads();
#undef RESC
#undef KBASE
#undef SEAM_K0
#undef HALF_STEP
#undef MLOAD
}
#undef VMW
#undef VMWN
#undef SLOAD_H
#undef SWRITE_HK
#undef SWRITE_HV
#undef SWRITE_H
#undef KSWZ
#undef SBAR
}

constexpr int NWAVES = 8;
#ifndef MK_PER_PHASE
#define MK_PER_PHASE 0
#endif
constexpr int N_PHASES = 13;

constexpr int DM = 2048, SEQ = 8192, NBATCH = 2, NMETA = 16, DFF = 5632;
constexpr int R = NBATCH * SEQ;
constexpr int RP = 16640;
constexpr int TKV = 8256;
constexpr int NPROJ = 7424;
constexpr int NGU = 2 * DFF;
constexpr float EPS = 1e-6f;

constexpr size_t MiB = 1u << 20;
constexpr size_t WS_CTL = 0, CTL_ZERO_BYTES = 1 * MiB;
constexpr size_t WS_AB = 1 * MiB;
constexpr size_t WS_WB = 66 * MiB;
constexpr size_t WS_WGU = WS_WB, WS_WD = WS_WB + 44 * MiB, WS_WIN = WS_WB, WS_WOUT = WS_WB + 29 * MiB, WS_MASK = WS_WB + 40 * MiB;
constexpr size_t WS_SMALL = 132 * MiB;
constexpr size_t WS_RSTD1 = WS_SMALL, WS_RSTD2 = WS_SMALL + 128 * 1024, WS_RSTD3 = WS_SMALL + 256 * 1024, WS_DEC = WS_SMALL + 384 * 1024;
constexpr size_t WS_ACT = 133 * MiB;
constexpr size_t WS_F = 312 * MiB;
constexpr size_t WS_MIXA = 133 * MiB;
constexpr size_t WS_QH = 197 * MiB;
constexpr size_t WS_KH = 229 * MiB, WS_VH = 262 * MiB;
constexpr size_t WS_IQ = 295 * MiB;
constexpr size_t WS_GQ = 327 * MiB, WS_GK = 344 * MiB;
constexpr size_t WS_GV = 361 * MiB;
constexpr size_t WS_GO = 394 * MiB;
constexpr size_t WS_IK = 426 * MiB;
constexpr size_t WS_IW = 429 * MiB;
constexpr size_t WS_GLOW = 430 * MiB;
constexpr size_t WS_ST = 432 * MiB;
constexpr size_t WS_END = 496 * MiB;
constexpr int CW_BAR = 4096;

constexpr int SCR_BYTES = 147456;
constexpr int MISC_OFF = SCR_BYTES;
constexpr int LDS_BYTES = SCR_BYTES + 2048;

#define GAS __attribute__((address_space(1)))
#define LAS __attribute__((address_space(3)))
typedef unsigned short bf16;
typedef unsigned v4u __attribute__((ext_vector_type(4)));
typedef unsigned v2u __attribute__((ext_vector_type(2)));
typedef float f32x4 __attribute__((ext_vector_type(4)));
typedef float f32x16 __attribute__((ext_vector_type(16)));
typedef short bf16x8 __attribute__((ext_vector_type(8)));
typedef unsigned long long u64;
typedef GAS unsigned gu32;
#define RLX_AGENT __ATOMIC_RELAXED, __HIP_MEMORY_SCOPE_AGENT
#define LDS_WAIT() asm volatile("s_waitcnt lgkmcnt(0)" ::: "memory")
#define VM_WAIT() asm volatile("s_waitcnt vmcnt(0)" ::: "memory")
__device__ __forceinline__ unsigned f2bf(float f) { unsigned u = __builtin_bit_cast(unsigned, f); return (u + 0x7fffu + ((u >> 16) & 1u)) >> 16; }
__device__ __forceinline__ unsigned pk2(float lo, float hi) { return f2bf(lo) | (f2bf(hi) << 16); }
__device__ __forceinline__ float bf2f(unsigned short b) { return __builtin_bit_cast(float, (unsigned)b << 16); }
__device__ __forceinline__ float bflo(unsigned w) { return __builtin_bit_cast(float, w << 16); }
__device__ __forceinline__ float bfhi(unsigned w) { return __builtin_bit_cast(float, w & 0xffff0000u); }
#define XB_TMO      128
#define XB_XCNT(j)  (256  + 64 * (j))
#define XB_XSUB(j)  (1280 + 64 * (j))
#define XB_XGEN(j)  (2304 + 64 * (j))
#define XB_TOP      3328
#define XB_TOPGEN   3392
#define XCD_BAR_WORDS 3456
#define XB_SPIN_CAP (1u << 22)

__device__ __forceinline__ unsigned xb_ld(unsigned* p)              { return __hip_atomic_load(p, __ATOMIC_RELAXED, __HIP_MEMORY_SCOPE_AGENT); }
__device__ __forceinline__ unsigned xb_add(unsigned* p, unsigned v) { return __hip_atomic_fetch_add(p, v, __ATOMIC_RELAXED, __HIP_MEMORY_SCOPE_AGENT); }
__device__ __forceinline__ unsigned xb_xcc_id() { return (unsigned)__builtin_amdgcn_s_getreg((3 << 11) | 20) & 0xFu; }
#define XB_SPIN(cond, bar) do { unsigned _sp = 0; while (cond) { __builtin_amdgcn_s_sleep(1); \
    if ((++_sp & 255u) == 0u) { if (xb_ld(&(bar)[XB_TMO])) break; if (_sp > XB_SPIN_CAP) { atomicAdd(&(bar)[XB_TMO], 1u); break; } } } } while (0)

struct XcdBarrier {
    unsigned* bar; unsigned x;
    volatile LAS unsigned* st;
};

__device__ __forceinline__ XcdBarrier xcd_barrier_post(unsigned* bar, volatile LAS unsigned* st) {
    XcdBarrier b; b.bar = bar; b.x = xb_xcc_id(); b.st = st;
    if (threadIdx.x == 0) (void)xb_add(&bar[XB_XCNT(b.x)], 1u);
    return b;
}
__device__ __forceinline__ void xcd_barrier_complete(unsigned* bar, unsigned x, unsigned& nloc, unsigned& nx) {
    const unsigned G = gridDim.x * gridDim.y * gridDim.z;
    unsigned sum, cnt, mine, sp = 0u;
    for (;;) {
        sum = 0u; cnt = 0u; mine = 0u;
#pragma unroll
        for (unsigned j = 0; j < 16; ++j) { const unsigned c = xb_ld(&bar[XB_XCNT(j)]); sum += c; cnt += (c > 0u) ? 1u : 0u; mine = (j == x) ? c : mine; }
        if (sum == G) break;
        __builtin_amdgcn_s_sleep(1);
        if ((++sp & 255u) == 0u) { if (xb_ld(&bar[XB_TMO])) break; if (sp > XB_SPIN_CAP) { atomicAdd(&bar[XB_TMO], 1u); break; } }
    }
    nloc = mine > 0u ? mine : 1u; nx = cnt > 0u ? cnt : 1u;
}

__device__ __forceinline__ void xcd_barrier(const XcdBarrier& b) {
    asm volatile("s_waitcnt vmcnt(0)" ::: "memory");
    __syncthreads();
    if (threadIdx.x == 0) {
        unsigned* bar = b.bar;
        __builtin_amdgcn_s_waitcnt(0);
        unsigned nloc = b.st[0], nx = b.st[1];
        if (nloc == 0u) { xcd_barrier_complete(bar, b.x, nloc, nx); b.st[0] = nloc; b.st[1] = nx; }
        const unsigned old = xb_add(&bar[XB_XSUB(b.x)], 1u);
        const unsigned gen = old / nloc;
        if (old + 1u == (gen + 1u) * nloc) {
            __builtin_amdgcn_fence(__ATOMIC_RELEASE, "agent");
            asm volatile("s_waitcnt vmcnt(0)" ::: "memory");
            const unsigned og = xb_add(&bar[XB_TOP], 1u);
            const unsigned tg = og / nx;
            if (og + 1u == (tg + 1u) * nx) xb_add(&bar[XB_TOPGEN], 1u);
            else XB_SPIN(xb_ld(&bar[XB_TOPGEN]) == tg, bar);
            __builtin_amdgcn_fence(__ATOMIC_ACQUIRE, "agent");
            xb_add(&bar[XB_XGEN(b.x)], 1u);
            asm volatile("s_waitcnt vmcnt(0)" ::: "memory");
        } else {
            XB_SPIN(xb_ld(&bar[XB_XGEN(b.x)]) == gen, bar);
            __builtin_amdgcn_fence(__ATOMIC_ACQUIRE, "agent");
            asm volatile("s_waitcnt vmcnt(0)" ::: "memory");
        }
    }
    __syncthreads();
}

struct Frame {
    LAS unsigned char* lds;
    unsigned char* ldsg;
    volatile LAS unsigned* MISC;
    unsigned* ctl;
    int tid, lane, wave, vcu, G;
    float* out; unsigned char* ws;
};
enum { I_X = 0, I_META, I_G1PRE, I_W1G, I_W1U, I_W1D, I_G1POST, I_GMIX, I_WIN, I_WGATE, I_BGATE, I_GGLA, I_WOUT, I_GMIXPOST, I_G2PRE, I_W2G, I_W2U, I_W2D, I_G2POST };
#ifndef PROBE_K
#define PROBE_K (-1)
#endif
#ifndef PROBE_BLOCK
#define PROBE_BLOCK 37
#endif
#ifndef PROBE_AMP
#define PROBE_AMP 4
#endif
#define TIC(k) do { if (PROBE_K == (k) && blockIdx.x == PROBE_BLOCK && threadIdx.x == 0) { const unsigned long long t_ = __builtin_amdgcn_s_memrealtime(); F.MISC[20] = (unsigned)t_; F.MISC[21] = (unsigned)(t_ >> 32); } } while (0)
#define TOC(k) do { if (PROBE_K == (k) && blockIdx.x == PROBE_BLOCK && threadIdx.x == 0) { const unsigned long long t0_ = ((unsigned long long)F.MISC[21] << 32) | F.MISC[20]; \
        const unsigned long long a_ = (((unsigned long long)F.MISC[23] << 32) | F.MISC[22]) + (__builtin_amdgcn_s_memrealtime() - t0_); F.MISC[22] = (unsigned)a_; F.MISC[23] = (unsigned)(a_ >> 32); } } while (0)
#define PROBE_SPIN() do { if (PROBE_K >= 0 && blockIdx.x == PROBE_BLOCK && threadIdx.x == 0) { const unsigned long long a_ = (((unsigned long long)F.MISC[23] << 32) | F.MISC[22]) * PROBE_AMP; \
        const unsigned long long s_ = __builtin_amdgcn_s_memrealtime(); while (__builtin_amdgcn_s_memrealtime() - s_ < a_) __builtin_amdgcn_s_sleep(8); } } while (0)

__device__ __forceinline__ float wave_sum(float v) {
#pragma unroll
    for (int o = 1; o < 64; o <<= 1) v += __shfl_xor(v, o);
    return v;
}
__device__ __forceinline__ unsigned wave_sum_u(unsigned v) {
    v += (unsigned)__builtin_amdgcn_update_dpp(0, (int)v, 0xB1, 0xf, 0xf, false);
    v += (unsigned)__builtin_amdgcn_update_dpp(0, (int)v, 0x4E, 0xf, 0xf, false);
    v += (unsigned)__builtin_amdgcn_update_dpp(0, (int)v, 0x141, 0xf, 0xf, false);
    v += (unsigned)__builtin_amdgcn_update_dpp(0, (int)v, 0x140, 0xf, 0xf, false);
    return (unsigned)__builtin_amdgcn_readlane((int)v, 0) + (unsigned)__builtin_amdgcn_readlane((int)v, 16) + (unsigned)__builtin_amdgcn_readlane((int)v, 32) + (unsigned)__builtin_amdgcn_readlane((int)v, 48);
}

__device__ __forceinline__ void tr_item(const float* W, int N, int K, bf16* WT, int drow0, int scol, const float* gain, LAS float* scr, int k0, int lane) {
#pragma unroll 8
    for (int i = 0; i < 32; ++i) { const int kk = 2 * i + (lane >> 5); float v = 0.f;
        if (scol >= 0) v = W[(size_t)(k0 + kk) * N + scol];
        if (gain) v *= gain[k0 + kk];
        scr[kk * 33 + (lane & 31)] = v; }
    LDS_WAIT(); asm volatile("" ::: "memory");
    const int c = lane & 7;
#pragma unroll
    for (int j = 0; j < 4; ++j) { const int n = (lane >> 3) + 8 * j; const LAS float* s = scr + (8 * c) * 33 + n;
        v4u o; o.x = pk2(s[0 * 33], s[1 * 33]); o.y = pk2(s[2 * 33], s[3 * 33]); o.z = pk2(s[4 * 33], s[5 * 33]); o.w = pk2(s[6 * 33], s[7 * 33]);
        *(GAS v4u*)(WT + (size_t)(drow0 + n) * K + k0 + 8 * c) = o; }
    LDS_WAIT(); asm volatile("" ::: "memory");
}
__device__ __forceinline__ void convert_ffn(Frame& F, const float* Wg, const float* Wu, const float* Wd, const float* gain, bf16* WGU, bf16* WD) {
    LAS float* scr = (LAS float*)(F.lds + F.wave * 16384);
    const int gw = F.vcu * NWAVES + F.wave, NGW = F.G * NWAVES;
    constexpr int I_GU = (NGU / 32) * (DM / 64), I_D = (DM / 32) * (DFF / 64);
    for (int it = gw; it < I_GU + I_D; it += NGW) {
        if (it < I_GU) { const int g = it % (NGU / 32), kb = it / (NGU / 32), tile = g >> 3, w = g & 7;
            tr_item(w < 4 ? Wg : Wu, DFF, DM, WGU, g * 32, tile * 128 + (w & 3) * 32 + (F.lane & 31), gain, scr, kb * 64, F.lane); }
        else { const int r = it - I_GU, g = r % (DM / 32), kb = r / (DM / 32);
            tr_item(Wd, DM, DFF, WD, g * 32, g * 32 + (F.lane & 31), nullptr, scr, kb * 64, F.lane); }
    }
}
__device__ __forceinline__ int win_src_col(int j) {
    const int t = j >> 8, c = j & 255;
    if (t < 16) return j;
    if (t < 18) return 4176 + (j - 4096);
    if (t < 20) return 4688 + (j - 4608);
    if (t < 24) return 5200 + (j - 5120);
    if (t < 28) return 6240 + (j - 6144);
    if (c < 64) return 4096 + c;
    if (c < 80) return 4160 + (c - 64);
    if (c < 96) return 6224 + (c - 80);
    return -1;
}
__device__ __forceinline__ void convert_mix(Frame& F, const float* Win, const float* Wout, const float* gain, bf16* WIN, bf16* WOUT) {
    LAS float* scr = (LAS float*)(F.lds + F.wave * 16384);
    const int gw = F.vcu * NWAVES + F.wave, NGW = F.G * NWAVES;
    constexpr int I_IN = (NPROJ / 32) * (DM / 64), I_OUT = (DM / 32) * (DM / 64);
    for (int it = gw; it < I_IN + I_OUT; it += NGW) {
        if (it < I_IN) { const int g = it % (NPROJ / 32), kb = it / (NPROJ / 32);
            tr_item(Win, 7264, DM, WIN, g * 32, win_src_col(g * 32 + (F.lane & 31)), gain, scr, kb * 64, F.lane); }
        else { const int r = it - I_IN, g = r % (DM / 32), kb = r / (DM / 32);
            tr_item(Wout, DM, DM, WOUT, g * 32, g * 32 + (F.lane & 31), nullptr, scr, kb * 64, F.lane); }
    }
}

__device__ __forceinline__ void p0_rows(Frame& F, const float* X, const float* META) {
    const int gw = F.vcu * NWAVES + F.wave, NGW = F.G * NWAVES;
    bf16* AB = (bf16*)(F.ws + WS_AB); float* rstd = (float*)(F.ws + WS_RSTD1);
    for (int row = gw; row < RP; row += NGW) {
        GAS v2u* o = (GAS v2u*)(AB + (size_t)row * DM) + F.lane;
        if (row < R + NMETA) {
            const float* xr = row < R ? X + (size_t)row * DM : META + (size_t)(row - R) * DM;
            const GAS f32x4* xp = (const GAS f32x4*)xr + F.lane;
            f32x4 v[8]; float ss = 0.f;
#pragma unroll
            for (int j = 0; j < 8; ++j) { v[j] = xp[64 * j]; ss += (v[j].x * v[j].x + v[j].y * v[j].y) + (v[j].z * v[j].z + v[j].w * v[j].w); }
            ss = wave_sum(ss);
#pragma unroll
            for (int j = 0; j < 8; ++j) o[64 * j] = (v2u){pk2(v[j].x, v[j].y), pk2(v[j].z, v[j].w)};
            if (F.lane == 0) rstd[row] = 1.0f / sqrtf(ss * (1.0f / DM) + EPS);
        } else {
#pragma unroll
            for (int j = 0; j < 8; ++j) o[64 * j] = (v2u){0u, 0u};
            if (F.lane == 0) rstd[row] = 0.f;
        }
    }
}
template <int MODE>
__device__ __forceinline__ void norm_rows(Frame& F, const float* g, float* rstd_out, const float* X, const float* META) {
    const int gw = F.vcu * NWAVES + F.wave, NGW = F.G * NWAVES;
    bf16* AB = (bf16*)(F.ws + WS_AB); const bf16* FB = (const bf16*)(F.ws + WS_F);
    const int nrows = (MODE == 0) ? RP : R;
    f32x4 gv[8];
#pragma unroll
    for (int j = 0; j < 8; ++j) gv[j] = ((const GAS f32x4*)g)[64 * j + F.lane];
    for (int row = gw; row < nrows; row += NGW) {
        if (MODE == 0 && row >= R + NMETA) { if (F.lane == 0) rstd_out[row] = 0.f; continue; }
        const GAS v2u* fp = (const GAS v2u*)(FB + (size_t)row * DM) + F.lane;
        GAS v2u* ab = (GAS v2u*)(AB + (size_t)row * DM) + F.lane;
        f32x4 f[8], h[8]; float ss = 0.f;
#pragma unroll
        for (int j = 0; j < 8; ++j) { const v2u w = fp[64 * j]; f[j] = (f32x4){bflo(w.x), bfhi(w.x), bflo(w.y), bfhi(w.y)};
            ss += (f[j].x * f[j].x + f[j].y * f[j].y) + (f[j].z * f[j].z + f[j].w * f[j].w); }
        if (MODE == 0) {
            const float* xr = row < R ? X + (size_t)row * DM : META + (size_t)(row - R) * DM;
            const GAS f32x4* xp = (const GAS f32x4*)xr + F.lane;
#pragma unroll
            for (int j = 0; j < 8; ++j) h[j] = xp[64 * j];
        } else {
#pragma unroll
            for (int j = 0; j < 8; ++j) { const v2u w = ab[64 * j]; h[j] = (f32x4){bflo(w.x), bfhi(w.x), bflo(w.y), bfhi(w.y)}; }
        }
        ss = wave_sum(ss);
        const float rf = (MODE == 1 ? 1.0f : 0.5f) / sqrtf(ss * (1.0f / DM) + EPS);
        float s2 = 0.f;
#pragma unroll
        for (int j = 0; j < 8; ++j) { h[j] = h[j] + f[j] * gv[j] * rf; s2 += (h[j].x * h[j].x + h[j].y * h[j].y) + (h[j].z * h[j].z + h[j].w * h[j].w); }
        if (MODE == 2) {
            GAS f32x4* op = (GAS f32x4*)(F.out + (size_t)row * DM) + F.lane;
#pragma unroll
            for (int j = 0; j < 8; ++j) op[64 * j] = h[j];
        } else {
            s2 = wave_sum(s2);
#pragma unroll
            for (int j = 0; j < 8; ++j) ab[64 * j] = (v2u){pk2(h[j].x, h[j].y), pk2(h[j].z, h[j].w)};
            if (F.lane == 0) rstd_out[row] = 1.0f / sqrtf(s2 * (1.0f / DM) + EPS);
        }
    }
}

__device__ __forceinline__ void zero_pads(Frame& F) {
    const int gt = F.vcu * (NWAVES * 64) + F.tid, NG = F.G * NWAVES * 64;
    bf16* Kh = (bf16*)(F.ws + WS_KH); bf16* Vh = (bf16*)(F.ws + WS_VH); bf16* IK = (bf16*)(F.ws + WS_IK);
    const v4u z = {0u, 0u, 0u, 0u};
    for (int i = gt; i < 2 * 16 * 768 + 2 * 384; i += NG) {
        if (i < 2 * 16 * 768) { const int which = i / (16 * 768), r = i % (16 * 768), bh = r / 768, o = r % 768;
            *(GAS v4u*)((which ? Vh : Kh) + ((size_t)bh * TKV + 8208) * 128 + o * 8) = z; }
        else { const int r = i - 2 * 16 * 768, b = r / 384, o = r % 384, pos = 8208 + (o >> 3), ch = o & 7;
               *(GAS v4u*)(IK + (size_t)b * TKV * 64 + (size_t)(pos >> 5) * 2048 + (ch >> 1) * 512 + (ch & 1) * 256 + (pos & 31) * 8) = z; }
    }
}

__device__ __forceinline__ unsigned row_or16(unsigned v) {
    v |= (unsigned)__builtin_amdgcn_update_dpp(0, (int)v, 0xB1, 0xf, 0xf, false);
    v |= (unsigned)__builtin_amdgcn_update_dpp(0, (int)v, 0x4E, 0xf, 0xf, false);
    v |= (unsigned)__builtin_amdgcn_update_dpp(0, (int)v, 0x141, 0xf, 0xf, false);
    v |= (unsigned)__builtin_amdgcn_update_dpp(0, (int)v, 0x140, 0xf, 0xf, false);
    return v;
}
#ifndef P5_REP_SCORE
#define P5_REP_SCORE 1
#endif
#ifndef P5_REP_SEL
#define P5_REP_SEL 1
#endif
#ifndef P5_REP_MMA
#define P5_REP_MMA 1
#endif
#ifndef P5_REP_SCV
#define P5_REP_SCV 1
#endif
#ifndef P5_REP_BIS
#define P5_REP_BIS 1
#endif
#ifndef P5_REP_EMIT
#define P5_REP_EMIT 1
#endif
__device__ __forceinline__ void p5_item(Frame& F, int b, int t) {
    const int lane = F.lane, wid = F.wave, r32 = lane & 31, hi = lane >> 5;
    const GAS bf16* IQ = (const GAS bf16*)(F.ws + WS_IQ); const GAS bf16* IK = (const GAS bf16*)(F.ws + WS_IK); const GAS float* IW = (const GAS float*)(F.ws + WS_IW);
    GAS u64* MASK = (GAS u64*)(F.ws + WS_MASK);
    LAS unsigned short* S16 = (LAS unsigned short*)F.lds;
    constexpr int SROWD = 129 * 33, SROWH = 2 * SROWD;
    const int s0 = 8 * t, qb = s0 >> 8, nwords = 4 * qb + 5;
    const int kmax = 16 + s0 + 7, nkt = (kmax >> 5) + 1;
    TIC(0); TIC(1);
    {
        bf16x8 Af[4][4];
        LAS float* WL = (LAS float*)(F.lds + 8 * SROWH * 2);
        if (F.tid < 128) WL[F.tid] = IW[((size_t)(b * SEQ + s0)) * 16 + F.tid];
        {
            const int qo = (r32 >> 2) & 1, h = (r32 & 3) + 4 * (r32 >> 3);
#pragma unroll
            for (int rb = 0; rb < 4; ++rb) {
                const GAS bf16* qp = IQ + ((size_t)(b * SEQ + s0 + 2 * rb + qo)) * 1024 + h * 64 + 8 * hi;
#pragma unroll
                for (int ks = 0; ks < 4; ++ks) Af[rb][ks] = *(const GAS bf16x8*)(qp + ks * 16);
            }
        }
        __syncthreads();
        float wv[4][16];
#pragma unroll
        for (int rb = 0; rb < 4; ++rb) { const LAS f32x4* wl = (const LAS f32x4*)(WL + hi * 16 + 32 * rb);
#pragma unroll
            for (int r4 = 0; r4 < 4; ++r4) { const f32x4 w4 = wl[r4]; wv[rb][4 * r4] = w4.x; wv[rb][4 * r4 + 1] = w4.y; wv[rb][4 * r4 + 2] = w4.z; wv[rb][4 * r4 + 3] = w4.w; } }
        TOC(1); TIC(2);
        const GAS char* kbase = (const GAS char*)(IK + (size_t)b * TKV * 64);
        const unsigned koff = (unsigned)(lane * 16);
        bf16x8 Bn[4];
        for (int rep_ = 0; rep_ < P5_REP_SCORE; ++rep_) {
        if (wid < nkt) {
#pragma unroll
            for (int ks = 0; ks < 4; ++ks) Bn[ks] = *(const GAS bf16x8*)(kbase + (koff + (unsigned)(wid * 4096 + ks * 1024)));
        }
        for (int kt = wid; kt < nkt; kt += 8) {
            bf16x8 Bf[4];
#pragma unroll
            for (int ks = 0; ks < 4; ++ks) Bf[ks] = Bn[ks];
            if (kt + 8 < nkt) {
#pragma unroll
                for (int ks = 0; ks < 4; ++ks) Bn[ks] = *(const GAS bf16x8*)(kbase + (koff + (unsigned)((kt + 8) * 4096 + ks * 1024)));
            }
            const int key = kt * 32 + r32;
            f32x16 acc[4];
#pragma unroll
            for (int m_ = 0; m_ < P5_REP_MMA; ++m_) {
#pragma unroll
            for (int rb = 0; rb < 4; ++rb) acc[rb] = (f32x16){};
#pragma unroll
            for (int ks = 0; ks < 4; ++ks)
#pragma unroll
                for (int rb = 0; rb < 4; ++rb) acc[rb] = __builtin_amdgcn_mfma_f32_32x32x16_bf16(Af[rb][ks], Bf[ks], acc[rb], 0, 0, 0);
            if (m_ + 1 < P5_REP_MMA) asm volatile("" : "+v"(acc[0]), "+v"(acc[1]), "+v"(acc[2]), "+v"(acc[3]));
            }
#pragma unroll
            for (int v_ = 0; v_ < P5_REP_SCV; ++v_)
#pragma unroll
            for (int rb = 0; rb < 4; ++rb) {
                if (P5_REP_SCV > 1) asm volatile("" : "+v"(acc[rb]));
                float sc0 = 0.f, sc1 = 0.f;
#pragma unroll
                for (int r = 0; r < 16; r += 2) {
                    { const float a_ = acc[rb][r]; const int ai_ = __float_as_int(a_); sc0 = fmaf(__int_as_float(ai_ > 0 ? ai_ : 0), wv[rb][r], sc0); }
                    { const float a_ = acc[rb][r + 1]; const int ai_ = __float_as_int(a_); sc1 = fmaf(__int_as_float(ai_ > 0 ? ai_ : 0), wv[rb][r + 1], sc1); }
                }
                float sc = sc0 + sc1;
                sc = fminf(fmaxf(sc, -60000.f), 60000.f);
                const _Float16 hf = (_Float16)sc;
                const unsigned hb = (unsigned)__builtin_bit_cast(unsigned short, hf);
                unsigned sk = (hb & 0x8000u) ? (~hb & 0xffffu) : (hb | 0x8000u);
                sk = (sk >> 1) | 0x8000u;
                if (key > 16 + s0 + 2 * rb + hi) sk = 0x81ffu;
                S16[(2 * rb + hi) * SROWH + (key >> 6) * 66 + (key & 63)] = (unsigned short)sk;
            }
        }
        }
    }
    TOC(2); TIC(3);
    {
        LAS unsigned* row = (LAS unsigned*)(S16 + wid * SROWH);
        for (int k2 = nkt * 16 + lane; k2 < 4128; k2 += 64) row[(k2 >> 5) * 33 + (k2 & 31)] = 0x81ff81ffu;
    }
    asm volatile("s_waitcnt lgkmcnt(0)" ::: "memory"); __builtin_amdgcn_s_barrier(); asm volatile("" ::: "memory");
    TOC(3); TIC(4);
    {
        const LAS unsigned* srow = (const LAS unsigned*)(S16 + wid * SROWH);
        const bool second = nwords > 64, last = nwords > 128;
        unsigned d[64];
#pragma unroll
        for (int i = 0; i < 32; ++i) d[i] = srow[lane * 33 + i];
#pragma unroll
        for (int i = 0; i < 32; ++i) { const unsigned x = srow[(lane + 64) * 33 + i]; d[32 + i] = second ? x : 0x81ff81ffu; }
        unsigned d128 = 0x81ff81ffu;
        if (last) d128 = 0x81ff0000u | (unsigned)(S16 + wid * SROWH)[128 * 66 + lane];
#define CNT_GE(cnt_, c15) do { const unsigned C_ = (unsigned)(c15) * 0x10001u; \
            _Pragma("unroll") for (int i = 0; i < 32; ++i) cnt_ += (unsigned)__builtin_popcount((d[i] - C_) & 0x80008000u); \
            if (second) { _Pragma("unroll") for (int i = 32; i < 64; ++i) cnt_ += (unsigned)__builtin_popcount((d[i] - C_) & 0x80008000u); \
                cnt_ += (unsigned)__builtin_popcount((d128 - C_) & 0x80008000u); } } while (0)
        unsigned thr = 0u;
        for (int bit = 14; bit >= 0; --bit) {
            const unsigned cand = thr | (1u << bit); unsigned c = 0u;
            CNT_GE(c, cand);
            if (wave_sum_u(c) >= 256u) thr = cand;
        }
        TOC(4); TIC(5);
        if (thr < 0x0200u) thr = 0x0200u;
        unsigned cg = 0u, ce = 0u;
        CNT_GE(cg, thr + 1u); CNT_GE(ce, thr);
        const unsigned cgt = wave_sum_u(cg), cge = wave_sum_u(ce);
#undef CNT_GE
        const int need = 256 - (int)cgt;
        GAS unsigned* mrow = (GAS unsigned*)(MASK + ((size_t)(b * SEQ + s0 + wid)) * 130);
        if (cge <= 256u) {
            const unsigned T_ = thr * 0x10001u;
#pragma unroll
            for (int tt = 0; tt < 2; ++tt) {
                if (tt == 0 || second) {
                    unsigned w0 = 0u, w1 = 0u;
#pragma unroll
                    for (int i = 0; i < 32; ++i) {
                        const unsigned sw = d[32 * tt + i] - T_;
                        const unsigned b2 = ((sw >> 15) & 1u) | ((sw >> 30) & 2u);
                        constexpr int dummy_ = 0; (void)dummy_;
                        const int pos = 16 * (i >> 4) + 2 * (i & 1) + 4 * ((i & 15) >> 2);
                        if (((i & 15) >> 1) & 1) w1 |= b2 << pos; else w0 |= b2 << pos;
                    }
                    *(GAS v2u*)(mrow + 2 * (64 * tt + lane)) = (v2u){w0, w1};
                }
            }
            if (last) {
                const u64 w = __ballot((((d128 - T_) >> 15) & 1u) != 0u);
                const unsigned vl = (unsigned)w, vh = (unsigned)(w >> 32), ul = vl >> 4, uh = vh >> 4;
                const unsigned a0 = (vl & 0xFu) | ((vl >> 4) & 0xF0u) | ((vl >> 8) & 0xF00u) | ((vl >> 12) & 0xF000u), a1 = (ul & 0xFu) | ((ul >> 4) & 0xF0u) | ((ul >> 8) & 0xF00u) | ((ul >> 12) & 0xF000u);
                const unsigned b0 = (vh & 0xFu) | ((vh >> 4) & 0xF0u) | ((vh >> 8) & 0xF00u) | ((vh >> 12) & 0xF000u), b1 = (uh & 0xFu) | ((uh >> 4) & 0xF0u) | ((uh >> 8) & 0xF00u) | ((uh >> 12) & 0xF000u);
                if (lane == 0) { mrow[256] = a0 | (b0 << 16); mrow[257] = a1 | (b1 << 16); }
            }
        } else {
            const unsigned T_ = thr * 0x10001u, T1_ = (thr + 1u) * 0x10001u;
            unsigned e1 = 0u, e2 = 0u;
#pragma unroll
            for (int i = 0; i < 32; ++i) e1 += (unsigned)__builtin_popcount((d[i] - T_) & 0x80008000u) - (unsigned)__builtin_popcount((d[i] - T1_) & 0x80008000u);
#pragma unroll
            for (int i = 32; i < 64; ++i) e2 += (unsigned)__builtin_popcount((d[i] - T_) & 0x80008000u) - (unsigned)__builtin_popcount((d[i] - T1_) & 0x80008000u);
            int base1 = 0, base2 = 0, tot1 = 0, tot2 = 0;
#pragma unroll
            for (int bt = 0; bt < 7; ++bt) {
                const u64 m1 = __ballot(((e1 >> bt) & 1u) != 0u), m2 = __ballot(((e2 >> bt) & 1u) != 0u);
                base1 += (int)__builtin_amdgcn_mbcnt_hi((unsigned)(m1 >> 32), __builtin_amdgcn_mbcnt_lo((unsigned)m1, 0u)) << bt; tot1 += __popcll(m1) << bt;
                base2 += (int)__builtin_amdgcn_mbcnt_hi((unsigned)(m2 >> 32), __builtin_amdgcn_mbcnt_lo((unsigned)m2, 0u)) << bt; tot2 += __popcll(m2) << bt;
            }
#pragma unroll
            for (int tt = 0; tt < 2; ++tt) {
                if (tt == 0 || second) {
                    int quota = need - (tt == 0 ? base1 : tot1 + base2);
                    unsigned w0 = 0u, w1 = 0u;
#pragma unroll
                    for (int i = 0; i < 32; ++i) {
                        const unsigned sw = d[32 * tt + i] - T_, sg = d[32 * tt + i] - T1_;
                        const unsigned ge_lo = (sw >> 15) & 1u, ge_hi = (sw >> 31) & 1u, gt_lo = (sg >> 15) & 1u, gt_hi = (sg >> 31) & 1u;
                        const unsigned eq_lo = ge_lo ^ gt_lo, eq_hi = ge_hi ^ gt_hi;
                        const unsigned s_lo = gt_lo | (eq_lo & (quota > 0 ? 1u : 0u)); quota -= (int)eq_lo;
                        const unsigned s_hi = gt_hi | (eq_hi & (quota > 0 ? 1u : 0u)); quota -= (int)eq_hi;
                        const unsigned b2 = s_lo | (s_hi << 1);
                        const int pos = 16 * (i >> 4) + 2 * (i & 1) + 4 * ((i & 15) >> 2);
                        if (((i & 15) >> 1) & 1) w1 |= b2 << pos; else w0 |= b2 << pos;
                    }
                    *(GAS v2u*)(mrow + 2 * (64 * tt + lane)) = (v2u){w0, w1};
                }
            }
            if (last) {
                const unsigned k128 = d128 & 0x7fffu;
                const u64 em = __ballot(k128 == thr);
                const int rank = tot1 + tot2 + (int)__builtin_amdgcn_mbcnt_hi((unsigned)(em >> 32), __builtin_amdgcn_mbcnt_lo((unsigned)em, 0u));
                const u64 w = __ballot(k128 > thr || (k128 == thr && rank < need));
                const unsigned vl = (unsigned)w, vh = (unsigned)(w >> 32), ul = vl >> 4, uh = vh >> 4;
                const unsigned a0 = (vl & 0xFu) | ((vl >> 4) & 0xF0u) | ((vl >> 8) & 0xF00u) | ((vl >> 12) & 0xF000u), a1 = (ul & 0xFu) | ((ul >> 4) & 0xF0u) | ((ul >> 8) & 0xF00u) | ((ul >> 12) & 0xF000u);
                const unsigned b0 = (vh & 0xFu) | ((vh >> 4) & 0xF0u) | ((vh >> 8) & 0xF00u) | ((vh >> 12) & 0xF000u), b1 = (uh & 0xFu) | ((uh >> 4) & 0xF0u) | ((uh >> 8) & 0xF00u) | ((uh >> 12) & 0xF000u);
                if (lane == 0) { mrow[256] = a0 | (b0 << 16); mrow[257] = a1 | (b1 << 16); }
            }
        }
    }
    asm volatile("s_waitcnt lgkmcnt(0)" ::: "memory"); __builtin_amdgcn_s_barrier(); asm volatile("" ::: "memory");
    TOC(5); TOC(0);
}

template <int KSTEPS>
__device__ __forceinline__ void mma_ll(f32x16& acc, const LAS bf16* A, int sa, const LAS bf16* B, int sb, int r32, int hi) {
#pragma unroll
    for (int ks = 0; ks < KSTEPS; ++ks) {
        const bf16x8 a = *(const LAS bf16x8*)(A + r32 * sa + ks * 16 + 8 * hi), bb = *(const LAS bf16x8*)(B + r32 * sb + ks * 16 + 8 * hi);
        acc = __builtin_amdgcn_mfma_f32_32x32x16_bf16(a, bb, acc, 0, 0, 0);
    }
}
__device__ __forceinline__ float log_sigmoid_f(float z) { return fminf(z, 0.f) - __logf(1.0f + __expf(-fabsf(z))); }
__device__ __forceinline__ void gla_bcum(Frame& F, LAS float* BC, LAS float* GT, int b, int h, int n, const float* Wg, const float* bg) {
    const GAS float* GLOW = (const GAS float*)(F.ws + WS_GLOW);
    const int k = F.tid & 127, ig = __builtin_amdgcn_readfirstlane(F.tid >> 7);
    float wc[16];
#pragma unroll
    for (int r = 0; r < 16; ++r) wc[r] = Wg[r * 512 + h * 128 + k];
    const float bk = bg[h * 128 + k];
    float run = 0.f, pre[16];
#pragma unroll
    for (int ii = 0; ii < 16; ++ii) {
        const int i = 16 * ig + ii, pp = 64 * n + i; float lg = 0.f;
        if (!(n == 0 && i < 48)) {
            const GAS f32x4* gl = (const GAS f32x4*)(GLOW + ((size_t)b * TKV + pp) * 16); float z = bk;
#pragma unroll
            for (int r4 = 0; r4 < 4; ++r4) { const f32x4 g4 = gl[r4];
                z = fmaf(g4.x, wc[4 * r4 + 0], z); z = fmaf(g4.y, wc[4 * r4 + 1], z); z = fmaf(g4.z, wc[4 * r4 + 2], z); z = fmaf(g4.w, wc[4 * r4 + 3], z); }
            lg = log_sigmoid_f(z) * (1.0f / 16.0f);
        }
        run += lg; pre[ii] = run;
    }
    GT[ig * 128 + k] = run;
    __syncthreads();
    float off = 0.f;
#pragma unroll
    for (int gq = 0; gq < 3; ++gq) off += (gq < ig) ? GT[gq * 128 + k] : 0.f;
#pragma unroll
    for (int ii = 0; ii < 16; ++ii) BC[(16 * ig + ii) * 128 + k] = pre[ii] + off;
    __syncthreads();
}
__device__ __forceinline__ void gla_load_vt(Frame& F, LAS bf16* VT, int b, int h, int n) {
    const GAS bf16* GV = (const GAS bf16*)(F.ws + WS_GV);
    const int v0 = 8 * (F.tid & 31);
#pragma unroll
    for (int pass = 0; pass < 4; ++pass) {
        const int i = (F.tid >> 5) + 16 * pass, pp = 64 * n + i;
        v4u raw = {0u, 0u, 0u, 0u};
        if (!(n == 0 && i < 48)) raw = *(const GAS v4u*)(GV + ((size_t)b * TKV + pp) * 1024 + h * 256 + v0);
        VT[(v0 + 0) * 72 + i] = (bf16)(raw.x & 0xffffu); VT[(v0 + 1) * 72 + i] = (bf16)(raw.x >> 16);
        VT[(v0 + 2) * 72 + i] = (bf16)(raw.y & 0xffffu); VT[(v0 + 3) * 72 + i] = (bf16)(raw.y >> 16);
        VT[(v0 + 4) * 72 + i] = (bf16)(raw.z & 0xffffu); VT[(v0 + 5) * 72 + i] = (bf16)(raw.z >> 16);
        VT[(v0 + 6) * 72 + i] = (bf16)(raw.w & 0xffffu); VT[(v0 + 7) * 72 + i] = (bf16)(raw.w >> 16);
    }
}
__device__ __forceinline__ void g1_unit(Frame& F, int b, int h, int n, const float* Wg, const float* bg) {
    const int lane = F.lane, wid = F.wave, r32 = lane & 31, hi = lane >> 5, tid = F.tid;
    LAS float* BC = (LAS float*)F.lds; LAS bf16* KDT = (LAS bf16*)(F.lds + 32768); LAS bf16* VT = (LAS bf16*)(F.lds + 51200);
    const GAS bf16* GK = (const GAS bf16*)(F.ws + WS_GK); GAS bf16* ST = (GAS bf16*)(F.ws + WS_ST); GAS float* DEC = (GAS float*)(F.ws + WS_DEC);
    gla_bcum(F, BC, (LAS float*)(F.lds + 131072), b, h, n, Wg, bg);
    { const int k0 = 8 * (tid & 15);
#pragma unroll
      for (int pass = 0; pass < 2; ++pass) {
        const int i = (tid >> 4) + 32 * pass, pp = 64 * n + i;
        v4u raw = {0u, 0u, 0u, 0u};
        if (!(n == 0 && i < 48)) raw = *(const GAS v4u*)(GK + ((size_t)b * TKV + pp) * 512 + h * 128 + k0);
        const unsigned rw[4] = {raw.x, raw.y, raw.z, raw.w};
#pragma unroll
        for (int j = 0; j < 8; ++j) { const float kv = (j & 1) ? bfhi(rw[j >> 1]) : bflo(rw[j >> 1]);
            const float d = __expf(BC[63 * 128 + k0 + j] - BC[i * 128 + k0 + j]);
            KDT[(k0 + j) * 72 + i] = (bf16)f2bf(kv * d); }
      } }
    gla_load_vt(F, VT, b, h, n);
    __syncthreads();
    GAS bf16* dst = ST + ((size_t)((b * 4 + h) * 128 + n) * 256) * 128;
    const float declast = (tid < 128) ? __expf(BC[63 * 128 + tid]) : 0.f;
    f32x16 acc[4];
#pragma unroll
    for (int cb = 0; cb < 4; ++cb) { acc[cb] = (f32x16){}; mma_ll<4>(acc[cb], VT + (32 * wid) * 72, 72, KDT + (32 * cb) * 72, 72, r32, hi); }
    __syncthreads();
    {   LAS bf16* LT = (LAS bf16*)F.lds;
#pragma unroll
        for (int cb = 0; cb < 4; ++cb)
#pragma unroll
            for (int r = 0; r < 16; ++r) LT[(32 * wid + (r & 3) + 8 * (r >> 2) + 4 * hi) * 128 + 32 * cb + r32] = (bf16)f2bf(acc[cb][r]);
        __syncthreads();
        const LAS v4u* src = (const LAS v4u*)F.lds; GAS v4u* d4 = (GAS v4u*)dst;
#pragma unroll
        for (int q = 0; q < 8; ++q) d4[q * 512 + tid] = src[q * 512 + tid];
    }
    if (tid < 128) DEC[(size_t)((b * 4 + h) * 128 + n) * 128 + tid] = declast;
    __syncthreads();
}
__device__ __forceinline__ void g2_scan(Frame& F) {
    GAS bf16* ST = (GAS bf16*)(F.ws + WS_ST); const GAS float* DEC = (const GAS float*)(F.ws + WS_DEC);
    const int NG = F.G * NWAVES * 64;
    for (int e = F.vcu * (NWAVES * 64) + F.tid; e < 8 * 16384; e += NG) {
        const int bh = e >> 14, rem = e & 16383, v = rem >> 6, k = (rem & 63) * 2;
        GAS unsigned* p = (GAS unsigned*)(ST + ((size_t)bh * 128 * 256 + v) * 128 + k);
        const GAS float* d = DEC + (size_t)bh * 128 * 128 + k;
        float s0 = 0.f, s1 = 0.f;
        for (int n = 0; n < 128; n += 8) {
            unsigned w[8]; float d0[8], d1[8];
#pragma unroll
            for (int u = 0; u < 8; ++u) { w[u] = p[(size_t)(n + u) * 16384]; d0[u] = d[(n + u) * 128]; d1[u] = d[(n + u) * 128 + 1]; }
#pragma unroll
            for (int u = 0; u < 8; ++u) { s0 = fmaf(s0, d0[u], bflo(w[u])); s1 = fmaf(s1, d1[u], bfhi(w[u])); p[(size_t)(n + u) * 16384] = pk2(s0, s1); }
        }
    }
}
__device__ __forceinline__ void g3_unit(Frame& F, int b, int h, int c, const float* Wg, const float* bg, const float* ggla) {
    const int lane = F.lane, wid = F.wave, r32 = lane & 31, hi = lane >> 5, tid = F.tid;
    LAS float* BC = (LAS float*)F.lds; LAS bf16* Q1 = (LAS bf16*)(F.lds + 32768); LAS bf16* Q2 = (LAS bf16*)(F.lds + 50176); LAS bf16* KD = (LAS bf16*)(F.lds + 67584);
    LAS bf16* VT = (LAS bf16*)(F.lds + 84992); LAS bf16* AT = (LAS bf16*)(F.lds + 121856); LAS float* OS = (LAS float*)F.lds;
    const GAS bf16* GQ = (const GAS bf16*)(F.ws + WS_GQ); const GAS bf16* GK = (const GAS bf16*)(F.ws + WS_GK); const GAS bf16* GO = (const GAS bf16*)(F.ws + WS_GO);
    const GAS bf16* ST = (const GAS bf16*)(F.ws + WS_ST); GAS bf16* MIXA = (GAS bf16*)(F.ws + WS_MIXA);
    gla_bcum(F, BC, (LAS float*)(F.lds + 131072), b, h, c, Wg, bg);
    { const int k0 = 8 * (tid & 15);
#pragma unroll
      for (int pass = 0; pass < 2; ++pass) {
        const int i = (tid >> 4) + 32 * pass, pp = 64 * c + i;
        const v4u rq = *(const GAS v4u*)(GQ + ((size_t)b * TKV + pp) * 512 + h * 128 + k0);
        const v4u rk = *(const GAS v4u*)(GK + ((size_t)b * TKV + pp) * 512 + h * 128 + k0);
        const unsigned qw[4] = {rq.x, rq.y, rq.z, rq.w}, kw[4] = {rk.x, rk.y, rk.z, rk.w};
        float q1[8], q2[8], kd[8];
#pragma unroll
        for (int j = 0; j < 8; ++j) { const float qv = (j & 1) ? bfhi(qw[j >> 1]) : bflo(qw[j >> 1]), kv = (j & 1) ? bfhi(kw[j >> 1]) : bflo(kw[j >> 1]);
            const float bc = BC[i * 128 + k0 + j], bl = BC[63 * 128 + k0 + j];
            q1[j] = qv * __expf(bc); q2[j] = qv * __expf(bc - bl); kd[j] = kv * __expf(bl - bc); }
        *(LAS v4u*)(Q1 + i * 136 + k0) = (v4u){pk2(q1[0], q1[1]), pk2(q1[2], q1[3]), pk2(q1[4], q1[5]), pk2(q1[6], q1[7])};
        *(LAS v4u*)(Q2 + i * 136 + k0) = (v4u){pk2(q2[0], q2[1]), pk2(q2[2], q2[3]), pk2(q2[4], q2[5]), pk2(q2[6], q2[7])};
        *(LAS v4u*)(KD + i * 136 + k0) = (v4u){pk2(kd[0], kd[1]), pk2(kd[2], kd[3]), pk2(kd[4], kd[5]), pk2(kd[6], kd[7])};
      } }
    gla_load_vt(F, VT, b, h, c);
    __syncthreads();
    const int rbI = wid & 1, cbV = (wid >> 1) * 2;
    f32x16 acc[2] = {};
    {
        const GAS bf16* sp = ST + ((size_t)((b * 4 + h) * 128 + (c - 1)) * 256) * 128;
#pragma unroll
        for (int ks = 0; ks < 8; ++ks) {
            const bf16x8 a = *(const LAS bf16x8*)(Q1 + (32 * rbI + r32) * 136 + ks * 16 + 8 * hi);
#pragma unroll
            for (int t = 0; t < 2; ++t) { const bf16x8 bb = *(const GAS bf16x8*)(sp + (size_t)(32 * (cbV + t) + r32) * 128 + ks * 16 + 8 * hi);
                acc[t] = __builtin_amdgcn_mfma_f32_32x32x16_bf16(a, bb, acc[t], 0, 0, 0); }
        }
    }
    if (wid < 4) {
        const int ib = wid & 1, jb = wid >> 1;
        f32x16 at = {};
        mma_ll<8>(at, Q2 + (32 * ib) * 136, 136, KD + (32 * jb) * 136, 136, r32, hi);
#pragma unroll
        for (int r = 0; r < 16; ++r) { const int i = 32 * ib + (r & 3) + 8 * (r >> 2) + 4 * hi, j = 32 * jb + r32;
            AT[i * 72 + j] = (bf16)f2bf(j <= i ? at[r] : 0.f); }
    }
    __syncthreads();
#pragma unroll
    for (int t = 0; t < 2; ++t) mma_ll<4>(acc[t], AT + (32 * rbI) * 72, 72, VT + (32 * (cbV + t)) * 72, 72, r32, hi);
    __syncthreads();
#pragma unroll
    for (int t = 0; t < 2; ++t)
#pragma unroll
        for (int r = 0; r < 16; ++r) OS[(32 * rbI + (r & 3) + 8 * (r >> 2) + 4 * hi) * 260 + 32 * (cbV + t) + r32] = acc[t][r];
    __syncthreads();
    {
        const int i = tid >> 3, seg = tid & 7; const LAS float* orow = OS + i * 260 + 32 * seg;
        float ss = 0.f; f32x4 ov[8];
#pragma unroll
        for (int q = 0; q < 8; ++q) { ov[q] = *(const LAS f32x4*)(orow + 4 * q); ss += (ov[q].x * ov[q].x + ov[q].y * ov[q].y) + (ov[q].z * ov[q].z + ov[q].w * ov[q].w); }
        ss += __shfl_xor(ss, 1); ss += __shfl_xor(ss, 2); ss += __shfl_xor(ss, 4);
        const float rs = 1.0f / sqrtf(ss * (1.0f / 256.0f) + EPS);
        const size_t row = (size_t)b * SEQ + 64 * (c - 1) + i;
        const float* gn = ggla + 32 * seg;
        const GAS bf16* gp = GO + row * 1024 + h * 256 + 32 * seg;
        GAS bf16* op = MIXA + row * 2048 + 1024 + h * 256 + 32 * seg;
#pragma unroll
        for (int q2 = 0; q2 < 4; ++q2) {
            const v4u gw = *(const GAS v4u*)(gp + 8 * q2);
            const f32x4 g0 = *(const f32x4*)(gn + 8 * q2), g1 = *(const f32x4*)(gn + 8 * q2 + 4);
            const f32x4 a = ov[2 * q2], bq = ov[2 * q2 + 1];
            float y[8];
            y[0] = a.x * rs * g0.x * pg8::silu_f(bflo(gw.x)); y[1] = a.y * rs * g0.y * pg8::silu_f(bfhi(gw.x));
            y[2] = a.z * rs * g0.z * pg8::silu_f(bflo(gw.y)); y[3] = a.w * rs * g0.w * pg8::silu_f(bfhi(gw.y));
            y[4] = bq.x * rs * g1.x * pg8::silu_f(bflo(gw.z)); y[5] = bq.y * rs * g1.y * pg8::silu_f(bfhi(gw.z));
            y[6] = bq.z * rs * g1.z * pg8::silu_f(bflo(gw.w)); y[7] = bq.w * rs * g1.w * pg8::silu_f(bfhi(gw.w));
            *(GAS v4u*)(op + 8 * q2) = (v4u){pk2(y[0], y[1]), pk2(y[2], y[3]), pk2(y[4], y[5]), pk2(y[6], y[7])};
        }
    }
    __syncthreads();
}

__device__ __forceinline__ att::BlockRef att_ref(Frame& F, int bh, int qb) {
    const int b = bh >> 3, h = bh & 7; att::BlockRef r;
    r.Q = (const bf16*)(F.ws + WS_QH) + ((size_t)bh * SEQ + (size_t)qb * 256) * 128;
    r.K = (const bf16*)(F.ws + WS_KH) + (size_t)bh * TKV * 128; r.V = (const bf16*)(F.ws + WS_VH) + (size_t)bh * TKV * 128;
    r.O = (bf16*)(F.ws + WS_MIXA) + ((size_t)b * SEQ + (size_t)qb * 256) * 2048 + h * 128;
    r.M = (const u64*)(F.ws + WS_MASK) + ((size_t)b * SEQ + (size_t)qb * 256) * 130;
    r.NT = 4 * qb + 5;
    return r;
}
__device__ __forceinline__ void p7_attention(Frame& F) {
    constexpr int total = 256;
    int L = F.vcu; if (L >= total) return;
    int pass = 0;
    att::BlockRef cur = att_ref(F, L >> 4, L & 15);
    att::Seam S;
    att::att_prime(cur, (char*)F.ldsg, S);
    for (;;) {
        const bool more_pass = pass == 0, more_item = L + F.G < total, last = !more_pass && !more_item;
        int passn = pass + 1, Ln = L;
        if (!more_pass) { passn = 0; Ln = more_item ? L + F.G : L; }
        const att::BlockRef nxt = last ? cur : att_ref(F, Ln >> 4, passn ? 31 - (Ln & 15) : (Ln & 15));
        att::att_block(cur, nxt, (char*)F.ldsg, S);
        if (last) break;
        cur = nxt; pass = passn; L = Ln;
    }
}
typedef float f32x4s __attribute__((ext_vector_type(4)));
template <int KSTEPS>
__device__ __forceinline__ f32x4s skinny_k(const GAS bf16* a, const GAS bf16* b) {
    f32x4s acc = {0.f, 0.f, 0.f, 0.f};
#pragma unroll
    for (int ks = 0; ks < KSTEPS; ++ks) acc = __builtin_amdgcn_mfma_f32_16x16x32_bf16(*(const GAS bf16x8*)(a + 32 * ks), *(const GAS bf16x8*)(b + 32 * ks), acc, 0, 0, 0);
    return acc;
}
__device__ __forceinline__ f32x4s wg_reduce(Frame& F, LAS f32x4s* red, f32x4s v) {
    red[F.wave * 64 + F.lane] = v;
    __syncthreads();
    f32x4s s = red[F.lane];
#pragma unroll
    for (int w = 1; w < NWAVES; ++w) s += red[w * 64 + F.lane];
    __syncthreads();
    return s;
}
__device__ __forceinline__ void meta_p1(Frame& F) {
    const int c = F.lane & 15, kq = F.lane >> 4; LAS f32x4s* red = (LAS f32x4s*)F.lds;
    const GAS bf16* AB = (const GAS bf16*)(F.ws + WS_AB); const GAS bf16* WGU = (const GAS bf16*)(F.ws + WS_WGU); GAS bf16* ACT = (GAS bf16*)(F.ws + WS_ACT);
    const GAS float* rstd = (const GAS float*)(F.ws + WS_RSTD1);
    for (int u = F.vcu; u < 352; u += F.G) {
        const int tile = u >> 3, j = u & 7, k0 = F.wave * (DM / 8);
        const GAS bf16* a = AB + (size_t)(R + c) * DM + k0 + 8 * kq;
        const GAS bf16* bg = WGU + (size_t)(tile * 256 + 16 * j + c) * DM + k0 + 8 * kq;
        const f32x4s ag = wg_reduce(F, red, skinny_k<DM / 256>(a, bg)), au = wg_reduce(F, red, skinny_k<DM / 256>(a, bg + (size_t)128 * DM));
        if (F.wave == 0) {
#pragma unroll
            for (int q = 0; q < 4; ++q) { const int m = 4 * kq + q; const float rs = rstd[R + m];
                ACT[(size_t)(R + m) * DFF + tile * 128 + 16 * j + c] = (bf16)f2bf(pg8::silu_f(ag[q] * rs) * (au[q] * rs)); }
        }
    }
}
__device__ __forceinline__ void meta_p2(Frame& F) {
    const int c = F.lane & 15, kq = F.lane >> 4; LAS f32x4s* red = (LAS f32x4s*)F.lds;
    const GAS bf16* ACT = (const GAS bf16*)(F.ws + WS_ACT); const GAS bf16* WD = (const GAS bf16*)(F.ws + WS_WD); GAS bf16* FB = (GAS bf16*)(F.ws + WS_F);
    for (int u = F.vcu; u < 128; u += F.G) {
        const int k0 = F.wave * (DFF / 8);
        const f32x4s acc = wg_reduce(F, red, skinny_k<DFF / 256>(ACT + (size_t)(R + c) * DFF + k0 + 8 * kq, WD + (size_t)(16 * u + c) * DFF + k0 + 8 * kq));
        if (F.wave == 0) {
#pragma unroll
            for (int q = 0; q < 4; ++q) FB[(size_t)(R + 4 * kq + q) * DM + 16 * u + c] = (bf16)f2bf(acc[q]);
        }
    }
}
__device__ __forceinline__ void meta_p4(Frame& F) {
    const int c = F.lane & 15, kq = F.lane >> 4; LAS f32x4s* red = (LAS f32x4s*)F.lds;
    const GAS bf16* AB = (const GAS bf16*)(F.ws + WS_AB); const GAS bf16* WIN = (const GAS bf16*)(F.ws + WS_WIN); const GAS float* rstd = (const GAS float*)(F.ws + WS_RSTD2);
    GAS bf16* Kh = (GAS bf16*)(F.ws + WS_KH); GAS bf16* Vh = (GAS bf16*)(F.ws + WS_VH); GAS bf16* GK = (GAS bf16*)(F.ws + WS_GK); GAS bf16* GV = (GAS bf16*)(F.ws + WS_GV);
    GAS bf16* IK = (GAS bf16*)(F.ws + WS_IK); GAS float* GLOW = (GAS float*)(F.ws + WS_GLOW);
    for (int u = F.vcu; u < 230; u += F.G) {
        int sec, cs;
        if (u < 64) { sec = 0; cs = u * 16; } else if (u < 128) { sec = 1; cs = (u - 64) * 16; } else if (u < 160) { sec = 2; cs = (u - 128) * 16; } else if (u < 224) { sec = 3; cs = (u - 160) * 16; } else { sec = 4; cs = (u - 224) * 16; }
        const int wrow = (sec == 0 ? 4 * 256 : sec == 1 ? 8 * 256 : sec == 2 ? 18 * 256 : sec == 3 ? 20 * 256 : 7168) + cs, k0 = F.wave * (DM / 8);
        const f32x4s acc = wg_reduce(F, red, skinny_k<DM / 256>(AB + (size_t)(R + c) * DM + k0 + 8 * kq, WIN + (size_t)(wrow + c) * DM + k0 + 8 * kq));
        if (F.wave == 0) {
            const int col = cs + c;
#pragma unroll
            for (int q = 0; q < 4; ++q) { const int m = 4 * kq + q; const float vf = acc[q] * rstd[R + m]; const bf16 v = (bf16)f2bf(vf);
                if (sec == 4) {
                    if (col < 64) { const int ch = col >> 3, fo = (ch >> 1) * 512 + (ch & 1) * 256 + (col & 7); IK[fo + m * 8] = v; IK[(size_t)TKV * 64 + fo + m * 8] = v; }
                    else if (col >= 80) { GLOW[((size_t)48 + m) * 16 + (col - 80)] = vf; GLOW[((size_t)TKV + 48 + m) * 16 + (col - 80)] = vf; }
                } else if (sec < 2) { GAS bf16* base = sec == 0 ? Kh : Vh; const int h = col >> 7, d = col & 127;
                    base[((size_t)h * TKV + m) * 128 + d] = v; base[((size_t)(8 + h) * TKV + m) * 128 + d] = v; }
                else if (sec == 2) { GK[((size_t)48 + m) * 512 + col] = v; GK[((size_t)TKV + 48 + m) * 512 + col] = v; }
                else { GV[((size_t)48 + m) * 1024 + col] = v; GV[((size_t)TKV + 48 + m) * 1024 + col] = v; }
            }
        }
    }
}
__device__ __forceinline__ void small_cols(Frame& F) {
    const int c = F.lane & 15, kq = F.lane >> 4, rg = F.wave & 3, ch3 = (F.wave >> 2) * 3;
    const GAS bf16* AB = (const GAS bf16*)(F.ws + WS_AB); const GAS bf16* WIN = (const GAS bf16*)(F.ws + WS_WIN); const GAS float* rstd = (const GAS float*)(F.ws + WS_RSTD2);
    GAS bf16* IK = (GAS bf16*)(F.ws + WS_IK); GAS float* IW = (GAS float*)(F.ws + WS_IW); GAS float* GLOW = (GAS float*)(F.ws + WS_GLOW);
    LAS bf16* Bs = (LAS bf16*)F.lds; constexpr int BP = 264;
    for (int u = F.vcu; u < 256; u += F.G) {
        const int r0 = 64 * u + 16 * rg;
        const GAS bf16* a = AB + (size_t)(r0 + c) * DM + 8 * kq;
        const GAS bf16* bsrc = WIN + (size_t)7168 * DM;
        f32x4s acc[3];
#pragma unroll
        for (int g = 0; g < 3; ++g) acc[g] = (f32x4s){0.f, 0.f, 0.f, 0.f};
        v4u breg[6]; bf16x8 an[8];
#pragma unroll
        for (int i = 0; i < 6; ++i) { const int p = F.tid + 512 * i; breg[i] = *(const GAS v4u*)(bsrc + (size_t)(p >> 5) * DM + (p & 31) * 8); }
#pragma unroll
        for (int ks = 0; ks < 8; ++ks) an[ks] = *(const GAS bf16x8*)(a + 32 * ks);
        for (int kc = 0; kc < 8; ++kc) {
#pragma unroll
            for (int i = 0; i < 6; ++i) { const int p = F.tid + 512 * i; *(LAS v4u*)(Bs + (p >> 5) * BP + (p & 31) * 8) = breg[i]; }
            bf16x8 ac[8];
#pragma unroll
            for (int ks = 0; ks < 8; ++ks) ac[ks] = an[ks];
            __syncthreads();
            if (kc + 1 < 8) {
#pragma unroll
                for (int i = 0; i < 6; ++i) { const int p = F.tid + 512 * i; breg[i] = *(const GAS v4u*)(bsrc + (size_t)(p >> 5) * DM + (kc + 1) * 256 + (p & 31) * 8); }
#pragma unroll
                for (int ks = 0; ks < 8; ++ks) an[ks] = *(const GAS bf16x8*)(a + (kc + 1) * 256 + 32 * ks);
            }
#pragma unroll
            for (int ks = 0; ks < 8; ++ks)
#pragma unroll
                for (int g = 0; g < 3; ++g) acc[g] = __builtin_amdgcn_mfma_f32_16x16x32_bf16(ac[ks], *(const LAS bf16x8*)(Bs + (16 * (ch3 + g) + c) * BP + 32 * ks + 8 * kq), acc[g], 0, 0, 0);
            __syncthreads();
        }
#pragma unroll
        for (int q = 0; q < 4; ++q) {
            const int row = r0 + 4 * kq + q; const float rs = rstd[row]; const int bb = row >> 13, s = row & 8191, pos = 16 + s;
#pragma unroll
            for (int g = 0; g < 3; ++g) {
                const float v = acc[g][q] * rs; const int col = 16 * (ch3 + g) + c;
                if (col < 64) {
                    const int ch = col >> 3, fo = (ch >> 1) * 512 + (ch & 1) * 256 + (col & 7);
                    IK[(size_t)bb * TKV * 64 + (size_t)(pos >> 5) * 2048 + fo + (pos & 31) * 8] = (bf16)f2bf(v);
                } else if (col < 80) IW[(size_t)row * 16 + (col - 64)] = v * 0.25f;
                else GLOW[((size_t)bb * TKV + 64 + s) * 16 + (col - 80)] = v;
            }
        }
    }
}

struct Args { const float* in[19]; float* out; unsigned char* ws; int ph_lo, ph_hi; };
#ifndef PG8_SP2
#define PG8_SP2 true
#endif
#ifndef PG8_ALIGN
#define PG8_ALIGN true
#endif
__global__ void __launch_bounds__(NWAVES * 64, 2) hymba_fwd(Args args) {
    extern __shared__ __attribute__((aligned(16))) unsigned char lds[];
    Frame F;
    F.lds = (LAS unsigned char*)lds; F.ldsg = lds;
    F.MISC = (volatile LAS unsigned*)(F.lds + MISC_OFF);
    F.tid = threadIdx.x; F.lane = F.tid & 63; F.wave = __builtin_amdgcn_readfirstlane(F.tid >> 6);
    F.G = gridDim.x; { const int bx = blockIdx.x; F.vcu = (F.G % 8 == 0) ? (bx % 8) * (F.G / 8) + bx / 8 : bx; }
    F.ws = args.ws; F.ctl = (unsigned*)(args.ws + WS_CTL); F.out = args.out;
    for (int u = F.tid; u < (LDS_BYTES - MISC_OFF) / 4; u += NWAVES * 64) ((LAS unsigned*)(F.lds + MISC_OFF))[u] = 0u;
    __syncthreads();
    XcdBarrier bar; bar.bar = F.ctl + CW_BAR; bar.x = 0; bar.st = nullptr;
    if (!MK_PER_PHASE) bar = xcd_barrier_post(F.ctl + CW_BAR, F.MISC + 8);
    const int lo = args.ph_lo, hi = args.ph_hi;
#define PHASE_BEGIN() do { int t_ = threadIdx.x; asm volatile("" : "+v"(t_)); F.tid = t_; F.lane = t_ & 63; F.wave = __builtin_amdgcn_readfirstlane(t_ >> 6); } while (0)
#ifndef PH_MASK
#define PH_MASK 0x1fff
#endif
#define IN(k) ((((PH_MASK) >> (k)) & 1) && lo <= (k) && (k) < hi)
#define SEAM(k) do { if (!MK_PER_PHASE && IN((k) + 1)) xcd_barrier(bar); } while (0)
#ifndef PH_DUP
#define PH_DUP 0
#endif
#define AB ((bf16*)(F.ws + WS_AB))
#define ACT ((bf16*)(F.ws + WS_ACT))
#define FB ((bf16*)(F.ws + WS_F))
#define WGU ((bf16*)(F.ws + WS_WGU))
#define WD ((bf16*)(F.ws + WS_WD))
#define WIN ((bf16*)(F.ws + WS_WIN))
#define WOUT ((bf16*)(F.ws + WS_WOUT))
#define rstd1 ((float*)(F.ws + WS_RSTD1))
#define rstd2 ((float*)(F.ws + WS_RSTD2))
#define rstd3 ((float*)(F.ws + WS_RSTD3))

    #define BODY0 do { convert_ffn(F, args.in[I_W1G], args.in[I_W1U], args.in[I_W1D], args.in[I_G1PRE], WGU, WD); p0_rows(F, args.in[I_X], args.in[I_META]); } while (0)
    if (IN(0)) { PHASE_BEGIN();
#if (PH_DUP >> 0) & 1
        BODY0; xcd_barrier(bar);
#endif
        BODY0; SEAM(0); }
    if (IN(1)) { PHASE_BEGIN();
        pg8::Gemm g{AB, WGU, R, NGU, DM}; pg8::StaticOrder S; S.init(R, NGU, F.G, (int)blockIdx.x);
        pg8::EpiSwiGLU E{ACT, DFF, rstd1};
#if (PH_DUP >> 1) & 1
        pg8::gemm_phase<pg8::EpiSwiGLU, pg8::StaticOrder, PG8_ALIGN, PG8_SP2>(F.lds, g, S, E); xcd_barrier(bar);
#endif
        pg8::gemm_phase<pg8::EpiSwiGLU, pg8::StaticOrder, PG8_ALIGN, PG8_SP2>(F.lds, g, S, E);
        TIC(6); meta_p1(F); TOC(6);
        SEAM(1);
    }
    if (IN(2)) { PHASE_BEGIN();
        pg8::Gemm g{ACT, WD, R, DM, DFF}; pg8::StaticOrder S; S.init(R, DM, F.G, (int)blockIdx.x);
        pg8::EpiStoreBf16 E{FB, DM};
        pg8::gemm_phase<pg8::EpiStoreBf16, pg8::StaticOrder, PG8_ALIGN, PG8_SP2>(F.lds, g, S, E);
        TIC(7); meta_p2(F); TOC(7);
        SEAM(2);
    }
    #define BODY3 do { norm_rows<0>(F, args.in[I_G1POST], rstd2, args.in[I_X], args.in[I_META]); convert_mix(F, args.in[I_WIN], args.in[I_WOUT], args.in[I_GMIX], WIN, WOUT); } while (0)
    if (IN(3)) { PHASE_BEGIN();
#if (PH_DUP >> 3) & 1
        BODY3; xcd_barrier(bar);
#endif
        BODY3; SEAM(3); }
    if (IN(4)) { PHASE_BEGIN();
        zero_pads(F);
        pg8::Gemm g{AB, WIN, R, 7168, DM}; pg8::StaticOrder S; S.init(R, 7168, F.G, (int)blockIdx.x);
        pg8::EpiProj E{F.ws, WS_RSTD2, WS_QH, WS_KH, WS_VH, WS_IQ, WS_GQ, WS_GK, WS_GV, WS_GO, WS_IK, WS_IW, WS_GLOW};
        pg8::gemm_phase<pg8::EpiProj, pg8::StaticOrder, PG8_ALIGN, PG8_SP2>(F.lds, g, S, E);
        TIC(8); meta_p4(F); TOC(8); TIC(9); small_cols(F); TOC(9);
        SEAM(4);
    }
#define BODY5A do { for (int v = F.vcu; v < 256; v += F.G) \
            for (int bq = 0; bq < 8; ++bq) { const int b = bq >> 2, q = bq & 3; const int t = q == 0 ? v : (q == 1 ? 511 - v : (q == 2 ? 512 + v : 1023 - v)); p5_item(F, b, t); } } while (0)
#define BODY5B do { PHASE_BEGIN(); for (int u = F.vcu; u < 1024; u += F.G) g1_unit(F, u >> 9, (u >> 7) & 3, u & 127, args.in[I_WGATE], args.in[I_BGATE]); } while (0)
    if (IN(5)) { PHASE_BEGIN();
#if (PH_DUP >> 5) & 1
        BODY5A; xcd_barrier(bar);
#endif
#if (PH_DUP >> 13) & 1
        BODY5B; xcd_barrier(bar);
#endif
        BODY5A; BODY5B;
        SEAM(5);
    }
    if (IN(6)) { PHASE_BEGIN(); g2_scan(F); SEAM(6); }
#define BODY7A do { p7_attention(F); } while (0)
#define BODY7B do { PHASE_BEGIN(); for (int u = F.vcu; u < 1024; u += F.G) g3_unit(F, u >> 9, (u >> 7) & 3, (u & 127) + 1, args.in[I_WGATE], args.in[I_BGATE], args.in[I_GGLA]); } while (0)
    if (IN(7)) { PHASE_BEGIN();
#if (PH_DUP >> 7) & 1
        BODY7A; xcd_barrier(bar);
#endif
#if (PH_DUP >> 14) & 1
        BODY7B; xcd_barrier(bar);
#endif
#ifndef SKIP_ATT
        BODY7A;
#endif
#ifndef SKIP_G3
        BODY7B;
#endif
        SEAM(7);
    }
    if (IN(8)) { PHASE_BEGIN();
        pg8::Gemm g{(const bf16*)(F.ws + WS_MIXA), WOUT, R, DM, DM}; pg8::StaticOrder S; S.init(R, DM, F.G, (int)blockIdx.x);
        pg8::EpiStoreBf16 E{FB, DM};
        pg8::gemm_phase<pg8::EpiStoreBf16, pg8::StaticOrder, PG8_ALIGN, PG8_SP2>(F.lds, g, S, E);
        SEAM(8);
    }
    if (IN(9)) { PHASE_BEGIN(); norm_rows<1>(F, args.in[I_GMIXPOST], rstd3, nullptr, nullptr); convert_ffn(F, args.in[I_W2G], args.in[I_W2U], args.in[I_W2D], args.in[I_G2PRE], WGU, WD); SEAM(9); }
    if (IN(10)) { PHASE_BEGIN();
        pg8::Gemm g{AB, WGU, R, NGU, DM}; pg8::StaticOrder S; S.init(R, NGU, F.G, (int)blockIdx.x);
        pg8::EpiSwiGLU E{ACT, DFF, rstd3};
        pg8::gemm_phase<pg8::EpiSwiGLU, pg8::StaticOrder, PG8_ALIGN, PG8_SP2>(F.lds, g, S, E);
        SEAM(10);
    }
    if (IN(11)) { PHASE_BEGIN();
        pg8::Gemm g{ACT, WD, R, DM, DFF}; pg8::StaticOrder S; S.init(R, DM, F.G, (int)blockIdx.x);
        pg8::EpiStoreBf16 E{FB, DM};
        pg8::gemm_phase<pg8::EpiStoreBf16, pg8::StaticOrder, PG8_ALIGN, PG8_SP2>(F.lds, g, S, E);
        SEAM(11);
    }
    if (IN(12)) { PHASE_BEGIN(); norm_rows<2>(F, args.in[I_G2POST], nullptr, nullptr, nullptr); PROBE_SPIN(); }
#undef IN
#undef SEAM
#undef AB
#undef ACT
#undef FB
#undef WGU
#undef WD
#undef WIN
#undef WOUT
#undef rstd1
#undef rstd2
#undef rstd3
}

extern "C" void kernel_launch(void* const* d_in, const int* in_sizes, int n_in, void* d_out, int out_size, void* d_ws, size_t ws_size, hipStream_t stream) {
    static int grid = 0;
    if (grid == 0) {
        if (n_in != 19 || in_sizes[0] != R * DM || out_size != R * DM || ws_size < WS_END) {
            fprintf(stderr, "kernel_launch: unexpected shapes (n_in %d, in0 %d, out %d, ws %zu; need ws >= %zu); nothing launched\n", n_in, n_in > 0 ? in_sizes[0] : -1, out_size, ws_size, (size_t)WS_END); grid = -1; return; }
        int dev = 0, cus = 0, per_cu = 0;
        if (hipGetDevice(&dev) != hipSuccess || hipDeviceGetAttribute(&cus, hipDeviceAttributeMultiprocessorCount, dev) != hipSuccess) { grid = -1; return; }
        if (hipFuncSetAttribute((const void*)hymba_fwd, hipFuncAttributeMaxDynamicSharedMemorySize, LDS_BYTES) != hipSuccess) { fprintf(stderr, "kernel_launch: hipFuncSetAttribute failed\n"); grid = -1; return; }
        if (hipOccupancyMaxActiveBlocksPerMultiprocessor(&per_cu, (const void*)hymba_fwd, NWAVES * 64, LDS_BYTES) != hipSuccess || per_cu < 1)
            fprintf(stderr, "kernel_launch: note: occupancy query reports %d workgroups per CU\n", per_cu);
        (void)hipGetLastError();
        grid = cus;
    }
    if (grid < 0) return;
    if (hipMemsetAsync((char*)d_ws + WS_CTL, 0, CTL_ZERO_BYTES, stream) != hipSuccess) return;
    Args a{};
    for (int i = 0; i < 19; ++i) a.in[i] = (const float*)d_in[i];
    a.out = (float*)d_out; a.ws = (unsigned char*)d_ws;
#if MK_PER_PHASE
    for (int p = 0; p < N_PHASES; ++p) { a.ph_lo = p; a.ph_hi = p + 1; hipLaunchKernelGGL(hymba_fwd, dim3(grid), dim3(NWAVES * 64), LDS_BYTES, stream, a); }
#else
    a.ph_lo = 0; a.ph_hi = N_PHASES;
    hipLaunchKernelGGL(hymba_fwd, dim3(grid), dim3(NWAVES * 64), LDS_BYTES, stream, a);
#endif
    const hipError_t le = hipPeekAtLastError();
    if (le != hipSuccess) fprintf(stderr, "kernel_launch: launch failed: %s\n", hipGetErrorName(le));
}
```

```cpp
#include <hip/hip_runtime.h>
#include <cstdio>
#include <cstdint>
#define MK_PER_PHASE 0
namespace pg8 {
#define PG8_LAS __attribute__((address_space(3)))
typedef unsigned short bf16_t;
typedef short bf16x8 __attribute__((ext_vector_type(8)));
typedef float f32x4 __attribute__((ext_vector_type(4)));
typedef unsigned u32x4 __attribute__((ext_vector_type(4)));
constexpr int BM = 256, BK = 64, HALF = 128, HTB = HALF * BK * 2  , STAGE_BYTES = 8 * HTB, NXCD = 8, WGM = 8;

__host__ __device__ __forceinline__ int lds_byte(int r, int c) { const int st = (r >> 4) * 2 + (c >> 5), rr = r & 15, cc = c & 31, ob = rr * 64 + cc * 2; return st * 1024 + (ob ^ (((ob >> 9) & 1) << 5)); }
__host__ __device__ __forceinline__ void stage_rc(int b, int& R, int& C) { const int st = b / 1024, sb = b % 1024, swz = sb ^ (((sb >> 9) & 1) << 5); R = (st >> 1) * 16 + swz / 64; C = (st & 1) * 32 + (swz % 64) / 2; }
__host__ __device__ __forceinline__ int perm32(int rho) { const int n = rho >> 4, i = rho & 15; return 8 * (i >> 2) + 4 * n + (i & 3); }

struct Unit { int pm, pn; };
struct Gemm { const bf16_t* A; const bf16_t* Bt; int M, N, K; };

struct StaticOrder {
    int nM, nN, nwg, G, c;
    __host__ __device__ void init(int M, int N, int G_, int c_) { nM = M / BM; nN = N / BM; nwg = nM * nN; G = G_; c = c_; }
    __host__ __device__ bool next(int i, Unit& u) const {
        const long L = (long)i * G + c; if (L >= nwg) return false;
        int wgid = (int)L; { const int q = nwg / NXCD, r = nwg % NXCD, xcd = wgid % NXCD, off = wgid / NXCD; wgid = (xcd < r ? xcd * (q + 1) : r * (q + 1) + (xcd - r) * q) + off; }
        const int nig = WGM * nN, gid = wgid / nig, fm = gid * WGM, gsz = (nM - fm) < WGM ? (nM - fm) : WGM;
        u.pm = fm + ((wgid % nig) % gsz); u.pn = (wgid % nig) / gsz; return true;
    }
    __device__ __forceinline__ void a_ready(const Unit&) const {}
    __device__ __forceinline__ void done(const Unit&) const {}
};

__device__ __forceinline__ unsigned cvt_pk_bf16(float lo, float hi) { unsigned r; asm volatile("v_cvt_pk_bf16_f32 %0, %1, %2" : "=v"(r) : "v"(lo), "v"(hi)); return r; }
typedef float f32x2 __attribute__((ext_vector_type(2)));

__device__ __forceinline__ void st8bf(bf16_t* p, const f32x4 v0, const f32x4 v1) {
    u32x4 w; w.x = cvt_pk_bf16(v0[0], v0[1]); w.y = cvt_pk_bf16(v0[2], v0[3]); w.z = cvt_pk_bf16(v1[0], v1[1]); w.w = cvt_pk_bf16(v1[2], v1[3]);
    *(u32x4*)p = w;
}
__device__ __forceinline__ float silu_f(float x) { return x * __builtin_amdgcn_rcpf(1.0f + __builtin_amdgcn_exp2f(-1.4426950408889634f * x)); }

struct EpiStoreBf16 {
    static constexpr bool PERM = true, AFTER_DRAIN = false;
    bf16_t* O; int ldc;
    __device__ __forceinline__ void operator()(const f32x4 (&acc)[2][2][4][2], const Unit& u, int wr, int wc, int fr, int fq) const {
        const int row0 = u.pm * BM + wr * 64 + fr, col0 = u.pn * BM + wc * 32 + 8 * fq;
#pragma unroll
        for (int ai = 0; ai < 2; ++ai)
#pragma unroll
            for (int m = 0; m < 4; ++m) { bf16_t* rowp = O + (size_t)(row0 + ai * HALF + m * 16) * ldc + col0;
#pragma unroll
                for (int bj = 0; bj < 2; ++bj) st8bf(rowp + bj * HALF, acc[ai][bj][m][0], acc[ai][bj][m][1]); }
    }
};
struct EpiSwiGLU {
    static constexpr bool PERM = true, AFTER_DRAIN = false;
    bf16_t* O; int ldc; const float* rstd;
    __device__ __forceinline__ void operator()(const f32x4 (&acc)[2][2][4][2], const Unit& u, int wr, int wc, int fr, int fq) const {
        const int row0 = u.pm * BM + wr * 64 + fr, col0 = u.pn * HALF + wc * 32 + 8 * fq;
#pragma unroll
        for (int ai = 0; ai < 2; ++ai)
#pragma unroll
            for (int m = 0; m < 4; ++m) { const int row = row0 + ai * HALF + m * 16; const float rs = rstd[row];
                f32x4 o0, o1;
#pragma unroll
                for (int j = 0; j < 4; ++j) { o0[j] = silu_f(acc[ai][0][m][0][j] * rs) * (acc[ai][1][m][0][j] * rs); o1[j] = silu_f(acc[ai][0][m][1][j] * rs) * (acc[ai][1][m][1][j] * rs); }
                st8bf(O + (size_t)row * ldc + col0, o0, o1); }
    }
};
struct EpiProj {
    static constexpr bool PERM = true, AFTER_DRAIN = false;
    static constexpr int TKV = 8256;
    unsigned char* ws; size_t o_rstd, o_qh, o_kh, o_vh, o_iq, o_gq, o_gk, o_gv, o_go, o_ik, o_iw, o_glow;
    __device__ __forceinline__ void operator()(const f32x4 (&acc)[2][2][4][2], const Unit& u, int wr, int wc, int fr, int fq) const {
        const float* rstd = (const float*)(ws + o_rstd);
        bf16_t* Qh = (bf16_t*)(ws + o_qh); bf16_t* Kh = (bf16_t*)(ws + o_kh); bf16_t* Vh = (bf16_t*)(ws + o_vh); bf16_t* IQ = (bf16_t*)(ws + o_iq); bf16_t* GQ = (bf16_t*)(ws + o_gq);
        bf16_t* GK = (bf16_t*)(ws + o_gk); bf16_t* GV = (bf16_t*)(ws + o_gv); bf16_t* GO = (bf16_t*)(ws + o_go); bf16_t* IK = (bf16_t*)(ws + o_ik); float* IW = (float*)(ws + o_iw); float* GLOW = (float*)(ws + o_glow);
        const int pn = u.pn;
        const int row0 = u.pm * BM + wr * 64 + fr;
#pragma unroll
        for (int ai = 0; ai < 2; ++ai)
#pragma unroll
            for (int m = 0; m < 4; ++m) {
                const int row = row0 + ai * HALF + m * 16; const float rs = rstd[row];
                const bool mainr = row < 16384, metar = (row >= 16384) && (row < 16400);
                const int b = row >> 13, s = row & 8191, mi = row - 16384;
#pragma unroll
                for (int bj = 0; bj < 2; ++bj) {
                    const int col = bj * HALF + wc * 32 + 8 * fq;
                    f32x4 v0 = acc[ai][bj][m][0] * rs, v1 = acc[ai][bj][m][1] * rs;
                    if (pn < 4) {
                        if (mainr) { const int h = pn * 2 + (col >> 7), d = col & 127; st8bf(Qh + ((size_t)(b * 8 + h) * 8192 + s) * 128 + d, v0, v1); }
                    } else if (pn < 12) {
                        bf16_t* base = pn < 8 ? Kh : Vh; const int h = (pn & 3) * 2 + (col >> 7), d = col & 127;
                        if (mainr) st8bf(base + ((size_t)(b * 8 + h) * TKV + 16 + s) * 128 + d, v0, v1);
                        else if (metar) { st8bf(base + ((size_t)h * TKV + mi) * 128 + d, v0, v1); st8bf(base + ((size_t)(8 + h) * TKV + mi) * 128 + d, v0, v1); }
                    } else if (pn < 16) {
                        if (mainr) st8bf(IQ + (size_t)row * 1024 + (pn - 12) * 256 + col, v0 * 0.125f, v1 * 0.125f);
                    } else if (pn < 18) {
                        if (mainr) st8bf(GQ + ((size_t)b * TKV + 64 + s) * 512 + (pn - 16) * 256 + col, v0 * 0.08838834764831845f, v1 * 0.08838834764831845f);
                    } else if (pn < 20) {
                        const int c = (pn - 18) * 256 + col;
                        if (mainr) st8bf(GK + ((size_t)b * TKV + 64 + s) * 512 + c, v0, v1);
                        else if (metar) { st8bf(GK + ((size_t)48 + mi) * 512 + c, v0, v1); st8bf(GK + ((size_t)TKV + 48 + mi) * 512 + c, v0, v1); }
                    } else if (pn < 24) {
                        const int c = (pn - 20) * 256 + col;
                        if (mainr) st8bf(GV + ((size_t)b * TKV + 64 + s) * 1024 + c, v0, v1);
                        else if (metar) { st8bf(GV + ((size_t)48 + mi) * 1024 + c, v0, v1); st8bf(GV + ((size_t)TKV + 48 + mi) * 1024 + c, v0, v1); }
                    } else if (pn < 28) {
                        if (mainr) st8bf(GO + (size_t)row * 1024 + (pn - 24) * 256 + col, v0, v1);
                    } else {
                        if (col < 64) {
                            const int ch = col >> 3, fo = (ch >> 1) * 512 + (ch & 1) * 256;
                            if (mainr) { const int pos = 16 + s; st8bf(IK + (size_t)b * TKV * 64 + (size_t)(pos >> 5) * 2048 + fo + (pos & 31) * 8, v0, v1); }
                            else if (metar) { st8bf(IK + fo + mi * 8, v0, v1); st8bf(IK + (size_t)TKV * 64 + fo + mi * 8, v0, v1); }
                        } else if (col < 80) {
                            if (mainr) { float* p = IW + (size_t)row * 16 + (col - 64); *(f32x4*)p = v0 * 0.25f; *(f32x4*)(p + 4) = v1 * 0.25f; }
                        } else if (col < 96) {
                            const int c = col - 80;
                            if (mainr) { float* p = GLOW + ((size_t)b * TKV + 64 + s) * 16 + c; *(f32x4*)p = v0; *(f32x4*)(p + 4) = v1; }
                            else if (metar) { float* p = GLOW + ((size_t)48 + mi) * 16 + c; *(f32x4*)p = v0; *(f32x4*)(p + 4) = v1;
                                              float* p2 = GLOW + ((size_t)TKV + 48 + mi) * 16 + c; *(f32x4*)p2 = v0; *(f32x4*)(p2 + 4) = v1; }
                        }
                    }
                }
            }
    }
};
template <class Epi, class Sched, bool ALIGN_EPI = false, bool SP2 = false>
__device__ __forceinline__ void gemm_phase(PG8_LAS unsigned char* lds, const Gemm g, const Sched& S, const Epi& E) {
    const int tid = threadIdx.x, wid = __builtin_amdgcn_readfirstlane(tid >> 6), lane = tid & 63, wr = wid >> 2, wc = wid & 3, fr = lane & 15, fq = lane >> 4;
    const int K = g.K, nt = K / BK;
    unsigned voffA[2], voffB[2];
#pragma unroll
    for (int i = 0; i < 2; ++i) { int R, C; stage_rc(tid * 16 + i * 8192, R, C); const int Rb = Epi::PERM ? ((R & ~31) + perm32(R & 31)) : R;
        voffA[i] = (unsigned)(R * K + C) * 2u; voffB[i] = (unsigned)(Rb * K + C) * 2u; }
    const size_t kstep = (size_t)(BK * 2);
    const size_t hstep = (size_t)HALF * K * 2;
    const size_t tstep = 2 * hstep;
    const unsigned ldsw = (unsigned)wid * 1024u;
    const int aoff = lds_byte(wr * 64 + fr, fq * 8), boff = lds_byte(wc * 32 + fr, fq * 8);
#define PG8_SA(b, h) (((b) * 2 + (h)) * HTB)
#define PG8_SB(b, h) ((4 + (b) * 2 + (h)) * HTB)
#define PG8_STAGE(bufoff, gbase, voff) do { _Pragma("unroll") for (int _i = 0; _i < 2; ++_i) \
        __builtin_amdgcn_global_load_lds((const unsigned*)((const char*)(gbase) + (voff)[_i]), (PG8_LAS unsigned*)(lds + (bufoff) + ldsw + _i * 8192), 16, 0, 0); } while (0)
#define PG8_LDA(dst, b, h) do { _Pragma("unroll") for (int m = 0; m < 4; ++m) _Pragma("unroll") for (int k = 0; k < 2; ++k) dst[m][k] = *(const PG8_LAS bf16x8*)(lds + PG8_SA(b, h) + aoff + m * 2048 + k * 1024); } while (0)
#define PG8_LDB(dst, b, h) do { _Pragma("unroll") for (int n = 0; n < 2; ++n) _Pragma("unroll") for (int k = 0; k < 2; ++k) dst[n][k] = *(const PG8_LAS bf16x8*)(lds + PG8_SB(b, h) + boff + n * 2048 + k * 1024); } while (0)
#define PG8_MMA(ai, bj, At, Bt) do { __builtin_amdgcn_s_setprio(1); _Pragma("unroll") for (int m = 0; m < 4; ++m) _Pragma("unroll") for (int n = 0; n < 2; ++n) _Pragma("unroll") for (int k = 0; k < 2; ++k) \
        acc[ai][bj][m][n] = __builtin_amdgcn_mfma_f32_16x16x32_bf16(Bt[n][k], At[m][k], acc[ai][bj][m][n], 0, 0, 0); __builtin_amdgcn_s_setprio(0); } while (0)
#define PG8_WAIT_V(n) asm volatile("s_waitcnt vmcnt(" #n ")" ::: "memory")
#define PG8_WAIT_L(n) asm volatile("s_waitcnt lgkmcnt(" #n ")" ::: "memory")
#define PG8_BAR __builtin_amdgcn_s_barrier()
#define PG8_SCHED __builtin_amdgcn_sched_barrier(0)
    Unit cur, nxt; int ui = 0;
    if (!S.next(0, cur)) return;
    f32x4 acc[2][2][4][2];
#pragma unroll
    for (int a = 0; a < 2; ++a)
#pragma unroll
        for (int b = 0; b < 2; ++b)
#pragma unroll
            for (int m = 0; m < 4; ++m)
#pragma unroll
                for (int n = 0; n < 2; ++n) acc[a][b][m][n] = (f32x4){0.f, 0.f, 0.f, 0.f};
    bf16x8 At[4][2], B0[2][2], B1[2][2];
    const char* cA = (const char*)g.A + (size_t)cur.pm * tstep; const char* cB = (const char*)g.Bt + (size_t)cur.pn * tstep;
    S.a_ready(cur);
    if constexpr (SP2) {
        PG8_STAGE(PG8_SB(0, 0), cB, voffB); PG8_STAGE(PG8_SB(0, 1), cB + hstep, voffB); PG8_STAGE(PG8_SA(0, 0), cA, voffA); PG8_STAGE(PG8_SA(0, 1), cA + hstep, voffA);
        if (wr == 1) PG8_BAR;
        PG8_WAIT_V(2); PG8_BAR;
        PG8_STAGE(PG8_SB(1, 0), cB + kstep, voffB); PG8_STAGE(PG8_SA(1, 0), cA + kstep, voffA); PG8_STAGE(PG8_SB(1, 1), cB + hstep + kstep, voffB);
        PG8_WAIT_V(6); PG8_BAR;
    } else {
        PG8_STAGE(PG8_SB(0, 0), cB, voffB); PG8_STAGE(PG8_SA(0, 0), cA, voffA); PG8_STAGE(PG8_SB(0, 1), cB + hstep, voffB); PG8_STAGE(PG8_SA(0, 1), cA + hstep, voffA);
        if (wr == 1) PG8_BAR;
        PG8_WAIT_V(4); PG8_BAR;
        PG8_STAGE(PG8_SB(1, 0), cB + kstep, voffB); PG8_STAGE(PG8_SA(1, 0), cA + kstep, voffA); PG8_STAGE(PG8_SB(1, 1), cB + hstep + kstep, voffB);
        PG8_WAIT_V(6); PG8_BAR;
    }
    for (;;) {
        const bool has_next = S.next(ui + 1, nxt);
        const char* nA = has_next ? (const char*)g.A + (size_t)nxt.pm * tstep : cA; const char* nB = has_next ? (const char*)g.Bt + (size_t)nxt.pn * tstep : cB;
        for (int t = 0; t < nt; t += 2) {
            const bool last = (t == nt - 2);
            const char* a1 = cA + (size_t)(t + 1) * kstep;
            const char* a2 = last ? nA : cA + (size_t)(t + 2) * kstep; const char* b2 = last ? nB : cB + (size_t)(t + 2) * kstep;
            const char* a3 = a2 + kstep; const char* b3 = b2 + kstep;
            if (last && has_next) S.a_ready(nxt);
            if constexpr (SP2) {
            PG8_LDB(B0, 0, 0); PG8_LDB(B1, 0, 1); PG8_SCHED; PG8_LDA(At, 0, 0); PG8_STAGE(PG8_SA(1, 1), a1 + hstep, voffA);
            PG8_WAIT_V(8); PG8_WAIT_L(0); PG8_BAR; PG8_MMA(0, 0, At, B0); PG8_MMA(0, 1, At, B1); PG8_BAR; PG8_SCHED;
            PG8_LDA(At, 0, 1); PG8_STAGE(PG8_SB(0, 0), b2, voffB); PG8_STAGE(PG8_SB(0, 1), b2 + hstep, voffB); PG8_STAGE(PG8_SA(0, 0), a2, voffA);
            PG8_WAIT_V(8); PG8_WAIT_L(0); PG8_BAR; PG8_MMA(1, 0, At, B0); PG8_MMA(1, 1, At, B1); PG8_BAR; PG8_SCHED;
            PG8_LDB(B0, 1, 0); PG8_LDB(B1, 1, 1); PG8_SCHED; PG8_LDA(At, 1, 0); PG8_STAGE(PG8_SA(0, 1), a2 + hstep, voffA);
            PG8_WAIT_V(8); PG8_WAIT_L(0); PG8_BAR; PG8_MMA(0, 0, At, B0); PG8_MMA(0, 1, At, B1); PG8_BAR; PG8_SCHED;
            PG8_LDA(At, 1, 1); PG8_STAGE(PG8_SB(1, 0), b3, voffB); PG8_STAGE(PG8_SB(1, 1), b3 + hstep, voffB); PG8_STAGE(PG8_SA(1, 0), a3, voffA);
            PG8_WAIT_V(8); PG8_WAIT_L(0); PG8_BAR; PG8_MMA(1, 0, At, B0); PG8_MMA(1, 1, At, B1); PG8_BAR; PG8_SCHED;
            } else {
            PG8_LDB(B0, 0, 0); PG8_SCHED; PG8_LDA(At, 0, 0); PG8_STAGE(PG8_SA(1, 1), a1 + hstep, voffA);
            PG8_WAIT_L(8); PG8_BAR; PG8_WAIT_L(0); PG8_MMA(0, 0, At, B0); PG8_BAR; PG8_SCHED;
            PG8_LDB(B1, 0, 1); PG8_STAGE(PG8_SB(0, 0), b2, voffB);
            PG8_BAR; PG8_WAIT_L(0); PG8_MMA(0, 1, At, B1); PG8_BAR;
            PG8_LDA(At, 0, 1); PG8_STAGE(PG8_SA(0, 0), a2, voffA);
            PG8_BAR; PG8_WAIT_L(0); PG8_MMA(1, 0, At, B0); PG8_BAR; PG8_SCHED;
            PG8_STAGE(PG8_SB(0, 1), b2 + hstep, voffB);
            PG8_WAIT_V(6); PG8_BAR; PG8_MMA(1, 1, At, B1); PG8_BAR;
            PG8_LDB(B0, 1, 0); PG8_SCHED; PG8_LDA(At, 1, 0); PG8_STAGE(PG8_SA(0, 1), a2 + hstep, voffA);
            PG8_WAIT_L(8); PG8_BAR; PG8_WAIT_L(0); PG8_MMA(0, 0, At, B0); PG8_BAR; PG8_SCHED;
            PG8_LDB(B1, 1, 1); PG8_STAGE(PG8_SB(1, 0), b3, voffB);
            PG8_BAR; PG8_WAIT_L(0); PG8_MMA(0, 1, At, B1); PG8_BAR;
            PG8_LDA(At, 1, 1); PG8_STAGE(PG8_SA(1, 0), a3, voffA);
            PG8_BAR; PG8_WAIT_L(0); PG8_MMA(1, 0, At, B0); PG8_BAR; PG8_SCHED;
            PG8_STAGE(PG8_SB(1, 1), b3 + hstep, voffB);
            PG8_WAIT_V(6); PG8_BAR; PG8_MMA(1, 1, At, B1); PG8_BAR;
            }
        }
        if constexpr (ALIGN_EPI) { if (wr == 0) PG8_BAR; }
        if constexpr (!Epi::AFTER_DRAIN) { E(acc, cur, wr, wc, fr, fq); S.done(cur); }
        if (!has_next) break;
#pragma unroll
        for (int a = 0; a < 2; ++a)
#pragma unroll
            for (int b = 0; b < 2; ++b)
#pragma unroll
                for (int m = 0; m < 4; ++m)
#pragma unroll
                    for (int n = 0; n < 2; ++n) acc[a][b][m][n] = (f32x4){0.f, 0.f, 0.f, 0.f};
        cur = nxt; cA = nA; cB = nB; ++ui;
        if constexpr (ALIGN_EPI) { if (wr == 1) PG8_BAR; }
    }
    PG8_WAIT_V(0);
    if constexpr (!ALIGN_EPI) { if (wr == 0) PG8_BAR; }
    PG8_BAR;
    if constexpr (Epi::AFTER_DRAIN) { E.fused(acc, cur, wr, wc, fr, fq, lds, wid, lane); S.done(cur); }
#undef PG8_SA
#undef PG8_SB
#undef PG8_STAGE
#undef PG8_LDA
#undef PG8_LDB
#undef PG8_MMA
#undef PG8_WAIT_V
#undef PG8_WAIT_L
#undef PG8_BAR
#undef PG8_SCHED
}
}

namespace att {
typedef unsigned short bf16;
typedef short bf16x8 __attribute__((ext_vector_type(8)));
typedef short s16x4 __attribute__((ext_vector_type(4)));
typedef float f32x16 __attribute__((ext_vector_type(16)));
typedef float f32x4 __attribute__((ext_vector_type(4)));
typedef unsigned u32x4 __attribute__((ext_vector_type(4)));
typedef unsigned long long u64;
constexpr int HD = 128, NW = 8, QBLK = 32, KVBLK = 64, QB = NW * QBLK;
constexpr int SHM_V = KVBLK * HD * 2, SHM_K = KVBLK * HD * 2;
constexpr int ATT_LDS_BYTES = 2 * SHM_V + 2 * SHM_K + NW * 64 * 4;
constexpr float SCALE = 0.08838834764831845f;
constexpr float THR = 8.f;
constexpr int OSTR = 2048;
constexpr int MWORDS = 130;

#define KSWZ(row, colB) ((row) * 256 + ((colB) ^ (((row) & 7) << 4)))
#define SBAR() __builtin_amdgcn_sched_barrier(0)
__device__ __forceinline__ int v_st(int k, int c) { const int kk = (k & ~0xC) | ((k & 4) << 1) | ((k & 8) >> 1); return ((kk >> 3) * 4 + (c >> 5)) * 512 + ((kk & 7) * 32 + (c & 31)) * 2; }
__device__ __forceinline__ int v_rd_base(int lane) { return ((lane & 3) << 3) | (((lane >> 2) & 3) << 6) | (((lane >> 4) & 1) << 5) | (((lane >> 5) & 1) << 8); }
constexpr int v_rd_off(int d0, int ks, int half) { return d0 * 512 + ks * 4096 + half * 2048; }
__device__ __forceinline__ int crow(int r, int hi) { return (r & 3) + 8 * (r >> 2) + 4 * hi; }
__device__ __forceinline__ unsigned cvtpk(float lo, float hi) {
    unsigned r; asm volatile("v_cvt_pk_bf16_f32 %0, %1, %2" : "=v"(r) : "v"(lo), "v"(hi)); return r;
}
__device__ __forceinline__ bf16x8 load8(const bf16* p) { return *reinterpret_cast<const bf16x8*>(p); }
__device__ __forceinline__ void mask_bits(f32x16& p0, f32x16& p1, unsigned mw) {
    const float NEG = -__builtin_inff();
#pragma unroll
    for (int r = 0; r < 16; ++r) {
        if (!((mw >> r) & 1u)) p0[r] = NEG;
        if (!((mw >> (16 + r)) & 1u)) p1[r] = NEG;
    }
}
__device__ __forceinline__ void partialSM(f32x16& p0, f32x16& p1, float& m_reg, float& mn, float& alpha) {
    float pmax = p0[0]; for (int r = 1; r < 16; ++r) pmax = fmaxf(pmax, p0[r]); for (int r = 0; r < 16; ++r) pmax = fmaxf(pmax, p1[r]);
    { auto rr = __builtin_amdgcn_permlane32_swap(__float_as_uint(pmax), __float_as_uint(pmax), false, false);
      pmax = fmaxf(__uint_as_float(rr[0]), __uint_as_float(rr[1])); }
    constexpr float C2 = 1.4426950408889634f * SCALE;
    if (__builtin_expect(__all((pmax - m_reg) * SCALE <= THR), 1)) { mn = m_reg; alpha = 1.f; }
    else { mn = fmaxf(m_reg, pmax); alpha = __builtin_amdgcn_exp2f((m_reg - mn) * C2); m_reg = mn; }
    const float mnL = -mn * C2;
    for (int r = 0; r < 16; ++r) p0[r] = fmaf(p0[r], C2, mnL); for (int r = 0; r < 16; ++r) p1[r] = fmaf(p1[r], C2, mnL);
    for (int r = 0; r < 16; ++r) p0[r] = __builtin_amdgcn_exp2f(p0[r]);
}
__device__ __forceinline__ void finishSM(f32x16& p0, f32x16& p1, float alpha, float& l_reg, bf16x8& pa0, bf16x8& pa1, bf16x8& pa2, bf16x8& pa3) {
    for (int r = 0; r < 16; ++r) p1[r] = __builtin_amdgcn_exp2f(p1[r]);
    float ps = 0; for (int r = 0; r < 16; ++r) ps += p0[r]; for (int r = 0; r < 16; ++r) ps += p1[r];
    { auto rr = __builtin_amdgcn_permlane32_swap(__float_as_uint(ps), __float_as_uint(ps), false, false);
      ps = __uint_as_float(rr[0]) + __uint_as_float(rr[1]); }
    l_reg = l_reg * alpha + ps;
#define PK4(P, B_, OUT) do { unsigned a0 = cvtpk(P[B_+0], P[B_+1]), a1 = cvtpk(P[B_+2], P[B_+3]);                          \
        unsigned b0 = cvtpk(P[B_+4], P[B_+5]), b1 = cvtpk(P[B_+6], P[B_+7]);                                             \
        auto r0 = __builtin_amdgcn_permlane32_swap(a0, b0, false, false); auto r1 = __builtin_amdgcn_permlane32_swap(a1, b1, false, false); \
        u32x4 w = {r0[0], r1[0], r0[1], r1[1]}; OUT = *reinterpret_cast<bf16x8*>(&w); } while (0)
    PK4(p0, 0, pa0); PK4(p0, 8, pa1); PK4(p1, 0, pa2); PK4(p1, 8, pa3);
#undef PK4
}
template <int KB>
__device__ __forceinline__ void qkt(f32x16& p0, f32x16& p1, const char* K_lds, int r32, int hi, const bf16x8* qr) {
    p0 = f32x16{}; p1 = f32x16{};
    const char* kb[4];
#pragma unroll
    for (int dd = 0; dd < 4; ++dd) kb[dd] = K_lds + KB * SHM_K + KSWZ(r32, (dd * 16 + hi * 8) * 2);
#pragma unroll
    for (int d0 = 0; d0 < 8; ++d0) { const char* a = kb[d0 & 3] + (d0 >> 2) * 128;
        bf16x8 b0 = *reinterpret_cast<const bf16x8*>(a);
        bf16x8 b1 = *reinterpret_cast<const bf16x8*>(a + 32 * 256);
        p0 = __builtin_amdgcn_mfma_f32_32x32x16_bf16(b0, qr[d0], p0, 0, 0, 0);
        p1 = __builtin_amdgcn_mfma_f32_32x32x16_bf16(b1, qr[d0], p1, 0, 0, 0); }
}
template <int VB>
__device__ __forceinline__ void pv_tile(f32x16* o, int vb0, bf16x8 pa0, bf16x8 pa1, bf16x8 pa2, bf16x8 pa3) {
#define TRRD(dst, off) asm volatile("ds_read_b64_tr_b16 %0, %1 offset:%2" : "=&v"(dst) : "v"(vb0), "i"(off) : "memory")
#define PV_D0(d0) do { s16x4 l0, l1, l2, l3, h0, h1, h2, h3; constexpr int b_ = VB * SHM_V + v_rd_off(d0, 0, 0);     \
        TRRD(l0, b_); TRRD(h0, b_ + 2048); TRRD(l1, b_ + 4096); TRRD(h1, b_ + 6144); TRRD(l2, b_ + 8192); TRRD(h2, b_ + 10240); TRRD(l3, b_ + 12288); TRRD(h3, b_ + 14336); \
        asm volatile("s_waitcnt lgkmcnt(0)" ::: "memory"); SBAR();             \
        o[d0] = __builtin_amdgcn_mfma_f32_32x32x16_bf16(pa0, (bf16x8){l0[0], l0[1], l0[2], l0[3], h0[0], h0[1], h0[2], h0[3]}, o[d0], 0, 0, 0);   \
        o[d0] = __builtin_amdgcn_mfma_f32_32x32x16_bf16(pa1, (bf16x8){l1[0], l1[1], l1[2], l1[3], h1[0], h1[1], h1[2], h1[3]}, o[d0], 0, 0, 0);   \
        o[d0] = __builtin_amdgcn_mfma_f32_32x32x16_bf16(pa2, (bf16x8){l2[0], l2[1], l2[2], l2[3], h2[0], h2[1], h2[2], h2[3]}, o[d0], 0, 0, 0);   \
        o[d0] = __builtin_amdgcn_mfma_f32_32x32x16_bf16(pa3, (bf16x8){l3[0], l3[1], l3[2], l3[3], h3[0], h3[1], h3[2], h3[3]}, o[d0], 0, 0, 0); } while (0)
    PV_D0(0); PV_D0(1); PV_D0(2); PV_D0(3);
#undef PV_D0
#undef TRRD
}

struct BlockRef { const bf16* Q; const bf16* K; const bf16* V; bf16* O; const u64* M; int NT; };
struct Seam { bf16x8 qr[8]; bf16x8 st_v0, st_v1, st_k0, st_k1; };
#define VMW() asm volatile("s_waitcnt vmcnt(0)" ::: "memory")
#define VMWN(n) asm volatile("s_waitcnt vmcnt(%0)" :: "i"(n) : "memory")
#define SLOAD_H(Kp, Vp, k0) do { int t_ = tid; asm volatile("" : "+v"(t_)); const unsigned go_ = (unsigned)((k0) * (HD * 2)) + (unsigned)t_ * 16u;               \
                         S.st_v0 = load8((const bf16*)((const char*)(Vp) + go_)); S.st_v1 = load8((const bf16*)((const char*)(Vp) + (go_ + 8192u)));              \
                         S.st_k0 = load8((const bf16*)((const char*)(Kp) + go_)); S.st_k1 = load8((const bf16*)((const char*)(Kp) + (go_ + 8192u))); } while (0)
#define SWRITE_HK(bf) do { int t_ = tid; asm volatile("" : "+v"(t_)); const int sr_ = t_ >> 4, sc_ = (t_ & 15) * 8, kws_ = KSWZ(sr_, sc_ * 2);                      \
                         *(bf16x8*)(K_lds + (bf) * SHM_K + kws_) = S.st_k0; *(bf16x8*)(K_lds + (bf) * SHM_K + kws_ + 32 * 256) = S.st_k1; } while (0)
#define SWRITE_HV(bf) do { int t_ = tid; asm volatile("" : "+v"(t_)); const int sr_ = t_ >> 4, sc_ = (t_ & 15) * 8, vs_ = v_st(sr_, sc_);                            \
                         *(bf16x8*)(V_lds + (bf) * SHM_V + vs_) = S.st_v0; *(bf16x8*)(V_lds + (bf) * SHM_V + vs_ + 8192) = S.st_v1; } while (0)
#define SWRITE_H(bf) do { SWRITE_HV(bf); SWRITE_HK(bf); } while (0)
__device__ __forceinline__ void att_prime(const BlockRef& cur, char* lds, Seam& S) {
    const int tid = threadIdx.x, wid = __builtin_amdgcn_readfirstlane(tid >> 6), lane = tid & 63, r32 = lane & 31, hi = lane >> 5;
    char* K_lds = lds + 2 * SHM_V;
#pragma unroll
    for (int d0 = 0; d0 < 8; ++d0) S.qr[d0] = load8((const bf16*)((const char*)cur.Q + (unsigned)(((wid * QBLK + r32) * HD + hi * 8) * 2 + d0 * 32)));
    SLOAD_H(cur.K, cur.V, 0); VMW(); SWRITE_HK(0);
    __syncthreads();
}
__device__ __forceinline__ void att_block(const BlockRef& cur, const BlockRef& nxt, char* lds, Seam& S) {
    const int tid = threadIdx.x, wid = __builtin_amdgcn_readfirstlane(tid >> 6), lane = tid & 63, r32 = lane & 31, hi = lane >> 5;
    const int NT = cur.NT;
    char* V_lds = lds; char* K_lds = lds + 2 * SHM_V;
    float* ws = (float*)(lds + 2 * SHM_V + 2 * SHM_K) + wid * 64; float* li_l = ws, * al_l = ws + 32;
    float m_reg = -1e30f, l_reg = 0; f32x16 o[4] = {};
    const int vb0 = (int)(uintptr_t)V_lds + v_rd_base(lane);
    const bf16* Kh = cur.K; const bf16* Vh = cur.V;
    const char* Mb = (const char*)cur.M; const unsigned moff = (unsigned)((wid * QBLK + r32) * (MWORDS * 8) + hi * 4);
#define MLOAD(t) (*(const unsigned*)(Mb + (moff + (unsigned)(t) * 8u)))
    unsigned mwA = MLOAD(0), mwB = 0u;
#define RESC(a) do { if (__any((a) < 1.f)) { if (hi == 0) al_l[r32] = (a); asm volatile("s_waitcnt lgkmcnt(0)" ::: "memory");              \
                     for (int d_ = 0; d_ < 4; ++d_) for (int r = 0; r < 16; ++r) o[d_][r] *= al_l[crow(r, hi)]; } } while (0)
#define KBASE(t) ((t) * KVBLK)
    constexpr int NQL = 8;
#define SEAM_K0() do { VMWN(NQL); SWRITE_HK(0); SBAR(); } while (0)
    f32x16 pA0, pA1, pB0, pB1; float mnA, mnB, alA, alB; bf16x8 pa0, pa1, pa2, pa3;
    SWRITE_HV(0); SBAR();
    if (NT > 1) { SLOAD_H(Kh, Vh, KBASE(1)); }
    SBAR(); qkt<0>(pA0, pA1, K_lds, r32, hi, S.qr);
    mask_bits(pA0, pA1, mwA); partialSM(pA0, pA1, m_reg, mnA, alA);
    if (NT > 1) { VMW(); SWRITE_H(1); }
    __syncthreads();
#define HALF_STEP(PX0, PX1, mnX, alX, PY0, PY1, alY, t, KB, VB, SB, MWX, MWY) do {                                             \
        MWX = MLOAD(t);                                                                                                       \
        SBAR(); qkt<KB>(PX0, PX1, K_lds, r32, hi, S.qr);                                                                      \
        finishSM(PY0, PY1, alY, l_reg, pa0, pa1, pa2, pa3); SBAR();                                                           \
        if ((t) + 1 < NT) { SLOAD_H(Kh, Vh, KBASE((t) + 1)); SBAR(); }                                                        \
        pv_tile<VB>(o, vb0, pa0, pa1, pa2, pa3); mask_bits(PX0, PX1, MWX); partialSM(PX0, PX1, m_reg, mnX, alX);          \
        __syncthreads();                                                                                                      \
        if ((t) + 1 < NT) { VMW(); SWRITE_H(SB); }                                                                            \
        RESC(alX); __syncthreads(); } while (0)
    for (int t = 1; t + 1 < NT; t += 2) {
        HALF_STEP(pB0, pB1, mnB, alB, pA0, pA1, alA, t, 1, 0, 0, mwB, mwA);
        HALF_STEP(pA0, pA1, mnA, alA, pB0, pB1, alB, t + 1, 0, 1, 1, mwA, mwB);
    }
    const bool even = (NT & 1) == 0;
    if (even) { mwB = MLOAD(NT - 1); SBAR(); qkt<1>(pB0, pB1, K_lds, r32, hi, S.qr); SBAR(); }
    SLOAD_H(nxt.K, nxt.V, 0); SBAR();
#pragma unroll
    for (int d0 = 0; d0 < 8; ++d0) S.qr[d0] = load8((const bf16*)((const char*)nxt.Q + (unsigned)(((wid * QBLK + r32) * HD + hi * 8) * 2 + d0 * 32)));
    SBAR();
    finishSM(pA0, pA1, alA, l_reg, pa0, pa1, pa2, pa3); SBAR();
    pv_tile<0>(o, vb0, pa0, pa1, pa2, pa3);
    if (even) { mask_bits(pB0, pB1, mwB); partialSM(pB0, pB1, m_reg, mnB, alB); __syncthreads(); RESC(alB);
        finishSM(pB0, pB1, alB, l_reg, pa0, pa1, pa2, pa3); SBAR(); pv_tile<1>(o, vb0, pa0, pa1, pa2, pa3); }
    SBAR(); SEAM_K0();
    if (hi == 0) li_l[r32] = l_reg; asm volatile("s_waitcnt lgkmcnt(0)" ::: "memory");
    float rli[16];
#pragma unroll
    for (int r = 0; r < 16; ++r) rli[r] = __builtin_amdgcn_rcpf(li_l[crow(r, hi)]);
    char* Owb = (char*)(cur.O + (size_t)(wid * QBLK) * OSTR);
    int hi_e = hi, r32_e = r32; asm volatile("" : "+v"(hi_e), "+v"(r32_e));
    const unsigned lane_off = (unsigned)(4 * hi_e * OSTR + r32_e) * 2u;
#pragma unroll
    for (int r = 0; r < 16; ++r) { constexpr int dummy = 0; (void)dummy; const unsigned rowb = (unsigned)(((r & 3) + 8 * (r >> 2)) * OSTR * 2);
#pragma unroll
        for (int d0 = 0; d0 < 4; ++d0) { const float v = o[d0][r] * rli[r];
            const float vn = __shfl_xor(v, 1);
            if ((r32 & 1) == 0) *(unsigned*)(Owb + rowb + d0 * 64 + lane_off) = cvtpk(v, vn); } }
    __syncthreads();
#undef RESC
#undef KBASE
#undef SEAM_K0
#undef HALF_STEP
#undef MLOAD
}
#undef VMW
#undef VMWN
#undef SLOAD_H
#undef SWRITE_HK
#undef SWRITE_HV
#undef SWRITE_H
#undef KSWZ
#undef SBAR
}

constexpr int NWAVES = 8;
#ifndef MK_PER_PHASE
#define MK_PER_PHASE 0
#endif
constexpr int N_PHASES = 13;

constexpr int DM = 2048, SEQ = 8192, NBATCH = 2, NMETA = 16, DFF = 5632;
constexpr int R = NBATCH * SEQ;
constexpr int RP = 16640;
constexpr int TKV = 8256;
constexpr int NPROJ = 7424;
constexpr int NGU = 2 * DFF;
constexpr float EPS = 1e-6f;

constexpr size_t MiB = 1u << 20;
constexpr size_t WS_CTL = 0, CTL_ZERO_BYTES = 1 * MiB;
constexpr size_t WS_AB = 1 * MiB;
constexpr size_t WS_WB = 66 * MiB;
constexpr size_t WS_WGU = WS_WB, WS_WD = WS_WB + 44 * MiB, WS_WIN = WS_WB, WS_WOUT = WS_WB + 29 * MiB, WS_MASK = WS_WB + 40 * MiB;
constexpr size_t WS_SMALL = 132 * MiB;
constexpr size_t WS_RSTD1 = WS_SMALL, WS_RSTD2 = WS_SMALL + 128 * 1024, WS_RSTD3 = WS_SMALL + 256 * 1024, WS_DEC = WS_SMALL + 384 * 1024;
constexpr size_t WS_ACT = 133 * MiB;
constexpr size_t WS_F = 312 * MiB;
constexpr size_t WS_MIXA = 133 * MiB;
constexpr size_t WS_QH = 197 * MiB;
constexpr size_t WS_KH = 229 * MiB, WS_VH = 262 * MiB;
constexpr size_t WS_IQ = 295 * MiB;
constexpr size_t WS_GQ = 327 * MiB, WS_GK = 344 * MiB;
constexpr size_t WS_GV = 361 * MiB;
constexpr size_t WS_GO = 394 * MiB;
constexpr size_t WS_IK = 426 * MiB;
constexpr size_t WS_IW = 429 * MiB;
constexpr size_t WS_GLOW = 430 * MiB;
constexpr size_t WS_ST = 432 * MiB;
constexpr size_t WS_END = 496 * MiB;
constexpr int CW_BAR = 4096;

constexpr int SCR_BYTES = 147456;
constexpr int MISC_OFF = SCR_BYTES;
constexpr int LDS_BYTES = SCR_BYTES + 2048;

#define GAS __attribute__((address_space(1)))
#define LAS __attribute__((address_space(3)))
typedef unsigned short bf16;
typedef unsigned v4u __attribute__((ext_vector_type(4)));
typedef unsigned v2u __attribute__((ext_vector_type(2)));
typedef float f32x4 __attribute__((ext_vector_type(4)));
typedef float f32x16 __attribute__((ext_vector_type(16)));
typedef short bf16x8 __attribute__((ext_vector_type(8)));
typedef unsigned long long u64;
typedef GAS unsigned gu32;
#define RLX_AGENT __ATOMIC_RELAXED, __HIP_MEMORY_SCOPE_AGENT
#define LDS_WAIT() asm volatile("s_waitcnt lgkmcnt(0)" ::: "memory")
#define VM_WAIT() asm volatile("s_waitcnt vmcnt(0)" ::: "memory")
__device__ __forceinline__ unsigned f2bf(float f) { unsigned u = __builtin_bit_cast(unsigned, f); return (u + 0x7fffu + ((u >> 16) & 1u)) >> 16; }
__device__ __forceinline__ unsigned pk2(float lo, float hi) { return f2bf(lo) | (f2bf(hi) << 16); }
__device__ __forceinline__ float bf2f(unsigned short b) { return __builtin_bit_cast(float, (unsigned)b << 16); }
__device__ __forceinline__ float bflo(unsigned w) { return __builtin_bit_cast(float, w << 16); }
__device__ __forceinline__ float bfhi(unsigned w) { return __builtin_bit_cast(float, w & 0xffff0000u); }
#define XB_TMO      128
#define XB_XCNT(j)  (256  + 64 * (j))
#define XB_XSUB(j)  (1280 + 64 * (j))
#define XB_XGEN(j)  (2304 + 64 * (j))
#define XB_TOP      3328
#define XB_TOPGEN   3392
#define XCD_BAR_WORDS 3456
#define XB_SPIN_CAP (1u << 22)

__device__ __forceinline__ unsigned xb_ld(unsigned* p)              { return __hip_atomic_load(p, __ATOMIC_RELAXED, __HIP_MEMORY_SCOPE_AGENT); }
__device__ __forceinline__ unsigned xb_add(unsigned* p, unsigned v) { return __hip_atomic_fetch_add(p, v, __ATOMIC_RELAXED, __HIP_MEMORY_SCOPE_AGENT); }
__device__ __forceinline__ unsigned xb_xcc_id() { return (unsigned)__builtin_amdgcn_s_getreg((3 << 11) | 20) & 0xFu; }
#define XB_SPIN(cond, bar) do { unsigned _sp = 0; while (cond) { __builtin_amdgcn_s_sleep(1); \
    if ((++_sp & 255u) == 0u) { if (xb_ld(&(bar)[XB_TMO])) break; if (_sp > XB_SPIN_CAP) { atomicAdd(&(bar)[XB_TMO], 1u); break; } } } } while (0)

struct XcdBarrier {
    unsigned* bar; unsigned x;
    volatile LAS unsigned* st;
};

__device__ __forceinline__ XcdBarrier xcd_barrier_post(unsigned* bar, volatile LAS unsigned* st) {
    XcdBarrier b; b.bar = bar; b.x = xb_xcc_id(); b.st = st;
    if (threadIdx.x == 0) (void)xb_add(&bar[XB_XCNT(b.x)], 1u);
    return b;
}
__device__ __forceinline__ void xcd_barrier_complete(unsigned* bar, unsigned x, unsigned& nloc, unsigned& nx) {
    const unsigned G = gridDim.x * gridDim.y * gridDim.z;
    unsigned sum, cnt, mine, sp = 0u;
    for (;;) {
        sum = 0u; cnt = 0u; mine = 0u;
#pragma unroll
        for (unsigned j = 0; j < 16; ++j) { const unsigned c = xb_ld(&bar[XB_XCNT(j)]); sum += c; cnt += (c > 0u) ? 1u : 0u; mine = (j == x) ? c : mine; }
        if (sum == G) break;
        __builtin_amdgcn_s_sleep(1);
        if ((++sp & 255u) == 0u) { if (xb_ld(&bar[XB_TMO])) break; if (sp > XB_SPIN_CAP) { atomicAdd(&bar[XB_TMO], 1u); break; } }
    }
    nloc = mine > 0u ? mine : 1u; nx = cnt > 0u ? cnt : 1u;
}

__device__ __forceinline__ void xcd_barrier(const XcdBarrier& b) {
    asm volatile("s_waitcnt vmcnt(0)" ::: "memory");
    __syncthreads();
    if (threadIdx.x == 0) {
        unsigned* bar = b.bar;
        __builtin_amdgcn_s_waitcnt(0);
        unsigned nloc = b.st[0], nx = b.st[1];
        if (nloc == 0u) { xcd_barrier_complete(bar, b.x, nloc, nx); b.st[0] = nloc; b.st[1] = nx; }
        const unsigned old = xb_add(&bar[XB_XSUB(b.x)], 1u);
        const unsigned gen = old / nloc;
        if (old + 1u == (gen + 1u) * nloc) {
            __builtin_amdgcn_fence(__ATOMIC_RELEASE, "agent");
            asm volatile("s_waitcnt vmcnt(0)" ::: "memory");
            const unsigned og = xb_add(&bar[XB_TOP], 1u);
            const unsigned tg = og / nx;
            if (og + 1u == (tg + 1u) * nx) xb_add(&bar[XB_TOPGEN], 1u);
            else XB_SPIN(xb_ld(&bar[XB_TOPGEN]) == tg, bar);
            __builtin_amdgcn_fence(__ATOMIC_ACQUIRE, "agent");
            xb_add(&bar[XB_XGEN(b.x)], 1u);
            asm volatile("s_waitcnt vmcnt(0)" ::: "memory");
        } else {
            XB_SPIN(xb_ld(&bar[XB_XGEN(b.x)]) == gen, bar);
            __builtin_amdgcn_fence(__ATOMIC_ACQUIRE, "agent");
            asm volatile("s_waitcnt vmcnt(0)" ::: "memory");
        }
    }
    __syncthreads();
}

struct Frame {
    LAS unsigned char* lds;
    unsigned char* ldsg;
    volatile LAS unsigned* MISC;
    unsigned* ctl;
    int tid, lane, wave, vcu, G;
    float* out; unsigned char* ws;
};
enum { I_X = 0, I_META, I_G1PRE, I_W1G, I_W1U, I_W1D, I_G1POST, I_GMIX, I_WIN, I_WGATE, I_BGATE, I_GGLA, I_WOUT, I_GMIXPOST, I_G2PRE, I_W2G, I_W2U, I_W2D, I_G2POST };
#ifndef PROBE_K
#define PROBE_K (-1)
#endif
#ifndef PROBE_BLOCK
#define PROBE_BLOCK 37
#endif
#ifndef PROBE_AMP
#define PROBE_AMP 4
#endif
#define TIC(k) do { if (PROBE_K == (k) && blockIdx.x == PROBE_BLOCK && threadIdx.x == 0) { const unsigned long long t_ = __builtin_amdgcn_s_memrealtime(); F.MISC[20] = (unsigned)t_; F.MISC[21] = (unsigned)(t_ >> 32); } } while (0)
#define TOC(k) do { if (PROBE_K == (k) && blockIdx.x == PROBE_BLOCK && threadIdx.x == 0) { const unsigned long long t0_ = ((unsigned long long)F.MISC[21] << 32) | F.MISC[20]; \
        const unsigned long long a_ = (((unsigned long long)F.MISC[23] << 32) | F.MISC[22]) + (__builtin_amdgcn_s_memrealtime() - t0_); F.MISC[22] = (unsigned)a_; F.MISC[23] = (unsigned)(a_ >> 32); } } while (0)
#define TICC(k) do { if (PROBE_K == (k) && blockIdx.x == PROBE_BLOCK && threadIdx.x == 0) { const unsigned long long t_ = __builtin_amdgcn_s_memtime(); F.MISC[20] = (unsigned)t_; F.MISC[21] = (unsigned)(t_ >> 32); } } while (0)
#define TOCC(k) do { if (PROBE_K == (k) && blockIdx.x == PROBE_BLOCK && threadIdx.x == 0) { const unsigned long long t0_ = ((unsigned long long)F.MISC[21] << 32) | F.MISC[20]; \
        const unsigned long long a_ = (((unsigned long long)F.MISC[23] << 32) | F.MISC[22]) + (__builtin_amdgcn_s_memtime() - t0_) / 20ull; F.MISC[22] = (unsigned)a_; F.MISC[23] = (unsigned)(a_ >> 32); } } while (0)
#define PROBE_SPIN() do { if (PROBE_K >= 0 && blockIdx.x == PROBE_BLOCK && threadIdx.x == 0) { const unsigned long long a_ = (((unsigned long long)F.MISC[23] << 32) | F.MISC[22]) * PROBE_AMP; \
        const unsigned long long s_ = __builtin_amdgcn_s_memrealtime(); while (__builtin_amdgcn_s_memrealtime() - s_ < a_) __builtin_amdgcn_s_sleep(8); } } while (0)

__device__ __forceinline__ float wave_sum(float v) {
#pragma unroll
    for (int o = 1; o < 64; o <<= 1) v += __shfl_xor(v, o);
    return v;
}
__device__ __forceinline__ unsigned wave_sum_u(unsigned v) {
    v += (unsigned)__builtin_amdgcn_update_dpp(0, (int)v, 0xB1, 0xf, 0xf, false);
    v += (unsigned)__builtin_amdgcn_update_dpp(0, (int)v, 0x4E, 0xf, 0xf, false);
    v += (unsigned)__builtin_amdgcn_update_dpp(0, (int)v, 0x141, 0xf, 0xf, false);
    v += (unsigned)__builtin_amdgcn_update_dpp(0, (int)v, 0x140, 0xf, 0xf, false);
    return (unsigned)__builtin_amdgcn_readlane((int)v, 0) + (unsigned)__builtin_amdgcn_readlane((int)v, 16) + (unsigned)__builtin_amdgcn_readlane((int)v, 32) + (unsigned)__builtin_amdgcn_readlane((int)v, 48);
}

template <int KR>
__device__ __forceinline__ void tr_item(const float* W, int N, int K, bf16* WT, int drow0, int scol, const float* gain, LAS float* scr, int k0, int lane) {
#pragma unroll 8
    for (int i = 0; i < KR / 2; ++i) { const int kk = 2 * i + (lane >> 5); float v = 0.f;
        if (scol >= 0) v = W[(size_t)(k0 + kk) * N + scol];
        if (gain) v *= gain[k0 + kk];
        scr[kk * 33 + (lane & 31)] = v; }
    LDS_WAIT(); asm volatile("" ::: "memory");
    if (KR == 64) {
        const int c = lane & 7;
#pragma unroll
        for (int j = 0; j < 4; ++j) { const int n = (lane >> 3) + 8 * j; const LAS float* s = scr + (8 * c) * 33 + n;
            v4u o; o.x = pk2(s[0 * 33], s[1 * 33]); o.y = pk2(s[2 * 33], s[3 * 33]); o.z = pk2(s[4 * 33], s[5 * 33]); o.w = pk2(s[6 * 33], s[7 * 33]);
            *(GAS v4u*)(WT + (size_t)(drow0 + n) * K + k0 + 8 * c) = o; }
    } else {
        const int c = lane & 1, n = lane >> 1; const LAS float* s = scr + (8 * c) * 33 + n;
        v4u o; o.x = pk2(s[0 * 33], s[1 * 33]); o.y = pk2(s[2 * 33], s[3 * 33]); o.z = pk2(s[4 * 33], s[5 * 33]); o.w = pk2(s[6 * 33], s[7 * 33]);
        *(GAS v4u*)(WT + (size_t)(drow0 + n) * K + k0 + 8 * c) = o;
    }
    LDS_WAIT(); asm volatile("" ::: "memory");
}
template <int KR>
__device__ __forceinline__ void ffn_item(Frame& F, int it, int ksub, const float* Wg, const float* Wu, const float* Wd, const float* gain, bf16* WGU, bf16* WD, LAS float* scr) {
    constexpr int I_GU = (NGU / 32) * (DM / 64);
    if (it < I_GU) { const int g = it % (NGU / 32), kb = it / (NGU / 32), tile = g >> 3, w = g & 7;
        tr_item<KR>(w < 4 ? Wg : Wu, DFF, DM, WGU, g * 32, tile * 128 + (w & 3) * 32 + (F.lane & 31), gain, scr, kb * 64 + ksub * 16, F.lane); }
    else { const int r = it - I_GU, g = r % (DM / 32), kb = r / (DM / 32);
        tr_item<KR>(Wd, DM, DFF, WD, g * 32, g * 32 + (F.lane & 31), nullptr, scr, kb * 64 + ksub * 16, F.lane); }
}
__device__ __forceinline__ void convert_ffn(Frame& F, const float* Wg, const float* Wu, const float* Wd, const float* gain, bf16* WGU, bf16* WD) {
    LAS float* scr = (LAS float*)(F.lds + F.wave * 16384);
    const int gw = F.vcu * NWAVES + F.wave, NGW = F.G * NWAVES;
    constexpr int NIT = (NGU / 32) * (DM / 64) + (DM / 32) * (DFF / 64);
    const int nmain = (NIT / NGW) * NGW;
    for (int it = gw; it < nmain; it += NGW) ffn_item<64>(F, it, 0, Wg, Wu, Wd, gain, WGU, WD, scr);
    for (int q = gw; q < 4 * (NIT - nmain); q += NGW) ffn_item<16>(F, nmain + (q >> 2), q & 3, Wg, Wu, Wd, gain, WGU, WD, scr);
}
__device__ __forceinline__ int win_src_col(int j) {
    const int t = j >> 8, c = j & 255;
    if (t < 16) return j;
    if (t < 18) return 4176 + (j - 4096);
    if (t < 20) return 4688 + (j - 4608);
    if (t < 24) return 5200 + (j - 5120);
    if (t < 28) return 6240 + (j - 6144);
    if (c < 64) return 4096 + c;
    if (c < 80) return 4160 + (c - 64);
    if (c < 96) return 6224 + (c - 80);
    return -1;
}
template <int KR>
__device__ __forceinline__ void mix_item(Frame& F, int it, int ksub, const float* Win, const float* Wout, const float* gain, bf16* WIN, bf16* WOUT, LAS float* scr) {
    constexpr int I_IN = (NPROJ / 32) * (DM / 64);
    if (it < I_IN) { const int g = it % (NPROJ / 32), kb = it / (NPROJ / 32);
        tr_item<KR>(Win, 7264, DM, WIN, g * 32, win_src_col(g * 32 + (F.lane & 31)), gain, scr, kb * 64 + ksub * 16, F.lane); }
    else { const int r = it - I_IN, g = r % (DM / 32), kb = r / (DM / 32);
        tr_item<KR>(Wout, DM, DM, WOUT, g * 32, g * 32 + (F.lane & 31), nullptr, scr, kb * 64 + ksub * 16, F.lane); }
}
__device__ __forceinline__ void convert_mix(Frame& F, const float* Win, const float* Wout, const float* gain, bf16* WIN, bf16* WOUT) {
    LAS float* scr = (LAS float*)(F.lds + F.wave * 16384);
    const int gw = F.vcu * NWAVES + F.wave, NGW = F.G * NWAVES;
    constexpr int NIT = (NPROJ / 32) * (DM / 64) + (DM / 32) * (DM / 64);
    const int nmain = (NIT / NGW) * NGW;
    for (int it = gw; it < nmain; it += NGW) mix_item<64>(F, it, 0, Win, Wout, gain, WIN, WOUT, scr);
    for (int q = gw; q < 4 * (NIT - nmain); q += NGW) mix_item<16>(F, nmain + (q >> 2), q & 3, Win, Wout, gain, WIN, WOUT, scr);
}

__device__ __forceinline__ void p0_rows(Frame& F, const float* X, const float* META) {
    const int gw = F.vcu * NWAVES + F.wave, NGW = F.G * NWAVES;
    bf16* AB = (bf16*)(F.ws + WS_AB); float* rstd = (float*)(F.ws + WS_RSTD1);
    for (int row = gw; row < RP; row += NGW) {
        GAS v2u* o = (GAS v2u*)(AB + (size_t)row * DM) + F.lane;
        if (row < R + NMETA) {
            const float* xr = row < R ? X + (size_t)row * DM : META + (size_t)(row - R) * DM;
            const GAS f32x4* xp = (const GAS f32x4*)xr + F.lane;
            f32x4 v[8]; float ss = 0.f;
#pragma unroll
            for (int j = 0; j < 8; ++j) { v[j] = xp[64 * j]; ss += (v[j].x * v[j].x + v[j].y * v[j].y) + (v[j].z * v[j].z + v[j].w * v[j].w); }
            ss = wave_sum(ss);
#pragma unroll
            for (int j = 0; j < 8; ++j) o[64 * j] = (v2u){pk2(v[j].x, v[j].y), pk2(v[j].z, v[j].w)};
            if (F.lane == 0) rstd[row] = 1.0f / sqrtf(ss * (1.0f / DM) + EPS);
        } else {
#pragma unroll
            for (int j = 0; j < 8; ++j) o[64 * j] = (v2u){0u, 0u};
            if (F.lane == 0) rstd[row] = 0.f;
        }
    }
}
template <int MODE>
__device__ __forceinline__ void norm_rows(Frame& F, const float* g, float* rstd_out, const float* X, const float* META) {
    const int gw = F.vcu * NWAVES + F.wave, NGW = F.G * NWAVES;
    bf16* AB = (bf16*)(F.ws + WS_AB); const bf16* FB = (const bf16*)(F.ws + WS_F);
    const int nrows = (MODE == 0) ? RP : R;
    f32x4 gv[8];
#pragma unroll
    for (int j = 0; j < 8; ++j) gv[j] = ((const GAS f32x4*)g)[64 * j + F.lane];
    for (int row = gw; row < nrows; row += NGW) {
        if (MODE == 0 && row >= R + NMETA) { if (F.lane == 0) rstd_out[row] = 0.f; continue; }
        const GAS v2u* fp = (const GAS v2u*)(FB + (size_t)row * DM) + F.lane;
        GAS v2u* ab = (GAS v2u*)(AB + (size_t)row * DM) + F.lane;
        f32x4 f[8], h[8]; float ss = 0.f;
#pragma unroll
        for (int j = 0; j < 8; ++j) { const v2u w = fp[64 * j]; f[j] = (f32x4){bflo(w.x), bfhi(w.x), bflo(w.y), bfhi(w.y)};
            ss += (f[j].x * f[j].x + f[j].y * f[j].y) + (f[j].z * f[j].z + f[j].w * f[j].w); }
        {
#pragma unroll
            for (int j = 0; j < 8; ++j) { const v2u w = ab[64 * j]; h[j] = (f32x4){bflo(w.x), bfhi(w.x), bflo(w.y), bfhi(w.y)}; }
        }
        ss = wave_sum(ss);
        const float rf = (MODE == 1 ? 1.0f : 0.5f) / sqrtf(ss * (1.0f / DM) + EPS);
        float s2 = 0.f;
#pragma unroll
        for (int j = 0; j < 8; ++j) { h[j] = h[j] + f[j] * gv[j] * rf; s2 += (h[j].x * h[j].x + h[j].y * h[j].y) + (h[j].z * h[j].z + h[j].w * h[j].w); }
        if (MODE == 2) {
            GAS f32x4* op = (GAS f32x4*)(F.out + (size_t)row * DM) + F.lane;
#pragma unroll
            for (int j = 0; j < 8; ++j) op[64 * j] = h[j];
        } else {
            s2 = wave_sum(s2);
#pragma unroll
            for (int j = 0; j < 8; ++j) ab[64 * j] = (v2u){pk2(h[j].x, h[j].y), pk2(h[j].z, h[j].w)};
            if (F.lane == 0) rstd_out[row] = 1.0f / sqrtf(s2 * (1.0f / DM) + EPS);
        }
    }
}

__device__ __forceinline__ void zero_pads(Frame& F) {
    const int gt = F.vcu * (NWAVES * 64) + F.tid, NG = F.G * NWAVES * 64;
    bf16* Kh = (bf16*)(F.ws + WS_KH); bf16* Vh = (bf16*)(F.ws + WS_VH); bf16* IK = (bf16*)(F.ws + WS_IK);
    const v4u z = {0u, 0u, 0u, 0u};
    for (int i = gt; i < 2 * 16 * 768 + 2 * 384; i += NG) {
        if (i < 2 * 16 * 768) { const int which = i / (16 * 768), r = i % (16 * 768), bh = r / 768, o = r % 768;
            *(GAS v4u*)((which ? Vh : Kh) + ((size_t)bh * TKV + 8208) * 128 + o * 8) = z; }
        else { const int r = i - 2 * 16 * 768, b = r / 384, o = r % 384, pos = 8208 + (o >> 3), ch = o & 7;
               *(GAS v4u*)(IK + (size_t)b * TKV * 64 + (size_t)(pos >> 5) * 2048 + (ch >> 1) * 512 + (ch & 1) * 256 + (pos & 31) * 8) = z; }
    }
}

__device__ __forceinline__ unsigned row_or16(unsigned v) {
    v |= (unsigned)__builtin_amdgcn_update_dpp(0, (int)v, 0xB1, 0xf, 0xf, false);
    v |= (unsigned)__builtin_amdgcn_update_dpp(0, (int)v, 0x4E, 0xf, 0xf, false);
    v |= (unsigned)__builtin_amdgcn_update_dpp(0, (int)v, 0x141, 0xf, 0xf, false);
    v |= (unsigned)__builtin_amdgcn_update_dpp(0, (int)v, 0x140, 0xf, 0xf, false);
    return v;
}
#ifndef P5_REP_SCORE
#define P5_REP_SCORE 1
#endif
#ifndef P5_REP_SEL
#define P5_REP_SEL 1
#endif
#ifndef P5_REP_MMA
#define P5_REP_MMA 1
#endif
#ifndef P5_REP_SCV
#define P5_REP_SCV 1
#endif
#ifndef P5_REP_BIS
#define P5_REP_BIS 1
#endif
#ifndef P5_REP_EMIT
#define P5_REP_EMIT 1
#endif
__device__ __forceinline__ void p5_item(Frame& F, int b, int t) {
    const int lane = F.lane, wid = F.wave, r32 = lane & 31, hi = lane >> 5;
    const GAS bf16* IQ = (const GAS bf16*)(F.ws + WS_IQ); const GAS bf16* IK = (const GAS bf16*)(F.ws + WS_IK); const GAS float* IW = (const GAS float*)(F.ws + WS_IW);
    GAS u64* MASK = (GAS u64*)(F.ws + WS_MASK);
    LAS unsigned short* S16 = (LAS unsigned short*)F.lds;
    constexpr int SROWD = 129 * 33, SROWH = 2 * SROWD;
    const int s0 = 8 * t, qb = s0 >> 8, nwords = 4 * qb + 5;
    const int kmax = 16 + s0 + 7, nkt = (kmax >> 5) + 1;
    TIC(0); TIC(1);
    {
        bf16x8 Af[4][4];
        LAS float* WL = (LAS float*)(F.lds + 8 * SROWH * 2);
        if (F.tid < 128) WL[F.tid] = 0.5f * IW[((size_t)(b * SEQ + s0)) * 16 + F.tid];
        LAS bf16* QL = (LAS bf16*)(F.lds + 8 * SROWH * 2 + 512);
        { const int q = F.tid >> 6, dd = F.tid & 63; const GAS bf16* qrow = IQ + ((size_t)(b * SEQ + s0 + q)) * 1024 + dd; const GAS float* wrow = IW + ((size_t)(b * SEQ + s0 + q)) * 16;
          float s = 0.f;
#pragma unroll
          for (int hh = 0; hh < 16; ++hh) s = fmaf(0.5f * wrow[hh], bf2f(qrow[hh * 64]), s);
          QL[q * 64 + dd] = (bf16)f2bf(s); }
        {
            const int qo = (r32 >> 2) & 1, h = (r32 & 3) + 4 * (r32 >> 3);
#pragma unroll
            for (int rb = 0; rb < 4; ++rb) {
                const GAS bf16* qp = IQ + ((size_t)(b * SEQ + s0 + 2 * rb + qo)) * 1024 + h * 64 + 8 * hi;
#pragma unroll
                for (int ks = 0; ks < 4; ++ks) Af[rb][ks] = *(const GAS bf16x8*)(qp + ks * 16);
            }
        }
        __syncthreads();
        float wv[4][16];
#pragma unroll
        for (int rb = 0; rb < 4; ++rb) { const LAS f32x4* wl = (const LAS f32x4*)(WL + hi * 16 + 32 * rb);
#pragma unroll
            for (int r4 = 0; r4 < 4; ++r4) { const f32x4 w4 = wl[r4]; wv[rb][4 * r4] = w4.x; wv[rb][4 * r4 + 1] = w4.y; wv[rb][4 * r4 + 2] = w4.z; wv[rb][4 * r4 + 3] = w4.w; } }
        bf16x8 Al[4];
#pragma unroll
        for (int ks = 0; ks < 4; ++ks) { bf16x8 z = {0, 0, 0, 0, 0, 0, 0, 0};
            if (r32 < 8) z = *(const LAS bf16x8*)(QL + (r32 < 4 ? 2 * r32 : 2 * (r32 - 4) + 1) * 64 + ks * 16 + 8 * hi);
            Al[ks] = z; }
        TOC(1); TIC(2);
        const GAS char* kbase = (const GAS char*)(IK + (size_t)b * TKV * 64);
        const unsigned koff = (unsigned)(lane * 16);
        bf16x8 Bn[4];
        for (int rep_ = 0; rep_ < P5_REP_SCORE; ++rep_) {
        if (wid < nkt) {
#pragma unroll
            for (int ks = 0; ks < 4; ++ks) Bn[ks] = *(const GAS bf16x8*)(kbase + (koff + (unsigned)(wid * 4096 + ks * 1024)));
        }
        for (int kt = wid; kt < nkt; kt += 8) {
            bf16x8 Bf[4];
#pragma unroll
            for (int ks = 0; ks < 4; ++ks) Bf[ks] = Bn[ks];
            if (kt + 8 < nkt) {
#pragma unroll
                for (int ks = 0; ks < 4; ++ks) Bn[ks] = *(const GAS bf16x8*)(kbase + (koff + (unsigned)((kt + 8) * 4096 + ks * 1024)));
            }
            const int key = kt * 32 + r32;
            f32x16 acc[4], accl;
#pragma unroll
            for (int m_ = 0; m_ < P5_REP_MMA; ++m_) {
#pragma unroll
            for (int rb = 0; rb < 4; ++rb) acc[rb] = (f32x16){};
            accl = (f32x16){};
#pragma unroll
            for (int ks = 0; ks < 4; ++ks) {
#pragma unroll
                for (int rb = 0; rb < 4; ++rb) acc[rb] = __builtin_amdgcn_mfma_f32_32x32x16_bf16(Af[rb][ks], Bf[ks], acc[rb], 0, 0, 0);
                accl = __builtin_amdgcn_mfma_f32_32x32x16_bf16(Al[ks], Bf[ks], accl, 0, 0, 0); }
            if (m_ + 1 < P5_REP_MMA) asm volatile("" : "+v"(acc[0]), "+v"(acc[1]), "+v"(acc[2]), "+v"(acc[3]));
            }
#pragma unroll
            for (int v_ = 0; v_ < P5_REP_SCV; ++v_)
#pragma unroll
            for (int rb = 0; rb < 4; ++rb) {
                if (P5_REP_SCV > 1) asm volatile("" : "+v"(acc[rb]));
                float sc = accl[rb];
#pragma unroll
                for (int r = 0; r < 16; ++r) { const float a_ = acc[rb][r]; sc = fmaf(__builtin_fabsf(a_), wv[rb][r], sc); }
                sc = fminf(fmaxf(sc, -60000.f), 60000.f);
                const _Float16 hf = (_Float16)sc;
                const unsigned hb = (unsigned)__builtin_bit_cast(unsigned short, hf);
                unsigned sk = (hb & 0x8000u) ? (~hb & 0xffffu) : (hb | 0x8000u);
                sk = (sk >> 1) | 0x8000u;
                if (key > 16 + s0 + 2 * rb + hi) sk = 0x81ffu;
                S16[(2 * rb + hi) * SROWH + (key >> 6) * 66 + (key & 63)] = (unsigned short)sk;
            }
        }
        }
    }
    TOC(2); TIC(3);
    {
        LAS unsigned* row = (LAS unsigned*)(S16 + wid * SROWH);
        for (int k2 = nkt * 16 + lane; k2 < 4128; k2 += 64) row[(k2 >> 5) * 33 + (k2 & 31)] = 0x81ff81ffu;
    }
    asm volatile("s_waitcnt lgkmcnt(0)" ::: "memory"); __builtin_amdgcn_s_barrier(); asm volatile("" ::: "memory");
    TOC(3); TIC(4);
    {
        const LAS unsigned* srow = (const LAS unsigned*)(S16 + wid * SROWH);
        const bool second = nwords > 64, last = nwords > 128;
        unsigned d[64];
#pragma unroll
        for (int i = 0; i < 32; ++i) d[i] = srow[lane * 33 + i];
#pragma unroll
        for (int i = 0; i < 32; ++i) { const unsigned x = srow[(lane + 64) * 33 + i]; d[32 + i] = second ? x : 0x81ff81ffu; }
        unsigned d128 = 0x81ff81ffu;
        if (last) d128 = 0x81ff0000u | (unsigned)(S16 + wid * SROWH)[128 * 66 + lane];
#define CNT_GE(cnt_, c15) do { const unsigned C_ = (unsigned)(c15) * 0x10001u; \
            _Pragma("unroll") for (int i = 0; i < 32; ++i) cnt_ += (unsigned)__builtin_popcount((d[i] - C_) & 0x80008000u); \
            if (second) { _Pragma("unroll") for (int i = 32; i < 64; ++i) cnt_ += (unsigned)__builtin_popcount((d[i] - C_) & 0x80008000u); \
                cnt_ += (unsigned)__builtin_popcount((d128 - C_) & 0x80008000u); } } while (0)
        unsigned thr = 0u;
        for (int bit = 14; bit >= 0; --bit) {
            const unsigned cand = thr | (1u << bit); unsigned c = 0u;
            CNT_GE(c, cand);
            if (wave_sum_u(c) >= 256u) thr = cand;
        }
        TOC(4); TIC(5);
        if (thr < 0x0200u) thr = 0x0200u;
        unsigned cg = 0u, ce = 0u;
        CNT_GE(cg, thr + 1u); CNT_GE(ce, thr);
        const unsigned cgt = wave_sum_u(cg), cge = wave_sum_u(ce);
#undef CNT_GE
        const int need = 256 - (int)cgt;
        GAS unsigned* mrow = (GAS unsigned*)(MASK + ((size_t)(b * SEQ + s0 + wid)) * 130);
        if (cge <= 256u) {
            const unsigned T_ = thr * 0x10001u;
#pragma unroll
            for (int tt = 0; tt < 2; ++tt) {
                if (tt == 0 || second) {
                    unsigned w0 = 0u, w1 = 0u;
#pragma unroll
                    for (int i = 0; i < 32; ++i) {
                        const unsigned sw = d[32 * tt + i] - T_;
                        const unsigned b2 = ((sw >> 15) & 1u) | ((sw >> 30) & 2u);
                        constexpr int dummy_ = 0; (void)dummy_;
                        const int pos = 16 * (i >> 4) + 2 * (i & 1) + 4 * ((i & 15) >> 2);
                        if (((i & 15) >> 1) & 1) w1 |= b2 << pos; else w0 |= b2 << pos;
                    }
                    *(GAS v2u*)(mrow + 2 * (64 * tt + lane)) = (v2u){w0, w1};
                }
            }
            if (last) {
                const u64 w = __ballot((((d128 - T_) >> 15) & 1u) != 0u);
                const unsigned vl = (unsigned)w, vh = (unsigned)(w >> 32), ul = vl >> 4, uh = vh >> 4;
                const unsigned a0 = (vl & 0xFu) | ((vl >> 4) & 0xF0u) | ((vl >> 8) & 0xF00u) | ((vl >> 12) & 0xF000u), a1 = (ul & 0xFu) | ((ul >> 4) & 0xF0u) | ((ul >> 8) & 0xF00u) | ((ul >> 12) & 0xF000u);
                const unsigned b0 = (vh & 0xFu) | ((vh >> 4) & 0xF0u) | ((vh >> 8) & 0xF00u) | ((vh >> 12) & 0xF000u), b1 = (uh & 0xFu) | ((uh >> 4) & 0xF0u) | ((uh >> 8) & 0xF00u) | ((uh >> 12) & 0xF000u);
                if (lane == 0) { mrow[256] = a0 | (b0 << 16); mrow[257] = a1 | (b1 << 16); }
            }
        } else {
            const unsigned T_ = thr * 0x10001u, T1_ = (thr + 1u) * 0x10001u;
            unsigned e1 = 0u, e2 = 0u;
#pragma unroll
            for (int i = 0; i < 32; ++i) e1 += (unsigned)__builtin_popcount((d[i] - T_) & 0x80008000u) - (unsigned)__builtin_popcount((d[i] - T1_) & 0x80008000u);
#pragma unroll
            for (int i = 32; i < 64; ++i) e2 += (unsigned)__builtin_popcount((d[i] - T_) & 0x80008000u) - (unsigned)__builtin_popcount((d[i] - T1_) & 0x80008000u);
            int base1 = 0, base2 = 0, tot1 = 0, tot2 = 0;
#pragma unroll
            for (int bt = 0; bt < 7; ++bt) {
                const u64 m1 = __ballot(((e1 >> bt) & 1u) != 0u), m2 = __ballot(((e2 >> bt) & 1u) != 0u);
                base1 += (int)__builtin_amdgcn_mbcnt_hi((unsigned)(m1 >> 32), __builtin_amdgcn_mbcnt_lo((unsigned)m1, 0u)) << bt; tot1 += __popcll(m1) << bt;
                base2 += (int)__builtin_amdgcn_mbcnt_hi((unsigned)(m2 >> 32), __builtin_amdgcn_mbcnt_lo((unsigned)m2, 0u)) << bt; tot2 += __popcll(m2) << bt;
            }
#pragma unroll
            for (int tt = 0; tt < 2; ++tt) {
                if (tt == 0 || second) {
                    int quota = need - (tt == 0 ? base1 : tot1 + base2);
                    unsigned w0 = 0u, w1 = 0u;
#pragma unroll
                    for (int i = 0; i < 32; ++i) {
                        const unsigned sw = d[32 * tt + i] - T_, sg = d[32 * tt + i] - T1_;
                        const unsigned ge_lo = (sw >> 15) & 1u, ge_hi = (sw >> 31) & 1u, gt_lo = (sg >> 15) & 1u, gt_hi = (sg >> 31) & 1u;
                        const unsigned eq_lo = ge_lo ^ gt_lo, eq_hi = ge_hi ^ gt_hi;
                        const unsigned s_lo = gt_lo | (eq_lo & (quota > 0 ? 1u : 0u)); quota -= (int)eq_lo;
                        const unsigned s_hi = gt_hi | (eq_hi & (quota > 0 ? 1u : 0u)); quota -= (int)eq_hi;
                        const unsigned b2 = s_lo | (s_hi << 1);
                        const int pos = 16 * (i >> 4) + 2 * (i & 1) + 4 * ((i & 15) >> 2);
                        if (((i & 15) >> 1) & 1) w1 |= b2 << pos; else w0 |= b2 << pos;
                    }
                    *(GAS v2u*)(mrow + 2 * (64 * tt + lane)) = (v2u){w0, w1};
                }
            }
            if (last) {
                const unsigned k128 = d128 & 0x7fffu;
                const u64 em = __ballot(k128 == thr);
                const int rank = tot1 + tot2 + (int)__builtin_amdgcn_mbcnt_hi((unsigned)(em >> 32), __builtin_amdgcn_mbcnt_lo((unsigned)em, 0u));
                const u64 w = __ballot(k128 > thr || (k128 == thr && rank < need));
                const unsigned vl = (unsigned)w, vh = (unsigned)(w >> 32), ul = vl >> 4, uh = vh >> 4;
                const unsigned a0 = (vl & 0xFu) | ((vl >> 4) & 0xF0u) | ((vl >> 8) & 0xF00u) | ((vl >> 12) & 0xF000u), a1 = (ul & 0xFu) | ((ul >> 4) & 0xF0u) | ((ul >> 8) & 0xF00u) | ((ul >> 12) & 0xF000u);
                const unsigned b0 = (vh & 0xFu) | ((vh >> 4) & 0xF0u) | ((vh >> 8) & 0xF00u) | ((vh >> 12) & 0xF000u), b1 = (uh & 0xFu) | ((uh >> 4) & 0xF0u) | ((uh >> 8) & 0xF00u) | ((uh >> 12) & 0xF000u);
                if (lane == 0) { mrow[256] = a0 | (b0 << 16); mrow[257] = a1 | (b1 << 16); }
            }
        }
    }
    asm volatile("s_waitcnt lgkmcnt(0)" ::: "memory"); __builtin_amdgcn_s_barrier(); asm volatile("" ::: "memory");
    TOC(5); TOC(0);
}

typedef short s16x4g __attribute__((ext_vector_type(4)));
template <int KSTEPS>
__device__ __forceinline__ void mma_ll(f32x16& acc, const LAS bf16* A, int sa, const LAS bf16* B, int sb, int r32, int hi) {
#pragma unroll
    for (int ks = 0; ks < KSTEPS; ++ks) {
        const bf16x8 a = *(const LAS bf16x8*)(A + r32 * sa + ks * 16 + 8 * hi), bb = *(const LAS bf16x8*)(B + r32 * sb + ks * 16 + 8 * hi);
        acc = __builtin_amdgcn_mfma_f32_32x32x16_bf16(a, bb, acc, 0, 0, 0);
    }
}
__device__ __forceinline__ bf16x8 tr_frag(unsigned base, int pb, int lane) {
    const unsigned a0 = base + (unsigned)((8 * (lane >> 5) + ((lane >> 2) & 3)) * pb + (16 * ((lane >> 4) & 1) + 4 * (lane & 3)) * 2), a1 = a0 + 4u * (unsigned)pb;
    s16x4g lo, hh;
    asm volatile("ds_read_b64_tr_b16 %0, %2\n\tds_read_b64_tr_b16 %1, %3\n\ts_waitcnt lgkmcnt(0)" : "=&v"(lo), "=&v"(hh) : "v"(a0), "v"(a1) : "memory");
    return (bf16x8){lo[0], lo[1], lo[2], lo[3], hh[0], hh[1], hh[2], hh[3]};
}
__device__ __forceinline__ float log_sigmoid_f(float z) { return fminf(z, 0.f) - __logf(1.0f + __expf(-fabsf(z))); }
__device__ __forceinline__ void gla_bcum(Frame& F, LAS float* BC, LAS float* GT, LAS float* GLs, int b, int h, int n, const float* Wg, const float* bg) {
    const GAS float* GLOW = (const GAS float*)(F.ws + WS_GLOW);
    const int k = F.tid & 127, ig = __builtin_amdgcn_readfirstlane(F.tid >> 7);
    if (F.tid < 256) { const int i = F.tid >> 2, pc = F.tid & 3; f32x4 v = {0.f, 0.f, 0.f, 0.f};
        if (!(n == 0 && i < 48)) v = *(const GAS f32x4*)(GLOW + ((size_t)b * TKV + 64 * n + i) * 16 + 4 * pc);
        *(LAS f32x4*)(GLs + i * 16 + 4 * pc) = v; }
    float wc[16];
#pragma unroll
    for (int r = 0; r < 16; ++r) wc[r] = Wg[r * 512 + h * 128 + k];
    const float bk = bg[h * 128 + k];
    __syncthreads();
    float run = 0.f, pre[16];
#pragma unroll
    for (int ii = 0; ii < 16; ++ii) {
        const int i = 16 * ig + ii; float lg = 0.f;
        if (!(n == 0 && i < 48)) {
            const LAS f32x4* gl = (const LAS f32x4*)(GLs + i * 16); float z = bk;
#pragma unroll
            for (int r4 = 0; r4 < 4; ++r4) { const f32x4 g4 = gl[r4];
                z = fmaf(g4.x, wc[4 * r4 + 0], z); z = fmaf(g4.y, wc[4 * r4 + 1], z); z = fmaf(g4.z, wc[4 * r4 + 2], z); z = fmaf(g4.w, wc[4 * r4 + 3], z); }
            lg = log_sigmoid_f(z) * (1.0f / 16.0f);
        }
        run += lg; pre[ii] = run;
    }
    GT[ig * 128 + k] = run;
    __syncthreads();
    float off = 0.f;
#pragma unroll
    for (int gq = 0; gq < 3; ++gq) off += (gq < ig) ? GT[gq * 128 + k] : 0.f;
#pragma unroll
    for (int ii = 0; ii < 16; ++ii) BC[(16 * ig + ii) * 128 + k] = pre[ii] + off;
    __syncthreads();
}
constexpr int GLA_VP = 288, GLA_KP1 = 160;
__device__ __forceinline__ void gla_load_vn(Frame& F, LAS bf16* Vn, int b, int h, int n) {
    const GAS bf16* GV = (const GAS bf16*)(F.ws + WS_GV);
    const int v0 = 8 * (F.tid & 31);
#pragma unroll
    for (int pass = 0; pass < 4; ++pass) {
        const int i = (F.tid >> 5) + 16 * pass, pp = 64 * n + i;
        v4u raw = {0u, 0u, 0u, 0u};
        if (!(n == 0 && i < 48)) raw = *(const GAS v4u*)(GV + ((size_t)b * TKV + pp) * 1024 + h * 256 + v0);
        *(LAS v4u*)(Vn + i * GLA_VP + v0) = raw;
    }
}
__device__ __forceinline__ void g1_unit(Frame& F, int b, int h, int n, const float* Wg, const float* bg) {
    const int lane = F.lane, wid = F.wave, r32 = lane & 31, hi = lane >> 5, tid = F.tid;
    LAS float* BC = (LAS float*)F.lds; LAS float* GLs = (LAS float*)(F.lds + 32768); LAS bf16* KD = (LAS bf16*)(F.lds + 36864); LAS bf16* Vn = (LAS bf16*)(F.lds + 57344);
    const GAS bf16* GK = (const GAS bf16*)(F.ws + WS_GK); GAS bf16* ST = (GAS bf16*)(F.ws + WS_ST); GAS float* DEC = (GAS float*)(F.ws + WS_DEC);
    TIC(10); gla_bcum(F, BC, (LAS float*)(F.lds + 131072), GLs, b, h, n, Wg, bg); TOC(10); TIC(11);
    { const int k0 = 8 * (tid & 15);
#pragma unroll
      for (int pass = 0; pass < 2; ++pass) {
        const int i = (tid >> 4) + 32 * pass, pp = 64 * n + i;
        v4u raw = {0u, 0u, 0u, 0u};
        if (!(n == 0 && i < 48)) raw = *(const GAS v4u*)(GK + ((size_t)b * TKV + pp) * 512 + h * 128 + k0);
        const unsigned rw[4] = {raw.x, raw.y, raw.z, raw.w}; float kd[8];
        const f32x4 bc0 = *(const LAS f32x4*)(BC + i * 128 + k0), bc1 = *(const LAS f32x4*)(BC + i * 128 + k0 + 4), bl0 = *(const LAS f32x4*)(BC + 63 * 128 + k0), bl1 = *(const LAS f32x4*)(BC + 63 * 128 + k0 + 4);
        const float bcv[8] = {bc0.x, bc0.y, bc0.z, bc0.w, bc1.x, bc1.y, bc1.z, bc1.w}, blv[8] = {bl0.x, bl0.y, bl0.z, bl0.w, bl1.x, bl1.y, bl1.z, bl1.w};
#pragma unroll
        for (int j = 0; j < 8; ++j) { const float kv = (j & 1) ? bfhi(rw[j >> 1]) : bflo(rw[j >> 1]); kd[j] = kv * __expf(blv[j] - bcv[j]); }
        *(LAS v4u*)(KD + i * GLA_KP1 + k0) = (v4u){pk2(kd[0], kd[1]), pk2(kd[2], kd[3]), pk2(kd[4], kd[5]), pk2(kd[6], kd[7])};
      } }
    gla_load_vn(F, Vn, b, h, n);
    __syncthreads();
    TOC(11); TIC(12);
    GAS bf16* dst = ST + ((size_t)((b * 4 + h) * 128 + n) * 256) * 128;
    const float declast = (tid < 128) ? __expf(BC[63 * 128 + tid]) : 0.f;
    f32x16 acc[4];
    {
        const unsigned vb = (unsigned)(uintptr_t)Vn + (unsigned)(32 * wid * 2), kb = (unsigned)(uintptr_t)KD;
        bf16x8 af[4];
#pragma unroll
        for (int ks = 0; ks < 4; ++ks) af[ks] = tr_frag(vb + (unsigned)(16 * ks * GLA_VP * 2), GLA_VP * 2, lane);
#pragma unroll
        for (int cb = 0; cb < 4; ++cb) { acc[cb] = (f32x16){};
#pragma unroll
            for (int ks = 0; ks < 4; ++ks) acc[cb] = __builtin_amdgcn_mfma_f32_32x32x16_bf16(af[ks], tr_frag(kb + (unsigned)(16 * ks * GLA_KP1 * 2 + 32 * cb * 2), GLA_KP1 * 2, lane), acc[cb], 0, 0, 0); }
    }
    __syncthreads();
    {   LAS bf16* LT = (LAS bf16*)F.lds;
#pragma unroll
        for (int cb = 0; cb < 4; ++cb)
#pragma unroll
            for (int r = 0; r < 16; ++r) LT[(32 * wid + (r & 3) + 8 * (r >> 2) + 4 * hi) * 128 + 32 * cb + r32] = (bf16)f2bf(acc[cb][r]);
        __syncthreads();
        const LAS v4u* src = (const LAS v4u*)F.lds; GAS v4u* d4 = (GAS v4u*)dst;
#pragma unroll
        for (int q = 0; q < 8; ++q) d4[q * 512 + tid] = src[q * 512 + tid];
    }
    if (tid < 128) DEC[(size_t)((b * 4 + h) * 128 + n) * 128 + tid] = declast;
    __syncthreads();
    TOC(12);
}
__device__ __forceinline__ void g2_scan(Frame& F) {
    GAS bf16* ST = (GAS bf16*)(F.ws + WS_ST); const GAS float* DEC = (const GAS float*)(F.ws + WS_DEC);
    const int NG = F.G * NWAVES * 64;
    for (int e = F.vcu * (NWAVES * 64) + F.tid; e < 8 * 16384; e += NG) {
        const int bh = e >> 14, rem = e & 16383, v = rem >> 6, k = (rem & 63) * 2;
        GAS unsigned* p = (GAS unsigned*)(ST + ((size_t)bh * 128 * 256 + v) * 128 + k);
        const GAS float* d = DEC + (size_t)bh * 128 * 128 + k;
        float s0 = 0.f, s1 = 0.f;
        for (int n = 0; n < 128; n += 8) {
            unsigned w[8]; float d0[8], d1[8];
#pragma unroll
            for (int u = 0; u < 8; ++u) { w[u] = p[(size_t)(n + u) * 16384]; d0[u] = d[(n + u) * 128]; d1[u] = d[(n + u) * 128 + 1]; }
#pragma unroll
            for (int u = 0; u < 8; ++u) { s0 = fmaf(s0, d0[u], bflo(w[u])); s1 = fmaf(s1, d1[u], bfhi(w[u])); p[(size_t)(n + u) * 16384] = pk2(s0, s1); }
        }
    }
}
__device__ __forceinline__ void g3_unit(Frame& F, int b, int h, int c, const float* Wg, const float* bg, const float* ggla) {
    const int lane = F.lane, wid = F.wave, r32 = lane & 31, hi = lane >> 5, tid = F.tid;
    LAS float* BC = (LAS float*)F.lds; LAS bf16* Q1 = (LAS bf16*)(F.lds + 32768); LAS bf16* Q2 = (LAS bf16*)(F.lds + 50176); LAS bf16* KD = (LAS bf16*)(F.lds + 67584);
    LAS bf16* Vn = (LAS bf16*)(F.lds + 84992); LAS bf16* AT = (LAS bf16*)(F.lds + 121856); LAS float* OS = (LAS float*)F.lds; LAS float* GLs = (LAS float*)(F.lds + 133120);
    const GAS bf16* GQ = (const GAS bf16*)(F.ws + WS_GQ); const GAS bf16* GK = (const GAS bf16*)(F.ws + WS_GK); const GAS bf16* GO = (const GAS bf16*)(F.ws + WS_GO);
    const GAS bf16* ST = (const GAS bf16*)(F.ws + WS_ST); GAS bf16* MIXA = (GAS bf16*)(F.ws + WS_MIXA);
    const int rbI = wid & 1, cbV = (wid >> 1) * 2;
    bf16x8 sf[8][2];
    { const GAS bf16* sp = ST + ((size_t)((b * 4 + h) * 128 + (c - 1)) * 256) * 128;
#pragma unroll
      for (int ks = 0; ks < 8; ++ks)
#pragma unroll
        for (int t = 0; t < 2; ++t) sf[ks][t] = *(const GAS bf16x8*)(sp + (size_t)(32 * (cbV + t) + r32) * 128 + ks * 16 + 8 * hi); }
    TIC(13); gla_bcum(F, BC, (LAS float*)(F.lds + 131072), GLs, b, h, c, Wg, bg); TOC(13); TIC(14);
    { const int k0 = 8 * (tid & 15);
#pragma unroll
      for (int pass = 0; pass < 2; ++pass) {
        const int i = (tid >> 4) + 32 * pass, pp = 64 * c + i;
        const v4u rq = *(const GAS v4u*)(GQ + ((size_t)b * TKV + pp) * 512 + h * 128 + k0);
        const v4u rk = *(const GAS v4u*)(GK + ((size_t)b * TKV + pp) * 512 + h * 128 + k0);
        const unsigned qw[4] = {rq.x, rq.y, rq.z, rq.w}, kw[4] = {rk.x, rk.y, rk.z, rk.w};
        const f32x4 bc0 = *(const LAS f32x4*)(BC + i * 128 + k0), bc1 = *(const LAS f32x4*)(BC + i * 128 + k0 + 4), bl0 = *(const LAS f32x4*)(BC + 63 * 128 + k0), bl1 = *(const LAS f32x4*)(BC + 63 * 128 + k0 + 4);
        const float bcv[8] = {bc0.x, bc0.y, bc0.z, bc0.w, bc1.x, bc1.y, bc1.z, bc1.w}, blv[8] = {bl0.x, bl0.y, bl0.z, bl0.w, bl1.x, bl1.y, bl1.z, bl1.w};
        float q1[8], q2[8], kd[8];
#pragma unroll
        for (int j = 0; j < 8; ++j) { const float qv = (j & 1) ? bfhi(qw[j >> 1]) : bflo(qw[j >> 1]), kv = (j & 1) ? bfhi(kw[j >> 1]) : bflo(kw[j >> 1]);
            const float e1 = __expf(bcv[j] - blv[j]);
            q1[j] = qv * __expf(bcv[j]); q2[j] = qv * e1; kd[j] = kv * __builtin_amdgcn_rcpf(e1); }
        *(LAS v4u*)(Q1 + i * 136 + k0) = (v4u){pk2(q1[0], q1[1]), pk2(q1[2], q1[3]), pk2(q1[4], q1[5]), pk2(q1[6], q1[7])};
        *(LAS v4u*)(Q2 + i * 136 + k0) = (v4u){pk2(q2[0], q2[1]), pk2(q2[2], q2[3]), pk2(q2[4], q2[5]), pk2(q2[6], q2[7])};
        *(LAS v4u*)(KD + i * 136 + k0) = (v4u){pk2(kd[0], kd[1]), pk2(kd[2], kd[3]), pk2(kd[4], kd[5]), pk2(kd[6], kd[7])};
      } }
    gla_load_vn(F, Vn, b, h, c);
    __syncthreads();
    TOC(14); TIC(15);
    f32x16 acc[2] = {};
#pragma unroll
    for (int ks = 0; ks < 8; ++ks) {
        const bf16x8 a = *(const LAS bf16x8*)(Q1 + (32 * rbI + r32) * 136 + ks * 16 + 8 * hi);
#pragma unroll
        for (int t = 0; t < 2; ++t) acc[t] = __builtin_amdgcn_mfma_f32_32x32x16_bf16(a, sf[ks][t], acc[t], 0, 0, 0);
    }
    if (wid < 4) {
        const int ib = wid & 1, jb = wid >> 1;
        f32x16 at = {};
        mma_ll<8>(at, Q2 + (32 * ib) * 136, 136, KD + (32 * jb) * 136, 136, r32, hi);
#pragma unroll
        for (int r = 0; r < 16; ++r) { const int i = 32 * ib + (r & 3) + 8 * (r >> 2) + 4 * hi, j = 32 * jb + r32;
            AT[i * 72 + j] = (bf16)f2bf(j <= i ? at[r] : 0.f); }
    }
    __syncthreads();
    TOC(15); TIC(16);
    {
        const unsigned vb = (unsigned)(uintptr_t)Vn;
#pragma unroll
        for (int ks = 0; ks < 4; ++ks) {
            const bf16x8 a = *(const LAS bf16x8*)(AT + (32 * rbI + r32) * 72 + ks * 16 + 8 * hi);
#pragma unroll
            for (int t = 0; t < 2; ++t) acc[t] = __builtin_amdgcn_mfma_f32_32x32x16_bf16(a, tr_frag(vb + (unsigned)(16 * ks * GLA_VP * 2 + 32 * (cbV + t) * 2), GLA_VP * 2, lane), acc[t], 0, 0, 0);
        }
    }
    __syncthreads();
#pragma unroll
    for (int t = 0; t < 2; ++t)
#pragma unroll
        for (int r = 0; r < 16; ++r) OS[(32 * rbI + (r & 3) + 8 * (r >> 2) + 4 * hi) * 260 + 32 * (cbV + t) + r32] = acc[t][r];
    __syncthreads();
    {
        const int i = tid >> 3, seg = tid & 7; const LAS float* orow = OS + i * 260 + 32 * seg;
        float ss = 0.f; f32x4 ov[8];
#pragma unroll
        for (int q = 0; q < 8; ++q) { ov[q] = *(const LAS f32x4*)(orow + 4 * q); ss += (ov[q].x * ov[q].x + ov[q].y * ov[q].y) + (ov[q].z * ov[q].z + ov[q].w * ov[q].w); }
        ss += __shfl_xor(ss, 1); ss += __shfl_xor(ss, 2); ss += __shfl_xor(ss, 4);
        const float rs = 1.0f / sqrtf(ss * (1.0f / 256.0f) + EPS);
        const size_t row = (size_t)b * SEQ + 64 * (c - 1) + i;
        const float* gn = ggla + 32 * seg;
        const GAS bf16* gp = GO + row * 1024 + h * 256 + 32 * seg;
        GAS bf16* op = MIXA + row * 2048 + 1024 + h * 256 + 32 * seg;
#pragma unroll
        for (int q2 = 0; q2 < 4; ++q2) {
            const v4u gw = *(const GAS v4u*)(gp + 8 * q2);
            const f32x4 g0 = *(const f32x4*)(gn + 8 * q2), g1 = *(const f32x4*)(gn + 8 * q2 + 4);
            const f32x4 a = ov[2 * q2], bq = ov[2 * q2 + 1];
            float y[8];
            y[0] = a.x * rs * g0.x * pg8::silu_f(bflo(gw.x)); y[1] = a.y * rs * g0.y * pg8::silu_f(bfhi(gw.x));
            y[2] = a.z * rs * g0.z * pg8::silu_f(bflo(gw.y)); y[3] = a.w * rs * g0.w * pg8::silu_f(bfhi(gw.y));
            y[4] = bq.x * rs * g1.x * pg8::silu_f(bflo(gw.z)); y[5] = bq.y * rs * g1.y * pg8::silu_f(bfhi(gw.z));
            y[6] = bq.z * rs * g1.z * pg8::silu_f(bflo(gw.w)); y[7] = bq.w * rs * g1.w * pg8::silu_f(bfhi(gw.w));
            *(GAS v4u*)(op + 8 * q2) = (v4u){pk2(y[0], y[1]), pk2(y[2], y[3]), pk2(y[4], y[5]), pk2(y[6], y[7])};
        }
    }
    __syncthreads();
    TOC(16);
}
__device__ __forceinline__ att::BlockRef att_ref(Frame& F, int bh, int qb) {
    const int b = bh >> 3, h = bh & 7; att::BlockRef r;
    r.Q = (const bf16*)(F.ws + WS_QH) + ((size_t)bh * SEQ + (size_t)qb * 256) * 128;
    r.K = (const bf16*)(F.ws + WS_KH) + (size_t)bh * TKV * 128; r.V = (const bf16*)(F.ws + WS_VH) + (size_t)bh * TKV * 128;
    r.O = (bf16*)(F.ws + WS_MIXA) + ((size_t)b * SEQ + (size_t)qb * 256) * 2048 + h * 128;
    r.M = (const u64*)(F.ws + WS_MASK) + ((size_t)b * SEQ + (size_t)qb * 256) * 130;
    r.NT = 4 * qb + 5;
    return r;
}
__device__ __forceinline__ void p7_attention(Frame& F) {
    constexpr int total = 256;
    int L = F.vcu; if (L >= total) return;
    int pass = 0;
    att::BlockRef cur = att_ref(F, L >> 4, L & 15);
    att::Seam S;
    att::att_prime(cur, (char*)F.ldsg, S);
    for (;;) {
        const bool more_pass = pass == 0, more_item = L + F.G < total, last = !more_pass && !more_item;
        int passn = pass + 1, Ln = L;
        if (!more_pass) { passn = 0; Ln = more_item ? L + F.G : L; }
        const att::BlockRef nxt = last ? cur : att_ref(F, Ln >> 4, passn ? 31 - (Ln & 15) : (Ln & 15));
        att::att_block(cur, nxt, (char*)F.ldsg, S);
        if (last) break;
        cur = nxt; pass = passn; L = Ln;
    }
}
typedef float f32x4s __attribute__((ext_vector_type(4)));
template <int KSTEPS>
__device__ __forceinline__ f32x4s skinny_k(const GAS bf16* a, const GAS bf16* b) {
    f32x4s acc = {0.f, 0.f, 0.f, 0.f};
#pragma unroll
    for (int ks = 0; ks < KSTEPS; ++ks) acc = __builtin_amdgcn_mfma_f32_16x16x32_bf16(*(const GAS bf16x8*)(a + 32 * ks), *(const GAS bf16x8*)(b + 32 * ks), acc, 0, 0, 0);
    return acc;
}
__device__ __forceinline__ f32x4s wg_reduce(Frame& F, LAS f32x4s* red, f32x4s v) {
    red[F.wave * 64 + F.lane] = v;
    __syncthreads();
    f32x4s s = red[F.lane];
#pragma unroll
    for (int w = 1; w < NWAVES; ++w) s += red[w * 64 + F.lane];
    __syncthreads();
    return s;
}
__device__ __forceinline__ void meta_p1(Frame& F) {
    const int c = F.lane & 15, kq = F.lane >> 4; LAS f32x4s* red = (LAS f32x4s*)F.lds;
    const GAS bf16* AB = (const GAS bf16*)(F.ws + WS_AB); const GAS bf16* WGU = (const GAS bf16*)(F.ws + WS_WGU); GAS bf16* ACT = (GAS bf16*)(F.ws + WS_ACT);
    const GAS float* rstd = (const GAS float*)(F.ws + WS_RSTD1);
    for (int u = F.vcu; u < 352; u += F.G) {
        const int tile = u >> 3, j = u & 7, k0 = F.wave * (DM / 8);
        const GAS bf16* a = AB + (size_t)(R + c) * DM + k0 + 8 * kq;
        const GAS bf16* bg = WGU + (size_t)(tile * 256 + 16 * j + c) * DM + k0 + 8 * kq;
        const f32x4s ag = wg_reduce(F, red, skinny_k<DM / 256>(a, bg)), au = wg_reduce(F, red, skinny_k<DM / 256>(a, bg + (size_t)128 * DM));
        if (F.wave == 0) {
#pragma unroll
            for (int q = 0; q < 4; ++q) { const int m = 4 * kq + q; const float rs = rstd[R + m];
                ACT[(size_t)(R + m) * DFF + tile * 128 + 16 * j + c] = (bf16)f2bf(pg8::silu_f(ag[q] * rs) * (au[q] * rs)); }
        }
    }
}
__device__ __forceinline__ void meta_p2(Frame& F) {
    const int c = F.lane & 15, kq = F.lane >> 4; LAS f32x4s* red = (LAS f32x4s*)F.lds;
    const GAS bf16* ACT = (const GAS bf16*)(F.ws + WS_ACT); const GAS bf16* WD = (const GAS bf16*)(F.ws + WS_WD); GAS bf16* FB = (GAS bf16*)(F.ws + WS_F);
    for (int u = F.vcu; u < 128; u += F.G) {
        const int k0 = F.wave * (DFF / 8);
        const f32x4s acc = wg_reduce(F, red, skinny_k<DFF / 256>(ACT + (size_t)(R + c) * DFF + k0 + 8 * kq, WD + (size_t)(16 * u + c) * DFF + k0 + 8 * kq));
        if (F.wave == 0) {
#pragma unroll
            for (int q = 0; q < 4; ++q) FB[(size_t)(R + 4 * kq + q) * DM + 16 * u + c] = (bf16)f2bf(acc[q]);
        }
    }
}
__device__ __forceinline__ void meta_p4(Frame& F) {
    const int c = F.lane & 15, kq = F.lane >> 4; LAS f32x4s* red = (LAS f32x4s*)F.lds;
    const GAS bf16* AB = (const GAS bf16*)(F.ws + WS_AB); const GAS bf16* WIN = (const GAS bf16*)(F.ws + WS_WIN); const GAS float* rstd = (const GAS float*)(F.ws + WS_RSTD2);
    GAS bf16* Kh = (GAS bf16*)(F.ws + WS_KH); GAS bf16* Vh = (GAS bf16*)(F.ws + WS_VH); GAS bf16* GK = (GAS bf16*)(F.ws + WS_GK); GAS bf16* GV = (GAS bf16*)(F.ws + WS_GV);
    GAS bf16* IK = (GAS bf16*)(F.ws + WS_IK); GAS float* GLOW = (GAS float*)(F.ws + WS_GLOW);
    for (int u = F.vcu; u < 230; u += F.G) {
        int sec, cs;
        if (u < 64) { sec = 0; cs = u * 16; } else if (u < 128) { sec = 1; cs = (u - 64) * 16; } else if (u < 160) { sec = 2; cs = (u - 128) * 16; } else if (u < 224) { sec = 3; cs = (u - 160) * 16; } else { sec = 4; cs = (u - 224) * 16; }
        const int wrow = (sec == 0 ? 4 * 256 : sec == 1 ? 8 * 256 : sec == 2 ? 18 * 256 : sec == 3 ? 20 * 256 : 7168) + cs, k0 = F.wave * (DM / 8);
        const f32x4s acc = wg_reduce(F, red, skinny_k<DM / 256>(AB + (size_t)(R + c) * DM + k0 + 8 * kq, WIN + (size_t)(wrow + c) * DM + k0 + 8 * kq));
        if (F.wave == 0) {
            const int col = cs + c;
#pragma unroll
            for (int q = 0; q < 4; ++q) { const int m = 4 * kq + q; const float vf = acc[q] * rstd[R + m]; const bf16 v = (bf16)f2bf(vf);
                if (sec == 4) {
                    if (col < 64) { const int ch = col >> 3, fo = (ch >> 1) * 512 + (ch & 1) * 256 + (col & 7); IK[fo + m * 8] = v; IK[(size_t)TKV * 64 + fo + m * 8] = v; }
                    else if (col >= 80) { GLOW[((size_t)48 + m) * 16 + (col - 80)] = vf; GLOW[((size_t)TKV + 48 + m) * 16 + (col - 80)] = vf; }
                } else if (sec < 2) { GAS bf16* base = sec == 0 ? Kh : Vh; const int h = col >> 7, d = col & 127;
                    base[((size_t)h * TKV + m) * 128 + d] = v; base[((size_t)(8 + h) * TKV + m) * 128 + d] = v; }
                else if (sec == 2) { GK[((size_t)48 + m) * 512 + col] = v; GK[((size_t)TKV + 48 + m) * 512 + col] = v; }
                else { GV[((size_t)48 + m) * 1024 + col] = v; GV[((size_t)TKV + 48 + m) * 1024 + col] = v; }
            }
        }
    }
}
__device__ __forceinline__ void small_cols(Frame& F) {
    const int c = F.lane & 15, kq = F.lane >> 4, rg = F.wave & 3, ch3 = (F.wave >> 2) * 3;
    const GAS bf16* AB = (const GAS bf16*)(F.ws + WS_AB); const GAS bf16* WIN = (const GAS bf16*)(F.ws + WS_WIN); const GAS float* rstd = (const GAS float*)(F.ws + WS_RSTD2);
    GAS bf16* IK = (GAS bf16*)(F.ws + WS_IK); GAS float* IW = (GAS float*)(F.ws + WS_IW); GAS float* GLOW = (GAS float*)(F.ws + WS_GLOW);
    LAS bf16* Bs = (LAS bf16*)F.lds; constexpr int BP = 264;
    for (int u = F.vcu; u < 256; u += F.G) {
        const int r0 = 64 * u + 16 * rg;
        const GAS bf16* a = AB + (size_t)(r0 + c) * DM + 8 * kq;
        const GAS bf16* bsrc = WIN + (size_t)7168 * DM;
        f32x4s acc[3];
#pragma unroll
        for (int g = 0; g < 3; ++g) acc[g] = (f32x4s){0.f, 0.f, 0.f, 0.f};
        v4u breg[6]; bf16x8 an[8];
#pragma unroll
        for (int i = 0; i < 6; ++i) { const int p = F.tid + 512 * i; breg[i] = *(const GAS v4u*)(bsrc + (size_t)(p >> 5) * DM + (p & 31) * 8); }
#pragma unroll
        for (int ks = 0; ks < 8; ++ks) an[ks] = *(const GAS bf16x8*)(a + 32 * ks);
        for (int kc = 0; kc < 8; ++kc) {
#pragma unroll
            for (int i = 0; i < 6; ++i) { const int p = F.tid + 512 * i; *(LAS v4u*)(Bs + (p >> 5) * BP + (p & 31) * 8) = breg[i]; }
            bf16x8 ac[8];
#pragma unroll
            for (int ks = 0; ks < 8; ++ks) ac[ks] = an[ks];
            __syncthreads();
            if (kc + 1 < 8) {
#pragma unroll
                for (int i = 0; i < 6; ++i) { const int p = F.tid + 512 * i; breg[i] = *(const GAS v4u*)(bsrc + (size_t)(p >> 5) * DM + (kc + 1) * 256 + (p & 31) * 8); }
#pragma unroll
                for (int ks = 0; ks < 8; ++ks) an[ks] = *(const GAS bf16x8*)(a + (kc + 1) * 256 + 32 * ks);
            }
#pragma unroll
            for (int ks = 0; ks < 8; ++ks)
#pragma unroll
                for (int g = 0; g < 3; ++g) acc[g] = __builtin_amdgcn_mfma_f32_16x16x32_bf16(ac[ks], *(const LAS bf16x8*)(Bs + (16 * (ch3 + g) + c) * BP + 32 * ks + 8 * kq), acc[g], 0, 0, 0);
            __syncthreads();
        }
#pragma unroll
        for (int q = 0; q < 4; ++q) {
            const int row = r0 + 4 * kq + q; const float rs = rstd[row]; const int bb = row >> 13, s = row & 8191, pos = 16 + s;
#pragma unroll
            for (int g = 0; g < 3; ++g) {
                const float v = acc[g][q] * rs; const int col = 16 * (ch3 + g) + c;
                if (col < 64) {
                    const int ch = col >> 3, fo = (ch >> 1) * 512 + (ch & 1) * 256 + (col & 7);
                    IK[(size_t)bb * TKV * 64 + (size_t)(pos >> 5) * 2048 + fo + (pos & 31) * 8] = (bf16)f2bf(v);
                } else if (col < 80) IW[(size_t)row * 16 + (col - 64)] = v * 0.25f;
                else GLOW[((size_t)bb * TKV + 64 + s) * 16 + (col - 80)] = v;
            }
        }
    }
}

struct Args { const float* in[19]; float* out; unsigned char* ws; int ph_lo, ph_hi; };
#ifndef PG8_SP2
#define PG8_SP2 true
#endif
#ifndef PG8_ALIGN
#define PG8_ALIGN true
#endif
__global__ void __launch_bounds__(NWAVES * 64, 2) hymba_fwd(Args args) {
    extern __shared__ __attribute__((aligned(16))) unsigned char lds[];
    Frame F;
    F.lds = (LAS unsigned char*)lds; F.ldsg = lds;
    F.MISC = (volatile LAS unsigned*)(F.lds + MISC_OFF);
    F.tid = threadIdx.x; F.lane = F.tid & 63; F.wave = __builtin_amdgcn_readfirstlane(F.tid >> 6);
    F.G = gridDim.x; { const int bx = blockIdx.x; F.vcu = (F.G % 8 == 0) ? (bx % 8) * (F.G / 8) + bx / 8 : bx; }
    F.ws = args.ws; F.ctl = (unsigned*)(args.ws + WS_CTL); F.out = args.out;
    for (int u = F.tid; u < (LDS_BYTES - MISC_OFF) / 4; u += NWAVES * 64) ((LAS unsigned*)(F.lds + MISC_OFF))[u] = 0u;
    __syncthreads();
    XcdBarrier bar; bar.bar = F.ctl + CW_BAR; bar.x = 0; bar.st = nullptr;
    if (!MK_PER_PHASE) bar = xcd_barrier_post(F.ctl + CW_BAR, F.MISC + 8);
    const int lo = args.ph_lo, hi = args.ph_hi;
#define PHASE_BEGIN() do { int t_ = threadIdx.x; asm volatile("" : "+v"(t_)); F.tid = t_; F.lane = t_ & 63; F.wave = __builtin_amdgcn_readfirstlane(t_ >> 6); } while (0)
#ifndef PH_MASK
#define PH_MASK 0x1fff
#endif
#define IN(k) ((((PH_MASK) >> (k)) & 1) && lo <= (k) && (k) < hi)
#define SEAM(k) do { if (!MK_PER_PHASE && IN((k) + 1)) { TIC(30); TIC(40 + (k)); xcd_barrier(bar); TOC(40 + (k)); TOC(30); } } while (0)
#ifndef PH_DUP
#define PH_DUP 0
#endif
#define AB ((bf16*)(F.ws + WS_AB))
#define ACT ((bf16*)(F.ws + WS_ACT))
#define FB ((bf16*)(F.ws + WS_F))
#define WGU ((bf16*)(F.ws + WS_WGU))
#define WD ((bf16*)(F.ws + WS_WD))
#define WIN ((bf16*)(F.ws + WS_WIN))
#define WOUT ((bf16*)(F.ws + WS_WOUT))
#define rstd1 ((float*)(F.ws + WS_RSTD1))
#define rstd2 ((float*)(F.ws + WS_RSTD2))
#define rstd3 ((float*)(F.ws + WS_RSTD3))

    #define BODY0 do { convert_ffn(F, args.in[I_W1G], args.in[I_W1U], args.in[I_W1D], args.in[I_G1PRE], WGU, WD); p0_rows(F, args.in[I_X], args.in[I_META]); } while (0)
    if (IN(0)) { PHASE_BEGIN();
#if (PH_DUP >> 0) & 1
        BODY0; xcd_barrier(bar);
#endif
        BODY0; SEAM(0); }
    if (IN(1)) { PHASE_BEGIN();
        pg8::Gemm g{AB, WGU, R, NGU, DM}; pg8::StaticOrder S; S.init(R, NGU, F.G, (int)blockIdx.x);
        pg8::EpiSwiGLU E{ACT, DFF, rstd1};
#if (PH_DUP >> 1) & 1
        pg8::gemm_phase<pg8::EpiSwiGLU, pg8::StaticOrder, PG8_ALIGN, PG8_SP2>(F.lds, g, S, E); xcd_barrier(bar);
#endif
        TIC(60); TICC(61); pg8::gemm_phase<pg8::EpiSwiGLU, pg8::StaticOrder, PG8_ALIGN, PG8_SP2>(F.lds, g, S, E); TOCC(61); TOC(60);
        TIC(6); meta_p1(F); TOC(6);
        SEAM(1);
    }
    if (IN(2)) { PHASE_BEGIN();
        pg8::Gemm g{ACT, WD, R, DM, DFF}; pg8::StaticOrder S; S.init(R, DM, F.G, (int)blockIdx.x);
        pg8::EpiStoreBf16 E{FB, DM};
        pg8::gemm_phase<pg8::EpiStoreBf16, pg8::StaticOrder, PG8_ALIGN, PG8_SP2>(F.lds, g, S, E);
        TIC(7); meta_p2(F); TOC(7);
        SEAM(2);
    }
    #define BODY3 do { norm_rows<0>(F, args.in[I_G1POST], rstd2, args.in[I_X], args.in[I_META]); convert_mix(F, args.in[I_WIN], args.in[I_WOUT], args.in[I_GMIX], WIN, WOUT); } while (0)
    if (IN(3)) { PHASE_BEGIN();
#if (PH_DUP >> 3) & 1
        BODY3; xcd_barrier(bar);
#endif
        BODY3; SEAM(3); }
    if (IN(4)) { PHASE_BEGIN();
        zero_pads(F);
        pg8::Gemm g{AB, WIN, R, 7168, DM}; pg8::StaticOrder S; S.init(R, 7168, F.G, (int)blockIdx.x);
        pg8::EpiProj E{F.ws, WS_RSTD2, WS_QH, WS_KH, WS_VH, WS_IQ, WS_GQ, WS_GK, WS_GV, WS_GO, WS_IK, WS_IW, WS_GLOW};
        pg8::gemm_phase<pg8::EpiProj, pg8::StaticOrder, PG8_ALIGN, PG8_SP2>(F.lds, g, S, E);
        TIC(8); meta_p4(F); TOC(8); TIC(9); small_cols(F); TOC(9);
        SEAM(4);
    }
#define BODY5A do { for (int v = F.vcu; v < 256; v += F.G) \
            for (int bq = 0; bq < 8; ++bq) { const int b = bq >> 2, q = bq & 3; const int t = q == 0 ? v : (q == 1 ? 511 - v : (q == 2 ? 512 + v : 1023 - v)); p5_item(F, b, t); } } while (0)
#define BODY5B do { PHASE_BEGIN(); for (int u = F.vcu; u < 1024; u += F.G) g1_unit(F, u >> 9, (u >> 7) & 3, u & 127, args.in[I_WGATE], args.in[I_BGATE]); } while (0)
    if (IN(5)) { PHASE_BEGIN();
#if (PH_DUP >> 5) & 1
        BODY5A; xcd_barrier(bar);
#endif
#if (PH_DUP >> 13) & 1
        BODY5B; xcd_barrier(bar);
#endif
        BODY5A; BODY5B;
        SEAM(5);
    }
    if (IN(6)) { PHASE_BEGIN(); TIC(17); g2_scan(F); TOC(17); SEAM(6); }
#define BODY7A do { TIC(18); p7_attention(F); TOC(18); } while (0)
#define BODY7B do { PHASE_BEGIN(); for (int u = F.vcu; u < 1024; u += F.G) g3_unit(F, u >> 9, (u >> 7) & 3, (u & 127) + 1, args.in[I_WGATE], args.in[I_BGATE], args.in[I_GGLA]); } while (0)
    if (IN(7)) { PHASE_BEGIN();
#if (PH_DUP >> 7) & 1
        BODY7A; xcd_barrier(bar);
#endif
#if (PH_DUP >> 14) & 1
        BODY7B; xcd_barrier(bar);
#endif
#ifndef SKIP_ATT
        BODY7A;
#endif
#ifndef SKIP_G3
        BODY7B;
#endif
        SEAM(7);
    }
    if (IN(8)) { PHASE_BEGIN();
        pg8::Gemm g{(const bf16*)(F.ws + WS_MIXA), WOUT, R, DM, DM}; pg8::StaticOrder S; S.init(R, DM, F.G, (int)blockIdx.x);
        pg8::EpiStoreBf16 E{FB, DM};
        pg8::gemm_phase<pg8::EpiStoreBf16, pg8::StaticOrder, PG8_ALIGN, PG8_SP2>(F.lds, g, S, E);
        SEAM(8);
    }
    if (IN(9)) { PHASE_BEGIN(); norm_rows<1>(F, args.in[I_GMIXPOST], rstd3, nullptr, nullptr); convert_ffn(F, args.in[I_W2G], args.in[I_W2U], args.in[I_W2D], args.in[I_G2PRE], WGU, WD); SEAM(9); }
    if (IN(10)) { PHASE_BEGIN();
        pg8::Gemm g{AB, WGU, R, NGU, DM}; pg8::StaticOrder S; S.init(R, NGU, F.G, (int)blockIdx.x);
        pg8::EpiSwiGLU E{ACT, DFF, rstd3};
        pg8::gemm_phase<pg8::EpiSwiGLU, pg8::StaticOrder, PG8_ALIGN, PG8_SP2>(F.lds, g, S, E);
        SEAM(10);
    }
    if (IN(11)) { PHASE_BEGIN();
        pg8::Gemm g{ACT, WD, R, DM, DFF}; pg8::StaticOrder S; S.init(R, DM, F.G, (int)blockIdx.x);
        pg8::EpiStoreBf16 E{FB, DM};
        pg8::gemm_phase<pg8::EpiStoreBf16, pg8::StaticOrder, PG8_ALIGN, PG8_SP2>(F.lds, g, S, E);
        SEAM(11);
    }
    if (IN(12)) { PHASE_BEGIN(); norm_rows<2>(F, args.in[I_G2POST], nullptr, nullptr, nullptr); PROBE_SPIN(); }
#undef IN
#undef SEAM
#undef AB
#undef ACT
#undef FB
#undef WGU
#undef WD
#undef WIN
#undef WOUT
#undef rstd1
#undef rstd2
#undef rstd3
}

extern "C" void kernel_launch(void* const* d_in, const int* in_sizes, int n_in, void* d_out, int out_size, void* d_ws, size_t ws_size, hipStream_t stream) {
    static int grid = 0;
    if (grid == 0) {
        if (n_in != 19 || in_sizes[0] != R * DM || out_size != R * DM || ws_size < WS_END) {
            fprintf(stderr, "kernel_launch: unexpected shapes (n_in %d, in0 %d, out %d, ws %zu; need ws >= %zu); nothing launched\n", n_in, n_in > 0 ? in_sizes[0] : -1, out_size, ws_size, (size_t)WS_END); grid = -1; return; }
        int dev = 0, cus = 0, per_cu = 0;
        if (hipGetDevice(&dev) != hipSuccess || hipDeviceGetAttribute(&cus, hipDeviceAttributeMultiprocessorCount, dev) != hipSuccess) { grid = -1; return; }
        if (hipFuncSetAttribute((const void*)hymba_fwd, hipFuncAttributeMaxDynamicSharedMemorySize, LDS_BYTES) != hipSuccess) { fprintf(stderr, "kernel_launch: hipFuncSetAttribute failed\n"); grid = -1; return; }
        if (hipOccupancyMaxActiveBlocksPerMultiprocessor(&per_cu, (const void*)hymba_fwd, NWAVES * 64, LDS_BYTES) != hipSuccess || per_cu < 1)
            fprintf(stderr, "kernel_launch: note: occupancy query reports %d workgroups per CU\n", per_cu);
        (void)hipGetLastError();
        grid = cus;
    }
    if (grid < 0) return;
    if (hipMemsetAsync((char*)d_ws + WS_CTL, 0, CTL_ZERO_BYTES, stream) != hipSuccess) return;
    Args a{};
    for (int i = 0; i < 19; ++i) a.in[i] = (const float*)d_in[i];
    a.out = (float*)d_out; a.ws = (unsigned char*)d_ws;
#if MK_PER_PHASE
    for (int p = 0; p < N_PHASES; ++p) { a.ph_lo = p; a.ph_hi = p + 1; hipLaunchKernelGGL(hymba_fwd, dim3(grid), dim3(NWAVES * 64), LDS_BYTES, stream, a); }
#else
    a.ph_lo = 0; a.ph_hi = N_PHASES;
    hipLaunchKernelGGL(hymba_fwd, dim3(grid), dim3(NWAVES * 64), LDS_BYTES, stream, a);
#endif
    const hipError_t le = hipPeekAtLastError();
    if (le != hipSuccess) fprintf(stderr, "kernel_launch: launch failed: %s\n", hipGetErrorName(le));
}
```

```cpp
#include <hip/hip_runtime.h>
#include <cstdio>
#include <cstdint>
#define MK_PER_PHASE 0
namespace pg8 {
#define PG8_LAS __attribute__((address_space(3)))
typedef unsigned short bf16_t;
typedef short bf16x8 __attribute__((ext_vector_type(8)));
typedef float f32x4 __attribute__((ext_vector_type(4)));
typedef unsigned u32x4 __attribute__((ext_vector_type(4)));
constexpr int BM = 256, BK = 64, HALF = 128, HTB = HALF * BK * 2  , STAGE_BYTES = 8 * HTB, NXCD = 8, WGM = 8;

__host__ __device__ __forceinline__ int lds_byte(int r, int c) { const int st = (r >> 4) * 2 + (c >> 5), rr = r & 15, cc = c & 31, ob = rr * 64 + cc * 2; return st * 1024 + (ob ^ (((ob >> 9) & 1) << 5)); }
__host__ __device__ __forceinline__ void stage_rc(int b, int& R, int& C) { const int st = b / 1024, sb = b % 1024, swz = sb ^ (((sb >> 9) & 1) << 5); R = (st >> 1) * 16 + swz / 64; C = (st & 1) * 32 + (swz % 64) / 2; }
__host__ __device__ __forceinline__ int perm32(int rho) { const int n = rho >> 4, i = rho & 15; return 8 * (i >> 2) + 4 * n + (i & 3); }

struct Unit { int pm, pn; };
struct Gemm { const bf16_t* A; const bf16_t* Bt; int M, N, K; };

struct StaticOrder {
    int nM, nN, nwg, G, c;
    __host__ __device__ void init(int M, int N, int G_, int c_) { nM = M / BM; nN = N / BM; nwg = nM * nN; G = G_; c = c_; }
    __host__ __device__ bool next(int i, Unit& u) const {
        const long L = (long)i * G + c; if (L >= nwg) return false;
        int wgid = (int)L; { const int q = nwg / NXCD, r = nwg % NXCD, xcd = wgid % NXCD, off = wgid / NXCD; wgid = (xcd < r ? xcd * (q + 1) : r * (q + 1) + (xcd - r) * q) + off; }
        const int nig = WGM * nN, gid = wgid / nig, fm = gid * WGM, gsz = (nM - fm) < WGM ? (nM - fm) : WGM;
        u.pm = fm + ((wgid % nig) % gsz); u.pn = (wgid % nig) / gsz; return true;
    }
    __device__ __forceinline__ void a_ready(const Unit&) const {}
    __device__ __forceinline__ void done(const Unit&) const {}
};

__device__ __forceinline__ unsigned cvt_pk_bf16(float lo, float hi) { unsigned r; asm volatile("v_cvt_pk_bf16_f32 %0, %1, %2" : "=v"(r) : "v"(lo), "v"(hi)); return r; }
typedef float f32x2 __attribute__((ext_vector_type(2)));

__device__ __forceinline__ void st8bf(bf16_t* p, const f32x4 v0, const f32x4 v1) {
    u32x4 w; w.x = cvt_pk_bf16(v0[0], v0[1]); w.y = cvt_pk_bf16(v0[2], v0[3]); w.z = cvt_pk_bf16(v1[0], v1[1]); w.w = cvt_pk_bf16(v1[2], v1[3]);
    *(u32x4*)p = w;
}
__device__ __forceinline__ float silu_f(float x) { return x * __builtin_amdgcn_rcpf(1.0f + __builtin_amdgcn_exp2f(-1.4426950408889634f * x)); }

struct EpiStoreBf16 {
    static constexpr bool PERM = true, AFTER_DRAIN = false;
    bf16_t* O; int ldc;
    __device__ __forceinline__ void operator()(const f32x4 (&acc)[2][2][4][2], const Unit& u, int wr, int wc, int fr, int fq) const {
        const int row0 = u.pm * BM + wr * 64 + fr, col0 = u.pn * BM + wc * 32 + 8 * fq;
#pragma unroll
        for (int ai = 0; ai < 2; ++ai)
#pragma unroll
            for (int m = 0; m < 4; ++m) { bf16_t* rowp = O + (size_t)(row0 + ai * HALF + m * 16) * ldc + col0;
#pragma unroll
                for (int bj = 0; bj < 2; ++bj) st8bf(rowp + bj * HALF, acc[ai][bj][m][0], acc[ai][bj][m][1]); }
    }
};
struct EpiSwiGLU {
    static constexpr bool PERM = true, AFTER_DRAIN = false;
    bf16_t* O; int ldc; const float* rstd; float osc;
    __device__ __forceinline__ void operator()(const f32x4 (&acc)[2][2][4][2], const Unit& u, int wr, int wc, int fr, int fq) const {
        const int row0 = u.pm * BM + wr * 64 + fr, col0 = u.pn * HALF + wc * 32 + 8 * fq;
#pragma unroll
        for (int ai = 0; ai < 2; ++ai)
#pragma unroll
            for (int m = 0; m < 4; ++m) { const int row = row0 + ai * HALF + m * 16; const float rs = rstd[row] * osc;
                f32x4 o0, o1;
#pragma unroll
                for (int j = 0; j < 4; ++j) { o0[j] = silu_f(acc[ai][0][m][0][j] * rs) * (acc[ai][1][m][0][j] * rs); o1[j] = silu_f(acc[ai][0][m][1][j] * rs) * (acc[ai][1][m][1][j] * rs); }
                st8bf(O + (size_t)row * ldc + col0, o0, o1); }
    }
};
struct EpiProj {
    static constexpr bool PERM = true, AFTER_DRAIN = false;
    static constexpr int TKV = 8256;
    unsigned char* ws; size_t o_rstd, o_qh, o_kh, o_vh, o_iq, o_gq, o_gk, o_gv, o_go, o_ik, o_iw, o_glow;
    __device__ __forceinline__ void operator()(const f32x4 (&acc)[2][2][4][2], const Unit& u, int wr, int wc, int fr, int fq) const {
        const float* rstd = (const float*)(ws + o_rstd);
        bf16_t* Qh = (bf16_t*)(ws + o_qh); bf16_t* Kh = (bf16_t*)(ws + o_kh); bf16_t* Vh = (bf16_t*)(ws + o_vh); bf16_t* IQ = (bf16_t*)(ws + o_iq); bf16_t* GQ = (bf16_t*)(ws + o_gq);
        bf16_t* GK = (bf16_t*)(ws + o_gk); bf16_t* GV = (bf16_t*)(ws + o_gv); bf16_t* GO = (bf16_t*)(ws + o_go); bf16_t* IK = (bf16_t*)(ws + o_ik); float* IW = (float*)(ws + o_iw); float* GLOW = (float*)(ws + o_glow);
        const int pn = u.pn;
        const int row0 = u.pm * BM + wr * 64 + fr;
#pragma unroll
        for (int ai = 0; ai < 2; ++ai)
#pragma unroll
            for (int m = 0; m < 4; ++m) {
                const int row = row0 + ai * HALF + m * 16; const float rs = rstd[row];
                const bool mainr = row < 16384, metar = (row >= 16384) && (row < 16400);
                const int b = row >> 13, s = row & 8191, mi = row - 16384;
#pragma unroll
                for (int bj = 0; bj < 2; ++bj) {
                    const int col = bj * HALF + wc * 32 + 8 * fq;
                    f32x4 v0 = acc[ai][bj][m][0] * rs, v1 = acc[ai][bj][m][1] * rs;
                    if (pn < 4) {
                        if (mainr) { const int h = pn * 2 + (col >> 7), d = col & 127; st8bf(Qh + ((size_t)(b * 8 + h) * 8192 + s) * 128 + d, v0, v1); }
                    } else if (pn < 12) {
                        bf16_t* base = pn < 8 ? Kh : Vh; const int h = (pn & 3) * 2 + (col >> 7), d = col & 127;
                        if (mainr) st8bf(base + ((size_t)(b * 8 + h) * TKV + 16 + s) * 128 + d, v0, v1);
                        else if (metar) { st8bf(base + ((size_t)h * TKV + mi) * 128 + d, v0, v1); st8bf(base + ((size_t)(8 + h) * TKV + mi) * 128 + d, v0, v1); }
                    } else if (pn < 16) {
                        if (mainr) st8bf(IQ + (size_t)row * 1024 + (pn - 12) * 256 + col, v0 * 0.125f, v1 * 0.125f);
                    } else if (pn < 18) {
                        if (mainr) st8bf(GQ + ((size_t)b * TKV + 64 + s) * 512 + (pn - 16) * 256 + col, v0 * 0.08838834764831845f, v1 * 0.08838834764831845f);
                    } else if (pn < 20) {
                        const int c = (pn - 18) * 256 + col;
                        if (mainr) st8bf(GK + ((size_t)b * TKV + 64 + s) * 512 + c, v0, v1);
                        else if (metar) { st8bf(GK + ((size_t)48 + mi) * 512 + c, v0, v1); st8bf(GK + ((size_t)TKV + 48 + mi) * 512 + c, v0, v1); }
                    } else if (pn < 24) {
                        const int c = (pn - 20) * 256 + col;
                        if (mainr) st8bf(GV + ((size_t)b * TKV + 64 + s) * 1024 + c, v0, v1);
                        else if (metar) { st8bf(GV + ((size_t)48 + mi) * 1024 + c, v0, v1); st8bf(GV + ((size_t)TKV + 48 + mi) * 1024 + c, v0, v1); }
                    } else if (pn < 28) {
                        if (mainr) st8bf(GO + (size_t)row * 1024 + (pn - 24) * 256 + col, v0, v1);
                    } else {
                        if (col < 64) {
                            const int ch = col >> 3, fo = (ch >> 1) * 512 + (ch & 1) * 256;
                            if (mainr) { const int pos = 16 + s; st8bf(IK + (size_t)b * TKV * 64 + (size_t)(pos >> 5) * 2048 + fo + (pos & 31) * 8, v0, v1); }
                            else if (metar) { st8bf(IK + fo + mi * 8, v0, v1); st8bf(IK + (size_t)TKV * 64 + fo + mi * 8, v0, v1); }
                        } else if (col < 80) {
                            if (mainr) { float* p = IW + (size_t)row * 16 + (col - 64); *(f32x4*)p = v0 * 0.25f; *(f32x4*)(p + 4) = v1 * 0.25f; }
                        } else if (col < 96) {
                            const int c = col - 80;
                            if (mainr) { float* p = GLOW + ((size_t)b * TKV + 64 + s) * 16 + c; *(f32x4*)p = v0; *(f32x4*)(p + 4) = v1; }
                            else if (metar) { float* p = GLOW + ((size_t)48 + mi) * 16 + c; *(f32x4*)p = v0; *(f32x4*)(p + 4) = v1;
                                              float* p2 = GLOW + ((size_t)TKV + 48 + mi) * 16 + c; *(f32x4*)p2 = v0; *(f32x4*)(p2 + 4) = v1; }
                        }
                    }
                }
            }
    }
};
typedef int v8i_t __attribute__((ext_vector_type(8)));
__device__ __forceinline__ v8i_t cat8(bf16x8 lo, bf16x8 hi) { typedef int v4i_t __attribute__((ext_vector_type(4)));
    return __builtin_shufflevector(__builtin_bit_cast(v4i_t, lo), __builtin_bit_cast(v4i_t, hi), 0, 1, 2, 3, 4, 5, 6, 7); }
template <class Epi, class Sched, bool ALIGN_EPI = false, bool SP2 = false, bool FP8 = false>
__device__ __forceinline__ void gemm_phase(PG8_LAS unsigned char* lds, const Gemm g, const Sched& S, const Epi& E) {
    const int tid = threadIdx.x, wid = __builtin_amdgcn_readfirstlane(tid >> 6), lane = tid & 63, wr = wid >> 2, wc = wid & 3, fr = lane & 15, fq = lane >> 4;
    const int K = g.K, nt = K / BK;
    unsigned voffA[2], voffB[2];
#pragma unroll
    for (int i = 0; i < 2; ++i) { int R, C; stage_rc(tid * 16 + i * 8192, R, C); const int Rb = Epi::PERM ? ((R & ~31) + perm32(R & 31)) : R;
        voffA[i] = (unsigned)(R * K + C) * 2u; voffB[i] = (unsigned)(Rb * K + C) * 2u; }
    const size_t kstep = (size_t)(BK * 2);
    const size_t hstep = (size_t)HALF * K * 2;
    const size_t tstep = 2 * hstep;
    const unsigned ldsw = (unsigned)wid * 1024u;
    const int f8o = (fq >> 1) * 1024 + ((fr * 64 + 32 * (fq & 1)) ^ (((fr >> 3) & 1) << 5));
    const int aoff = FP8 ? wr * 8192 + f8o : lds_byte(wr * 64 + fr, fq * 8), boff = FP8 ? wc * 4096 + f8o : lds_byte(wc * 32 + fr, fq * 8);
    constexpr int KSTR = FP8 ? 16 : 1024;
    int sc8 = 0x7f7f7f7f; if (FP8) asm volatile("" : "+v"(sc8));
#define PG8_SA(b, h) (((b) * 2 + (h)) * HTB)
#define PG8_SB(b, h) ((4 + (b) * 2 + (h)) * HTB)
#define PG8_STAGE(bufoff, gbase, voff) do { _Pragma("unroll") for (int _i = 0; _i < 2; ++_i) \
        __builtin_amdgcn_global_load_lds((const unsigned*)((const char*)(gbase) + (voff)[_i]), (PG8_LAS unsigned*)(lds + (bufoff) + ldsw + _i * 8192), 16, 0, 0); } while (0)
#define PG8_LDA(dst, b, h) do { _Pragma("unroll") for (int m = 0; m < 4; ++m) _Pragma("unroll") for (int k = 0; k < 2; ++k) dst[m][k] = *(const PG8_LAS bf16x8*)(lds + PG8_SA(b, h) + aoff + m * 2048 + k * KSTR); } while (0)
#define PG8_LDB(dst, b, h) do { _Pragma("unroll") for (int n = 0; n < 2; ++n) _Pragma("unroll") for (int k = 0; k < 2; ++k) dst[n][k] = *(const PG8_LAS bf16x8*)(lds + PG8_SB(b, h) + boff + n * 2048 + k * KSTR); } while (0)
#define PG8_MMA(ai, bj, At, Bt) do { __builtin_amdgcn_s_setprio(1); _Pragma("unroll") for (int m = 0; m < 4; ++m) _Pragma("unroll") for (int n = 0; n < 2; ++n) { \
        if constexpr (FP8) { const v8i_t b8_ = cat8(Bt[n][0], Bt[n][1]), a8_ = cat8(At[m][0], At[m][1]);     \
            asm volatile("v_mfma_scale_f32_16x16x128_f8f6f4 %0, %1, %2, %0, %3, %3 op_sel_hi:[0,0,0]" : "+v"(acc[ai][bj][m][n]) : "v"(b8_), "v"(a8_), "v"(sc8)); } \
        else { _Pragma("unroll") for (int k = 0; k < 2; ++k) acc[ai][bj][m][n] = __builtin_amdgcn_mfma_f32_16x16x32_bf16(Bt[n][k], At[m][k], acc[ai][bj][m][n], 0, 0, 0); } } __builtin_amdgcn_s_setprio(0); } while (0)
#define PG8_WAIT_V(n) asm volatile("s_waitcnt vmcnt(" #n ")" ::: "memory")
#define PG8_WAIT_L(n) asm volatile("s_waitcnt lgkmcnt(" #n ")" ::: "memory")
#define PG8_BAR __builtin_amdgcn_s_barrier()
#define PG8_SCHED __builtin_amdgcn_sched_barrier(0)
    Unit cur, nxt; int ui = 0;
    if (!S.next(0, cur)) return;
    f32x4 acc[2][2][4][2];
#pragma unroll
    for (int a = 0; a < 2; ++a)
#pragma unroll
        for (int b = 0; b < 2; ++b)
#pragma unroll
            for (int m = 0; m < 4; ++m)
#pragma unroll
                for (int n = 0; n < 2; ++n) acc[a][b][m][n] = (f32x4){0.f, 0.f, 0.f, 0.f};
    bf16x8 At[4][2], B0[2][2], B1[2][2];
    const char* cA = (const char*)g.A + (size_t)cur.pm * tstep; const char* cB = (const char*)g.Bt + (size_t)cur.pn * tstep;
    S.a_ready(cur);
    if constexpr (SP2) {
        PG8_STAGE(PG8_SB(0, 0), cB, voffB); PG8_STAGE(PG8_SB(0, 1), cB + hstep, voffB); PG8_STAGE(PG8_SA(0, 0), cA, voffA); PG8_STAGE(PG8_SA(0, 1), cA + hstep, voffA);
        if (wr == 1) PG8_BAR;
        PG8_WAIT_V(2); PG8_BAR;
        PG8_STAGE(PG8_SB(1, 0), cB + kstep, voffB); PG8_STAGE(PG8_SA(1, 0), cA + kstep, voffA); PG8_STAGE(PG8_SB(1, 1), cB + hstep + kstep, voffB);
        PG8_WAIT_V(6); PG8_BAR;
    } else {
        PG8_STAGE(PG8_SB(0, 0), cB, voffB); PG8_STAGE(PG8_SA(0, 0), cA, voffA); PG8_STAGE(PG8_SB(0, 1), cB + hstep, voffB); PG8_STAGE(PG8_SA(0, 1), cA + hstep, voffA);
        if (wr == 1) PG8_BAR;
        PG8_WAIT_V(4); PG8_BAR;
        PG8_STAGE(PG8_SB(1, 0), cB + kstep, voffB); PG8_STAGE(PG8_SA(1, 0), cA + kstep, voffA); PG8_STAGE(PG8_SB(1, 1), cB + hstep + kstep, voffB);
        PG8_WAIT_V(6); PG8_BAR;
    }
    for (;;) {
        const bool has_next = S.next(ui + 1, nxt);
        const char* nA = has_next ? (const char*)g.A + (size_t)nxt.pm * tstep : cA; const char* nB = has_next ? (const char*)g.Bt + (size_t)nxt.pn * tstep : cB;
        for (int t = 0; t < nt; t += 2) {
            const bool last = (t == nt - 2);
            const char* a1 = cA + (size_t)(t + 1) * kstep;
            const char* a2 = last ? nA : cA + (size_t)(t + 2) * kstep; const char* b2 = last ? nB : cB + (size_t)(t + 2) * kstep;
            const char* a3 = a2 + kstep; const char* b3 = b2 + kstep;
            if (last && has_next) S.a_ready(nxt);
            if constexpr (SP2) {
            PG8_LDB(B0, 0, 0); PG8_LDB(B1, 0, 1); PG8_SCHED; PG8_LDA(At, 0, 0); PG8_STAGE(PG8_SA(1, 1), a1 + hstep, voffA);
            PG8_WAIT_V(8); PG8_WAIT_L(0); PG8_BAR; PG8_MMA(0, 0, At, B0); PG8_MMA(0, 1, At, B1); PG8_BAR; PG8_SCHED;
            PG8_LDA(At, 0, 1); PG8_STAGE(PG8_SB(0, 0), b2, voffB); PG8_STAGE(PG8_SB(0, 1), b2 + hstep, voffB); PG8_STAGE(PG8_SA(0, 0), a2, voffA);
            PG8_WAIT_V(8); PG8_WAIT_L(0); PG8_BAR; PG8_MMA(1, 0, At, B0); PG8_MMA(1, 1, At, B1); PG8_BAR; PG8_SCHED;
            PG8_LDB(B0, 1, 0); PG8_LDB(B1, 1, 1); PG8_SCHED; PG8_LDA(At, 1, 0); PG8_STAGE(PG8_SA(0, 1), a2 + hstep, voffA);
            PG8_WAIT_V(8); PG8_WAIT_L(0); PG8_BAR; PG8_MMA(0, 0, At, B0); PG8_MMA(0, 1, At, B1); PG8_BAR; PG8_SCHED;
            PG8_LDA(At, 1, 1); PG8_STAGE(PG8_SB(1, 0), b3, voffB); PG8_STAGE(PG8_SB(1, 1), b3 + hstep, voffB); PG8_STAGE(PG8_SA(1, 0), a3, voffA);
            PG8_WAIT_V(8); PG8_WAIT_L(0); PG8_BAR; PG8_MMA(1, 0, At, B0); PG8_MMA(1, 1, At, B1); PG8_BAR; PG8_SCHED;
            } else {
            PG8_LDB(B0, 0, 0); PG8_SCHED; PG8_LDA(At, 0, 0); PG8_STAGE(PG8_SA(1, 1), a1 + hstep, voffA);
            PG8_WAIT_L(8); PG8_BAR; PG8_WAIT_L(0); PG8_MMA(0, 0, At, B0); PG8_BAR; PG8_SCHED;
            PG8_LDB(B1, 0, 1); PG8_STAGE(PG8_SB(0, 0), b2, voffB);
            PG8_BAR; PG8_WAIT_L(0); PG8_MMA(0, 1, At, B1); PG8_BAR;
            PG8_LDA(At, 0, 1); PG8_STAGE(PG8_SA(0, 0), a2, voffA);
            PG8_BAR; PG8_WAIT_L(0); PG8_MMA(1, 0, At, B0); PG8_BAR; PG8_SCHED;
            PG8_STAGE(PG8_SB(0, 1), b2 + hstep, voffB);
            PG8_WAIT_V(6); PG8_BAR; PG8_MMA(1, 1, At, B1); PG8_BAR;
            PG8_LDB(B0, 1, 0); PG8_SCHED; PG8_LDA(At, 1, 0); PG8_STAGE(PG8_SA(0, 1), a2 + hstep, voffA);
            PG8_WAIT_L(8); PG8_BAR; PG8_WAIT_L(0); PG8_MMA(0, 0, At, B0); PG8_BAR; PG8_SCHED;
            PG8_LDB(B1, 1, 1); PG8_STAGE(PG8_SB(1, 0), b3, voffB);
            PG8_BAR; PG8_WAIT_L(0); PG8_MMA(0, 1, At, B1); PG8_BAR;
            PG8_LDA(At, 1, 1); PG8_STAGE(PG8_SA(1, 0), a3, voffA);
            PG8_BAR; PG8_WAIT_L(0); PG8_MMA(1, 0, At, B0); PG8_BAR; PG8_SCHED;
            PG8_STAGE(PG8_SB(1, 1), b3 + hstep, voffB);
            PG8_WAIT_V(6); PG8_BAR; PG8_MMA(1, 1, At, B1); PG8_BAR;
            }
        }
        if constexpr (FP8) asm volatile("s_nop 15\n\ts_nop 15" ::: "memory");
        if constexpr (ALIGN_EPI) { if (wr == 0) PG8_BAR; }
        if constexpr (!Epi::AFTER_DRAIN) { E(acc, cur, wr, wc, fr, fq); S.done(cur); }
        if (!has_next) break;
#pragma unroll
        for (int a = 0; a < 2; ++a)
#pragma unroll
            for (int b = 0; b < 2; ++b)
#pragma unroll
                for (int m = 0; m < 4; ++m)
#pragma unroll
                    for (int n = 0; n < 2; ++n) acc[a][b][m][n] = (f32x4){0.f, 0.f, 0.f, 0.f};
        cur = nxt; cA = nA; cB = nB; ++ui;
        if constexpr (ALIGN_EPI) { if (wr == 1) PG8_BAR; }
    }
    PG8_WAIT_V(0);
    if constexpr (!ALIGN_EPI) { if (wr == 0) PG8_BAR; }
    PG8_BAR;
    if constexpr (Epi::AFTER_DRAIN) { E.fused(acc, cur, wr, wc, fr, fq, lds, wid, lane); S.done(cur); }
#undef PG8_SA
#undef PG8_SB
#undef PG8_STAGE
#undef PG8_LDA
#undef PG8_LDB
#undef PG8_MMA
#undef PG8_WAIT_V
#undef PG8_WAIT_L
#undef PG8_BAR
#undef PG8_SCHED
}
}

namespace att {
typedef unsigned short bf16;
typedef short bf16x8 __attribute__((ext_vector_type(8)));
typedef short s16x4 __attribute__((ext_vector_type(4)));
typedef float f32x16 __attribute__((ext_vector_type(16)));
typedef float f32x4 __attribute__((ext_vector_type(4)));
typedef unsigned u32x4 __attribute__((ext_vector_type(4)));
typedef unsigned long long u64;
constexpr int HD = 128, NW = 8, QBLK = 32, KVBLK = 64, QB = NW * QBLK;
constexpr int SHM_V = KVBLK * HD * 2, SHM_K = KVBLK * HD * 2;
constexpr int ATT_LDS_BYTES = 2 * SHM_V + 2 * SHM_K + NW * 64 * 4;
constexpr float SCALE = 0.08838834764831845f;
constexpr float THR = 8.f;
constexpr int OSTR = 2048;
constexpr int MWORDS = 130;

#define KSWZ(row, colB) ((row) * 256 + ((colB) ^ (((row) & 7) << 4)))
#define SBAR() __builtin_amdgcn_sched_barrier(0)
__device__ __forceinline__ int v_st(int k, int c) { const int kk = (k & ~0xC) | ((k & 4) << 1) | ((k & 8) >> 1); return ((kk >> 3) * 4 + (c >> 5)) * 512 + ((kk & 7) * 32 + (c & 31)) * 2; }
__device__ __forceinline__ int v_rd_base(int lane) { return ((lane & 3) << 3) | (((lane >> 2) & 3) << 6) | (((lane >> 4) & 1) << 5) | (((lane >> 5) & 1) << 8); }
constexpr int v_rd_off(int d0, int ks, int half) { return d0 * 512 + ks * 4096 + half * 2048; }
__device__ __forceinline__ int crow(int r, int hi) { return (r & 3) + 8 * (r >> 2) + 4 * hi; }
__device__ __forceinline__ unsigned cvtpk(float lo, float hi) {
    unsigned r; asm volatile("v_cvt_pk_bf16_f32 %0, %1, %2" : "=v"(r) : "v"(lo), "v"(hi)); return r;
}
__device__ __forceinline__ bf16x8 load8(const bf16* p) { return *reinterpret_cast<const bf16x8*>(p); }
__device__ __forceinline__ void mask_bits(f32x16& p0, f32x16& p1, unsigned mw) {
    const float NEG = -__builtin_inff();
#pragma unroll
    for (int r = 0; r < 16; ++r) {
        if (!((mw >> r) & 1u)) p0[r] = NEG;
        if (!((mw >> (16 + r)) & 1u)) p1[r] = NEG;
    }
}
__device__ __forceinline__ void partialSM(f32x16& p0, f32x16& p1, float& m_reg, float& mn, float& alpha) {
    float pmax = p0[0]; for (int r = 1; r < 16; ++r) pmax = fmaxf(pmax, p0[r]); for (int r = 0; r < 16; ++r) pmax = fmaxf(pmax, p1[r]);
    { auto rr = __builtin_amdgcn_permlane32_swap(__float_as_uint(pmax), __float_as_uint(pmax), false, false);
      pmax = fmaxf(__uint_as_float(rr[0]), __uint_as_float(rr[1])); }
    constexpr float C2 = 1.4426950408889634f * SCALE;
    if (__builtin_expect(__all((pmax - m_reg) * SCALE <= THR), 1)) { mn = m_reg; alpha = 1.f; }
    else { mn = fmaxf(m_reg, pmax); alpha = __builtin_amdgcn_exp2f((m_reg - mn) * C2); m_reg = mn; }
    const float mnL = -mn * C2;
    for (int r = 0; r < 16; ++r) p0[r] = fmaf(p0[r], C2, mnL); for (int r = 0; r < 16; ++r) p1[r] = fmaf(p1[r], C2, mnL);
    for (int r = 0; r < 16; ++r) p0[r] = __builtin_amdgcn_exp2f(p0[r]);
}
__device__ __forceinline__ void finishSM(f32x16& p0, f32x16& p1, float alpha, float& l_reg, bf16x8& pa0, bf16x8& pa1, bf16x8& pa2, bf16x8& pa3) {
    for (int r = 0; r < 16; ++r) p1[r] = __builtin_amdgcn_exp2f(p1[r]);
    float ps = 0; for (int r = 0; r < 16; ++r) ps += p0[r]; for (int r = 0; r < 16; ++r) ps += p1[r];
    { auto rr = __builtin_amdgcn_permlane32_swap(__float_as_uint(ps), __float_as_uint(ps), false, false);
      ps = __uint_as_float(rr[0]) + __uint_as_float(rr[1]); }
    l_reg = l_reg * alpha + ps;
#define PK4(P, B_, OUT) do { unsigned a0 = cvtpk(P[B_+0], P[B_+1]), a1 = cvtpk(P[B_+2], P[B_+3]);                          \
        unsigned b0 = cvtpk(P[B_+4], P[B_+5]), b1 = cvtpk(P[B_+6], P[B_+7]);                                             \
        auto r0 = __builtin_amdgcn_permlane32_swap(a0, b0, false, false); auto r1 = __builtin_amdgcn_permlane32_swap(a1, b1, false, false); \
        u32x4 w = {r0[0], r1[0], r0[1], r1[1]}; OUT = *reinterpret_cast<bf16x8*>(&w); } while (0)
    PK4(p0, 0, pa0); PK4(p0, 8, pa1); PK4(p1, 0, pa2); PK4(p1, 8, pa3);
#undef PK4
}
template <int KB>
__device__ __forceinline__ void qkt(f32x16& p0, f32x16& p1, const char* K_lds, int r32, int hi, const bf16x8* qr) {
    p0 = f32x16{}; p1 = f32x16{};
    const char* kb[4];
#pragma unroll
    for (int dd = 0; dd < 4; ++dd) kb[dd] = K_lds + KB * SHM_K + KSWZ(r32, (dd * 16 + hi * 8) * 2);
#pragma unroll
    for (int d0 = 0; d0 < 8; ++d0) { const char* a = kb[d0 & 3] + (d0 >> 2) * 128;
        bf16x8 b0 = *reinterpret_cast<const bf16x8*>(a);
        bf16x8 b1 = *reinterpret_cast<const bf16x8*>(a + 32 * 256);
        p0 = __builtin_amdgcn_mfma_f32_32x32x16_bf16(b0, qr[d0], p0, 0, 0, 0);
        p1 = __builtin_amdgcn_mfma_f32_32x32x16_bf16(b1, qr[d0], p1, 0, 0, 0); }
}
template <int VB>
__device__ __forceinline__ void pv_tile(f32x16* o, int vb0, bf16x8 pa0, bf16x8 pa1, bf16x8 pa2, bf16x8 pa3) {
#define TRRD(dst, off) asm volatile("ds_read_b64_tr_b16 %0, %1 offset:%2" : "=&v"(dst) : "v"(vb0), "i"(off) : "memory")
#define PV_D0(d0) do { s16x4 l0, l1, l2, l3, h0, h1, h2, h3; constexpr int b_ = VB * SHM_V + v_rd_off(d0, 0, 0);     \
        TRRD(l0, b_); TRRD(h0, b_ + 2048); TRRD(l1, b_ + 4096); TRRD(h1, b_ + 6144); TRRD(l2, b_ + 8192); TRRD(h2, b_ + 10240); TRRD(l3, b_ + 12288); TRRD(h3, b_ + 14336); \
        asm volatile("s_waitcnt lgkmcnt(0)" ::: "memory"); SBAR();             \
        o[d0] = __builtin_amdgcn_mfma_f32_32x32x16_bf16(pa0, (bf16x8){l0[0], l0[1], l0[2], l0[3], h0[0], h0[1], h0[2], h0[3]}, o[d0], 0, 0, 0);   \
        o[d0] = __builtin_amdgcn_mfma_f32_32x32x16_bf16(pa1, (bf16x8){l1[0], l1[1], l1[2], l1[3], h1[0], h1[1], h1[2], h1[3]}, o[d0], 0, 0, 0);   \
        o[d0] = __builtin_amdgcn_mfma_f32_32x32x16_bf16(pa2, (bf16x8){l2[0], l2[1], l2[2], l2[3], h2[0], h2[1], h2[2], h2[3]}, o[d0], 0, 0, 0);   \
        o[d0] = __builtin_amdgcn_mfma_f32_32x32x16_bf16(pa3, (bf16x8){l3[0], l3[1], l3[2], l3[3], h3[0], h3[1], h3[2], h3[3]}, o[d0], 0, 0, 0); } while (0)
    PV_D0(0); PV_D0(1); PV_D0(2); PV_D0(3);
#undef PV_D0
#undef TRRD
}

struct BlockRef { const bf16* Q; const bf16* K; const bf16* V; bf16* O; const u64* M; int NT; };
struct Seam { bf16x8 qr[8]; bf16x8 st_v0, st_v1, st_k0, st_k1; };
#define VMW() asm volatile("s_waitcnt vmcnt(0)" ::: "memory")
#define VMWN(n) asm volatile("s_waitcnt vmcnt(%0)" :: "i"(n) : "memory")
#define SLOAD_H(Kp, Vp, k0) do { int t_ = tid; asm volatile("" : "+v"(t_)); const unsigned go_ = (unsigned)((k0) * (HD * 2)) + (unsigned)t_ * 16u;               \
                         S.st_v0 = load8((const bf16*)((const char*)(Vp) + go_)); S.st_v1 = load8((const bf16*)((const char*)(Vp) + (go_ + 8192u)));              \
                         S.st_k0 = load8((const bf16*)((const char*)(Kp) + go_)); S.st_k1 = load8((const bf16*)((const char*)(Kp) + (go_ + 8192u))); } while (0)
#define SWRITE_HK(bf) do { int t_ = tid; asm volatile("" : "+v"(t_)); const int sr_ = t_ >> 4, sc_ = (t_ & 15) * 8, kws_ = KSWZ(sr_, sc_ * 2);                      \
                         *(bf16x8*)(K_lds + (bf) * SHM_K + kws_) = S.st_k0; *(bf16x8*)(K_lds + (bf) * SHM_K + kws_ + 32 * 256) = S.st_k1; } while (0)
#define SWRITE_HV(bf) do { int t_ = tid; asm volatile("" : "+v"(t_)); const int sr_ = t_ >> 4, sc_ = (t_ & 15) * 8, vs_ = v_st(sr_, sc_);                            \
                         *(bf16x8*)(V_lds + (bf) * SHM_V + vs_) = S.st_v0; *(bf16x8*)(V_lds + (bf) * SHM_V + vs_ + 8192) = S.st_v1; } while (0)
#define SWRITE_H(bf) do { SWRITE_HV(bf); SWRITE_HK(bf); } while (0)
__device__ __forceinline__ void att_prime(const BlockRef& cur, char* lds, Seam& S) {
    const int tid = threadIdx.x, wid = __builtin_amdgcn_readfirstlane(tid >> 6), lane = tid & 63, r32 = lane & 31, hi = lane >> 5;
    char* K_lds = lds + 2 * SHM_V;
#pragma unroll
    for (int d0 = 0; d0 < 8; ++d0) S.qr[d0] = load8((const bf16*)((const char*)cur.Q + (unsigned)(((wid * QBLK + r32) * HD + hi * 8) * 2 + d0 * 32)));
    SLOAD_H(cur.K, cur.V, 0); VMW(); SWRITE_HK(0);
    __syncthreads();
}
__device__ __forceinline__ void att_block(const BlockRef& cur, const BlockRef& nxt, char* lds, Seam& S) {
    const int tid = threadIdx.x, wid = __builtin_amdgcn_readfirstlane(tid >> 6), lane = tid & 63, r32 = lane & 31, hi = lane >> 5;
    const int NT = cur.NT;
    char* V_lds = lds; char* K_lds = lds + 2 * SHM_V;
    float* ws = (float*)(lds + 2 * SHM_V + 2 * SHM_K) + wid * 64; float* li_l = ws, * al_l = ws + 32;
    float m_reg = -1e30f, l_reg = 0; f32x16 o[4] = {};
    const int vb0 = (int)(uintptr_t)V_lds + v_rd_base(lane);
    const bf16* Kh = cur.K; const bf16* Vh = cur.V;
    const char* Mb = (const char*)cur.M; const unsigned moff = (unsigned)((wid * QBLK + r32) * (MWORDS * 8) + hi * 4);
#define MLOAD(t) (*(const unsigned*)(Mb + (moff + (unsigned)(t) * 8u)))
    unsigned mwA = MLOAD(0), mwB = 0u;
#define RESC(a) do { if (__any((a) < 1.f)) { if (hi == 0) al_l[r32] = (a); asm volatile("s_waitcnt lgkmcnt(0)" ::: "memory");              \
                     for (int d_ = 0; d_ < 4; ++d_) for (int r = 0; r < 16; ++r) o[d_][r] *= al_l[crow(r, hi)]; } } while (0)
#define KBASE(t) ((t) * KVBLK)
    constexpr int NQL = 8;
#define SEAM_K0() do { VMWN(NQL); SWRITE_HK(0); SBAR(); } while (0)
    f32x16 pA0, pA1, pB0, pB1; float mnA, mnB, alA, alB; bf16x8 pa0, pa1, pa2, pa3;
    SWRITE_HV(0); SBAR();
    if (NT > 1) { SLOAD_H(Kh, Vh, KBASE(1)); }
    SBAR(); qkt<0>(pA0, pA1, K_lds, r32, hi, S.qr);
    mask_bits(pA0, pA1, mwA); partialSM(pA0, pA1, m_reg, mnA, alA);
    if (NT > 1) { VMW(); SWRITE_H(1); }
    __syncthreads();
#define HALF_STEP(PX0, PX1, mnX, alX, PY0, PY1, alY, t, KB, VB, SB, MWX, MWY) do {                                             \
        MWX = MLOAD(t);                                                                                                       \
        SBAR(); qkt<KB>(PX0, PX1, K_lds, r32, hi, S.qr);                                                                      \
        finishSM(PY0, PY1, alY, l_reg, pa0, pa1, pa2, pa3); SBAR();                                                           \
        if ((t) + 1 < NT) { SLOAD_H(Kh, Vh, KBASE((t) + 1)); SBAR(); }                                                        \
        pv_tile<VB>(o, vb0, pa0, pa1, pa2, pa3); mask_bits(PX0, PX1, MWX); partialSM(PX0, PX1, m_reg, mnX, alX);          \
        __syncthreads();                                                                                                      \
        if ((t) + 1 < NT) { VMW(); SWRITE_H(SB); }                                                                            \
        RESC(alX); __syncthreads(); } while (0)
    for (int t = 1; t + 1 < NT; t += 2) {
        HALF_STEP(pB0, pB1, mnB, alB, pA0, pA1, alA, t, 1, 0, 0, mwB, mwA);
        HALF_STEP(pA0, pA1, mnA, alA, pB0, pB1, alB, t + 1, 0, 1, 1, mwA, mwB);
    }
    const bool even = (NT & 1) == 0;
    if (even) { mwB = MLOAD(NT - 1); SBAR(); qkt<1>(pB0, pB1, K_lds, r32, hi, S.qr); SBAR(); }
    SLOAD_H(nxt.K, nxt.V, 0); SBAR();
#pragma unroll
    for (int d0 = 0; d0 < 8; ++d0) S.qr[d0] = load8((const bf16*)((const char*)nxt.Q + (unsigned)(((wid * QBLK + r32) * HD + hi * 8) * 2 + d0 * 32)));
    SBAR();
    finishSM(pA0, pA1, alA, l_reg, pa0, pa1, pa2, pa3); SBAR();
    pv_tile<0>(o, vb0, pa0, pa1, pa2, pa3);
    if (even) { mask_bits(pB0, pB1, mwB); partialSM(pB0, pB1, m_reg, mnB, alB); __syncthreads(); RESC(alB);
        finishSM(pB0, pB1, alB, l_reg, pa0, pa1, pa2, pa3); SBAR(); pv_tile<1>(o, vb0, pa0, pa1, pa2, pa3); }
    SBAR(); SEAM_K0();
    if (hi == 0) li_l[r32] = l_reg; asm volatile("s_waitcnt lgkmcnt(0)" ::: "memory");
    float rli[16];
#pragma unroll
    for (int r = 0; r < 16; ++r) rli[r] = __builtin_amdgcn_rcpf(li_l[crow(r, hi)]);
    char* Owb = (char*)(cur.O + (size_t)(wid * QBLK) * OSTR);
    int hi_e = hi, r32_e = r32; asm volatile("" : "+v"(hi_e), "+v"(r32_e));
    const unsigned lane_off = (unsigned)(4 * hi_e * OSTR + r32_e) * 2u;
#pragma unroll
    for (int r = 0; r < 16; ++r) { constexpr int dummy = 0; (void)dummy; const unsigned rowb = (unsigned)(((r & 3) + 8 * (r >> 2)) * OSTR * 2);
#pragma unroll
        for (int d0 = 0; d0 < 4; ++d0) { const float v = o[d0][r] * rli[r];
            const float vn = __shfl_xor(v, 1);
            if ((r32 & 1) == 0) *(unsigned*)(Owb + rowb + d0 * 64 + lane_off) = cvtpk(v, vn); } }
    __syncthreads();
#undef RESC
#undef KBASE
#undef SEAM_K0
#undef HALF_STEP
#undef MLOAD
}
#undef VMW
#undef VMWN
#undef SLOAD_H
#undef SWRITE_HK
#undef SWRITE_HV
#undef SWRITE_H
#undef KSWZ
#undef SBAR
}

constexpr int NWAVES = 8;
#ifndef MK_PER_PHASE
#define MK_PER_PHASE 0
#endif
constexpr int N_PHASES = 13;

constexpr int DM = 2048, SEQ = 8192, NBATCH = 2, NMETA = 16, DFF = 5632;
constexpr int R = NBATCH * SEQ;
constexpr int RP = 16640;
constexpr int TKV = 8256;
constexpr int NPROJ = 7424;
constexpr int NGU = 2 * DFF;
constexpr float EPS = 1e-6f;

constexpr size_t MiB = 1u << 20;
constexpr size_t WS_CTL = 0, CTL_ZERO_BYTES = 1 * MiB;
constexpr size_t WS_AB = 1 * MiB;
constexpr size_t WS_WB = 66 * MiB;
constexpr size_t WS_WGU = WS_WB, WS_WD = WS_WB + 44 * MiB, WS_WIN = WS_WB, WS_WOUT = WS_WB + 29 * MiB, WS_MASK = WS_WB + 40 * MiB;
constexpr size_t WS_SMALL = 132 * MiB;
constexpr size_t WS_RSTD1 = WS_SMALL, WS_RSTD2 = WS_SMALL + 128 * 1024, WS_RSTD3 = WS_SMALL + 256 * 1024, WS_DEC = WS_SMALL + 384 * 1024;
constexpr size_t WS_ACT = 133 * MiB;
constexpr size_t WS_F = 312 * MiB;
constexpr size_t WS_MIXA = 133 * MiB;
constexpr size_t WS_QH = 197 * MiB;
constexpr size_t WS_KH = 229 * MiB, WS_VH = 262 * MiB;
constexpr size_t WS_IQ = 295 * MiB;
constexpr size_t WS_GQ = 327 * MiB, WS_GK = 344 * MiB;
constexpr size_t WS_GV = 361 * MiB;
constexpr size_t WS_GO = 394 * MiB;
constexpr size_t WS_IK = 426 * MiB;
constexpr size_t WS_IW = 429 * MiB;
constexpr size_t WS_GLOW = 430 * MiB;
constexpr size_t WS_ST = 432 * MiB;
constexpr size_t WS_END = 496 * MiB;
constexpr int CW_BAR = 4096;

constexpr int SCR_BYTES = 147456;
constexpr int MISC_OFF = SCR_BYTES;
constexpr int LDS_BYTES = SCR_BYTES + 2048;

#define GAS __attribute__((address_space(1)))
#define LAS __attribute__((address_space(3)))
typedef unsigned short bf16;
typedef unsigned v4u __attribute__((ext_vector_type(4)));
typedef unsigned v2u __attribute__((ext_vector_type(2)));
typedef float f32x4 __attribute__((ext_vector_type(4)));
typedef float f32x16 __attribute__((ext_vector_type(16)));
typedef short bf16x8 __attribute__((ext_vector_type(8)));
typedef unsigned long long u64;
typedef GAS unsigned gu32;
#define RLX_AGENT __ATOMIC_RELAXED, __HIP_MEMORY_SCOPE_AGENT
#define LDS_WAIT() asm volatile("s_waitcnt lgkmcnt(0)" ::: "memory")
#define VM_WAIT() asm volatile("s_waitcnt vmcnt(0)" ::: "memory")
__device__ __forceinline__ unsigned f2bf(float f) { unsigned u = __builtin_bit_cast(unsigned, f); return (u + 0x7fffu + ((u >> 16) & 1u)) >> 16; }
__device__ __forceinline__ unsigned pk2(float lo, float hi) { return f2bf(lo) | (f2bf(hi) << 16); }
__device__ __forceinline__ float bf2f(unsigned short b) { return __builtin_bit_cast(float, (unsigned)b << 16); }
__device__ __forceinline__ float bflo(unsigned w) { return __builtin_bit_cast(float, w << 16); }
__device__ __forceinline__ float bfhi(unsigned w) { return __builtin_bit_cast(float, w & 0xffff0000u); }
#define XB_TMO      128
#define XB_XCNT(j)  (256  + 64 * (j))
#define XB_XSUB(j)  (1280 + 64 * (j))
#define XB_XGEN(j)  (2304 + 64 * (j))
#define XB_TOP      3328
#define XB_TOPGEN   3392
#define XCD_BAR_WORDS 3456
#define XB_SPIN_CAP (1u << 22)

__device__ __forceinline__ unsigned xb_ld(unsigned* p)              { return __hip_atomic_load(p, __ATOMIC_RELAXED, __HIP_MEMORY_SCOPE_AGENT); }
__device__ __forceinline__ unsigned xb_add(unsigned* p, unsigned v) { return __hip_atomic_fetch_add(p, v, __ATOMIC_RELAXED, __HIP_MEMORY_SCOPE_AGENT); }
__device__ __forceinline__ unsigned xb_xcc_id() { return (unsigned)__builtin_amdgcn_s_getreg((3 << 11) | 20) & 0xFu; }
#define XB_SPIN(cond, bar) do { unsigned _sp = 0; while (cond) { __builtin_amdgcn_s_sleep(1); \
    if ((++_sp & 255u) == 0u) { if (xb_ld(&(bar)[XB_TMO])) break; if (_sp > XB_SPIN_CAP) { atomicAdd(&(bar)[XB_TMO], 1u); break; } } } } while (0)

struct XcdBarrier {
    unsigned* bar; unsigned x;
    volatile LAS unsigned* st;
};

__device__ __forceinline__ XcdBarrier xcd_barrier_post(unsigned* bar, volatile LAS unsigned* st) {
    XcdBarrier b; b.bar = bar; b.x = xb_xcc_id(); b.st = st;
    if (threadIdx.x == 0) (void)xb_add(&bar[XB_XCNT(b.x)], 1u);
    return b;
}
__device__ __forceinline__ void xcd_barrier_complete(unsigned* bar, unsigned x, unsigned& nloc, unsigned& nx) {
    const unsigned G = gridDim.x * gridDim.y * gridDim.z;
    unsigned sum, cnt, mine, sp = 0u;
    for (;;) {
        sum = 0u; cnt = 0u; mine = 0u;
#pragma unroll
        for (unsigned j = 0; j < 16; ++j) { const unsigned c = xb_ld(&bar[XB_XCNT(j)]); sum += c; cnt += (c > 0u) ? 1u : 0u; mine = (j == x) ? c : mine; }
        if (sum == G) break;
        __builtin_amdgcn_s_sleep(1);
        if ((++sp & 255u) == 0u) { if (xb_ld(&bar[XB_TMO])) break; if (sp > XB_SPIN_CAP) { atomicAdd(&bar[XB_TMO], 1u); break; } }
    }
    nloc = mine > 0u ? mine : 1u; nx = cnt > 0u ? cnt : 1u;
}

__device__ __forceinline__ void xcd_barrier(const XcdBarrier& b) {
    asm volatile("s_waitcnt vmcnt(0)" ::: "memory");
    __syncthreads();
    if (threadIdx.x == 0) {
        unsigned* bar = b.bar;
        __builtin_amdgcn_s_waitcnt(0);
        unsigned nloc = b.st[0], nx = b.st[1];
        if (nloc == 0u) { xcd_barrier_complete(bar, b.x, nloc, nx); b.st[0] = nloc; b.st[1] = nx; }
        const unsigned old = xb_add(&bar[XB_XSUB(b.x)], 1u);
        const unsigned gen = old / nloc;
        if (old + 1u == (gen + 1u) * nloc) {
            __builtin_amdgcn_fence(__ATOMIC_RELEASE, "agent");
            asm volatile("s_waitcnt vmcnt(0)" ::: "memory");
            const unsigned og = xb_add(&bar[XB_TOP], 1u);
            const unsigned tg = og / nx;
            if (og + 1u == (tg + 1u) * nx) xb_add(&bar[XB_TOPGEN], 1u);
            else XB_SPIN(xb_ld(&bar[XB_TOPGEN]) == tg, bar);
            __builtin_amdgcn_fence(__ATOMIC_ACQUIRE, "agent");
            xb_add(&bar[XB_XGEN(b.x)], 1u);
            asm volatile("s_waitcnt vmcnt(0)" ::: "memory");
        } else {
            XB_SPIN(xb_ld(&bar[XB_XGEN(b.x)]) == gen, bar);
            __builtin_amdgcn_fence(__ATOMIC_ACQUIRE, "agent");
            asm volatile("s_waitcnt vmcnt(0)" ::: "memory");
        }
    }
    __syncthreads();
}

struct Frame {
    LAS unsigned char* lds;
    unsigned char* ldsg;
    volatile LAS unsigned* MISC;
    unsigned* ctl;
    int tid, lane, wave, vcu, G;
    float* out; unsigned char* ws;
};
enum { I_X = 0, I_META, I_G1PRE, I_W1G, I_W1U, I_W1D, I_G1POST, I_GMIX, I_WIN, I_WGATE, I_BGATE, I_GGLA, I_WOUT, I_GMIXPOST, I_G2PRE, I_W2G, I_W2U, I_W2D, I_G2POST };
#ifndef PROBE_K
#define PROBE_K (-1)
#endif
#ifndef PROBE_BLOCK
#define PROBE_BLOCK 37
#endif
#ifndef PROBE_AMP
#define PROBE_AMP 4
#endif
#define TIC(k) do { if (PROBE_K == (k) && blockIdx.x == PROBE_BLOCK && threadIdx.x == 0) { const unsigned long long t_ = __builtin_amdgcn_s_memrealtime(); F.MISC[20] = (unsigned)t_; F.MISC[21] = (unsigned)(t_ >> 32); } } while (0)
#define TOC(k) do { if (PROBE_K == (k) && blockIdx.x == PROBE_BLOCK && threadIdx.x == 0) { const unsigned long long t0_ = ((unsigned long long)F.MISC[21] << 32) | F.MISC[20]; \
        const unsigned long long a_ = (((unsigned long long)F.MISC[23] << 32) | F.MISC[22]) + (__builtin_amdgcn_s_memrealtime() - t0_); F.MISC[22] = (unsigned)a_; F.MISC[23] = (unsigned)(a_ >> 32); } } while (0)
#define TICC(k) do { if (PROBE_K == (k) && blockIdx.x == PROBE_BLOCK && threadIdx.x == 0) { const unsigned long long t_ = __builtin_amdgcn_s_memtime(); F.MISC[20] = (unsigned)t_; F.MISC[21] = (unsigned)(t_ >> 32); } } while (0)
#define TOCC(k) do { if (PROBE_K == (k) && blockIdx.x == PROBE_BLOCK && threadIdx.x == 0) { const unsigned long long t0_ = ((unsigned long long)F.MISC[21] << 32) | F.MISC[20]; \
        const unsigned long long a_ = (((unsigned long long)F.MISC[23] << 32) | F.MISC[22]) + (__builtin_amdgcn_s_memtime() - t0_) / 20ull; F.MISC[22] = (unsigned)a_; F.MISC[23] = (unsigned)(a_ >> 32); } } while (0)
#define PROBE_SPIN() do { if (PROBE_K >= 0 && blockIdx.x == PROBE_BLOCK && threadIdx.x == 0) { const unsigned long long a_ = (((unsigned long long)F.MISC[23] << 32) | F.MISC[22]) * PROBE_AMP; \
        const unsigned long long s_ = __builtin_amdgcn_s_memrealtime(); while (__builtin_amdgcn_s_memrealtime() - s_ < a_) __builtin_amdgcn_s_sleep(8); } } while (0)

__device__ __forceinline__ float wave_sum(float v) {
#pragma unroll
    for (int o = 1; o < 64; o <<= 1) v += __shfl_xor(v, o);
    return v;
}
__device__ __forceinline__ unsigned wave_sum_u(unsigned v) {
    v += (unsigned)__builtin_amdgcn_update_dpp(0, (int)v, 0xB1, 0xf, 0xf, false);
    v += (unsigned)__builtin_amdgcn_update_dpp(0, (int)v, 0x4E, 0xf, 0xf, false);
    v += (unsigned)__builtin_amdgcn_update_dpp(0, (int)v, 0x141, 0xf, 0xf, false);
    v += (unsigned)__builtin_amdgcn_update_dpp(0, (int)v, 0x140, 0xf, 0xf, false);
    return (unsigned)__builtin_amdgcn_readlane((int)v, 0) + (unsigned)__builtin_amdgcn_readlane((int)v, 16) + (unsigned)__builtin_amdgcn_readlane((int)v, 32) + (unsigned)__builtin_amdgcn_readlane((int)v, 48);
}

__device__ __forceinline__ unsigned pk4_fp8(float a, float b, float c, float d) {
    a = fminf(fmaxf(a, -448.f), 448.f); b = fminf(fmaxf(b, -448.f), 448.f); c = fminf(fmaxf(c, -448.f), 448.f); d = fminf(fmaxf(d, -448.f), 448.f);
    int w = 0; w = __builtin_amdgcn_cvt_pk_fp8_f32(a, b, w, false); w = __builtin_amdgcn_cvt_pk_fp8_f32(c, d, w, true); return (unsigned)w;
}
constexpr float W8_SCALE = 32.0f;
__device__ __forceinline__ void tr_item8(const float* W, int N, int K, unsigned char* W8, int drow0, int scol, const float* gain, LAS float* scr, int k0, int lane) {
#pragma unroll 8
    for (int i = 0; i < 32; ++i) { const int kk = 2 * i + (lane >> 5); float v = W[(size_t)(k0 + kk) * N + scol] * W8_SCALE;
        if (gain) v *= gain[k0 + kk];
        scr[kk * 33 + (lane & 31)] = v; }
    LDS_WAIT(); asm volatile("" ::: "memory");
#pragma unroll
    for (int j = 0; j < 2; ++j) { const int pc = lane + 64 * j, n = pc >> 2, c = pc & 3; const LAS float* s = scr + (16 * c) * 33 + n;
        v4u o; o.x = pk4_fp8(s[0 * 33], s[1 * 33], s[2 * 33], s[3 * 33]); o.y = pk4_fp8(s[4 * 33], s[5 * 33], s[6 * 33], s[7 * 33]);
        o.z = pk4_fp8(s[8 * 33], s[9 * 33], s[10 * 33], s[11 * 33]); o.w = pk4_fp8(s[12 * 33], s[13 * 33], s[14 * 33], s[15 * 33]);
        *(GAS v4u*)(W8 + (size_t)(drow0 + n) * K + k0 + 16 * c) = o; }
    LDS_WAIT(); asm volatile("" ::: "memory");
}
template <int KR>
__device__ __forceinline__ void tr_item(const float* W, int N, int K, bf16* WT, int drow0, int scol, const float* gain, LAS float* scr, int k0, int lane) {
#pragma unroll 8
    for (int i = 0; i < KR / 2; ++i) { const int kk = 2 * i + (lane >> 5); float v = 0.f;
        if (scol >= 0) v = W[(size_t)(k0 + kk) * N + scol];
        if (gain) v *= gain[k0 + kk];
        scr[kk * 33 + (lane & 31)] = v; }
    LDS_WAIT(); asm volatile("" ::: "memory");
    if (KR == 64) {
        const int c = lane & 7;
#pragma unroll
        for (int j = 0; j < 4; ++j) { const int n = (lane >> 3) + 8 * j; const LAS float* s = scr + (8 * c) * 33 + n;
            v4u o; o.x = pk2(s[0 * 33], s[1 * 33]); o.y = pk2(s[2 * 33], s[3 * 33]); o.z = pk2(s[4 * 33], s[5 * 33]); o.w = pk2(s[6 * 33], s[7 * 33]);
            *(GAS v4u*)(WT + (size_t)(drow0 + n) * K + k0 + 8 * c) = o; }
    } else {
        const int c = lane & 1, n = lane >> 1; const LAS float* s = scr + (8 * c) * 33 + n;
        v4u o; o.x = pk2(s[0 * 33], s[1 * 33]); o.y = pk2(s[2 * 33], s[3 * 33]); o.z = pk2(s[4 * 33], s[5 * 33]); o.w = pk2(s[6 * 33], s[7 * 33]);
        *(GAS v4u*)(WT + (size_t)(drow0 + n) * K + k0 + 8 * c) = o;
    }
    LDS_WAIT(); asm volatile("" ::: "memory");
}
template <int KR, bool GU8>
__device__ __forceinline__ void ffn_item(Frame& F, int it, int ksub, const float* Wg, const float* Wu, const float* Wd, const float* gain, bf16* WGU, bf16* WD, LAS float* scr) {
    constexpr int I_GU = (NGU / 32) * (DM / 64);
    if (it < I_GU) { const int g = it % (NGU / 32), kb = it / (NGU / 32), tile = g >> 3, w = g & 7;
        if (GU8) tr_item8(w < 4 ? Wg : Wu, DFF, DM, (unsigned char*)WGU, g * 32, tile * 128 + (w & 3) * 32 + (F.lane & 31), gain, scr, kb * 64, F.lane);
        else tr_item<KR>(w < 4 ? Wg : Wu, DFF, DM, WGU, g * 32, tile * 128 + (w & 3) * 32 + (F.lane & 31), gain, scr, kb * 64 + ksub * 16, F.lane); }
    else { const int r = it - I_GU, g = r % (DM / 32), kb = r / (DM / 32);
        tr_item<KR>(Wd, DM, DFF, WD, g * 32, g * 32 + (F.lane & 31), nullptr, scr, kb * 64 + ksub * 16, F.lane); }
}
template <bool GU8>
__device__ __forceinline__ void convert_ffn(Frame& F, const float* Wg, const float* Wu, const float* Wd, const float* gain, bf16* WGU, bf16* WD) {
    LAS float* scr = (LAS float*)(F.lds + F.wave * 16384);
    const int gw = F.vcu * NWAVES + F.wave, NGW = F.G * NWAVES;
    constexpr int NIT = (NGU / 32) * (DM / 64) + (DM / 32) * (DFF / 64);
    const int nmain = (NIT / NGW) * NGW;
    for (int it = gw; it < nmain; it += NGW) ffn_item<64, GU8>(F, it, 0, Wg, Wu, Wd, gain, WGU, WD, scr);
    for (int q = gw; q < 4 * (NIT - nmain); q += NGW) ffn_item<16, GU8>(F, nmain + (q >> 2), q & 3, Wg, Wu, Wd, gain, WGU, WD, scr);
}
__device__ __forceinline__ int win_src_col(int j) {
    const int t = j >> 8, c = j & 255;
    if (t < 16) return j;
    if (t < 18) return 4176 + (j - 4096);
    if (t < 20) return 4688 + (j - 4608);
    if (t < 24) return 5200 + (j - 5120);
    if (t < 28) return 6240 + (j - 6144);
    if (c < 64) return 4096 + c;
    if (c < 80) return 4160 + (c - 64);
    if (c < 96) return 6224 + (c - 80);
    return -1;
}
template <int KR>
__device__ __forceinline__ void mix_item(Frame& F, int it, int ksub, const float* Win, const float* Wout, const float* gain, bf16* WIN, bf16* WOUT, LAS float* scr) {
    constexpr int I_IN = (NPROJ / 32) * (DM / 64);
    if (it < I_IN) { const int g = it % (NPROJ / 32), kb = it / (NPROJ / 32);
        tr_item<KR>(Win, 7264, DM, WIN, g * 32, win_src_col(g * 32 + (F.lane & 31)), gain, scr, kb * 64 + ksub * 16, F.lane); }
    else { const int r = it - I_IN, g = r % (DM / 32), kb = r / (DM / 32);
        tr_item<KR>(Wout, DM, DM, WOUT, g * 32, g * 32 + (F.lane & 31), nullptr, scr, kb * 64 + ksub * 16, F.lane); }
}
__device__ __forceinline__ void convert_mix(Frame& F, const float* Win, const float* Wout, const float* gain, bf16* WIN, bf16* WOUT) {
    LAS float* scr = (LAS float*)(F.lds + F.wave * 16384);
    const int gw = F.vcu * NWAVES + F.wave, NGW = F.G * NWAVES;
    constexpr int NIT = (NPROJ / 32) * (DM / 64) + (DM / 32) * (DM / 64);
    const int nmain = (NIT / NGW) * NGW;
    for (int it = gw; it < nmain; it += NGW) mix_item<64>(F, it, 0, Win, Wout, gain, WIN, WOUT, scr);
    for (int q = gw; q < 4 * (NIT - nmain); q += NGW) mix_item<16>(F, nmain + (q >> 2), q & 3, Win, Wout, gain, WIN, WOUT, scr);
}

template <bool OUT8>
__device__ __forceinline__ void p0_rows(Frame& F, const float* X, const float* META, unsigned char* X8) {
    const int gw = F.vcu * NWAVES + F.wave, NGW = F.G * NWAVES;
    bf16* AB = (bf16*)(F.ws + WS_AB); float* rstd = (float*)(F.ws + WS_RSTD1);
    for (int row = gw; row < RP; row += NGW) {
        GAS v2u* o = (GAS v2u*)(AB + (size_t)row * DM) + F.lane;
        if (row < R + NMETA) {
            const float* xr = row < R ? X + (size_t)row * DM : META + (size_t)(row - R) * DM;
            const GAS f32x4* xp = (const GAS f32x4*)xr + F.lane;
            f32x4 v[8]; float ss = 0.f;
#pragma unroll
            for (int j = 0; j < 8; ++j) { v[j] = xp[64 * j]; ss += (v[j].x * v[j].x + v[j].y * v[j].y) + (v[j].z * v[j].z + v[j].w * v[j].w); }
            ss = wave_sum(ss);
#pragma unroll
            for (int j = 0; j < 8; ++j) o[64 * j] = (v2u){pk2(v[j].x, v[j].y), pk2(v[j].z, v[j].w)};
            if (OUT8) { GAS unsigned* x8 = (GAS unsigned*)(X8 + (size_t)row * DM) + F.lane;
#pragma unroll
                for (int j = 0; j < 8; ++j) x8[64 * j] = pk4_fp8(v[j].x, v[j].y, v[j].z, v[j].w); }
            if (F.lane == 0) rstd[row] = 1.0f / sqrtf(ss * (1.0f / DM) + EPS);
        } else {
#pragma unroll
            for (int j = 0; j < 8; ++j) o[64 * j] = (v2u){0u, 0u};
            if (OUT8) { GAS unsigned* x8 = (GAS unsigned*)(X8 + (size_t)row * DM) + F.lane;
#pragma unroll
                for (int j = 0; j < 8; ++j) x8[64 * j] = 0u; }
            if (F.lane == 0) rstd[row] = 0.f;
        }
    }
}
template <int MODE, bool OUT8 = false>
__device__ __forceinline__ void norm_rows(Frame& F, const float* g, float* rstd_out, const float* X, const float* META, unsigned char* H8 = nullptr) {
    const int gw = F.vcu * NWAVES + F.wave, NGW = F.G * NWAVES;
    bf16* AB = (bf16*)(F.ws + WS_AB); const bf16* FB = (const bf16*)(F.ws + WS_F);
    const int nrows = (MODE == 0) ? RP : R;
    f32x4 gv[8];
#pragma unroll
    for (int j = 0; j < 8; ++j) gv[j] = ((const GAS f32x4*)g)[64 * j + F.lane];
    for (int row = gw; row < nrows; row += NGW) {
        if (MODE == 0 && row >= R + NMETA) { if (F.lane == 0) rstd_out[row] = 0.f; continue; }
        const GAS v2u* fp = (const GAS v2u*)(FB + (size_t)row * DM) + F.lane;
        GAS v2u* ab = (GAS v2u*)(AB + (size_t)row * DM) + F.lane;
        f32x4 f[8], h[8]; float ss = 0.f;
#pragma unroll
        for (int j = 0; j < 8; ++j) { const v2u w = fp[64 * j]; f[j] = (f32x4){bflo(w.x), bfhi(w.x), bflo(w.y), bfhi(w.y)};
            ss += (f[j].x * f[j].x + f[j].y * f[j].y) + (f[j].z * f[j].z + f[j].w * f[j].w); }
        {
#pragma unroll
            for (int j = 0; j < 8; ++j) { const v2u w = ab[64 * j]; h[j] = (f32x4){bflo(w.x), bfhi(w.x), bflo(w.y), bfhi(w.y)}; }
        }
        ss = wave_sum(ss);
        const float rf = (MODE == 1 ? 1.0f : 0.5f) / sqrtf(ss * (1.0f / DM) + EPS);
        float s2 = 0.f;
#pragma unroll
        for (int j = 0; j < 8; ++j) { h[j] = h[j] + f[j] * gv[j] * rf; s2 += (h[j].x * h[j].x + h[j].y * h[j].y) + (h[j].z * h[j].z + h[j].w * h[j].w); }
        if (MODE == 2) {
            GAS f32x4* op = (GAS f32x4*)(F.out + (size_t)row * DM) + F.lane;
#pragma unroll
            for (int j = 0; j < 8; ++j) op[64 * j] = h[j];
        } else {
            s2 = wave_sum(s2);
#pragma unroll
            for (int j = 0; j < 8; ++j) ab[64 * j] = (v2u){pk2(h[j].x, h[j].y), pk2(h[j].z, h[j].w)};
            if (OUT8) { GAS unsigned* h8 = (GAS unsigned*)(H8 + (size_t)row * DM) + F.lane;
#pragma unroll
                for (int j = 0; j < 8; ++j) h8[64 * j] = pk4_fp8(h[j].x, h[j].y, h[j].z, h[j].w); }
            if (F.lane == 0) rstd_out[row] = 1.0f / sqrtf(s2 * (1.0f / DM) + EPS);
        }
    }
}

__device__ __forceinline__ void zero_pads(Frame& F) {
    const int gt = F.vcu * (NWAVES * 64) + F.tid, NG = F.G * NWAVES * 64;
    bf16* Kh = (bf16*)(F.ws + WS_KH); bf16* Vh = (bf16*)(F.ws + WS_VH); bf16* IK = (bf16*)(F.ws + WS_IK);
    const v4u z = {0u, 0u, 0u, 0u};
    for (int i = gt; i < 2 * 16 * 768 + 2 * 384; i += NG) {
        if (i < 2 * 16 * 768) { const int which = i / (16 * 768), r = i % (16 * 768), bh = r / 768, o = r % 768;
            *(GAS v4u*)((which ? Vh : Kh) + ((size_t)bh * TKV + 8208) * 128 + o * 8) = z; }
        else { const int r = i - 2 * 16 * 768, b = r / 384, o = r % 384, pos = 8208 + (o >> 3), ch = o & 7;
               *(GAS v4u*)(IK + (size_t)b * TKV * 64 + (size_t)(pos >> 5) * 2048 + (ch >> 1) * 512 + (ch & 1) * 256 + (pos & 31) * 8) = z; }
    }
}

__device__ __forceinline__ unsigned row_or16(unsigned v) {
    v |= (unsigned)__builtin_amdgcn_update_dpp(0, (int)v, 0xB1, 0xf, 0xf, false);
    v |= (unsigned)__builtin_amdgcn_update_dpp(0, (int)v, 0x4E, 0xf, 0xf, false);
    v |= (unsigned)__builtin_amdgcn_update_dpp(0, (int)v, 0x141, 0xf, 0xf, false);
    v |= (unsigned)__builtin_amdgcn_update_dpp(0, (int)v, 0x140, 0xf, 0xf, false);
    return v;
}
#ifndef P5_REP_SCORE
#define P5_REP_SCORE 1
#endif
#ifndef P5_REP_SEL
#define P5_REP_SEL 1
#endif
#ifndef P5_REP_MMA
#define P5_REP_MMA 1
#endif
#ifndef P5_REP_SCV
#define P5_REP_SCV 1
#endif
#ifndef P5_REP_BIS
#define P5_REP_BIS 1
#endif
#ifndef P5_REP_EMIT
#define P5_REP_EMIT 1
#endif
__device__ __forceinline__ void p5_item(Frame& F, int b, int t) {
    const int lane = F.lane, wid = F.wave, r32 = lane & 31, hi = lane >> 5;
    const GAS bf16* IQ = (const GAS bf16*)(F.ws + WS_IQ); const GAS bf16* IK = (const GAS bf16*)(F.ws + WS_IK); const GAS float* IW = (const GAS float*)(F.ws + WS_IW);
    GAS u64* MASK = (GAS u64*)(F.ws + WS_MASK);
    LAS unsigned short* S16 = (LAS unsigned short*)F.lds;
    constexpr int SROWD = 129 * 33, SROWH = 2 * SROWD;
    const int s0 = 8 * t, qb = s0 >> 8, nwords = 4 * qb + 5;
    const int kmax = 16 + s0 + 7, nkt = (kmax >> 5) + 1;
    TIC(0); TIC(1);
    {
        bf16x8 Af[4][4];
        LAS float* WL = (LAS float*)(F.lds + 8 * SROWH * 2);
        if (F.tid < 128) WL[F.tid] = 0.5f * IW[((size_t)(b * SEQ + s0)) * 16 + F.tid];
        LAS bf16* QL = (LAS bf16*)(F.lds + 8 * SROWH * 2 + 512);
        { const int q = F.tid >> 6, dd = F.tid & 63; const GAS bf16* qrow = IQ + ((size_t)(b * SEQ + s0 + q)) * 1024 + dd; const GAS float* wrow = IW + ((size_t)(b * SEQ + s0 + q)) * 16;
          float s = 0.f;
#pragma unroll
          for (int hh = 0; hh < 16; ++hh) s = fmaf(0.5f * wrow[hh], bf2f(qrow[hh * 64]), s);
          QL[q * 64 + dd] = (bf16)f2bf(s); }
        {
            const int qo = (r32 >> 2) & 1, h = (r32 & 3) + 4 * (r32 >> 3);
#pragma unroll
            for (int rb = 0; rb < 4; ++rb) {
                const GAS bf16* qp = IQ + ((size_t)(b * SEQ + s0 + 2 * rb + qo)) * 1024 + h * 64 + 8 * hi;
#pragma unroll
                for (int ks = 0; ks < 4; ++ks) Af[rb][ks] = *(const GAS bf16x8*)(qp + ks * 16);
            }
        }
        __syncthreads();
        bf16x8 Al[4];
#pragma unroll
        for (int ks = 0; ks < 4; ++ks) { bf16x8 z = {0, 0, 0, 0, 0, 0, 0, 0};
            if (r32 < 8) z = *(const LAS bf16x8*)(QL + (r32 < 4 ? 2 * r32 : 2 * (r32 - 4) + 1) * 64 + ks * 16 + 8 * hi);
            Al[ks] = z; }
        TOC(1); TIC(2);
        const GAS char* kbase = (const GAS char*)(IK + (size_t)b * TKV * 64);
        const unsigned koff = (unsigned)(lane * 16);
        bf16x8 Bn[4];
        for (int rep_ = 0; rep_ < P5_REP_SCORE; ++rep_) {
        if (wid < nkt) {
#pragma unroll
            for (int ks = 0; ks < 4; ++ks) Bn[ks] = *(const GAS bf16x8*)(kbase + (koff + (unsigned)(wid * 4096 + ks * 1024)));
        }
        for (int kt = wid; kt < nkt; kt += 8) {
            bf16x8 Bf[4];
#pragma unroll
            for (int ks = 0; ks < 4; ++ks) Bf[ks] = Bn[ks];
            if (kt + 8 < nkt) {
#pragma unroll
                for (int ks = 0; ks < 4; ++ks) Bn[ks] = *(const GAS bf16x8*)(kbase + (koff + (unsigned)((kt + 8) * 4096 + ks * 1024)));
            }
            const int key = kt * 32 + r32;
            int wlo = hi * 16; asm volatile("" : "+v"(wlo));
            f32x16 acc[4], accl;
#pragma unroll
            for (int m_ = 0; m_ < P5_REP_MMA; ++m_) {
#pragma unroll
            for (int rb = 0; rb < 4; ++rb) acc[rb] = (f32x16){};
            accl = (f32x16){};
            __builtin_amdgcn_s_setprio(1);
#pragma unroll
            for (int ks = 0; ks < 4; ++ks) {
#pragma unroll
                for (int rb = 0; rb < 4; ++rb) acc[rb] = __builtin_amdgcn_mfma_f32_32x32x16_bf16(Af[rb][ks], Bf[ks], acc[rb], 0, 0, 0);
                accl = __builtin_amdgcn_mfma_f32_32x32x16_bf16(Al[ks], Bf[ks], accl, 0, 0, 0); }
            __builtin_amdgcn_s_setprio(0);
            if (m_ + 1 < P5_REP_MMA) asm volatile("" : "+v"(acc[0]), "+v"(acc[1]), "+v"(acc[2]), "+v"(acc[3]));
            }
#pragma unroll
            for (int v_ = 0; v_ < P5_REP_SCV; ++v_)
#pragma unroll
            for (int rb = 0; rb < 4; ++rb) {
                if (P5_REP_SCV > 1) asm volatile("" : "+v"(acc[rb]));
                const LAS f32x4* wl = (const LAS f32x4*)(WL + wlo + 32 * rb);
                const f32x4 w0 = wl[0], w1 = wl[1], w2 = wl[2], w3 = wl[3];
                const float wvr[16] = {w0.x, w0.y, w0.z, w0.w, w1.x, w1.y, w1.z, w1.w, w2.x, w2.y, w2.z, w2.w, w3.x, w3.y, w3.z, w3.w};
                float sc = accl[rb];
#pragma unroll
                for (int r = 0; r < 16; ++r) { const float a_ = acc[rb][r]; sc = fmaf(__builtin_fabsf(a_), wvr[r], sc); }
                sc = fminf(fmaxf(sc, -60000.f), 60000.f);
                const _Float16 hf = (_Float16)sc;
                const unsigned hb = (unsigned)__builtin_bit_cast(unsigned short, hf);
                unsigned sk = (hb & 0x8000u) ? (~hb & 0xffffu) : (hb | 0x8000u);
                sk = (sk >> 1) | 0x8000u;
                if (key > 16 + s0 + 2 * rb + hi) sk = 0x81ffu;
                S16[(2 * rb + hi) * SROWH + (key >> 6) * 66 + (key & 63)] = (unsigned short)sk;
            }
        }
        }
    }
    TOC(2); TIC(3);
    {
        LAS unsigned* row = (LAS unsigned*)(S16 + wid * SROWH);
        for (int k2 = nkt * 16 + lane; k2 < 4128; k2 += 64) row[(k2 >> 5) * 33 + (k2 & 31)] = 0x81ff81ffu;
    }
    asm volatile("s_waitcnt lgkmcnt(0)" ::: "memory"); __builtin_amdgcn_s_barrier(); asm volatile("" ::: "memory");
    TOC(3); TIC(4);
    {
        const LAS unsigned* srow = (const LAS unsigned*)(S16 + wid * SROWH);
        const bool second = nwords > 64, last = nwords > 128;
        unsigned d[64];
#pragma unroll
        for (int i = 0; i < 32; ++i) d[i] = srow[lane * 33 + i];
#pragma unroll
        for (int i = 0; i < 32; ++i) { const unsigned x = srow[(lane + 64) * 33 + i]; d[32 + i] = second ? x : 0x81ff81ffu; }
        unsigned d128 = 0x81ff81ffu;
        if (last) d128 = 0x81ff0000u | (unsigned)(S16 + wid * SROWH)[128 * 66 + lane];
#define CNT_GE(cnt_, c15) do { const unsigned C_ = (unsigned)(c15) * 0x10001u; \
            _Pragma("unroll") for (int i = 0; i < 32; ++i) cnt_ += (unsigned)__builtin_popcount((d[i] - C_) & 0x80008000u); \
            if (second) { _Pragma("unroll") for (int i = 32; i < 64; ++i) cnt_ += (unsigned)__builtin_popcount((d[i] - C_) & 0x80008000u); \
                cnt_ += (unsigned)__builtin_popcount((d128 - C_) & 0x80008000u); } } while (0)
        unsigned thr = 0u;
        for (int bit = 14; bit >= 0; --bit) {
            const unsigned cand = thr | (1u << bit); unsigned c = 0u;
            CNT_GE(c, cand);
            if (wave_sum_u(c) >= 256u) thr = cand;
        }
        TOC(4); TIC(5);
        if (thr < 0x0200u) thr = 0x0200u;
        unsigned cg = 0u, ce = 0u;
        CNT_GE(cg, thr + 1u); CNT_GE(ce, thr);
        const unsigned cgt = wave_sum_u(cg), cge = wave_sum_u(ce);
#undef CNT_GE
        const int need = 256 - (int)cgt;
        GAS unsigned* mrow = (GAS unsigned*)(MASK + ((size_t)(b * SEQ + s0 + wid)) * 130);
        if (cge <= 256u) {
            const unsigned T_ = thr * 0x10001u;
#pragma unroll
            for (int tt = 0; tt < 2; ++tt) {
                if (tt == 0 || second) {
                    unsigned w0 = 0u, w1 = 0u;
#pragma unroll
                    for (int i = 0; i < 32; ++i) {
                        const unsigned sw = d[32 * tt + i] - T_;
                        const unsigned b2 = ((sw >> 15) & 1u) | ((sw >> 30) & 2u);
                        constexpr int dummy_ = 0; (void)dummy_;
                        const int pos = 16 * (i >> 4) + 2 * (i & 1) + 4 * ((i & 15) >> 2);
                        if (((i & 15) >> 1) & 1) w1 |= b2 << pos; else w0 |= b2 << pos;
                    }
                    *(GAS v2u*)(mrow + 2 * (64 * tt + lane)) = (v2u){w0, w1};
                }
            }
            if (last) {
                const u64 w = __ballot((((d128 - T_) >> 15) & 1u) != 0u);
                const unsigned vl = (unsigned)w, vh = (unsigned)(w >> 32), ul = vl >> 4, uh = vh >> 4;
                const unsigned a0 = (vl & 0xFu) | ((vl >> 4) & 0xF0u) | ((vl >> 8) & 0xF00u) | ((vl >> 12) & 0xF000u), a1 = (ul & 0xFu) | ((ul >> 4) & 0xF0u) | ((ul >> 8) & 0xF00u) | ((ul >> 12) & 0xF000u);
                const unsigned b0 = (vh & 0xFu) | ((vh >> 4) & 0xF0u) | ((vh >> 8) & 0xF00u) | ((vh >> 12) & 0xF000u), b1 = (uh & 0xFu) | ((uh >> 4) & 0xF0u) | ((uh >> 8) & 0xF00u) | ((uh >> 12) & 0xF000u);
                if (lane == 0) { mrow[256] = a0 | (b0 << 16); mrow[257] = a1 | (b1 << 16); }
            }
        } else {
            const unsigned T_ = thr * 0x10001u, T1_ = (thr + 1u) * 0x10001u;
            unsigned e1 = 0u, e2 = 0u;
#pragma unroll
            for (int i = 0; i < 32; ++i) e1 += (unsigned)__builtin_popcount((d[i] - T_) & 0x80008000u) - (unsigned)__builtin_popcount((d[i] - T1_) & 0x80008000u);
#pragma unroll
            for (int i = 32; i < 64; ++i) e2 += (unsigned)__builtin_popcount((d[i] - T_) & 0x80008000u) - (unsigned)__builtin_popcount((d[i] - T1_) & 0x80008000u);
            int base1 = 0, base2 = 0, tot1 = 0, tot2 = 0;
#pragma unroll
            for (int bt = 0; bt < 7; ++bt) {
                const u64 m1 = __ballot(((e1 >> bt) & 1u) != 0u), m2 = __ballot(((e2 >> bt) & 1u) != 0u);
                base1 += (int)__builtin_amdgcn_mbcnt_hi((unsigned)(m1 >> 32), __builtin_amdgcn_mbcnt_lo((unsigned)m1, 0u)) << bt; tot1 += __popcll(m1) << bt;
                base2 += (int)__builtin_amdgcn_mbcnt_hi((unsigned)(m2 >> 32), __builtin_amdgcn_mbcnt_lo((unsigned)m2, 0u)) << bt; tot2 += __popcll(m2) << bt;
            }
#pragma unroll
            for (int tt = 0; tt < 2; ++tt) {
                if (tt == 0 || second) {
                    int quota = need - (tt == 0 ? base1 : tot1 + base2);
                    unsigned w0 = 0u, w1 = 0u;
#pragma unroll
                    for (int i = 0; i < 32; ++i) {
                        const unsigned sw = d[32 * tt + i] - T_, sg = d[32 * tt + i] - T1_;
                        const unsigned ge_lo = (sw >> 15) & 1u, ge_hi = (sw >> 31) & 1u, gt_lo = (sg >> 15) & 1u, gt_hi = (sg >> 31) & 1u;
                        const unsigned eq_lo = ge_lo ^ gt_lo, eq_hi = ge_hi ^ gt_hi;
                        const unsigned s_lo = gt_lo | (eq_lo & (quota > 0 ? 1u : 0u)); quota -= (int)eq_lo;
                        const unsigned s_hi = gt_hi | (eq_hi & (quota > 0 ? 1u : 0u)); quota -= (int)eq_hi;
                        const unsigned b2 = s_lo | (s_hi << 1);
                        const int pos = 16 * (i >> 4) + 2 * (i & 1) + 4 * ((i & 15) >> 2);
                        if (((i & 15) >> 1) & 1) w1 |= b2 << pos; else w0 |= b2 << pos;
                    }
                    *(GAS v2u*)(mrow + 2 * (64 * tt + lane)) = (v2u){w0, w1};
                }
            }
            if (last) {
                const unsigned k128 = d128 & 0x7fffu;
                const u64 em = __ballot(k128 == thr);
                const int rank = tot1 + tot2 + (int)__builtin_amdgcn_mbcnt_hi((unsigned)(em >> 32), __builtin_amdgcn_mbcnt_lo((unsigned)em, 0u));
                const u64 w = __ballot(k128 > thr || (k128 == thr && rank < need));
                const unsigned vl = (unsigned)w, vh = (unsigned)(w >> 32), ul = vl >> 4, uh = vh >> 4;
                const unsigned a0 = (vl & 0xFu) | ((vl >> 4) & 0xF0u) | ((vl >> 8) & 0xF00u) | ((vl >> 12) & 0xF000u), a1 = (ul & 0xFu) | ((ul >> 4) & 0xF0u) | ((ul >> 8) & 0xF00u) | ((ul >> 12) & 0xF000u);
                const unsigned b0 = (vh & 0xFu) | ((vh >> 4) & 0xF0u) | ((vh >> 8) & 0xF00u) | ((vh >> 12) & 0xF000u), b1 = (uh & 0xFu) | ((uh >> 4) & 0xF0u) | ((uh >> 8) & 0xF00u) | ((uh >> 12) & 0xF000u);
                if (lane == 0) { mrow[256] = a0 | (b0 << 16); mrow[257] = a1 | (b1 << 16); }
            }
        }
    }
    asm volatile("s_waitcnt lgkmcnt(0)" ::: "memory"); __builtin_amdgcn_s_barrier(); asm volatile("" ::: "memory");
    TOC(5); TOC(0);
}

typedef short s16x4g __attribute__((ext_vector_type(4)));
template <int KSTEPS>
__device__ __forceinline__ void mma_ll(f32x16& acc, const LAS bf16* A, int sa, const LAS bf16* B, int sb, int r32, int hi) {
#pragma unroll
    for (int ks = 0; ks < KSTEPS; ++ks) {
        const bf16x8 a = *(const LAS bf16x8*)(A + r32 * sa + ks * 16 + 8 * hi), bb = *(const LAS bf16x8*)(B + r32 * sb + ks * 16 + 8 * hi);
        acc = __builtin_amdgcn_mfma_f32_32x32x16_bf16(a, bb, acc, 0, 0, 0);
    }
}
__device__ __forceinline__ bf16x8 tr_frag(unsigned base, int pb, int lane) {
    const unsigned a0 = base + (unsigned)((8 * (lane >> 5) + ((lane >> 2) & 3)) * pb + (16 * ((lane >> 4) & 1) + 4 * (lane & 3)) * 2), a1 = a0 + 4u * (unsigned)pb;
    s16x4g lo, hh;
    asm volatile("ds_read_b64_tr_b16 %0, %2\n\tds_read_b64_tr_b16 %1, %3\n\ts_waitcnt lgkmcnt(0)" : "=&v"(lo), "=&v"(hh) : "v"(a0), "v"(a1) : "memory");
    return (bf16x8){lo[0], lo[1], lo[2], lo[3], hh[0], hh[1], hh[2], hh[3]};
}
__device__ __forceinline__ float log_sigmoid_f(float z) { return fminf(z, 0.f) - __logf(1.0f + __expf(-fabsf(z))); }
__device__ __forceinline__ void gla_bcum(Frame& F, LAS float* BC, LAS float* GT, LAS float* GLs, int b, int h, int n, const float* Wg, const float* bg) {
    const GAS float* GLOW = (const GAS float*)(F.ws + WS_GLOW);
    const int k = F.tid & 127, ig = __builtin_amdgcn_readfirstlane(F.tid >> 7);
    if (F.tid < 256) { const int i = F.tid >> 2, pc = F.tid & 3; f32x4 v = {0.f, 0.f, 0.f, 0.f};
        if (!(n == 0 && i < 48)) v = *(const GAS f32x4*)(GLOW + ((size_t)b * TKV + 64 * n + i) * 16 + 4 * pc);
        *(LAS f32x4*)(GLs + i * 16 + 4 * pc) = v; }
    float wc[16];
#pragma unroll
    for (int r = 0; r < 16; ++r) wc[r] = Wg[r * 512 + h * 128 + k];
    const float bk = bg[h * 128 + k];
    __syncthreads();
    float run = 0.f, pre[16];
#pragma unroll
    for (int ii = 0; ii < 16; ++ii) {
        const int i = 16 * ig + ii; float lg = 0.f;
        if (!(n == 0 && i < 48)) {
            const LAS f32x4* gl = (const LAS f32x4*)(GLs + i * 16); float z = bk;
#pragma unroll
            for (int r4 = 0; r4 < 4; ++r4) { const f32x4 g4 = gl[r4];
                z = fmaf(g4.x, wc[4 * r4 + 0], z); z = fmaf(g4.y, wc[4 * r4 + 1], z); z = fmaf(g4.z, wc[4 * r4 + 2], z); z = fmaf(g4.w, wc[4 * r4 + 3], z); }
            lg = log_sigmoid_f(z) * (1.0f / 16.0f);
        }
        run += lg; pre[ii] = run;
    }
    GT[ig * 128 + k] = run;
    __syncthreads();
    float off = 0.f;
#pragma unroll
    for (int gq = 0; gq < 3; ++gq) off += (gq < ig) ? GT[gq * 128 + k] : 0.f;
#pragma unroll
    for (int ii = 0; ii < 16; ++ii) BC[(16 * ig + ii) * 128 + k] = pre[ii] + off;
    __syncthreads();
}
constexpr int GLA_VP = 288, GLA_KP1 = 160;
__device__ __forceinline__ void gla_load_vn(Frame& F, LAS bf16* Vn, int b, int h, int n) {
    const GAS bf16* GV = (const GAS bf16*)(F.ws + WS_GV);
    const int v0 = 8 * (F.tid & 31);
#pragma unroll
    for (int pass = 0; pass < 4; ++pass) {
        const int i = (F.tid >> 5) + 16 * pass, pp = 64 * n + i;
        v4u raw = {0u, 0u, 0u, 0u};
        if (!(n == 0 && i < 48)) raw = *(const GAS v4u*)(GV + ((size_t)b * TKV + pp) * 1024 + h * 256 + v0);
        *(LAS v4u*)(Vn + i * GLA_VP + v0) = raw;
    }
}
__device__ __forceinline__ void g1_unit(Frame& F, int b, int h, int n, const float* Wg, const float* bg) {
    const int lane = F.lane, wid = F.wave, r32 = lane & 31, hi = lane >> 5, tid = F.tid;
    LAS float* BC = (LAS float*)F.lds; LAS float* GLs = (LAS float*)(F.lds + 32768); LAS bf16* KD = (LAS bf16*)(F.lds + 36864); LAS bf16* Vn = (LAS bf16*)(F.lds + 57344);
    const GAS bf16* GK = (const GAS bf16*)(F.ws + WS_GK); GAS bf16* ST = (GAS bf16*)(F.ws + WS_ST); GAS float* DEC = (GAS float*)(F.ws + WS_DEC);
    TIC(10); gla_bcum(F, BC, (LAS float*)(F.lds + 131072), GLs, b, h, n, Wg, bg); TOC(10); TIC(11);
    { const int k0 = 8 * (tid & 15);
#pragma unroll
      for (int pass = 0; pass < 2; ++pass) {
        const int i = (tid >> 4) + 32 * pass, pp = 64 * n + i;
        v4u raw = {0u, 0u, 0u, 0u};
        if (!(n == 0 && i < 48)) raw = *(const GAS v4u*)(GK + ((size_t)b * TKV + pp) * 512 + h * 128 + k0);
        const unsigned rw[4] = {raw.x, raw.y, raw.z, raw.w}; float kd[8];
        const f32x4 bc0 = *(const LAS f32x4*)(BC + i * 128 + k0), bc1 = *(const LAS f32x4*)(BC + i * 128 + k0 + 4), bl0 = *(const LAS f32x4*)(BC + 63 * 128 + k0), bl1 = *(const LAS f32x4*)(BC + 63 * 128 + k0 + 4);
        const float bcv[8] = {bc0.x, bc0.y, bc0.z, bc0.w, bc1.x, bc1.y, bc1.z, bc1.w}, blv[8] = {bl0.x, bl0.y, bl0.z, bl0.w, bl1.x, bl1.y, bl1.z, bl1.w};
#pragma unroll
        for (int j = 0; j < 8; ++j) { const float kv = (j & 1) ? bfhi(rw[j >> 1]) : bflo(rw[j >> 1]); kd[j] = kv * __expf(blv[j] - bcv[j]); }
        *(LAS v4u*)(KD + i * GLA_KP1 + k0) = (v4u){pk2(kd[0], kd[1]), pk2(kd[2], kd[3]), pk2(kd[4], kd[5]), pk2(kd[6], kd[7])};
      } }
    gla_load_vn(F, Vn, b, h, n);
    __syncthreads();
    TOC(11); TIC(12);
    GAS bf16* dst = ST + ((size_t)((b * 4 + h) * 128 + n) * 256) * 128;
    const float declast = (tid < 128) ? __expf(BC[63 * 128 + tid]) : 0.f;
    f32x16 acc[4];
    {
        const unsigned vb = (unsigned)(uintptr_t)Vn + (unsigned)(32 * wid * 2), kb = (unsigned)(uintptr_t)KD;
        bf16x8 af[4];
#pragma unroll
        for (int ks = 0; ks < 4; ++ks) af[ks] = tr_frag(vb + (unsigned)(16 * ks * GLA_VP * 2), GLA_VP * 2, lane);
#pragma unroll
        for (int cb = 0; cb < 4; ++cb) { acc[cb] = (f32x16){};
#pragma unroll
            for (int ks = 0; ks < 4; ++ks) acc[cb] = __builtin_amdgcn_mfma_f32_32x32x16_bf16(af[ks], tr_frag(kb + (unsigned)(16 * ks * GLA_KP1 * 2 + 32 * cb * 2), GLA_KP1 * 2, lane), acc[cb], 0, 0, 0); }
    }
    __syncthreads();
    {   LAS bf16* LT = (LAS bf16*)F.lds;
#pragma unroll
        for (int cb = 0; cb < 4; ++cb)
#pragma unroll
            for (int r = 0; r < 16; ++r) LT[(32 * wid + (r & 3) + 8 * (r >> 2) + 4 * hi) * 128 + 32 * cb + r32] = (bf16)f2bf(acc[cb][r]);
        __syncthreads();
        const LAS v4u* src = (const LAS v4u*)F.lds; GAS v4u* d4 = (GAS v4u*)dst;
#pragma unroll
        for (int q = 0; q < 8; ++q) d4[q * 512 + tid] = src[q * 512 + tid];
    }
    if (tid < 128) DEC[(size_t)((b * 4 + h) * 128 + n) * 128 + tid] = declast;
    __syncthreads();
    TOC(12);
}
__device__ __forceinline__ void g2_scan(Frame& F) {
    GAS bf16* ST = (GAS bf16*)(F.ws + WS_ST); const GAS float* DEC = (const GAS float*)(F.ws + WS_DEC);
    const int NG = F.G * NWAVES * 64;
    for (int e = F.vcu * (NWAVES * 64) + F.tid; e < 8 * 16384; e += NG) {
        const int bh = e >> 14, rem = e & 16383, v = rem >> 6, k = (rem & 63) * 2;
        GAS unsigned* p = (GAS unsigned*)(ST + ((size_t)bh * 128 * 256 + v) * 128 + k);
        const GAS float* d = DEC + (size_t)bh * 128 * 128 + k;
        float s0 = 0.f, s1 = 0.f;
        for (int n = 0; n < 128; n += 8) {
            unsigned w[8]; float d0[8], d1[8];
#pragma unroll
            for (int u = 0; u < 8; ++u) { w[u] = p[(size_t)(n + u) * 16384]; d0[u] = d[(n + u) * 128]; d1[u] = d[(n + u) * 128 + 1]; }
#pragma unroll
            for (int u = 0; u < 8; ++u) { s0 = fmaf(s0, d0[u], bflo(w[u])); s1 = fmaf(s1, d1[u], bfhi(w[u])); p[(size_t)(n + u) * 16384] = pk2(s0, s1); }
        }
    }
}
__device__ __forceinline__ void g3_unit(Frame& F, int b, int h, int c, const float* Wg, const float* bg, const float* ggla) {
    const int lane = F.lane, wid = F.wave, r32 = lane & 31, hi = lane >> 5, tid = F.tid;
    LAS float* BC = (LAS float*)F.lds; LAS bf16* Q1 = (LAS bf16*)(F.lds + 32768); LAS bf16* Q2 = (LAS bf16*)(F.lds + 50176); LAS bf16* KD = (LAS bf16*)(F.lds + 67584);
    LAS bf16* Vn = (LAS bf16*)(F.lds + 84992); LAS bf16* AT = (LAS bf16*)(F.lds + 121856); LAS float* OS = (LAS float*)F.lds; LAS float* GLs = (LAS float*)(F.lds + 133120);
    const GAS bf16* GQ = (const GAS bf16*)(F.ws + WS_GQ); const GAS bf16* GK = (const GAS bf16*)(F.ws + WS_GK); const GAS bf16* GO = (const GAS bf16*)(F.ws + WS_GO);
    const GAS bf16* ST = (const GAS bf16*)(F.ws + WS_ST); GAS bf16* MIXA = (GAS bf16*)(F.ws + WS_MIXA);
    const int rbI = wid & 1, cbV = (wid >> 1) * 2;
    bf16x8 sf[8][2];
    { const GAS bf16* sp = ST + ((size_t)((b * 4 + h) * 128 + (c - 1)) * 256) * 128;
#pragma unroll
      for (int ks = 0; ks < 8; ++ks)
#pragma unroll
        for (int t = 0; t < 2; ++t) sf[ks][t] = *(const GAS bf16x8*)(sp + (size_t)(32 * (cbV + t) + r32) * 128 + ks * 16 + 8 * hi); }
    TIC(13); gla_bcum(F, BC, (LAS float*)(F.lds + 131072), GLs, b, h, c, Wg, bg); TOC(13); TIC(14);
    { const int k0 = 8 * (tid & 15);
#pragma unroll
      for (int pass = 0; pass < 2; ++pass) {
        const int i = (tid >> 4) + 32 * pass, pp = 64 * c + i;
        const v4u rq = *(const GAS v4u*)(GQ + ((size_t)b * TKV + pp) * 512 + h * 128 + k0);
        const v4u rk = *(const GAS v4u*)(GK + ((size_t)b * TKV + pp) * 512 + h * 128 + k0);
        const unsigned qw[4] = {rq.x, rq.y, rq.z, rq.w}, kw[4] = {rk.x, rk.y, rk.z, rk.w};
        const f32x4 bc0 = *(const LAS f32x4*)(BC + i * 128 + k0), bc1 = *(const LAS f32x4*)(BC + i * 128 + k0 + 4), bl0 = *(const LAS f32x4*)(BC + 63 * 128 + k0), bl1 = *(const LAS f32x4*)(BC + 63 * 128 + k0 + 4);
        const float bcv[8] = {bc0.x, bc0.y, bc0.z, bc0.w, bc1.x, bc1.y, bc1.z, bc1.w}, blv[8] = {bl0.x, bl0.y, bl0.z, bl0.w, bl1.x, bl1.y, bl1.z, bl1.w};
        float q1[8], q2[8], kd[8];
#pragma unroll
        for (int j = 0; j < 8; ++j) { const float qv = (j & 1) ? bfhi(qw[j >> 1]) : bflo(qw[j >> 1]), kv = (j & 1) ? bfhi(kw[j >> 1]) : bflo(kw[j >> 1]);
            const float e1 = __expf(bcv[j] - blv[j]);
            q1[j] = qv * __expf(bcv[j]); q2[j] = qv * e1; kd[j] = kv * __builtin_amdgcn_rcpf(e1); }
        *(LAS v4u*)(Q1 + i * 136 + k0) = (v4u){pk2(q1[0], q1[1]), pk2(q1[2], q1[3]), pk2(q1[4], q1[5]), pk2(q1[6], q1[7])};
        *(LAS v4u*)(Q2 + i * 136 + k0) = (v4u){pk2(q2[0], q2[1]), pk2(q2[2], q2[3]), pk2(q2[4], q2[5]), pk2(q2[6], q2[7])};
        *(LAS v4u*)(KD + i * 136 + k0) = (v4u){pk2(kd[0], kd[1]), pk2(kd[2], kd[3]), pk2(kd[4], kd[5]), pk2(kd[6], kd[7])};
      } }
    gla_load_vn(F, Vn, b, h, c);
    __syncthreads();
    TOC(14); TIC(15);
    f32x16 acc[2] = {};
#pragma unroll
    for (int ks = 0; ks < 8; ++ks) {
        const bf16x8 a = *(const LAS bf16x8*)(Q1 + (32 * rbI + r32) * 136 + ks * 16 + 8 * hi);
#pragma unroll
        for (int t = 0; t < 2; ++t) acc[t] = __builtin_amdgcn_mfma_f32_32x32x16_bf16(a, sf[ks][t], acc[t], 0, 0, 0);
    }
    if (wid < 4) {
        const int ib = wid & 1, jb = wid >> 1;
        f32x16 at = {};
        mma_ll<8>(at, Q2 + (32 * ib) * 136, 136, KD + (32 * jb) * 136, 136, r32, hi);
#pragma unroll
        for (int r = 0; r < 16; ++r) { const int i = 32 * ib + (r & 3) + 8 * (r >> 2) + 4 * hi, j = 32 * jb + r32;
            AT[i * 72 + j] = (bf16)f2bf(j <= i ? at[r] : 0.f); }
    }
    __syncthreads();
    TOC(15); TIC(16);
    {
        const unsigned vb = (unsigned)(uintptr_t)Vn;
#pragma unroll
        for (int ks = 0; ks < 4; ++ks) {
            const bf16x8 a = *(const LAS bf16x8*)(AT + (32 * rbI + r32) * 72 + ks * 16 + 8 * hi);
#pragma unroll
            for (int t = 0; t < 2; ++t) acc[t] = __builtin_amdgcn_mfma_f32_32x32x16_bf16(a, tr_frag(vb + (unsigned)(16 * ks * GLA_VP * 2 + 32 * (cbV + t) * 2), GLA_VP * 2, lane), acc[t], 0, 0, 0);
        }
    }
    __syncthreads();
#pragma unroll
    for (int t = 0; t < 2; ++t)
#pragma unroll
        for (int r = 0; r < 16; ++r) OS[(32 * rbI + (r & 3) + 8 * (r >> 2) + 4 * hi) * 260 + 32 * (cbV + t) + r32] = acc[t][r];
    __syncthreads();
    {
        const int i = tid >> 3, seg = tid & 7; const LAS float* orow = OS + i * 260 + 32 * seg;
        float ss = 0.f; f32x4 ov[8];
#pragma unroll
        for (int q = 0; q < 8; ++q) { ov[q] = *(const LAS f32x4*)(orow + 4 * q); ss += (ov[q].x * ov[q].x + ov[q].y * ov[q].y) + (ov[q].z * ov[q].z + ov[q].w * ov[q].w); }
        ss += __shfl_xor(ss, 1); ss += __shfl_xor(ss, 2); ss += __shfl_xor(ss, 4);
        const float rs = 1.0f / sqrtf(ss * (1.0f / 256.0f) + EPS);
        const size_t row = (size_t)b * SEQ + 64 * (c - 1) + i;
        const float* gn = ggla + 32 * seg;
        const GAS bf16* gp = GO + row * 1024 + h * 256 + 32 * seg;
        GAS bf16* op = MIXA + row * 2048 + 1024 + h * 256 + 32 * seg;
#pragma unroll
        for (int q2 = 0; q2 < 4; ++q2) {
            const v4u gw = *(const GAS v4u*)(gp + 8 * q2);
            const f32x4 g0 = *(const f32x4*)(gn + 8 * q2), g1 = *(const f32x4*)(gn + 8 * q2 + 4);
            const f32x4 a = ov[2 * q2], bq = ov[2 * q2 + 1];
            float y[8];
            y[0] = a.x * rs * g0.x * pg8::silu_f(bflo(gw.x)); y[1] = a.y * rs * g0.y * pg8::silu_f(bfhi(gw.x));
            y[2] = a.z * rs * g0.z * pg8::silu_f(bflo(gw.y)); y[3] = a.w * rs * g0.w * pg8::silu_f(bfhi(gw.y));
            y[4] = bq.x * rs * g1.x * pg8::silu_f(bflo(gw.z)); y[5] = bq.y * rs * g1.y * pg8::silu_f(bfhi(gw.z));
            y[6] = bq.z * rs * g1.z * pg8::silu_f(bflo(gw.w)); y[7] = bq.w * rs * g1.w * pg8::silu_f(bfhi(gw.w));
            *(GAS v4u*)(op + 8 * q2) = (v4u){pk2(y[0], y[1]), pk2(y[2], y[3]), pk2(y[4], y[5]), pk2(y[6], y[7])};
        }
    }
    __syncthreads();
    TOC(16);
}
__device__ __forceinline__ att::BlockRef att_ref(Frame& F, int bh, int qb) {
    const int b = bh >> 3, h = bh & 7; att::BlockRef r;
    r.Q = (const bf16*)(F.ws + WS_QH) + ((size_t)bh * SEQ + (size_t)qb * 256) * 128;
    r.K = (const bf16*)(F.ws + WS_KH) + (size_t)bh * TKV * 128; r.V = (const bf16*)(F.ws + WS_VH) + (size_t)bh * TKV * 128;
    r.O = (bf16*)(F.ws + WS_MIXA) + ((size_t)b * SEQ + (size_t)qb * 256) * 2048 + h * 128;
    r.M = (const u64*)(F.ws + WS_MASK) + ((size_t)b * SEQ + (size_t)qb * 256) * 130;
    r.NT = 4 * qb + 5;
    return r;
}
__device__ __forceinline__ void p7_attention(Frame& F) {
    constexpr int total = 256;
    int L = F.vcu; if (L >= total) return;
    int pass = 0;
    att::BlockRef cur = att_ref(F, L >> 4, L & 15);
    att::Seam S;
    att::att_prime(cur, (char*)F.ldsg, S);
    for (;;) {
        const bool more_pass = pass == 0, more_item = L + F.G < total, last = !more_pass && !more_item;
        int passn = pass + 1, Ln = L;
        if (!more_pass) { passn = 0; Ln = more_item ? L + F.G : L; }
        const att::BlockRef nxt = last ? cur : att_ref(F, Ln >> 4, passn ? 31 - (Ln & 15) : (Ln & 15));
        att::att_block(cur, nxt, (char*)F.ldsg, S);
        if (last) break;
        cur = nxt; pass = passn; L = Ln;
    }
}
typedef float f32x4s __attribute__((ext_vector_type(4)));
template <int KSTEPS>
__device__ __forceinline__ f32x4s skinny_k(const GAS bf16* a, const GAS bf16* b) {
    f32x4s acc = {0.f, 0.f, 0.f, 0.f};
#pragma unroll
    for (int ks = 0; ks < KSTEPS; ++ks) acc = __builtin_amdgcn_mfma_f32_16x16x32_bf16(*(const GAS bf16x8*)(a + 32 * ks), *(const GAS bf16x8*)(b + 32 * ks), acc, 0, 0, 0);
    return acc;
}
__device__ __forceinline__ f32x4s wg_reduce(Frame& F, LAS f32x4s* red, f32x4s v) {
    red[F.wave * 64 + F.lane] = v;
    __syncthreads();
    f32x4s s = red[F.lane];
#pragma unroll
    for (int w = 1; w < NWAVES; ++w) s += red[w * 64 + F.lane];
    __syncthreads();
    return s;
}
template <int STEPS>
__device__ __forceinline__ f32x4s skinny_k8(const GAS unsigned char* a, const GAS unsigned char* b) {
    typedef int v8i_s __attribute__((ext_vector_type(8)));
    f32x4s acc = {0.f, 0.f, 0.f, 0.f};
#pragma unroll
    for (int st = 0; st < STEPS; ++st) {
        const v4u a0 = *(const GAS v4u*)(a + 128 * st), a1 = *(const GAS v4u*)(a + 128 * st + 16), b0 = *(const GAS v4u*)(b + 128 * st), b1 = *(const GAS v4u*)(b + 128 * st + 16);
        const v8i_s av = {(int)a0.x, (int)a0.y, (int)a0.z, (int)a0.w, (int)a1.x, (int)a1.y, (int)a1.z, (int)a1.w}, bv = {(int)b0.x, (int)b0.y, (int)b0.z, (int)b0.w, (int)b1.x, (int)b1.y, (int)b1.z, (int)b1.w};
        acc = __builtin_amdgcn_mfma_scale_f32_16x16x128_f8f6f4(av, bv, acc, 0, 0, 0, 0x7f7f7f7f, 0, 0x7f7f7f7f);
    }
    return acc;
}
template <bool FP8>
__device__ __forceinline__ void meta_p1(Frame& F) {
    const int c = F.lane & 15, kq = F.lane >> 4; LAS f32x4s* red = (LAS f32x4s*)F.lds;
    const GAS bf16* AB = (const GAS bf16*)(F.ws + WS_AB); const GAS bf16* WGU = (const GAS bf16*)(F.ws + WS_WGU); GAS bf16* ACT = (GAS bf16*)(F.ws + WS_ACT);
    const GAS unsigned char* X8 = (const GAS unsigned char*)(F.ws + WS_F); const GAS unsigned char* W8 = (const GAS unsigned char*)(F.ws + WS_WGU);
    const GAS float* rstd = (const GAS float*)(F.ws + WS_RSTD1);
    for (int u = F.vcu; u < 352; u += F.G) {
        const int tile = u >> 3, j = u & 7, k0 = F.wave * (DM / 8);
        f32x4s ag, au;
        if (FP8) { const GAS unsigned char* a = X8 + (size_t)(R + c) * DM + k0 + 32 * kq; const GAS unsigned char* bg = W8 + (size_t)(tile * 256 + 16 * j + c) * DM + k0 + 32 * kq;
            ag = wg_reduce(F, red, skinny_k8<DM / 1024>(a, bg)); au = wg_reduce(F, red, skinny_k8<DM / 1024>(a, bg + (size_t)128 * DM)); }
        else { const GAS bf16* a = AB + (size_t)(R + c) * DM + k0 + 8 * kq; const GAS bf16* bg = WGU + (size_t)(tile * 256 + 16 * j + c) * DM + k0 + 8 * kq;
            ag = wg_reduce(F, red, skinny_k<DM / 256>(a, bg)); au = wg_reduce(F, red, skinny_k<DM / 256>(a, bg + (size_t)128 * DM)); }
        if (F.wave == 0) {
#pragma unroll
            for (int q = 0; q < 4; ++q) { const int m = 4 * kq + q; const float rs = rstd[R + m] * (FP8 ? 1.0f / W8_SCALE : 1.0f);
                ACT[(size_t)(R + m) * DFF + tile * 128 + 16 * j + c] = (bf16)f2bf(pg8::silu_f(ag[q] * rs) * (au[q] * rs)); }
        }
    }
}
__device__ __forceinline__ void meta_p2(Frame& F) {
    const int c = F.lane & 15, kq = F.lane >> 4; LAS f32x4s* red = (LAS f32x4s*)F.lds;
    const GAS bf16* ACT = (const GAS bf16*)(F.ws + WS_ACT); const GAS bf16* WD = (const GAS bf16*)(F.ws + WS_WD); GAS bf16* FB = (GAS bf16*)(F.ws + WS_F);
    for (int u = F.vcu; u < 128; u += F.G) {
        const int k0 = F.wave * (DFF / 8);
        const f32x4s acc = wg_reduce(F, red, skinny_k<DFF / 256>(ACT + (size_t)(R + c) * DFF + k0 + 8 * kq, WD + (size_t)(16 * u + c) * DFF + k0 + 8 * kq));
        if (F.wave == 0) {
#pragma unroll
            for (int q = 0; q < 4; ++q) FB[(size_t)(R + 4 * kq + q) * DM + 16 * u + c] = (bf16)f2bf(acc[q]);
        }
    }
}
__device__ __forceinline__ void meta_p4(Frame& F) {
    const int c = F.lane & 15, kq = F.lane >> 4; LAS f32x4s* red = (LAS f32x4s*)F.lds;
    const GAS bf16* AB = (const GAS bf16*)(F.ws + WS_AB); const GAS bf16* WIN = (const GAS bf16*)(F.ws + WS_WIN); const GAS float* rstd = (const GAS float*)(F.ws + WS_RSTD2);
    GAS bf16* Kh = (GAS bf16*)(F.ws + WS_KH); GAS bf16* Vh = (GAS bf16*)(F.ws + WS_VH); GAS bf16* GK = (GAS bf16*)(F.ws + WS_GK); GAS bf16* GV = (GAS bf16*)(F.ws + WS_GV);
    GAS bf16* IK = (GAS bf16*)(F.ws + WS_IK); GAS float* GLOW = (GAS float*)(F.ws + WS_GLOW);
    for (int u = F.vcu; u < 230; u += F.G) {
        int sec, cs;
        if (u < 64) { sec = 0; cs = u * 16; } else if (u < 128) { sec = 1; cs = (u - 64) * 16; } else if (u < 160) { sec = 2; cs = (u - 128) * 16; } else if (u < 224) { sec = 3; cs = (u - 160) * 16; } else { sec = 4; cs = (u - 224) * 16; }
        const int wrow = (sec == 0 ? 4 * 256 : sec == 1 ? 8 * 256 : sec == 2 ? 18 * 256 : sec == 3 ? 20 * 256 : 7168) + cs, k0 = F.wave * (DM / 8);
        const f32x4s acc = wg_reduce(F, red, skinny_k<DM / 256>(AB + (size_t)(R + c) * DM + k0 + 8 * kq, WIN + (size_t)(wrow + c) * DM + k0 + 8 * kq));
        if (F.wave == 0) {
            const int col = cs + c;
#pragma unroll
            for (int q = 0; q < 4; ++q) { const int m = 4 * kq + q; const float vf = acc[q] * rstd[R + m]; const bf16 v = (bf16)f2bf(vf);
                if (sec == 4) {
                    if (col < 64) { const int ch = col >> 3, fo = (ch >> 1) * 512 + (ch & 1) * 256 + (col & 7); IK[fo + m * 8] = v; IK[(size_t)TKV * 64 + fo + m * 8] = v; }
                    else if (col >= 80) { GLOW[((size_t)48 + m) * 16 + (col - 80)] = vf; GLOW[((size_t)TKV + 48 + m) * 16 + (col - 80)] = vf; }
                } else if (sec < 2) { GAS bf16* base = sec == 0 ? Kh : Vh; const int h = col >> 7, d = col & 127;
                    base[((size_t)h * TKV + m) * 128 + d] = v; base[((size_t)(8 + h) * TKV + m) * 128 + d] = v; }
                else if (sec == 2) { GK[((size_t)48 + m) * 512 + col] = v; GK[((size_t)TKV + 48 + m) * 512 + col] = v; }
                else { GV[((size_t)48 + m) * 1024 + col] = v; GV[((size_t)TKV + 48 + m) * 1024 + col] = v; }
            }
        }
    }
}
__device__ __forceinline__ void small_cols(Frame& F) {
    const int c = F.lane & 15, kq = F.lane >> 4, rg = F.wave & 3, ch3 = (F.wave >> 2) * 3;
    const GAS bf16* AB = (const GAS bf16*)(F.ws + WS_AB); const GAS bf16* WIN = (const GAS bf16*)(F.ws + WS_WIN); const GAS float* rstd = (const GAS float*)(F.ws + WS_RSTD2);
    GAS bf16* IK = (GAS bf16*)(F.ws + WS_IK); GAS float* IW = (GAS float*)(F.ws + WS_IW); GAS float* GLOW = (GAS float*)(F.ws + WS_GLOW);
    LAS bf16* Bs = (LAS bf16*)F.lds; constexpr int BP = 264;
    for (int u = F.vcu; u < 256; u += F.G) {
        const int r0 = 64 * u + 16 * rg;
        const GAS bf16* a = AB + (size_t)(r0 + c) * DM + 8 * kq;
        const GAS bf16* bsrc = WIN + (size_t)7168 * DM;
        f32x4s acc[3];
#pragma unroll
        for (int g = 0; g < 3; ++g) acc[g] = (f32x4s){0.f, 0.f, 0.f, 0.f};
        v4u breg[6]; bf16x8 an[8];
#pragma unroll
        for (int i = 0; i < 6; ++i) { const int p = F.tid + 512 * i; breg[i] = *(const GAS v4u*)(bsrc + (size_t)(p >> 5) * DM + (p & 31) * 8); }
#pragma unroll
        for (int ks = 0; ks < 8; ++ks) an[ks] = *(const GAS bf16x8*)(a + 32 * ks);
        for (int kc = 0; kc < 8; ++kc) {
#pragma unroll
            for (int i = 0; i < 6; ++i) { const int p = F.tid + 512 * i; *(LAS v4u*)(Bs + (p >> 5) * BP + (p & 31) * 8) = breg[i]; }
            bf16x8 ac[8];
#pragma unroll
            for (int ks = 0; ks < 8; ++ks) ac[ks] = an[ks];
            __syncthreads();
            if (kc + 1 < 8) {
#pragma unroll
                for (int i = 0; i < 6; ++i) { const int p = F.tid + 512 * i; breg[i] = *(const GAS v4u*)(bsrc + (size_t)(p >> 5) * DM + (kc + 1) * 256 + (p & 31) * 8); }
#pragma unroll
                for (int ks = 0; ks < 8; ++ks) an[ks] = *(const GAS bf16x8*)(a + (kc + 1) * 256 + 32 * ks);
            }
#pragma unroll
            for (int ks = 0; ks < 8; ++ks)
#pragma unroll
                for (int g = 0; g < 3; ++g) acc[g] = __builtin_amdgcn_mfma_f32_16x16x32_bf16(ac[ks], *(const LAS bf16x8*)(Bs + (16 * (ch3 + g) + c) * BP + 32 * ks + 8 * kq), acc[g], 0, 0, 0);
            __syncthreads();
        }
#pragma unroll
        for (int q = 0; q < 4; ++q) {
            const int row = r0 + 4 * kq + q; const float rs = rstd[row]; const int bb = row >> 13, s = row & 8191, pos = 16 + s;
#pragma unroll
            for (int g = 0; g < 3; ++g) {
                const float v = acc[g][q] * rs; const int col = 16 * (ch3 + g) + c;
                if (col < 64) {
                    const int ch = col >> 3, fo = (ch >> 1) * 512 + (ch & 1) * 256 + (col & 7);
                    IK[(size_t)bb * TKV * 64 + (size_t)(pos >> 5) * 2048 + fo + (pos & 31) * 8] = (bf16)f2bf(v);
                } else if (col < 80) IW[(size_t)row * 16 + (col - 64)] = v * 0.25f;
                else GLOW[((size_t)bb * TKV + 64 + s) * 16 + (col - 80)] = v;
            }
        }
    }
}

struct Args { const float* in[19]; float* out; unsigned char* ws; int ph_lo, ph_hi; };
#ifndef FFN1_FP8
#define FFN1_FP8 false
#endif
#ifndef FFN2_FP8
#define FFN2_FP8 true
#endif
#ifndef PG8_SP2
#define PG8_SP2 true
#endif
#ifndef PG8_ALIGN
#define PG8_ALIGN true
#endif
__global__ void __launch_bounds__(NWAVES * 64, 2) hymba_fwd(Args args) {
    extern __shared__ __attribute__((aligned(16))) unsigned char lds[];
    Frame F;
    F.lds = (LAS unsigned char*)lds; F.ldsg = lds;
    F.MISC = (volatile LAS unsigned*)(F.lds + MISC_OFF);
    F.tid = threadIdx.x; F.lane = F.tid & 63; F.wave = __builtin_amdgcn_readfirstlane(F.tid >> 6);
    F.G = gridDim.x; { const int bx = blockIdx.x; F.vcu = (F.G % 8 == 0) ? (bx % 8) * (F.G / 8) + bx / 8 : bx; }
    F.ws = args.ws; F.ctl = (unsigned*)(args.ws + WS_CTL); F.out = args.out;
    for (int u = F.tid; u < (LDS_BYTES - MISC_OFF) / 4; u += NWAVES * 64) ((LAS unsigned*)(F.lds + MISC_OFF))[u] = 0u;
    __syncthreads();
    XcdBarrier bar; bar.bar = F.ctl + CW_BAR; bar.x = 0; bar.st = nullptr;
    if (!MK_PER_PHASE) bar = xcd_barrier_post(F.ctl + CW_BAR, F.MISC + 8);
    const int lo = args.ph_lo, hi = args.ph_hi;
#define PHASE_BEGIN() do { int t_ = threadIdx.x; asm volatile("" : "+v"(t_)); F.tid = t_; F.lane = t_ & 63; F.wave = __builtin_amdgcn_readfirstlane(t_ >> 6); } while (0)
#ifndef PH_MASK
#define PH_MASK 0x1fff
#endif
#define IN(k) ((((PH_MASK) >> (k)) & 1) && lo <= (k) && (k) < hi)
#define SEAM(k) do { if (!MK_PER_PHASE && IN((k) + 1)) { TIC(30); TIC(40 + (k)); xcd_barrier(bar); TOC(40 + (k)); TOC(30); } } while (0)
#ifndef PH_DUP
#define PH_DUP 0
#endif
#define AB ((bf16*)(F.ws + WS_AB))
#define ACT ((bf16*)(F.ws + WS_ACT))
#define FB ((bf16*)(F.ws + WS_F))
#define WGU ((bf16*)(F.ws + WS_WGU))
#define WD ((bf16*)(F.ws + WS_WD))
#define WIN ((bf16*)(F.ws + WS_WIN))
#define WOUT ((bf16*)(F.ws + WS_WOUT))
#define rstd1 ((float*)(F.ws + WS_RSTD1))
#define rstd2 ((float*)(F.ws + WS_RSTD2))
#define rstd3 ((float*)(F.ws + WS_RSTD3))

    #define BODY0 do { TIC(70); convert_ffn<FFN1_FP8>(F, args.in[I_W1G], args.in[I_W1U], args.in[I_W1D], args.in[I_G1PRE], WGU, WD); TOC(70); TIC(71); p0_rows<FFN1_FP8>(F, args.in[I_X], args.in[I_META], F.ws + WS_F); TOC(71); } while (0)
    if (IN(0)) { PHASE_BEGIN();
#if (PH_DUP >> 0) & 1
        BODY0; xcd_barrier(bar);
#endif
        BODY0; SEAM(0); }
    if (IN(1)) { PHASE_BEGIN();
        pg8::Gemm g{FFN1_FP8 ? (const bf16*)(F.ws + WS_F) : AB, WGU, R, NGU, FFN1_FP8 ? DM / 2 : DM}; pg8::StaticOrder S; S.init(R, NGU, F.G, (int)blockIdx.x);
        pg8::EpiSwiGLU E{ACT, DFF, rstd1, FFN1_FP8 ? 1.0f / W8_SCALE : 1.0f};
#if (PH_DUP >> 1) & 1
        pg8::gemm_phase<pg8::EpiSwiGLU, pg8::StaticOrder, PG8_ALIGN, PG8_SP2, FFN1_FP8>(F.lds, g, S, E); xcd_barrier(bar);
#endif
        TIC(60); TICC(61); pg8::gemm_phase<pg8::EpiSwiGLU, pg8::StaticOrder, PG8_ALIGN, PG8_SP2, FFN1_FP8>(F.lds, g, S, E); TOCC(61); TOC(60);
        TIC(6); meta_p1<FFN1_FP8>(F); TOC(6);
        SEAM(1);
    }
    if (IN(2)) { PHASE_BEGIN();
        pg8::Gemm g{ACT, WD, R, DM, DFF}; pg8::StaticOrder S; S.init(R, DM, F.G, (int)blockIdx.x);
        pg8::EpiStoreBf16 E{FB, DM};
        pg8::gemm_phase<pg8::EpiStoreBf16, pg8::StaticOrder, PG8_ALIGN, PG8_SP2>(F.lds, g, S, E);
        TIC(7); meta_p2(F); TOC(7);
        SEAM(2);
    }
    #define BODY3 do { norm_rows<0>(F, args.in[I_G1POST], rstd2, args.in[I_X], args.in[I_META]); convert_mix(F, args.in[I_WIN], args.in[I_WOUT], args.in[I_GMIX], WIN, WOUT); } while (0)
    if (IN(3)) { PHASE_BEGIN();
#if (PH_DUP >> 3) & 1
        BODY3; xcd_barrier(bar);
#endif
        BODY3; SEAM(3); }
    if (IN(4)) { PHASE_BEGIN();
        zero_pads(F);
        pg8::Gemm g{AB, WIN, R, 7168, DM}; pg8::StaticOrder S; S.init(R, 7168, F.G, (int)blockIdx.x);
        pg8::EpiProj E{F.ws, WS_RSTD2, WS_QH, WS_KH, WS_VH, WS_IQ, WS_GQ, WS_GK, WS_GV, WS_GO, WS_IK, WS_IW, WS_GLOW};
        pg8::gemm_phase<pg8::EpiProj, pg8::StaticOrder, PG8_ALIGN, PG8_SP2>(F.lds, g, S, E);
        TIC(8); meta_p4(F); TOC(8); TIC(9); small_cols(F); TOC(9);
        SEAM(4);
    }
#define BODY5A do { for (int v = F.vcu; v < 256; v += F.G) \
            for (int bq = 0; bq < 8; ++bq) { const int b = bq >> 2, q = bq & 3; const int t = q == 0 ? v : (q == 1 ? 511 - v : (q == 2 ? 512 + v : 1023 - v)); p5_item(F, b, t); } } while (0)
#define BODY5B do { PHASE_BEGIN(); for (int u = F.vcu; u < 1024; u += F.G) g1_unit(F, u >> 9, (u >> 7) & 3, u & 127, args.in[I_WGATE], args.in[I_BGATE]); } while (0)
    if (IN(5)) { PHASE_BEGIN();
#if (PH_DUP >> 5) & 1
        BODY5A; xcd_barrier(bar);
#endif
#if (PH_DUP >> 13) & 1
        BODY5B; xcd_barrier(bar);
#endif
        BODY5A; BODY5B;
        SEAM(5);
    }
    if (IN(6)) { PHASE_BEGIN(); TIC(17); g2_scan(F); TOC(17); SEAM(6); }
#define BODY7A do { TIC(18); p7_attention(F); TOC(18); } while (0)
#define BODY7B do { PHASE_BEGIN(); for (int u = F.vcu; u < 1024; u += F.G) g3_unit(F, u >> 9, (u >> 7) & 3, (u & 127) + 1, args.in[I_WGATE], args.in[I_BGATE], args.in[I_GGLA]); } while (0)
    if (IN(7)) { PHASE_BEGIN();
#if (PH_DUP >> 7) & 1
        BODY7A; xcd_barrier(bar);
#endif
#if (PH_DUP >> 14) & 1
        BODY7B; xcd_barrier(bar);
#endif
#ifndef SKIP_ATT
        BODY7A;
#endif
#ifndef SKIP_G3
        BODY7B;
#endif
        SEAM(7);
    }
    if (IN(8)) { PHASE_BEGIN();
        pg8::Gemm g{(const bf16*)(F.ws + WS_MIXA), WOUT, R, DM, DM}; pg8::StaticOrder S; S.init(R, DM, F.G, (int)blockIdx.x);
        pg8::EpiStoreBf16 E{FB, DM};
        pg8::gemm_phase<pg8::EpiStoreBf16, pg8::StaticOrder, PG8_ALIGN, PG8_SP2>(F.lds, g, S, E);
        SEAM(8);
    }
    if (IN(9)) { PHASE_BEGIN(); norm_rows<1, FFN2_FP8>(F, args.in[I_GMIXPOST], rstd3, nullptr, nullptr, F.ws + WS_ST); convert_ffn<FFN2_FP8>(F, args.in[I_W2G], args.in[I_W2U], args.in[I_W2D], args.in[I_G2PRE], WGU, WD); SEAM(9); }
    if (IN(10)) { PHASE_BEGIN();
        pg8::Gemm g{FFN2_FP8 ? (const bf16*)(F.ws + WS_ST) : AB, WGU, R, NGU, FFN2_FP8 ? DM / 2 : DM}; pg8::StaticOrder S; S.init(R, NGU, F.G, (int)blockIdx.x);
        pg8::EpiSwiGLU E{ACT, DFF, rstd3, FFN2_FP8 ? 1.0f / W8_SCALE : 1.0f};
        pg8::gemm_phase<pg8::EpiSwiGLU, pg8::StaticOrder, PG8_ALIGN, PG8_SP2, FFN2_FP8>(F.lds, g, S, E);
        SEAM(10);
    }
    if (IN(11)) { PHASE_BEGIN();
        pg8::Gemm g{ACT, WD, R, DM, DFF}; pg8::StaticOrder S; S.init(R, DM, F.G, (int)blockIdx.x);
        pg8::EpiStoreBf16 E{FB, DM};
        pg8::gemm_phase<pg8::EpiStoreBf16, pg8::StaticOrder, PG8_ALIGN, PG8_SP2>(F.lds, g, S, E);
        SEAM(11);
    }
    if (IN(12)) { PHASE_BEGIN(); norm_rows<2>(F, args.in[I_G2POST], nullptr, nullptr, nullptr); PROBE_SPIN(); }
#undef IN
#undef SEAM
#undef AB
#undef ACT
#undef FB
#undef WGU
#undef WD
#undef WIN
#undef WOUT
#undef rstd1
#undef rstd2
#undef rstd3
}

extern "C" void kernel_launch(void* const* d_in, const int* in_sizes, int n_in, void* d_out, int out_size, void* d_ws, size_t ws_size, hipStream_t stream) {
    static int grid = 0;
    if (grid == 0) {
        if (n_in != 19 || in_sizes[0] != R * DM || out_size != R * DM || ws_size < WS_END) {
            fprintf(stderr, "kernel_launch: unexpected shapes (n_in %d, in0 %d, out %d, ws %zu; need ws >= %zu); nothing launched\n", n_in, n_in > 0 ? in_sizes[0] : -1, out_size, ws_size, (size_t)WS_END); grid = -1; return; }
        int dev = 0, cus = 0, per_cu = 0;
        if (hipGetDevice(&dev) != hipSuccess || hipDeviceGetAttribute(&cus, hipDeviceAttributeMultiprocessorCount, dev) != hipSuccess) { grid = -1; return; }
        if (hipFuncSetAttribute((const void*)hymba_fwd, hipFuncAttributeMaxDynamicSharedMemorySize, LDS_BYTES) != hipSuccess) { fprintf(stderr, "kernel_launch: hipFuncSetAttribute failed\n"); grid = -1; return; }
        if (hipOccupancyMaxActiveBlocksPerMultiprocessor(&per_cu, (const void*)hymba_fwd, NWAVES * 64, LDS_BYTES) != hipSuccess || per_cu < 1)
            fprintf(stderr, "kernel_launch: note: occupancy query reports %d workgroups per CU\n", per_cu);
        (void)hipGetLastError();
        grid = cus;
    }
    if (grid < 0) return;
    if (hipMemsetAsync((char*)d_ws + WS_CTL, 0, CTL_ZERO_BYTES, stream) != hipSuccess) return;
    Args a{};
    for (int i = 0; i < 19; ++i) a.in[i] = (const float*)d_in[i];
    a.out = (float*)d_out; a.ws = (unsigned char*)d_ws;
#if MK_PER_PHASE
    for (int p = 0; p < N_PHASES; ++p) { a.ph_lo = p; a.ph_hi = p + 1; hipLaunchKernelGGL(hymba_fwd, dim3(grid), dim3(NWAVES * 64), LDS_BYTES, stream, a); }
#else
    a.ph_lo = 0; a.ph_hi = N_PHASES;
    hipLaunchKernelGGL(hymba_fwd, dim3(grid), dim3(NWAVES * 64), LDS_BYTES, stream, a);
#endif
    const hipError_t le = hipPeekAtLastError();
    if (le != hipSuccess) fprintf(stderr, "kernel_launch: launch failed: %s\n", hipGetErrorName(le));
}
```

```cpp
#include <hip/hip_runtime.h>
#include <cstdio>
#include <cstdint>
#define MK_PER_PHASE 0
namespace pg8 {
#define PG8_LAS __attribute__((address_space(3)))
typedef unsigned short bf16_t;
typedef short bf16x8 __attribute__((ext_vector_type(8)));
typedef float f32x4 __attribute__((ext_vector_type(4)));
typedef unsigned u32x4 __attribute__((ext_vector_type(4)));
constexpr int BM = 256, BK = 64, HALF = 128, HTB = HALF * BK * 2  , STAGE_BYTES = 8 * HTB, NXCD = 8, WGM = 8;

__host__ __device__ __forceinline__ int lds_byte(int r, int c) { const int st = (r >> 4) * 2 + (c >> 5), rr = r & 15, cc = c & 31, ob = rr * 64 + cc * 2; return st * 1024 + (ob ^ (((ob >> 9) & 1) << 5)); }
__host__ __device__ __forceinline__ void stage_rc(int b, int& R, int& C) { const int st = b / 1024, sb = b % 1024, swz = sb ^ (((sb >> 9) & 1) << 5); R = (st >> 1) * 16 + swz / 64; C = (st & 1) * 32 + (swz % 64) / 2; }
__host__ __device__ __forceinline__ int perm32(int rho) { const int n = rho >> 4, i = rho & 15; return 8 * (i >> 2) + 4 * n + (i & 3); }

struct Unit { int pm, pn; };
struct Gemm { const bf16_t* A; const bf16_t* Bt; int M, N, K; };

struct StaticOrder {
    int nM, nN, nwg, G, c;
    __host__ __device__ void init(int M, int N, int G_, int c_) { nM = M / BM; nN = N / BM; nwg = nM * nN; G = G_; c = c_; }
    __host__ __device__ bool next(int i, Unit& u) const {
        const long L = (long)i * G + c; if (L >= nwg) return false;
        int wgid = (int)L; { const int q = nwg / NXCD, r = nwg % NXCD, xcd = wgid % NXCD, off = wgid / NXCD; wgid = (xcd < r ? xcd * (q + 1) : r * (q + 1) + (xcd - r) * q) + off; }
        const int nig = WGM * nN, gid = wgid / nig, fm = gid * WGM, gsz = (nM - fm) < WGM ? (nM - fm) : WGM;
        u.pm = fm + ((wgid % nig) % gsz); u.pn = (wgid % nig) / gsz; return true;
    }
    __device__ __forceinline__ void a_ready(const Unit&) const {}
    __device__ __forceinline__ void done(const Unit&) const {}
};

__device__ __forceinline__ unsigned cvt_pk_bf16(float lo, float hi) { unsigned r; asm volatile("v_cvt_pk_bf16_f32 %0, %1, %2" : "=v"(r) : "v"(lo), "v"(hi)); return r; }
typedef float f32x2 __attribute__((ext_vector_type(2)));

__device__ __forceinline__ void st8bf(bf16_t* p, const f32x4 v0, const f32x4 v1) {
    u32x4 w; w.x = cvt_pk_bf16(v0[0], v0[1]); w.y = cvt_pk_bf16(v0[2], v0[3]); w.z = cvt_pk_bf16(v1[0], v1[1]); w.w = cvt_pk_bf16(v1[2], v1[3]);
    *(u32x4*)p = w;
}
__device__ __forceinline__ float silu_f(float x) { return x * __builtin_amdgcn_rcpf(1.0f + __builtin_amdgcn_exp2f(-1.4426950408889634f * x)); }

struct EpiStoreBf16 {
    static constexpr bool PERM = true, AFTER_DRAIN = false;
    bf16_t* O; int ldc; float osc;
    __device__ __forceinline__ void operator()(const f32x4 (&acc)[2][2][4][2], const Unit& u, int wr, int wc, int fr, int fq) const {
        const int row0 = u.pm * BM + wr * 64 + fr, col0 = u.pn * BM + wc * 32 + 8 * fq;
#pragma unroll
        for (int ai = 0; ai < 2; ++ai)
#pragma unroll
            for (int m = 0; m < 4; ++m) { bf16_t* rowp = O + (size_t)(row0 + ai * HALF + m * 16) * ldc + col0;
#pragma unroll
                for (int bj = 0; bj < 2; ++bj) st8bf(rowp + bj * HALF, acc[ai][bj][m][0] * osc, acc[ai][bj][m][1] * osc); }
    }
};
template <bool OUT8>
struct EpiSwiGLU {
    static constexpr bool PERM = true, AFTER_DRAIN = false;
    bf16_t* O; int ldc; const float* rstd; float osc;
    __device__ __forceinline__ void operator()(const f32x4 (&acc)[2][2][4][2], const Unit& u, int wr, int wc, int fr, int fq) const {
        const int row0 = u.pm * BM + wr * 64 + fr, col0 = u.pn * HALF + wc * 32 + 8 * fq;
#pragma unroll
        for (int ai = 0; ai < 2; ++ai)
#pragma unroll
            for (int m = 0; m < 4; ++m) { const int row = row0 + ai * HALF + m * 16; const float rs = rstd[row] * osc;
                f32x4 o0, o1;
#pragma unroll
                for (int j = 0; j < 4; ++j) { o0[j] = silu_f(acc[ai][0][m][0][j] * rs) * (acc[ai][1][m][0][j] * rs); o1[j] = silu_f(acc[ai][0][m][1][j] * rs) * (acc[ai][1][m][1][j] * rs); }
                if constexpr (OUT8) { typedef unsigned u32x2e __attribute__((ext_vector_type(2)));
                    float c_[8] = {o0[0], o0[1], o0[2], o0[3], o1[0], o1[1], o1[2], o1[3]};
#pragma unroll
                    for (int j = 0; j < 8; ++j) c_[j] = fminf(fmaxf(c_[j], -448.f), 448.f);
                    int w0 = 0, w1 = 0; w0 = __builtin_amdgcn_cvt_pk_fp8_f32(c_[0], c_[1], w0, false); w0 = __builtin_amdgcn_cvt_pk_fp8_f32(c_[2], c_[3], w0, true);
                    w1 = __builtin_amdgcn_cvt_pk_fp8_f32(c_[4], c_[5], w1, false); w1 = __builtin_amdgcn_cvt_pk_fp8_f32(c_[6], c_[7], w1, true);
                    *(u32x2e*)((unsigned char*)O + (size_t)row * ldc + col0) = (u32x2e){(unsigned)w0, (unsigned)w1}; }
                else st8bf(O + (size_t)row * ldc + col0, o0, o1); }
    }
};
struct EpiProj {
    static constexpr bool PERM = true, AFTER_DRAIN = false;
    static constexpr int TKV = 8256;
    unsigned char* ws; size_t o_rstd, o_qh, o_kh, o_vh, o_iq, o_gq, o_gk, o_gv, o_go, o_ik, o_iw, o_glow;
    __device__ __forceinline__ void operator()(const f32x4 (&acc)[2][2][4][2], const Unit& u, int wr, int wc, int fr, int fq) const {
        const float* rstd = (const float*)(ws + o_rstd);
        bf16_t* Qh = (bf16_t*)(ws + o_qh); bf16_t* Kh = (bf16_t*)(ws + o_kh); bf16_t* Vh = (bf16_t*)(ws + o_vh); bf16_t* IQ = (bf16_t*)(ws + o_iq); bf16_t* GQ = (bf16_t*)(ws + o_gq);
        bf16_t* GK = (bf16_t*)(ws + o_gk); bf16_t* GV = (bf16_t*)(ws + o_gv); bf16_t* GO = (bf16_t*)(ws + o_go); bf16_t* IK = (bf16_t*)(ws + o_ik); float* IW = (float*)(ws + o_iw); float* GLOW = (float*)(ws + o_glow);
        const int pn = u.pn;
        const int row0 = u.pm * BM + wr * 64 + fr;
#pragma unroll
        for (int ai = 0; ai < 2; ++ai)
#pragma unroll
            for (int m = 0; m < 4; ++m) {
                const int row = row0 + ai * HALF + m * 16; const float rs = rstd[row];
                const bool mainr = row < 16384, metar = (row >= 16384) && (row < 16400);
                const int b = row >> 13, s = row & 8191, mi = row - 16384;
#pragma unroll
                for (int bj = 0; bj < 2; ++bj) {
                    const int col = bj * HALF + wc * 32 + 8 * fq;
                    f32x4 v0 = acc[ai][bj][m][0] * rs, v1 = acc[ai][bj][m][1] * rs;
                    if (pn < 4) {
                        if (mainr) { const int h = pn * 2 + (col >> 7), d = col & 127; st8bf(Qh + ((size_t)(b * 8 + h) * 8192 + s) * 128 + d, v0, v1); }
                    } else if (pn < 12) {
                        bf16_t* base = pn < 8 ? Kh : Vh; const int h = (pn & 3) * 2 + (col >> 7), d = col & 127;
                        if (mainr) st8bf(base + ((size_t)(b * 8 + h) * TKV + 16 + s) * 128 + d, v0, v1);
                        else if (metar) { st8bf(base + ((size_t)h * TKV + mi) * 128 + d, v0, v1); st8bf(base + ((size_t)(8 + h) * TKV + mi) * 128 + d, v0, v1); }
                    } else if (pn < 16) {
                        if (mainr) st8bf(IQ + (size_t)row * 1024 + (pn - 12) * 256 + col, v0 * 0.125f, v1 * 0.125f);
                    } else if (pn < 18) {
                        if (mainr) st8bf(GQ + ((size_t)b * TKV + 64 + s) * 512 + (pn - 16) * 256 + col, v0 * 0.08838834764831845f, v1 * 0.08838834764831845f);
                    } else if (pn < 20) {
                        const int c = (pn - 18) * 256 + col;
                        if (mainr) st8bf(GK + ((size_t)b * TKV + 64 + s) * 512 + c, v0, v1);
                        else if (metar) { st8bf(GK + ((size_t)48 + mi) * 512 + c, v0, v1); st8bf(GK + ((size_t)TKV + 48 + mi) * 512 + c, v0, v1); }
                    } else if (pn < 24) {
                        const int c = (pn - 20) * 256 + col;
                        if (mainr) st8bf(GV + ((size_t)b * TKV + 64 + s) * 1024 + c, v0, v1);
                        else if (metar) { st8bf(GV + ((size_t)48 + mi) * 1024 + c, v0, v1); st8bf(GV + ((size_t)TKV + 48 + mi) * 1024 + c, v0, v1); }
                    } else if (pn < 28) {
                        if (mainr) st8bf(GO + (size_t)row * 1024 + (pn - 24) * 256 + col, v0, v1);
                    } else {
                        if (col < 64) {
                            const int ch = col >> 3, fo = (ch >> 1) * 512 + (ch & 1) * 256;
                            if (mainr) { const int pos = 16 + s; st8bf(IK + (size_t)b * TKV * 64 + (size_t)(pos >> 5) * 2048 + fo + (pos & 31) * 8, v0, v1); }
                            else if (metar) { st8bf(IK + fo + mi * 8, v0, v1); st8bf(IK + (size_t)TKV * 64 + fo + mi * 8, v0, v1); }
                        } else if (col < 80) {
                            if (mainr) { float* p = IW + (size_t)row * 16 + (col - 64); *(f32x4*)p = v0 * 0.25f; *(f32x4*)(p + 4) = v1 * 0.25f; }
                        } else if (col < 96) {
                            const int c = col - 80;
                            if (mainr) { float* p = GLOW + ((size_t)b * TKV + 64 + s) * 16 + c; *(f32x4*)p = v0; *(f32x4*)(p + 4) = v1; }
                            else if (metar) { float* p = GLOW + ((size_t)48 + mi) * 16 + c; *(f32x4*)p = v0; *(f32x4*)(p + 4) = v1;
                                              float* p2 = GLOW + ((size_t)TKV + 48 + mi) * 16 + c; *(f32x4*)p2 = v0; *(f32x4*)(p2 + 4) = v1; }
                        }
                    }
                }
            }
    }
};
typedef int v8i_t __attribute__((ext_vector_type(8)));
__device__ __forceinline__ v8i_t cat8(bf16x8 lo, bf16x8 hi) { typedef int v4i_t __attribute__((ext_vector_type(4)));
    return __builtin_shufflevector(__builtin_bit_cast(v4i_t, lo), __builtin_bit_cast(v4i_t, hi), 0, 1, 2, 3, 4, 5, 6, 7); }
template <class Epi, class Sched, bool ALIGN_EPI = false, bool SP2 = false, bool FP8 = false>
__device__ __forceinline__ void gemm_phase(PG8_LAS unsigned char* lds, const Gemm g, const Sched& S, const Epi& E) {
    const int tid = threadIdx.x, wid = __builtin_amdgcn_readfirstlane(tid >> 6), lane = tid & 63, wr = wid >> 2, wc = wid & 3, fr = lane & 15, fq = lane >> 4;
    const int K = g.K, nt = K / BK;
    unsigned voffA[2], voffB[2];
#pragma unroll
    for (int i = 0; i < 2; ++i) { int R, C; stage_rc(tid * 16 + i * 8192, R, C); const int Rb = Epi::PERM ? ((R & ~31) + perm32(R & 31)) : R;
        voffA[i] = (unsigned)(R * K + C) * 2u; voffB[i] = (unsigned)(Rb * K + C) * 2u; }
    const size_t kstep = (size_t)(BK * 2);
    const size_t hstep = (size_t)HALF * K * 2;
    const size_t tstep = 2 * hstep;
    const unsigned ldsw = (unsigned)wid * 1024u;
    const int f8o = (fq >> 1) * 1024 + ((fr * 64 + 32 * (fq & 1)) ^ (((fr >> 3) & 1) << 5));
    const int aoff = FP8 ? wr * 8192 + f8o : lds_byte(wr * 64 + fr, fq * 8), boff = FP8 ? wc * 4096 + f8o : lds_byte(wc * 32 + fr, fq * 8);
    constexpr int KSTR = FP8 ? 16 : 1024;
    int sc8 = 0x7f7f7f7f; if (FP8) asm volatile("" : "+v"(sc8));
#define PG8_SA(b, h) (((b) * 2 + (h)) * HTB)
#define PG8_SB(b, h) ((4 + (b) * 2 + (h)) * HTB)
#define PG8_STAGE(bufoff, gbase, voff) do { _Pragma("unroll") for (int _i = 0; _i < 2; ++_i) \
        __builtin_amdgcn_global_load_lds((const unsigned*)((const char*)(gbase) + (voff)[_i]), (PG8_LAS unsigned*)(lds + (bufoff) + ldsw + _i * 8192), 16, 0, 0); } while (0)
#define PG8_LDA(dst, b, h) do { _Pragma("unroll") for (int m = 0; m < 4; ++m) _Pragma("unroll") for (int k = 0; k < 2; ++k) dst[m][k] = *(const PG8_LAS bf16x8*)(lds + PG8_SA(b, h) + aoff + m * 2048 + k * KSTR); } while (0)
#define PG8_LDB(dst, b, h) do { _Pragma("unroll") for (int n = 0; n < 2; ++n) _Pragma("unroll") for (int k = 0; k < 2; ++k) dst[n][k] = *(const PG8_LAS bf16x8*)(lds + PG8_SB(b, h) + boff + n * 2048 + k * KSTR); } while (0)
#define PG8_MMA(ai, bj, At, Bt) do { __builtin_amdgcn_s_setprio(1); _Pragma("unroll") for (int m = 0; m < 4; ++m) _Pragma("unroll") for (int n = 0; n < 2; ++n) { \
        if constexpr (FP8) { const v8i_t b8_ = cat8(Bt[n][0], Bt[n][1]), a8_ = cat8(At[m][0], At[m][1]);     \
            asm volatile("v_mfma_scale_f32_16x16x128_f8f6f4 %0, %1, %2, %0, %3, %3 op_sel_hi:[0,0,0]" : "+v"(acc[ai][bj][m][n]) : "v"(b8_), "v"(a8_), "v"(sc8)); } \
        else { _Pragma("unroll") for (int k = 0; k < 2; ++k) acc[ai][bj][m][n] = __builtin_amdgcn_mfma_f32_16x16x32_bf16(Bt[n][k], At[m][k], acc[ai][bj][m][n], 0, 0, 0); } } __builtin_amdgcn_s_setprio(0); } while (0)
#define PG8_WAIT_V(n) asm volatile("s_waitcnt vmcnt(" #n ")" ::: "memory")
#define PG8_WAIT_L(n) asm volatile("s_waitcnt lgkmcnt(" #n ")" ::: "memory")
#define PG8_BAR __builtin_amdgcn_s_barrier()
#define PG8_SCHED __builtin_amdgcn_sched_barrier(0)
    Unit cur, nxt; int ui = 0;
    if (!S.next(0, cur)) return;
    f32x4 acc[2][2][4][2];
#pragma unroll
    for (int a = 0; a < 2; ++a)
#pragma unroll
        for (int b = 0; b < 2; ++b)
#pragma unroll
            for (int m = 0; m < 4; ++m)
#pragma unroll
                for (int n = 0; n < 2; ++n) acc[a][b][m][n] = (f32x4){0.f, 0.f, 0.f, 0.f};
    bf16x8 At[4][2], B0[2][2], B1[2][2];
    const char* cA = (const char*)g.A + (size_t)cur.pm * tstep; const char* cB = (const char*)g.Bt + (size_t)cur.pn * tstep;
    S.a_ready(cur);
    if constexpr (SP2) {
        PG8_STAGE(PG8_SB(0, 0), cB, voffB); PG8_STAGE(PG8_SB(0, 1), cB + hstep, voffB); PG8_STAGE(PG8_SA(0, 0), cA, voffA); PG8_STAGE(PG8_SA(0, 1), cA + hstep, voffA);
        if (wr == 1) PG8_BAR;
        PG8_WAIT_V(2); PG8_BAR;
        PG8_STAGE(PG8_SB(1, 0), cB + kstep, voffB); PG8_STAGE(PG8_SA(1, 0), cA + kstep, voffA); PG8_STAGE(PG8_SB(1, 1), cB + hstep + kstep, voffB);
        PG8_WAIT_V(6); PG8_BAR;
    } else {
        PG8_STAGE(PG8_SB(0, 0), cB, voffB); PG8_STAGE(PG8_SA(0, 0), cA, voffA); PG8_STAGE(PG8_SB(0, 1), cB + hstep, voffB); PG8_STAGE(PG8_SA(0, 1), cA + hstep, voffA);
        if (wr == 1) PG8_BAR;
        PG8_WAIT_V(4); PG8_BAR;
        PG8_STAGE(PG8_SB(1, 0), cB + kstep, voffB); PG8_STAGE(PG8_SA(1, 0), cA + kstep, voffA); PG8_STAGE(PG8_SB(1, 1), cB + hstep + kstep, voffB);
        PG8_WAIT_V(6); PG8_BAR;
    }
    for (;;) {
        const bool has_next = S.next(ui + 1, nxt);
        const char* nA = has_next ? (const char*)g.A + (size_t)nxt.pm * tstep : cA; const char* nB = has_next ? (const char*)g.Bt + (size_t)nxt.pn * tstep : cB;
        for (int t = 0; t < nt; t += 2) {
            const bool last = (t == nt - 2);
            const char* a1 = cA + (size_t)(t + 1) * kstep;
            const char* a2 = last ? nA : cA + (size_t)(t + 2) * kstep; const char* b2 = last ? nB : cB + (size_t)(t + 2) * kstep;
            const char* a3 = a2 + kstep; const char* b3 = b2 + kstep;
            if (last && has_next) S.a_ready(nxt);
            if constexpr (SP2) {
            PG8_LDB(B0, 0, 0); PG8_LDB(B1, 0, 1); PG8_SCHED; PG8_LDA(At, 0, 0); PG8_STAGE(PG8_SA(1, 1), a1 + hstep, voffA);
            PG8_WAIT_V(8); PG8_WAIT_L(0); PG8_BAR; PG8_MMA(0, 0, At, B0); PG8_MMA(0, 1, At, B1); PG8_BAR; PG8_SCHED;
            PG8_LDA(At, 0, 1); PG8_STAGE(PG8_SB(0, 0), b2, voffB); PG8_STAGE(PG8_SB(0, 1), b2 + hstep, voffB); PG8_STAGE(PG8_SA(0, 0), a2, voffA);
            PG8_WAIT_V(8); PG8_WAIT_L(0); PG8_BAR; PG8_MMA(1, 0, At, B0); PG8_MMA(1, 1, At, B1); PG8_BAR; PG8_SCHED;
            PG8_LDB(B0, 1, 0); PG8_LDB(B1, 1, 1); PG8_SCHED; PG8_LDA(At, 1, 0); PG8_STAGE(PG8_SA(0, 1), a2 + hstep, voffA);
            PG8_WAIT_V(8); PG8_WAIT_L(0); PG8_BAR; PG8_MMA(0, 0, At, B0); PG8_MMA(0, 1, At, B1); PG8_BAR; PG8_SCHED;
            PG8_LDA(At, 1, 1); PG8_STAGE(PG8_SB(1, 0), b3, voffB); PG8_STAGE(PG8_SB(1, 1), b3 + hstep, voffB); PG8_STAGE(PG8_SA(1, 0), a3, voffA);
            PG8_WAIT_V(8); PG8_WAIT_L(0); PG8_BAR; PG8_MMA(1, 0, At, B0); PG8_MMA(1, 1, At, B1); PG8_BAR; PG8_SCHED;
            } else {
            PG8_LDB(B0, 0, 0); PG8_SCHED; PG8_LDA(At, 0, 0); PG8_STAGE(PG8_SA(1, 1), a1 + hstep, voffA);
            PG8_WAIT_L(8); PG8_BAR; PG8_WAIT_L(0); PG8_MMA(0, 0, At, B0); PG8_BAR; PG8_SCHED;
            PG8_LDB(B1, 0, 1); PG8_STAGE(PG8_SB(0, 0), b2, voffB);
            PG8_BAR; PG8_WAIT_L(0); PG8_MMA(0, 1, At, B1); PG8_BAR;
            PG8_LDA(At, 0, 1); PG8_STAGE(PG8_SA(0, 0), a2, voffA);
            PG8_BAR; PG8_WAIT_L(0); PG8_MMA(1, 0, At, B0); PG8_BAR; PG8_SCHED;
            PG8_STAGE(PG8_SB(0, 1), b2 + hstep, voffB);
            PG8_WAIT_V(6); PG8_BAR; PG8_MMA(1, 1, At, B1); PG8_BAR;
            PG8_LDB(B0, 1, 0); PG8_SCHED; PG8_LDA(At, 1, 0); PG8_STAGE(PG8_SA(0, 1), a2 + hstep, voffA);
            PG8_WAIT_L(8); PG8_BAR; PG8_WAIT_L(0); PG8_MMA(0, 0, At, B0); PG8_BAR; PG8_SCHED;
            PG8_LDB(B1, 1, 1); PG8_STAGE(PG8_SB(1, 0), b3, voffB);
            PG8_BAR; PG8_WAIT_L(0); PG8_MMA(0, 1, At, B1); PG8_BAR;
            PG8_LDA(At, 1, 1); PG8_STAGE(PG8_SA(1, 0), a3, voffA);
            PG8_BAR; PG8_WAIT_L(0); PG8_MMA(1, 0, At, B0); PG8_BAR; PG8_SCHED;
            PG8_STAGE(PG8_SB(1, 1), b3 + hstep, voffB);
            PG8_WAIT_V(6); PG8_BAR; PG8_MMA(1, 1, At, B1); PG8_BAR;
            }
        }
        if constexpr (FP8) asm volatile("s_nop 15\n\ts_nop 15" ::: "memory");
        if constexpr (ALIGN_EPI) { if (wr == 0) PG8_BAR; }
        if constexpr (!Epi::AFTER_DRAIN) { E(acc, cur, wr, wc, fr, fq); S.done(cur); }
        if (!has_next) break;
#pragma unroll
        for (int a = 0; a < 2; ++a)
#pragma unroll
            for (int b = 0; b < 2; ++b)
#pragma unroll
                for (int m = 0; m < 4; ++m)
#pragma unroll
                    for (int n = 0; n < 2; ++n) acc[a][b][m][n] = (f32x4){0.f, 0.f, 0.f, 0.f};
        cur = nxt; cA = nA; cB = nB; ++ui;
        if constexpr (ALIGN_EPI) { if (wr == 1) PG8_BAR; }
    }
    PG8_WAIT_V(0);
    if constexpr (!ALIGN_EPI) { if (wr == 0) PG8_BAR; }
    PG8_BAR;
    if constexpr (Epi::AFTER_DRAIN) { E.fused(acc, cur, wr, wc, fr, fq, lds, wid, lane); S.done(cur); }
#undef PG8_SA
#undef PG8_SB
#undef PG8_STAGE
#undef PG8_LDA
#undef PG8_LDB
#undef PG8_MMA
#undef PG8_WAIT_V
#undef PG8_WAIT_L
#undef PG8_BAR
#undef PG8_SCHED
}
}

namespace att {
typedef unsigned short bf16;
typedef short bf16x8 __attribute__((ext_vector_type(8)));
typedef short s16x4 __attribute__((ext_vector_type(4)));
typedef float f32x16 __attribute__((ext_vector_type(16)));
typedef float f32x4 __attribute__((ext_vector_type(4)));
typedef unsigned u32x4 __attribute__((ext_vector_type(4)));
typedef unsigned long long u64;
constexpr int HD = 128, NW = 8, QBLK = 32, KVBLK = 64, QB = NW * QBLK;
constexpr int SHM_V = KVBLK * HD * 2, SHM_K = KVBLK * HD * 2;
constexpr int ATT_LDS_BYTES = 2 * SHM_V + 2 * SHM_K + NW * 64 * 4;
constexpr float SCALE = 0.08838834764831845f;
constexpr float THR = 8.f;
constexpr int OSTR = 2048;
constexpr int MWORDS = 130;

#define KSWZ(row, colB) ((row) * 256 + ((colB) ^ (((row) & 7) << 4)))
#define SBAR() __builtin_amdgcn_sched_barrier(0)
__device__ __forceinline__ int v_st(int k, int c) { const int kk = (k & ~0xC) | ((k & 4) << 1) | ((k & 8) >> 1); return ((kk >> 3) * 4 + (c >> 5)) * 512 + ((kk & 7) * 32 + (c & 31)) * 2; }
__device__ __forceinline__ int v_rd_base(int lane) { return ((lane & 3) << 3) | (((lane >> 2) & 3) << 6) | (((lane >> 4) & 1) << 5) | (((lane >> 5) & 1) << 8); }
constexpr int v_rd_off(int d0, int ks, int half) { return d0 * 512 + ks * 4096 + half * 2048; }
__device__ __forceinline__ int crow(int r, int hi) { return (r & 3) + 8 * (r >> 2) + 4 * hi; }
__device__ __forceinline__ unsigned cvtpk(float lo, float hi) {
    unsigned r; asm volatile("v_cvt_pk_bf16_f32 %0, %1, %2" : "=v"(r) : "v"(lo), "v"(hi)); return r;
}
__device__ __forceinline__ bf16x8 load8(const bf16* p) { return *reinterpret_cast<const bf16x8*>(p); }
__device__ __forceinline__ void mask_bits(f32x16& p0, f32x16& p1, unsigned mw) {
    const float NEG = -__builtin_inff();
#pragma unroll
    for (int r = 0; r < 16; ++r) {
        if (!((mw >> r) & 1u)) p0[r] = NEG;
        if (!((mw >> (16 + r)) & 1u)) p1[r] = NEG;
    }
}
__device__ __forceinline__ void partialSM(f32x16& p0, f32x16& p1, float& m_reg, float& mn, float& alpha) {
    float pmax = p0[0]; for (int r = 1; r < 16; ++r) pmax = fmaxf(pmax, p0[r]); for (int r = 0; r < 16; ++r) pmax = fmaxf(pmax, p1[r]);
    { auto rr = __builtin_amdgcn_permlane32_swap(__float_as_uint(pmax), __float_as_uint(pmax), false, false);
      pmax = fmaxf(__uint_as_float(rr[0]), __uint_as_float(rr[1])); }
    constexpr float C2 = 1.4426950408889634f * SCALE;
    if (__builtin_expect(__all((pmax - m_reg) * SCALE <= THR), 1)) { mn = m_reg; alpha = 1.f; }
    else { mn = fmaxf(m_reg, pmax); alpha = __builtin_amdgcn_exp2f((m_reg - mn) * C2); m_reg = mn; }
    const float mnL = -mn * C2;
    for (int r = 0; r < 16; ++r) p0[r] = fmaf(p0[r], C2, mnL); for (int r = 0; r < 16; ++r) p1[r] = fmaf(p1[r], C2, mnL);
    for (int r = 0; r < 16; ++r) p0[r] = __builtin_amdgcn_exp2f(p0[r]);
}
__device__ __forceinline__ void finishSM(f32x16& p0, f32x16& p1, float alpha, float& l_reg, bf16x8& pa0, bf16x8& pa1, bf16x8& pa2, bf16x8& pa3) {
    for (int r = 0; r < 16; ++r) p1[r] = __builtin_amdgcn_exp2f(p1[r]);
    float ps = 0; for (int r = 0; r < 16; ++r) ps += p0[r]; for (int r = 0; r < 16; ++r) ps += p1[r];
    { auto rr = __builtin_amdgcn_permlane32_swap(__float_as_uint(ps), __float_as_uint(ps), false, false);
      ps = __uint_as_float(rr[0]) + __uint_as_float(rr[1]); }
    l_reg = l_reg * alpha + ps;
#define PK4(P, B_, OUT) do { unsigned a0 = cvtpk(P[B_+0], P[B_+1]), a1 = cvtpk(P[B_+2], P[B_+3]);                          \
        unsigned b0 = cvtpk(P[B_+4], P[B_+5]), b1 = cvtpk(P[B_+6], P[B_+7]);                                             \
        auto r0 = __builtin_amdgcn_permlane32_swap(a0, b0, false, false); auto r1 = __builtin_amdgcn_permlane32_swap(a1, b1, false, false); \
        u32x4 w = {r0[0], r1[0], r0[1], r1[1]}; OUT = *reinterpret_cast<bf16x8*>(&w); } while (0)
    PK4(p0, 0, pa0); PK4(p0, 8, pa1); PK4(p1, 0, pa2); PK4(p1, 8, pa3);
#undef PK4
}
template <int KB>
__device__ __forceinline__ void qkt(f32x16& p0, f32x16& p1, const char* K_lds, int r32, int hi, const bf16x8* qr) {
    p0 = f32x16{}; p1 = f32x16{};
    const char* kb[4];
#pragma unroll
    for (int dd = 0; dd < 4; ++dd) kb[dd] = K_lds + KB * SHM_K + KSWZ(r32, (dd * 16 + hi * 8) * 2);
#pragma unroll
    for (int d0 = 0; d0 < 8; ++d0) { const char* a = kb[d0 & 3] + (d0 >> 2) * 128;
        bf16x8 b0 = *reinterpret_cast<const bf16x8*>(a);
        bf16x8 b1 = *reinterpret_cast<const bf16x8*>(a + 32 * 256);
        p0 = __builtin_amdgcn_mfma_f32_32x32x16_bf16(b0, qr[d0], p0, 0, 0, 0);
        p1 = __builtin_amdgcn_mfma_f32_32x32x16_bf16(b1, qr[d0], p1, 0, 0, 0); }
}
template <int VB>
__device__ __forceinline__ void pv_tile(f32x16* o, int vb0, bf16x8 pa0, bf16x8 pa1, bf16x8 pa2, bf16x8 pa3) {
#define TRRD(dst, off) asm volatile("ds_read_b64_tr_b16 %0, %1 offset:%2" : "=&v"(dst) : "v"(vb0), "i"(off) : "memory")
#define PV_D0(d0) do { s16x4 l0, l1, l2, l3, h0, h1, h2, h3; constexpr int b_ = VB * SHM_V + v_rd_off(d0, 0, 0);     \
        TRRD(l0, b_); TRRD(h0, b_ + 2048); TRRD(l1, b_ + 4096); TRRD(h1, b_ + 6144); TRRD(l2, b_ + 8192); TRRD(h2, b_ + 10240); TRRD(l3, b_ + 12288); TRRD(h3, b_ + 14336); \
        asm volatile("s_waitcnt lgkmcnt(0)" ::: "memory"); SBAR();             \
        o[d0] = __builtin_amdgcn_mfma_f32_32x32x16_bf16(pa0, (bf16x8){l0[0], l0[1], l0[2], l0[3], h0[0], h0[1], h0[2], h0[3]}, o[d0], 0, 0, 0);   \
        o[d0] = __builtin_amdgcn_mfma_f32_32x32x16_bf16(pa1, (bf16x8){l1[0], l1[1], l1[2], l1[3], h1[0], h1[1], h1[2], h1[3]}, o[d0], 0, 0, 0);   \
        o[d0] = __builtin_amdgcn_mfma_f32_32x32x16_bf16(pa2, (bf16x8){l2[0], l2[1], l2[2], l2[3], h2[0], h2[1], h2[2], h2[3]}, o[d0], 0, 0, 0);   \
        o[d0] = __builtin_amdgcn_mfma_f32_32x32x16_bf16(pa3, (bf16x8){l3[0], l3[1], l3[2], l3[3], h3[0], h3[1], h3[2], h3[3]}, o[d0], 0, 0, 0); } while (0)
    PV_D0(0); PV_D0(1); PV_D0(2); PV_D0(3);
#undef PV_D0
#undef TRRD
}

struct BlockRef { const bf16* Q; const bf16* K; const bf16* V; bf16* O; const u64* M; int NT; };
struct Seam { bf16x8 qr[8]; bf16x8 st_v0, st_v1, st_k0, st_k1; };
#define VMW() asm volatile("s_waitcnt vmcnt(0)" ::: "memory")
#define VMWN(n) asm volatile("s_waitcnt vmcnt(%0)" :: "i"(n) : "memory")
#define SLOAD_H(Kp, Vp, k0) do { int t_ = tid; asm volatile("" : "+v"(t_)); const unsigned go_ = (unsigned)((k0) * (HD * 2)) + (unsigned)t_ * 16u;               \
                         S.st_v0 = load8((const bf16*)((const char*)(Vp) + go_)); S.st_v1 = load8((const bf16*)((const char*)(Vp) + (go_ + 8192u)));              \
                         S.st_k0 = load8((const bf16*)((const char*)(Kp) + go_)); S.st_k1 = load8((const bf16*)((const char*)(Kp) + (go_ + 8192u))); } while (0)
#define SWRITE_HK(bf) do { int t_ = tid; asm volatile("" : "+v"(t_)); const int sr_ = t_ >> 4, sc_ = (t_ & 15) * 8, kws_ = KSWZ(sr_, sc_ * 2);                      \
                         *(bf16x8*)(K_lds + (bf) * SHM_K + kws_) = S.st_k0; *(bf16x8*)(K_lds + (bf) * SHM_K + kws_ + 32 * 256) = S.st_k1; } while (0)
#define SWRITE_HV(bf) do { int t_ = tid; asm volatile("" : "+v"(t_)); const int sr_ = t_ >> 4, sc_ = (t_ & 15) * 8, vs_ = v_st(sr_, sc_);                            \
                         *(bf16x8*)(V_lds + (bf) * SHM_V + vs_) = S.st_v0; *(bf16x8*)(V_lds + (bf) * SHM_V + vs_ + 8192) = S.st_v1; } while (0)
#define SWRITE_H(bf) do { SWRITE_HV(bf); SWRITE_HK(bf); } while (0)
__device__ __forceinline__ void att_prime(const BlockRef& cur, char* lds, Seam& S) {
    const int tid = threadIdx.x, wid = __builtin_amdgcn_readfirstlane(tid >> 6), lane = tid & 63, r32 = lane & 31, hi = lane >> 5;
    char* K_lds = lds + 2 * SHM_V;
#pragma unroll
    for (int d0 = 0; d0 < 8; ++d0) S.qr[d0] = load8((const bf16*)((const char*)cur.Q + (unsigned)(((wid * QBLK + r32) * HD + hi * 8) * 2 + d0 * 32)));
    SLOAD_H(cur.K, cur.V, 0); VMW(); SWRITE_HK(0);
    __syncthreads();
}
__device__ __forceinline__ void att_block(const BlockRef& cur, const BlockRef& nxt, char* lds, Seam& S) {
    const int tid = threadIdx.x, wid = __builtin_amdgcn_readfirstlane(tid >> 6), lane = tid & 63, r32 = lane & 31, hi = lane >> 5;
    const int NT = cur.NT;
    char* V_lds = lds; char* K_lds = lds + 2 * SHM_V;
    float* ws = (float*)(lds + 2 * SHM_V + 2 * SHM_K) + wid * 64; float* li_l = ws, * al_l = ws + 32;
    float m_reg = -1e30f, l_reg = 0; f32x16 o[4] = {};
    const int vb0 = (int)(uintptr_t)V_lds + v_rd_base(lane);
    const bf16* Kh = cur.K; const bf16* Vh = cur.V;
    const char* Mb = (const char*)cur.M; const unsigned moff = (unsigned)((wid * QBLK + r32) * (MWORDS * 8) + hi * 4);
#define MLOAD(t) (*(const unsigned*)(Mb + (moff + (unsigned)(t) * 8u)))
    unsigned mwA = MLOAD(0), mwB = 0u;
#define RESC(a) do { if (__any((a) < 1.f)) { if (hi == 0) al_l[r32] = (a); asm volatile("s_waitcnt lgkmcnt(0)" ::: "memory");              \
                     for (int d_ = 0; d_ < 4; ++d_) for (int r = 0; r < 16; ++r) o[d_][r] *= al_l[crow(r, hi)]; } } while (0)
#define KBASE(t) ((t) * KVBLK)
    constexpr int NQL = 8;
#define SEAM_K0() do { VMWN(NQL); SWRITE_HK(0); SBAR(); } while (0)
    f32x16 pA0, pA1, pB0, pB1; float mnA, mnB, alA, alB; bf16x8 pa0, pa1, pa2, pa3;
    SWRITE_HV(0); SBAR();
    if (NT > 1) { SLOAD_H(Kh, Vh, KBASE(1)); }
    SBAR(); qkt<0>(pA0, pA1, K_lds, r32, hi, S.qr);
    mask_bits(pA0, pA1, mwA); partialSM(pA0, pA1, m_reg, mnA, alA);
    if (NT > 1) { VMW(); SWRITE_H(1); }
    __syncthreads();
#define HALF_STEP(PX0, PX1, mnX, alX, PY0, PY1, alY, t, KB, VB, SB, MWX, MWY) do {                                             \
        MWX = MLOAD(t);                                                                                                       \
        SBAR(); qkt<KB>(PX0, PX1, K_lds, r32, hi, S.qr);                                                                      \
        finishSM(PY0, PY1, alY, l_reg, pa0, pa1, pa2, pa3); SBAR();                                                           \
        if ((t) + 1 < NT) { SLOAD_H(Kh, Vh, KBASE((t) + 1)); SBAR(); }                                                        \
        pv_tile<VB>(o, vb0, pa0, pa1, pa2, pa3); mask_bits(PX0, PX1, MWX); partialSM(PX0, PX1, m_reg, mnX, alX);          \
        __syncthreads();                                                                                                      \
        if ((t) + 1 < NT) { VMW(); SWRITE_H(SB); }                                                                            \
        RESC(alX); __syncthreads(); } while (0)
    for (int t = 1; t + 1 < NT; t += 2) {
        HALF_STEP(pB0, pB1, mnB, alB, pA0, pA1, alA, t, 1, 0, 0, mwB, mwA);
        HALF_STEP(pA0, pA1, mnA, alA, pB0, pB1, alB, t + 1, 0, 1, 1, mwA, mwB);
    }
    const bool even = (NT & 1) == 0;
    if (even) { mwB = MLOAD(NT - 1); SBAR(); qkt<1>(pB0, pB1, K_lds, r32, hi, S.qr); SBAR(); }
    SLOAD_H(nxt.K, nxt.V, 0); SBAR();
#pragma unroll
    for (int d0 = 0; d0 < 8; ++d0) S.qr[d0] = load8((const bf16*)((const char*)nxt.Q + (unsigned)(((wid * QBLK + r32) * HD + hi * 8) * 2 + d0 * 32)));
    SBAR();
    finishSM(pA0, pA1, alA, l_reg, pa0, pa1, pa2, pa3); SBAR();
    pv_tile<0>(o, vb0, pa0, pa1, pa2, pa3);
    if (even) { mask_bits(pB0, pB1, mwB); partialSM(pB0, pB1, m_reg, mnB, alB); __syncthreads(); RESC(alB);
        finishSM(pB0, pB1, alB, l_reg, pa0, pa1, pa2, pa3); SBAR(); pv_tile<1>(o, vb0, pa0, pa1, pa2, pa3); }
    SBAR(); SEAM_K0();
    if (hi == 0) li_l[r32] = l_reg; asm volatile("s_waitcnt lgkmcnt(0)" ::: "memory");
    float rli[16];
#pragma unroll
    for (int r = 0; r < 16; ++r) rli[r] = __builtin_amdgcn_rcpf(li_l[crow(r, hi)]);
    char* Owb = (char*)(cur.O + (size_t)(wid * QBLK) * OSTR);
    int hi_e = hi, r32_e = r32; asm volatile("" : "+v"(hi_e), "+v"(r32_e));
    const unsigned lane_off = (unsigned)(4 * hi_e * OSTR + r32_e) * 2u;
#pragma unroll
    for (int r = 0; r < 16; ++r) { constexpr int dummy = 0; (void)dummy; const unsigned rowb = (unsigned)(((r & 3) + 8 * (r >> 2)) * OSTR * 2);
#pragma unroll
        for (int d0 = 0; d0 < 4; ++d0) { const float v = o[d0][r] * rli[r];
            const float vn = __shfl_xor(v, 1);
            if ((r32 & 1) == 0) *(unsigned*)(Owb + rowb + d0 * 64 + lane_off) = cvtpk(v, vn); } }
    __syncthreads();
#undef RESC
#undef KBASE
#undef SEAM_K0
#undef HALF_STEP
#undef MLOAD
}
#undef VMW
#undef VMWN
#undef SLOAD_H
#undef SWRITE_HK
#undef SWRITE_HV
#undef SWRITE_H
#undef KSWZ
#undef SBAR
}

constexpr int NWAVES = 8;
#ifndef MK_PER_PHASE
#define MK_PER_PHASE 0
#endif
constexpr int N_PHASES = 13;

constexpr int DM = 2048, SEQ = 8192, NBATCH = 2, NMETA = 16, DFF = 5632;
constexpr int R = NBATCH * SEQ;
constexpr int RP = 16640;
constexpr int TKV = 8256;
constexpr int NPROJ = 7424;
constexpr int NGU = 2 * DFF;
constexpr float EPS = 1e-6f;

constexpr size_t MiB = 1u << 20;
constexpr size_t WS_CTL = 0, CTL_ZERO_BYTES = 1 * MiB;
constexpr size_t WS_AB = 1 * MiB;
constexpr size_t WS_WB = 66 * MiB;
constexpr size_t WS_WGU = WS_WB, WS_WD = WS_WB + 44 * MiB, WS_WIN = WS_WB, WS_WOUT = WS_WB + 29 * MiB, WS_MASK = WS_WB + 40 * MiB;
constexpr size_t WS_SMALL = 132 * MiB;
constexpr size_t WS_RSTD1 = WS_SMALL, WS_RSTD2 = WS_SMALL + 128 * 1024, WS_RSTD3 = WS_SMALL + 256 * 1024, WS_DEC = WS_SMALL + 384 * 1024;
constexpr size_t WS_ACT = 133 * MiB;
constexpr size_t WS_F = 312 * MiB;
constexpr size_t WS_MIXA = 133 * MiB;
constexpr size_t WS_QH = 197 * MiB;
constexpr size_t WS_KH = 229 * MiB, WS_VH = 262 * MiB;
constexpr size_t WS_IQ = 295 * MiB;
constexpr size_t WS_GQ = 327 * MiB, WS_GK = 344 * MiB;
constexpr size_t WS_GV = 361 * MiB;
constexpr size_t WS_GO = 394 * MiB;
constexpr size_t WS_IK = 426 * MiB;
constexpr size_t WS_IW = 429 * MiB;
constexpr size_t WS_GLOW = 430 * MiB;
constexpr size_t WS_ST = 432 * MiB;
constexpr size_t WS_END = 496 * MiB;
constexpr int CW_BAR = 4096;

constexpr int SCR_BYTES = 147456;
constexpr int MISC_OFF = SCR_BYTES;
constexpr int LDS_BYTES = SCR_BYTES + 2048;

#define GAS __attribute__((address_space(1)))
#define LAS __attribute__((address_space(3)))
typedef unsigned short bf16;
typedef unsigned v4u __attribute__((ext_vector_type(4)));
typedef unsigned v2u __attribute__((ext_vector_type(2)));
typedef float f32x4 __attribute__((ext_vector_type(4)));
typedef float f32x16 __attribute__((ext_vector_type(16)));
typedef short bf16x8 __attribute__((ext_vector_type(8)));
typedef unsigned long long u64;
typedef GAS unsigned gu32;
#define RLX_AGENT __ATOMIC_RELAXED, __HIP_MEMORY_SCOPE_AGENT
#define LDS_WAIT() asm volatile("s_waitcnt lgkmcnt(0)" ::: "memory")
#define VM_WAIT() asm volatile("s_waitcnt vmcnt(0)" ::: "memory")
__device__ __forceinline__ unsigned f2bf(float f) { unsigned u = __builtin_bit_cast(unsigned, f); return (u + 0x7fffu + ((u >> 16) & 1u)) >> 16; }
__device__ __forceinline__ unsigned pk2(float lo, float hi) { return f2bf(lo) | (f2bf(hi) << 16); }
__device__ __forceinline__ float bf2f(unsigned short b) { return __builtin_bit_cast(float, (unsigned)b << 16); }
__device__ __forceinline__ float bflo(unsigned w) { return __builtin_bit_cast(float, w << 16); }
__device__ __forceinline__ float bfhi(unsigned w) { return __builtin_bit_cast(float, w & 0xffff0000u); }
#define XB_TMO      128
#define XB_XCNT(j)  (256  + 64 * (j))
#define XB_XSUB(j)  (1280 + 64 * (j))
#define XB_XGEN(j)  (2304 + 64 * (j))
#define XB_TOP      3328
#define XB_TOPGEN   3392
#define XCD_BAR_WORDS 3456
#define XB_SPIN_CAP (1u << 22)

__device__ __forceinline__ unsigned xb_ld(unsigned* p)              { return __hip_atomic_load(p, __ATOMIC_RELAXED, __HIP_MEMORY_SCOPE_AGENT); }
__device__ __forceinline__ unsigned xb_add(unsigned* p, unsigned v) { return __hip_atomic_fetch_add(p, v, __ATOMIC_RELAXED, __HIP_MEMORY_SCOPE_AGENT); }
__device__ __forceinline__ unsigned xb_xcc_id() { return (unsigned)__builtin_amdgcn_s_getreg((3 << 11) | 20) & 0xFu; }
#define XB_SPIN(cond, bar) do { unsigned _sp = 0; while (cond) { __builtin_amdgcn_s_sleep(1); \
    if ((++_sp & 255u) == 0u) { if (xb_ld(&(bar)[XB_TMO])) break; if (_sp > XB_SPIN_CAP) { atomicAdd(&(bar)[XB_TMO], 1u); break; } } } } while (0)

struct XcdBarrier {
    unsigned* bar; unsigned x;
    volatile LAS unsigned* st;
};

__device__ __forceinline__ XcdBarrier xcd_barrier_post(unsigned* bar, volatile LAS unsigned* st) {
    XcdBarrier b; b.bar = bar; b.x = xb_xcc_id(); b.st = st;
    if (threadIdx.x == 0) (void)xb_add(&bar[XB_XCNT(b.x)], 1u);
    return b;
}
__device__ __forceinline__ void xcd_barrier_complete(unsigned* bar, unsigned x, unsigned& nloc, unsigned& nx) {
    const unsigned G = gridDim.x * gridDim.y * gridDim.z;
    unsigned sum, cnt, mine, sp = 0u;
    for (;;) {
        sum = 0u; cnt = 0u; mine = 0u;
#pragma unroll
        for (unsigned j = 0; j < 16; ++j) { const unsigned c = xb_ld(&bar[XB_XCNT(j)]); sum += c; cnt += (c > 0u) ? 1u : 0u; mine = (j == x) ? c : mine; }
        if (sum == G) break;
        __builtin_amdgcn_s_sleep(1);
        if ((++sp & 255u) == 0u) { if (xb_ld(&bar[XB_TMO])) break; if (sp > XB_SPIN_CAP) { atomicAdd(&bar[XB_TMO], 1u); break; } }
    }
    nloc = mine > 0u ? mine : 1u; nx = cnt > 0u ? cnt : 1u;
}

__device__ __forceinline__ void xcd_barrier(const XcdBarrier& b) {
    asm volatile("s_waitcnt vmcnt(0)" ::: "memory");
    __syncthreads();
    if (threadIdx.x == 0) {
        unsigned* bar = b.bar;
        __builtin_amdgcn_s_waitcnt(0);
        unsigned nloc = b.st[0], nx = b.st[1];
        if (nloc == 0u) { xcd_barrier_complete(bar, b.x, nloc, nx); b.st[0] = nloc; b.st[1] = nx; }
        const unsigned old = xb_add(&bar[XB_XSUB(b.x)], 1u);
        const unsigned gen = old / nloc;
        if (old + 1u == (gen + 1u) * nloc) {
            __builtin_amdgcn_fence(__ATOMIC_RELEASE, "agent");
            asm volatile("s_waitcnt vmcnt(0)" ::: "memory");
            const unsigned og = xb_add(&bar[XB_TOP], 1u);
            const unsigned tg = og / nx;
            if (og + 1u == (tg + 1u) * nx) xb_add(&bar[XB_TOPGEN], 1u);
            else XB_SPIN(xb_ld(&bar[XB_TOPGEN]) == tg, bar);
            __builtin_amdgcn_fence(__ATOMIC_ACQUIRE, "agent");
            xb_add(&bar[XB_XGEN(b.x)], 1u);
            asm volatile("s_waitcnt vmcnt(0)" ::: "memory");
        } else {
            XB_SPIN(xb_ld(&bar[XB_XGEN(b.x)]) == gen, bar);
            __builtin_amdgcn_fence(__ATOMIC_ACQUIRE, "agent");
            asm volatile("s_waitcnt vmcnt(0)" ::: "memory");
        }
    }
    __syncthreads();
}

struct Frame {
    LAS unsigned char* lds;
    unsigned char* ldsg;
    volatile LAS unsigned* MISC;
    unsigned* ctl;
    int tid, lane, wave, vcu, G;
    float* out; unsigned char* ws;
};
enum { I_X = 0, I_META, I_G1PRE, I_W1G, I_W1U, I_W1D, I_G1POST, I_GMIX, I_WIN, I_WGATE, I_BGATE, I_GGLA, I_WOUT, I_GMIXPOST, I_G2PRE, I_W2G, I_W2U, I_W2D, I_G2POST };
#ifndef PROBE_K
#define PROBE_K (-1)
#endif
#ifndef PROBE_BLOCK
#define PROBE_BLOCK 37
#endif
#ifndef PROBE_AMP
#define PROBE_AMP 4
#endif
#define TIC(k) do { if (PROBE_K == (k) && blockIdx.x == PROBE_BLOCK && threadIdx.x == 0) { const unsigned long long t_ = __builtin_amdgcn_s_memrealtime(); F.MISC[20] = (unsigned)t_; F.MISC[21] = (unsigned)(t_ >> 32); } } while (0)
#define TOC(k) do { if (PROBE_K == (k) && blockIdx.x == PROBE_BLOCK && threadIdx.x == 0) { const unsigned long long t0_ = ((unsigned long long)F.MISC[21] << 32) | F.MISC[20]; \
        const unsigned long long a_ = (((unsigned long long)F.MISC[23] << 32) | F.MISC[22]) + (__builtin_amdgcn_s_memrealtime() - t0_); F.MISC[22] = (unsigned)a_; F.MISC[23] = (unsigned)(a_ >> 32); } } while (0)
#define TICC(k) do { if (PROBE_K == (k) && blockIdx.x == PROBE_BLOCK && threadIdx.x == 0) { const unsigned long long t_ = __builtin_amdgcn_s_memtime(); F.MISC[20] = (unsigned)t_; F.MISC[21] = (unsigned)(t_ >> 32); } } while (0)
#define TOCC(k) do { if (PROBE_K == (k) && blockIdx.x == PROBE_BLOCK && threadIdx.x == 0) { const unsigned long long t0_ = ((unsigned long long)F.MISC[21] << 32) | F.MISC[20]; \
        const unsigned long long a_ = (((unsigned long long)F.MISC[23] << 32) | F.MISC[22]) + (__builtin_amdgcn_s_memtime() - t0_) / 20ull; F.MISC[22] = (unsigned)a_; F.MISC[23] = (unsigned)(a_ >> 32); } } while (0)
#define PROBE_SPIN() do { if (PROBE_K >= 0 && blockIdx.x == PROBE_BLOCK && threadIdx.x == 0) { const unsigned long long a_ = (((unsigned long long)F.MISC[23] << 32) | F.MISC[22]) * PROBE_AMP; \
        const unsigned long long s_ = __builtin_amdgcn_s_memrealtime(); while (__builtin_amdgcn_s_memrealtime() - s_ < a_) __builtin_amdgcn_s_sleep(8); } } while (0)

__device__ __forceinline__ float wave_sum(float v) {
#pragma unroll
    for (int o = 1; o < 64; o <<= 1) v += __shfl_xor(v, o);
    return v;
}
__device__ __forceinline__ unsigned wave_sum_u(unsigned v) {
    v += (unsigned)__builtin_amdgcn_update_dpp(0, (int)v, 0xB1, 0xf, 0xf, false);
    v += (unsigned)__builtin_amdgcn_update_dpp(0, (int)v, 0x4E, 0xf, 0xf, false);
    v += (unsigned)__builtin_amdgcn_update_dpp(0, (int)v, 0x141, 0xf, 0xf, false);
    v += (unsigned)__builtin_amdgcn_update_dpp(0, (int)v, 0x140, 0xf, 0xf, false);
    return (unsigned)__builtin_amdgcn_readlane((int)v, 0) + (unsigned)__builtin_amdgcn_readlane((int)v, 16) + (unsigned)__builtin_amdgcn_readlane((int)v, 32) + (unsigned)__builtin_amdgcn_readlane((int)v, 48);
}

__device__ __forceinline__ unsigned pk4_fp8(float a, float b, float c, float d) {
    a = fminf(fmaxf(a, -448.f), 448.f); b = fminf(fmaxf(b, -448.f), 448.f); c = fminf(fmaxf(c, -448.f), 448.f); d = fminf(fmaxf(d, -448.f), 448.f);
    int w = 0; w = __builtin_amdgcn_cvt_pk_fp8_f32(a, b, w, false); w = __builtin_amdgcn_cvt_pk_fp8_f32(c, d, w, true); return (unsigned)w;
}
constexpr float W8_SCALE = 32.0f;
template <int KR>
__device__ __forceinline__ void tr_item8(const float* W, int N, int K, unsigned char* W8, int drow0, int scol, const float* gain, float wscale, LAS float* scr, int k0, int lane) {
#pragma unroll 8
    for (int i = 0; i < KR / 2; ++i) { const int kk = 2 * i + (lane >> 5); float v = W[(size_t)(k0 + kk) * N + scol] * wscale;
        if (gain) v *= gain[k0 + kk];
        scr[kk * 33 + (lane & 31)] = v; }
    LDS_WAIT(); asm volatile("" ::: "memory");
#pragma unroll
    for (int j = 0; j < (KR == 64 ? 2 : 1); ++j) { const int pc = lane + 64 * j, n = KR == 64 ? pc >> 2 : pc, c = KR == 64 ? pc & 3 : 0;
        if (KR == 64 || lane < 32) { const LAS float* s = scr + (16 * c) * 33 + n;
            v4u o; o.x = pk4_fp8(s[0 * 33], s[1 * 33], s[2 * 33], s[3 * 33]); o.y = pk4_fp8(s[4 * 33], s[5 * 33], s[6 * 33], s[7 * 33]);
            o.z = pk4_fp8(s[8 * 33], s[9 * 33], s[10 * 33], s[11 * 33]); o.w = pk4_fp8(s[12 * 33], s[13 * 33], s[14 * 33], s[15 * 33]);
            *(GAS v4u*)(W8 + (size_t)(drow0 + n) * K + k0 + 16 * c) = o; } }
    LDS_WAIT(); asm volatile("" ::: "memory");
}
constexpr float W8D_SCALE = 64.0f;
template <int KR>
__device__ __forceinline__ void tr_item(const float* W, int N, int K, bf16* WT, int drow0, int scol, const float* gain, LAS float* scr, int k0, int lane) {
#pragma unroll 8
    for (int i = 0; i < KR / 2; ++i) { const int kk = 2 * i + (lane >> 5); float v = 0.f;
        if (scol >= 0) v = W[(size_t)(k0 + kk) * N + scol];
        if (gain) v *= gain[k0 + kk];
        scr[kk * 33 + (lane & 31)] = v; }
    LDS_WAIT(); asm volatile("" ::: "memory");
    if (KR == 64) {
        const int c = lane & 7;
#pragma unroll
        for (int j = 0; j < 4; ++j) { const int n = (lane >> 3) + 8 * j; const LAS float* s = scr + (8 * c) * 33 + n;
            v4u o; o.x = pk2(s[0 * 33], s[1 * 33]); o.y = pk2(s[2 * 33], s[3 * 33]); o.z = pk2(s[4 * 33], s[5 * 33]); o.w = pk2(s[6 * 33], s[7 * 33]);
            *(GAS v4u*)(WT + (size_t)(drow0 + n) * K + k0 + 8 * c) = o; }
    } else {
        const int c = lane & 1, n = lane >> 1; const LAS float* s = scr + (8 * c) * 33 + n;
        v4u o; o.x = pk2(s[0 * 33], s[1 * 33]); o.y = pk2(s[2 * 33], s[3 * 33]); o.z = pk2(s[4 * 33], s[5 * 33]); o.w = pk2(s[6 * 33], s[7 * 33]);
        *(GAS v4u*)(WT + (size_t)(drow0 + n) * K + k0 + 8 * c) = o;
    }
    LDS_WAIT(); asm volatile("" ::: "memory");
}
template <int KR, bool GU8, bool D8>
__device__ __forceinline__ void ffn_item(Frame& F, int it, int ksub, const float* Wg, const float* Wu, const float* Wd, const float* gain, bf16* WGU, bf16* WD, LAS float* scr) {
    constexpr int I_GU = (NGU / 32) * (DM / 64);
    if (it < I_GU) { const int g = it % (NGU / 32), kb = it / (NGU / 32), tile = g >> 3, w = g & 7;
        if (GU8) tr_item8<KR>(w < 4 ? Wg : Wu, DFF, DM, (unsigned char*)WGU, g * 32, tile * 128 + (w & 3) * 32 + (F.lane & 31), gain, W8_SCALE, scr, kb * 64 + ksub * 16, F.lane);
        else tr_item<KR>(w < 4 ? Wg : Wu, DFF, DM, WGU, g * 32, tile * 128 + (w & 3) * 32 + (F.lane & 31), gain, scr, kb * 64 + ksub * 16, F.lane); }
    else { const int r = it - I_GU, g = r % (DM / 32), kb = r / (DM / 32);
        if (D8) tr_item8<KR>(Wd, DM, DFF, (unsigned char*)WD, g * 32, g * 32 + (F.lane & 31), nullptr, W8D_SCALE, scr, kb * 64 + ksub * 16, F.lane);
        else tr_item<KR>(Wd, DM, DFF, WD, g * 32, g * 32 + (F.lane & 31), nullptr, scr, kb * 64 + ksub * 16, F.lane); }
}
template <bool GU8, bool D8>
__device__ __forceinline__ void convert_ffn(Frame& F, const float* Wg, const float* Wu, const float* Wd, const float* gain, bf16* WGU, bf16* WD) {
    LAS float* scr = (LAS float*)(F.lds + F.wave * 16384);
    const int gw = F.vcu * NWAVES + F.wave, NGW = F.G * NWAVES;
    constexpr int NIT = (NGU / 32) * (DM / 64) + (DM / 32) * (DFF / 64);
    const int nmain = (NIT / NGW) * NGW;
    for (int it = gw; it < nmain; it += NGW) ffn_item<64, GU8, D8>(F, it, 0, Wg, Wu, Wd, gain, WGU, WD, scr);
    for (int q = gw; q < 4 * (NIT - nmain); q += NGW) ffn_item<16, GU8, D8>(F, nmain + (q >> 2), q & 3, Wg, Wu, Wd, gain, WGU, WD, scr);
}
__device__ __forceinline__ int win_src_col(int j) {
    const int t = j >> 8, c = j & 255;
    if (t < 16) return j;
    if (t < 18) return 4176 + (j - 4096);
    if (t < 20) return 4688 + (j - 4608);
    if (t < 24) return 5200 + (j - 5120);
    if (t < 28) return 6240 + (j - 6144);
    if (c < 64) return 4096 + c;
    if (c < 80) return 4160 + (c - 64);
    if (c < 96) return 6224 + (c - 80);
    return -1;
}
template <int KR>
__device__ __forceinline__ void mix_item(Frame& F, int it, int ksub, const float* Win, const float* Wout, const float* gain, bf16* WIN, bf16* WOUT, LAS float* scr) {
    constexpr int I_IN = (NPROJ / 32) * (DM / 64);
    if (it < I_IN) { const int g = it % (NPROJ / 32), kb = it / (NPROJ / 32);
        tr_item<KR>(Win, 7264, DM, WIN, g * 32, win_src_col(g * 32 + (F.lane & 31)), gain, scr, kb * 64 + ksub * 16, F.lane); }
    else { const int r = it - I_IN, g = r % (DM / 32), kb = r / (DM / 32);
        tr_item<KR>(Wout, DM, DM, WOUT, g * 32, g * 32 + (F.lane & 31), nullptr, scr, kb * 64 + ksub * 16, F.lane); }
}
__device__ __forceinline__ void convert_mix(Frame& F, const float* Win, const float* Wout, const float* gain, bf16* WIN, bf16* WOUT) {
    LAS float* scr = (LAS float*)(F.lds + F.wave * 16384);
    const int gw = F.vcu * NWAVES + F.wave, NGW = F.G * NWAVES;
    constexpr int NIT = (NPROJ / 32) * (DM / 64) + (DM / 32) * (DM / 64);
    const int nmain = (NIT / NGW) * NGW;
    for (int it = gw; it < nmain; it += NGW) mix_item<64>(F, it, 0, Win, Wout, gain, WIN, WOUT, scr);
    for (int q = gw; q < 4 * (NIT - nmain); q += NGW) mix_item<16>(F, nmain + (q >> 2), q & 3, Win, Wout, gain, WIN, WOUT, scr);
}

template <bool OUT8>
__device__ __forceinline__ void p0_rows(Frame& F, const float* X, const float* META, unsigned char* X8) {
    const int gw = F.vcu * NWAVES + F.wave, NGW = F.G * NWAVES;
    bf16* AB = (bf16*)(F.ws + WS_AB); float* rstd = (float*)(F.ws + WS_RSTD1);
    for (int row = gw; row < RP; row += NGW) {
        GAS v2u* o = (GAS v2u*)(AB + (size_t)row * DM) + F.lane;
        if (row < R + NMETA) {
            const float* xr = row < R ? X + (size_t)row * DM : META + (size_t)(row - R) * DM;
            const GAS f32x4* xp = (const GAS f32x4*)xr + F.lane;
            f32x4 v[8]; float ss = 0.f;
#pragma unroll
            for (int j = 0; j < 8; ++j) { v[j] = xp[64 * j]; ss += (v[j].x * v[j].x + v[j].y * v[j].y) + (v[j].z * v[j].z + v[j].w * v[j].w); }
            ss = wave_sum(ss);
#pragma unroll
            for (int j = 0; j < 8; ++j) o[64 * j] = (v2u){pk2(v[j].x, v[j].y), pk2(v[j].z, v[j].w)};
            if (OUT8) { GAS unsigned* x8 = (GAS unsigned*)(X8 + (size_t)row * DM) + F.lane;
#pragma unroll
                for (int j = 0; j < 8; ++j) x8[64 * j] = pk4_fp8(v[j].x, v[j].y, v[j].z, v[j].w); }
            if (F.lane == 0) rstd[row] = 1.0f / sqrtf(ss * (1.0f / DM) + EPS);
        } else {
#pragma unroll
            for (int j = 0; j < 8; ++j) o[64 * j] = (v2u){0u, 0u};
            if (OUT8) { GAS unsigned* x8 = (GAS unsigned*)(X8 + (size_t)row * DM) + F.lane;
#pragma unroll
                for (int j = 0; j < 8; ++j) x8[64 * j] = 0u; }
            if (F.lane == 0) rstd[row] = 0.f;
        }
    }
}
template <int MODE, bool OUT8 = false>
__device__ __forceinline__ void norm_rows(Frame& F, const float* g, float* rstd_out, const float* X, const float* META, unsigned char* H8 = nullptr) {
    const int gw = F.vcu * NWAVES + F.wave, NGW = F.G * NWAVES;
    bf16* AB = (bf16*)(F.ws + WS_AB); const bf16* FB = (const bf16*)(F.ws + WS_F);
    const int nrows = (MODE == 0) ? RP : R;
    f32x4 gv[8];
#pragma unroll
    for (int j = 0; j < 8; ++j) gv[j] = ((const GAS f32x4*)g)[64 * j + F.lane];
    for (int row = gw; row < nrows; row += NGW) {
        if (MODE == 0 && row >= R + NMETA) { if (F.lane == 0) rstd_out[row] = 0.f; continue; }
        const GAS v2u* fp = (const GAS v2u*)(FB + (size_t)row * DM) + F.lane;
        GAS v2u* ab = (GAS v2u*)(AB + (size_t)row * DM) + F.lane;
        f32x4 f[8], h[8]; float ss = 0.f;
#pragma unroll
        for (int j = 0; j < 8; ++j) { const v2u w = fp[64 * j]; f[j] = (f32x4){bflo(w.x), bfhi(w.x), bflo(w.y), bfhi(w.y)};
            ss += (f[j].x * f[j].x + f[j].y * f[j].y) + (f[j].z * f[j].z + f[j].w * f[j].w); }
        {
#pragma unroll
            for (int j = 0; j < 8; ++j) { const v2u w = ab[64 * j]; h[j] = (f32x4){bflo(w.x), bfhi(w.x), bflo(w.y), bfhi(w.y)}; }
        }
        ss = wave_sum(ss);
        const float rf = (MODE == 1 ? 1.0f : 0.5f) / sqrtf(ss * (1.0f / DM) + EPS);
        float s2 = 0.f;
#pragma unroll
        for (int j = 0; j < 8; ++j) { h[j] = h[j] + f[j] * gv[j] * rf; s2 += (h[j].x * h[j].x + h[j].y * h[j].y) + (h[j].z * h[j].z + h[j].w * h[j].w); }
        if (MODE == 2) {
            GAS f32x4* op = (GAS f32x4*)(F.out + (size_t)row * DM) + F.lane;
#pragma unroll
            for (int j = 0; j < 8; ++j) op[64 * j] = h[j];
        } else {
            s2 = wave_sum(s2);
#pragma unroll
            for (int j = 0; j < 8; ++j) ab[64 * j] = (v2u){pk2(h[j].x, h[j].y), pk2(h[j].z, h[j].w)};
            if (OUT8) { GAS unsigned* h8 = (GAS unsigned*)(H8 + (size_t)row * DM) + F.lane;
#pragma unroll
                for (int j = 0; j < 8; ++j) h8[64 * j] = pk4_fp8(h[j].x, h[j].y, h[j].z, h[j].w); }
            if (F.lane == 0) rstd_out[row] = 1.0f / sqrtf(s2 * (1.0f / DM) + EPS);
        }
    }
}

__device__ __forceinline__ void zero_pads(Frame& F) {
    const int gt = F.vcu * (NWAVES * 64) + F.tid, NG = F.G * NWAVES * 64;
    bf16* Kh = (bf16*)(F.ws + WS_KH); bf16* Vh = (bf16*)(F.ws + WS_VH); bf16* IK = (bf16*)(F.ws + WS_IK);
    const v4u z = {0u, 0u, 0u, 0u};
    for (int i = gt; i < 2 * 16 * 768 + 2 * 384; i += NG) {
        if (i < 2 * 16 * 768) { const int which = i / (16 * 768), r = i % (16 * 768), bh = r / 768, o = r % 768;
            *(GAS v4u*)((which ? Vh : Kh) + ((size_t)bh * TKV + 8208) * 128 + o * 8) = z; }
        else { const int r = i - 2 * 16 * 768, b = r / 384, o = r % 384, pos = 8208 + (o >> 3), ch = o & 7;
               *(GAS v4u*)(IK + (size_t)b * TKV * 64 + (size_t)(pos >> 5) * 2048 + (ch >> 1) * 512 + (ch & 1) * 256 + (pos & 31) * 8) = z; }
    }
}

__device__ __forceinline__ unsigned row_or16(unsigned v) {
    v |= (unsigned)__builtin_amdgcn_update_dpp(0, (int)v, 0xB1, 0xf, 0xf, false);
    v |= (unsigned)__builtin_amdgcn_update_dpp(0, (int)v, 0x4E, 0xf, 0xf, false);
    v |= (unsigned)__builtin_amdgcn_update_dpp(0, (int)v, 0x141, 0xf, 0xf, false);
    v |= (unsigned)__builtin_amdgcn_update_dpp(0, (int)v, 0x140, 0xf, 0xf, false);
    return v;
}
#ifndef P5_REP_SCORE
#define P5_REP_SCORE 1
#endif
#ifndef P5_REP_SEL
#define P5_REP_SEL 1
#endif
#ifndef P5_REP_MMA
#define P5_REP_MMA 1
#endif
#ifndef P5_REP_SCV
#define P5_REP_SCV 1
#endif
#ifndef P5_REP_BIS
#define P5_REP_BIS 1
#endif
#ifndef P5_REP_EMIT
#define P5_REP_EMIT 1
#endif
__device__ __forceinline__ void p5_item(Frame& F, int b, int t) {
    const int lane = F.lane, wid = F.wave, r32 = lane & 31, hi = lane >> 5;
    const GAS bf16* IQ = (const GAS bf16*)(F.ws + WS_IQ); const GAS bf16* IK = (const GAS bf16*)(F.ws + WS_IK); const GAS float* IW = (const GAS float*)(F.ws + WS_IW);
    GAS u64* MASK = (GAS u64*)(F.ws + WS_MASK);
    LAS unsigned short* S16 = (LAS unsigned short*)F.lds;
    constexpr int SROWD = 129 * 33, SROWH = 2 * SROWD;
    const int s0 = 8 * t, qb = s0 >> 8, nwords = 4 * qb + 5;
    const int kmax = 16 + s0 + 7, nkt = (kmax >> 5) + 1;
    TIC(0); TIC(1);
    {
        bf16x8 Af[4][4];
        LAS float* WL = (LAS float*)(F.lds + 8 * SROWH * 2);
        if (F.tid < 128) WL[F.tid] = 0.5f * IW[((size_t)(b * SEQ + s0)) * 16 + F.tid];
        LAS bf16* QL = (LAS bf16*)(F.lds + 8 * SROWH * 2 + 512);
        { const int q = F.tid >> 6, dd = F.tid & 63; const GAS bf16* qrow = IQ + ((size_t)(b * SEQ + s0 + q)) * 1024 + dd; const GAS float* wrow = IW + ((size_t)(b * SEQ + s0 + q)) * 16;
          float s = 0.f;
#pragma unroll
          for (int hh = 0; hh < 16; ++hh) s = fmaf(0.5f * wrow[hh], bf2f(qrow[hh * 64]), s);
          QL[q * 64 + dd] = (bf16)f2bf(s); }
        {
            const int qo = (r32 >> 2) & 1, h = (r32 & 3) + 4 * (r32 >> 3);
#pragma unroll
            for (int rb = 0; rb < 4; ++rb) {
                const GAS bf16* qp = IQ + ((size_t)(b * SEQ + s0 + 2 * rb + qo)) * 1024 + h * 64 + 8 * hi;
#pragma unroll
                for (int ks = 0; ks < 4; ++ks) Af[rb][ks] = *(const GAS bf16x8*)(qp + ks * 16);
            }
        }
        __syncthreads();
        bf16x8 Al[4];
#pragma unroll
        for (int ks = 0; ks < 4; ++ks) { bf16x8 z = {0, 0, 0, 0, 0, 0, 0, 0};
            if (r32 < 8) z = *(const LAS bf16x8*)(QL + (r32 < 4 ? 2 * r32 : 2 * (r32 - 4) + 1) * 64 + ks * 16 + 8 * hi);
            Al[ks] = z; }
        TOC(1); TIC(2);
        const GAS char* kbase = (const GAS char*)(IK + (size_t)b * TKV * 64);
        const unsigned koff = (unsigned)(lane * 16);
        bf16x8 Bn[4];
        for (int rep_ = 0; rep_ < P5_REP_SCORE; ++rep_) {
        if (wid < nkt) {
#pragma unroll
            for (int ks = 0; ks < 4; ++ks) Bn[ks] = *(const GAS bf16x8*)(kbase + (koff + (unsigned)(wid * 4096 + ks * 1024)));
        }
        for (int kt = wid; kt < nkt; kt += 8) {
            bf16x8 Bf[4];
#pragma unroll
            for (int ks = 0; ks < 4; ++ks) Bf[ks] = Bn[ks];
            if (kt + 8 < nkt) {
#pragma unroll
                for (int ks = 0; ks < 4; ++ks) Bn[ks] = *(const GAS bf16x8*)(kbase + (koff + (unsigned)((kt + 8) * 4096 + ks * 1024)));
            }
            const int key = kt * 32 + r32;
            int wlo = hi * 16; asm volatile("" : "+v"(wlo));
            f32x16 acc[4], accl;
#pragma unroll
            for (int m_ = 0; m_ < P5_REP_MMA; ++m_) {
#pragma unroll
            for (int rb = 0; rb < 4; ++rb) acc[rb] = (f32x16){};
            accl = (f32x16){};
            __builtin_amdgcn_s_setprio(1);
#pragma unroll
            for (int ks = 0; ks < 4; ++ks) {
#pragma unroll
                for (int rb = 0; rb < 4; ++rb) acc[rb] = __builtin_amdgcn_mfma_f32_32x32x16_bf16(Af[rb][ks], Bf[ks], acc[rb], 0, 0, 0);
                accl = __builtin_amdgcn_mfma_f32_32x32x16_bf16(Al[ks], Bf[ks], accl, 0, 0, 0); }
            __builtin_amdgcn_s_setprio(0);
            if (m_ + 1 < P5_REP_MMA) asm volatile("" : "+v"(acc[0]), "+v"(acc[1]), "+v"(acc[2]), "+v"(acc[3]));
            }
#pragma unroll
            for (int v_ = 0; v_ < P5_REP_SCV; ++v_)
#pragma unroll
            for (int rb = 0; rb < 4; ++rb) {
                if (P5_REP_SCV > 1) asm volatile("" : "+v"(acc[rb]));
                const LAS f32x4* wl = (const LAS f32x4*)(WL + wlo + 32 * rb);
                const f32x4 w0 = wl[0], w1 = wl[1], w2 = wl[2], w3 = wl[3];
                const float wvr[16] = {w0.x, w0.y, w0.z, w0.w, w1.x, w1.y, w1.z, w1.w, w2.x, w2.y, w2.z, w2.w, w3.x, w3.y, w3.z, w3.w};
                float sc = accl[rb];
#pragma unroll
                for (int r = 0; r < 16; ++r) { const float a_ = acc[rb][r]; sc = fmaf(__builtin_fabsf(a_), wvr[r], sc); }
                sc = fminf(fmaxf(sc, -60000.f), 60000.f);
                const _Float16 hf = (_Float16)sc;
                const unsigned hb = (unsigned)__builtin_bit_cast(unsigned short, hf);
                unsigned sk = (hb & 0x8000u) ? (~hb & 0xffffu) : (hb | 0x8000u);
                sk = (sk >> 1) | 0x8000u;
                if (key > 16 + s0 + 2 * rb + hi) sk = 0x81ffu;
                S16[(2 * rb + hi) * SROWH + (key >> 6) * 66 + (key & 63)] = (unsigned short)sk;
            }
        }
        }
    }
    TOC(2); TIC(3);
    {
        LAS unsigned* row = (LAS unsigned*)(S16 + wid * SROWH);
        for (int k2 = nkt * 16 + lane; k2 < 4128; k2 += 64) row[(k2 >> 5) * 33 + (k2 & 31)] = 0x81ff81ffu;
    }
    asm volatile("s_waitcnt lgkmcnt(0)" ::: "memory"); __builtin_amdgcn_s_barrier(); asm volatile("" ::: "memory");
    TOC(3); TIC(4);
    {
        const LAS unsigned* srow = (const LAS unsigned*)(S16 + wid * SROWH);
        const bool second = nwords > 64, last = nwords > 128;
        unsigned d[64];
#pragma unroll
        for (int i = 0; i < 32; ++i) d[i] = srow[lane * 33 + i];
#pragma unroll
        for (int i = 0; i < 32; ++i) { const unsigned x = srow[(lane + 64) * 33 + i]; d[32 + i] = second ? x : 0x81ff81ffu; }
        unsigned d128 = 0x81ff81ffu;
        if (last) d128 = 0x81ff0000u | (unsigned)(S16 + wid * SROWH)[128 * 66 + lane];
#define CNT_GE(cnt_, c15) do { const unsigned C_ = (unsigned)(c15) * 0x10001u; \
            _Pragma("unroll") for (int i = 0; i < 32; ++i) cnt_ += (unsigned)__builtin_popcount((d[i] - C_) & 0x80008000u); \
            if (second) { _Pragma("unroll") for (int i = 32; i < 64; ++i) cnt_ += (unsigned)__builtin_popcount((d[i] - C_) & 0x80008000u); \
                cnt_ += (unsigned)__builtin_popcount((d128 - C_) & 0x80008000u); } } while (0)
        unsigned thr = 0u;
        for (int bit = 14; bit >= 0; --bit) {
            const unsigned cand = thr | (1u << bit); unsigned c = 0u;
            CNT_GE(c, cand);
            if (wave_sum_u(c) >= 256u) thr = cand;
        }
        TOC(4); TIC(5);
        if (thr < 0x0200u) thr = 0x0200u;
        unsigned cg = 0u, ce = 0u;
        CNT_GE(cg, thr + 1u); CNT_GE(ce, thr);
        const unsigned cgt = wave_sum_u(cg), cge = wave_sum_u(ce);
#undef CNT_GE
        const int need = 256 - (int)cgt;
        GAS unsigned* mrow = (GAS unsigned*)(MASK + ((size_t)(b * SEQ + s0 + wid)) * 130);
        if (cge <= 256u) {
            const unsigned T_ = thr * 0x10001u;
#pragma unroll
            for (int tt = 0; tt < 2; ++tt) {
                if (tt == 0 || second) {
                    unsigned w0 = 0u, w1 = 0u;
#pragma unroll
                    for (int i = 0; i < 32; ++i) {
                        const unsigned sw = d[32 * tt + i] - T_;
                        const unsigned b2 = ((sw >> 15) & 1u) | ((sw >> 30) & 2u);
                        constexpr int dummy_ = 0; (void)dummy_;
                        const int pos = 16 * (i >> 4) + 2 * (i & 1) + 4 * ((i & 15) >> 2);
                        if (((i & 15) >> 1) & 1) w1 |= b2 << pos; else w0 |= b2 << pos;
                    }
                    *(GAS v2u*)(mrow + 2 * (64 * tt + lane)) = (v2u){w0, w1};
                }
            }
            if (last) {
                const u64 w = __ballot((((d128 - T_) >> 15) & 1u) != 0u);
                const unsigned vl = (unsigned)w, vh = (unsigned)(w >> 32), ul = vl >> 4, uh = vh >> 4;
                const unsigned a0 = (vl & 0xFu) | ((vl >> 4) & 0xF0u) | ((vl >> 8) & 0xF00u) | ((vl >> 12) & 0xF000u), a1 = (ul & 0xFu) | ((ul >> 4) & 0xF0u) | ((ul >> 8) & 0xF00u) | ((ul >> 12) & 0xF000u);
                const unsigned b0 = (vh & 0xFu) | ((vh >> 4) & 0xF0u) | ((vh >> 8) & 0xF00u) | ((vh >> 12) & 0xF000u), b1 = (uh & 0xFu) | ((uh >> 4) & 0xF0u) | ((uh >> 8) & 0xF00u) | ((uh >> 12) & 0xF000u);
                if (lane == 0) { mrow[256] = a0 | (b0 << 16); mrow[257] = a1 | (b1 << 16); }
            }
        } else {
            const unsigned T_ = thr * 0x10001u, T1_ = (thr + 1u) * 0x10001u;
            unsigned e1 = 0u, e2 = 0u;
#pragma unroll
            for (int i = 0; i < 32; ++i) e1 += (unsigned)__builtin_popcount((d[i] - T_) & 0x80008000u) - (unsigned)__builtin_popcount((d[i] - T1_) & 0x80008000u);
#pragma unroll
            for (int i = 32; i < 64; ++i) e2 += (unsigned)__builtin_popcount((d[i] - T_) & 0x80008000u) - (unsigned)__builtin_popcount((d[i] - T1_) & 0x80008000u);
            int base1 = 0, base2 = 0, tot1 = 0, tot2 = 0;
#pragma unroll
            for (int bt = 0; bt < 7; ++bt) {
                const u64 m1 = __ballot(((e1 >> bt) & 1u) != 0u), m2 = __ballot(((e2 >> bt) & 1u) != 0u);
                base1 += (int)__builtin_amdgcn_mbcnt_hi((unsigned)(m1 >> 32), __builtin_amdgcn_mbcnt_lo((unsigned)m1, 0u)) << bt; tot1 += __popcll(m1) << bt;
                base2 += (int)__builtin_amdgcn_mbcnt_hi((unsigned)(m2 >> 32), __builtin_amdgcn_mbcnt_lo((unsigned)m2, 0u)) << bt; tot2 += __popcll(m2) << bt;
            }
#pragma unroll
            for (int tt = 0; tt < 2; ++tt) {
                if (tt == 0 || second) {
                    int quota = need - (tt == 0 ? base1 : tot1 + base2);
                    unsigned w0 = 0u, w1 = 0u;
#pragma unroll
                    for (int i = 0; i < 32; ++i) {
                        const unsigned sw = d[32 * tt + i] - T_, sg = d[32 * tt + i] - T1_;
                        const unsigned ge_lo = (sw >> 15) & 1u, ge_hi = (sw >> 31) & 1u, gt_lo = (sg >> 15) & 1u, gt_hi = (sg >> 31) & 1u;
                        const unsigned eq_lo = ge_lo ^ gt_lo, eq_hi = ge_hi ^ gt_hi;
                        const unsigned s_lo = gt_lo | (eq_lo & (quota > 0 ? 1u : 0u)); quota -= (int)eq_lo;
                        const unsigned s_hi = gt_hi | (eq_hi & (quota > 0 ? 1u : 0u)); quota -= (int)eq_hi;
                        const unsigned b2 = s_lo | (s_hi << 1);
                        const int pos = 16 * (i >> 4) + 2 * (i & 1) + 4 * ((i & 15) >> 2);
                        if (((i & 15) >> 1) & 1) w1 |= b2 << pos; else w0 |= b2 << pos;
                    }
                    *(GAS v2u*)(mrow + 2 * (64 * tt + lane)) = (v2u){w0, w1};
                }
            }
            if (last) {
                const unsigned k128 = d128 & 0x7fffu;
                const u64 em = __ballot(k128 == thr);
                const int rank = tot1 + tot2 + (int)__builtin_amdgcn_mbcnt_hi((unsigned)(em >> 32), __builtin_amdgcn_mbcnt_lo((unsigned)em, 0u));
                const u64 w = __ballot(k128 > thr || (k128 == thr && rank < need));
                const unsigned vl = (unsigned)w, vh = (unsigned)(w >> 32), ul = vl >> 4, uh = vh >> 4;
                const unsigned a0 = (vl & 0xFu) | ((vl >> 4) & 0xF0u) | ((vl >> 8) & 0xF00u) | ((vl >> 12) & 0xF000u), a1 = (ul & 0xFu) | ((ul >> 4) & 0xF0u) | ((ul >> 8) & 0xF00u) | ((ul >> 12) & 0xF000u);
                const unsigned b0 = (vh & 0xFu) | ((vh >> 4) & 0xF0u) | ((vh >> 8) & 0xF00u) | ((vh >> 12) & 0xF000u), b1 = (uh & 0xFu) | ((uh >> 4) & 0xF0u) | ((uh >> 8) & 0xF00u) | ((uh >> 12) & 0xF000u);
                if (lane == 0) { mrow[256] = a0 | (b0 << 16); mrow[257] = a1 | (b1 << 16); }
            }
        }
    }
    asm volatile("s_waitcnt lgkmcnt(0)" ::: "memory"); __builtin_amdgcn_s_barrier(); asm volatile("" ::: "memory");
    TOC(5); TOC(0);
}

typedef short s16x4g __attribute__((ext_vector_type(4)));
template <int KSTEPS>
__device__ __forceinline__ void mma_ll(f32x16& acc, const LAS bf16* A, int sa, const LAS bf16* B, int sb, int r32, int hi) {
#pragma unroll
    for (int ks = 0; ks < KSTEPS; ++ks) {
        const bf16x8 a = *(const LAS bf16x8*)(A + r32 * sa + ks * 16 + 8 * hi), bb = *(const LAS bf16x8*)(B + r32 * sb + ks * 16 + 8 * hi);
        acc = __builtin_amdgcn_mfma_f32_32x32x16_bf16(a, bb, acc, 0, 0, 0);
    }
}
__device__ __forceinline__ bf16x8 tr_frag(unsigned base, int pb, int lane) {
    const unsigned a0 = base + (unsigned)((8 * (lane >> 5) + ((lane >> 2) & 3)) * pb + (16 * ((lane >> 4) & 1) + 4 * (lane & 3)) * 2), a1 = a0 + 4u * (unsigned)pb;
    s16x4g lo, hh;
    asm volatile("ds_read_b64_tr_b16 %0, %2\n\tds_read_b64_tr_b16 %1, %3\n\ts_waitcnt lgkmcnt(0)" : "=&v"(lo), "=&v"(hh) : "v"(a0), "v"(a1) : "memory");
    return (bf16x8){lo[0], lo[1], lo[2], lo[3], hh[0], hh[1], hh[2], hh[3]};
}
__device__ __forceinline__ float log_sigmoid_f(float z) { return fminf(z, 0.f) - __logf(1.0f + __expf(-fabsf(z))); }
__device__ __forceinline__ void gla_bcum(Frame& F, LAS float* BC, LAS float* GT, LAS float* GLs, int b, int h, int n, const float* Wg, const float* bg) {
    const GAS float* GLOW = (const GAS float*)(F.ws + WS_GLOW);
    const int k = F.tid & 127, ig = __builtin_amdgcn_readfirstlane(F.tid >> 7);
    if (F.tid < 256) { const int i = F.tid >> 2, pc = F.tid & 3; f32x4 v = {0.f, 0.f, 0.f, 0.f};
        if (!(n == 0 && i < 48)) v = *(const GAS f32x4*)(GLOW + ((size_t)b * TKV + 64 * n + i) * 16 + 4 * pc);
        *(LAS f32x4*)(GLs + i * 16 + 4 * pc) = v; }
    float wc[16];
#pragma unroll
    for (int r = 0; r < 16; ++r) wc[r] = Wg[r * 512 + h * 128 + k];
    const float bk = bg[h * 128 + k];
    __syncthreads();
    float run = 0.f, pre[16];
#pragma unroll
    for (int ii = 0; ii < 16; ++ii) {
        const int i = 16 * ig + ii; float lg = 0.f;
        if (!(n == 0 && i < 48)) {
            const LAS f32x4* gl = (const LAS f32x4*)(GLs + i * 16); float z = bk;
#pragma unroll
            for (int r4 = 0; r4 < 4; ++r4) { const f32x4 g4 = gl[r4];
                z = fmaf(g4.x, wc[4 * r4 + 0], z); z = fmaf(g4.y, wc[4 * r4 + 1], z); z = fmaf(g4.z, wc[4 * r4 + 2], z); z = fmaf(g4.w, wc[4 * r4 + 3], z); }
            lg = log_sigmoid_f(z) * (1.0f / 16.0f);
        }
        run += lg; pre[ii] = run;
    }
    GT[ig * 128 + k] = run;
    __syncthreads();
    float off = 0.f;
#pragma unroll
    for (int gq = 0; gq < 3; ++gq) off += (gq < ig) ? GT[gq * 128 + k] : 0.f;
#pragma unroll
    for (int ii = 0; ii < 16; ++ii) BC[(16 * ig + ii) * 128 + k] = pre[ii] + off;
    __syncthreads();
}
constexpr int GLA_VP = 288, GLA_KP1 = 160;
__device__ __forceinline__ void gla_load_vn(Frame& F, LAS bf16* Vn, int b, int h, int n) {
    const GAS bf16* GV = (const GAS bf16*)(F.ws + WS_GV);
    const int v0 = 8 * (F.tid & 31);
#pragma unroll
    for (int pass = 0; pass < 4; ++pass) {
        const int i = (F.tid >> 5) + 16 * pass, pp = 64 * n + i;
        v4u raw = {0u, 0u, 0u, 0u};
        if (!(n == 0 && i < 48)) raw = *(const GAS v4u*)(GV + ((size_t)b * TKV + pp) * 1024 + h * 256 + v0);
        *(LAS v4u*)(Vn + i * GLA_VP + v0) = raw;
    }
}
__device__ __forceinline__ void g1_unit(Frame& F, int b, int h, int n, const float* Wg, const float* bg) {
    const int lane = F.lane, wid = F.wave, r32 = lane & 31, hi = lane >> 5, tid = F.tid;
    LAS float* BC = (LAS float*)F.lds; LAS float* GLs = (LAS float*)(F.lds + 32768); LAS bf16* KD = (LAS bf16*)(F.lds + 36864); LAS bf16* Vn = (LAS bf16*)(F.lds + 57344);
    const GAS bf16* GK = (const GAS bf16*)(F.ws + WS_GK); GAS bf16* ST = (GAS bf16*)(F.ws + WS_ST); GAS float* DEC = (GAS float*)(F.ws + WS_DEC);
    TIC(10); gla_bcum(F, BC, (LAS float*)(F.lds + 131072), GLs, b, h, n, Wg, bg); TOC(10); TIC(11);
    { const int k0 = 8 * (tid & 15);
#pragma unroll
      for (int pass = 0; pass < 2; ++pass) {
        const int i = (tid >> 4) + 32 * pass, pp = 64 * n + i;
        v4u raw = {0u, 0u, 0u, 0u};
        if (!(n == 0 && i < 48)) raw = *(const GAS v4u*)(GK + ((size_t)b * TKV + pp) * 512 + h * 128 + k0);
        const unsigned rw[4] = {raw.x, raw.y, raw.z, raw.w}; float kd[8];
        const f32x4 bc0 = *(const LAS f32x4*)(BC + i * 128 + k0), bc1 = *(const LAS f32x4*)(BC + i * 128 + k0 + 4), bl0 = *(const LAS f32x4*)(BC + 63 * 128 + k0), bl1 = *(const LAS f32x4*)(BC + 63 * 128 + k0 + 4);
        const float bcv[8] = {bc0.x, bc0.y, bc0.z, bc0.w, bc1.x, bc1.y, bc1.z, bc1.w}, blv[8] = {bl0.x, bl0.y, bl0.z, bl0.w, bl1.x, bl1.y, bl1.z, bl1.w};
#pragma unroll
        for (int j = 0; j < 8; ++j) { const float kv = (j & 1) ? bfhi(rw[j >> 1]) : bflo(rw[j >> 1]); kd[j] = kv * __expf(blv[j] - bcv[j]); }
        *(LAS v4u*)(KD + i * GLA_KP1 + k0) = (v4u){pk2(kd[0], kd[1]), pk2(kd[2], kd[3]), pk2(kd[4], kd[5]), pk2(kd[6], kd[7])};
      } }
    gla_load_vn(F, Vn, b, h, n);
    __syncthreads();
    TOC(11); TIC(12);
    GAS bf16* dst = ST + ((size_t)((b * 4 + h) * 128 + n) * 256) * 128;
    const float declast = (tid < 128) ? __expf(BC[63 * 128 + tid]) : 0.f;
    f32x16 acc[4];
    {
        const unsigned vb = (unsigned)(uintptr_t)Vn + (unsigned)(32 * wid * 2), kb = (unsigned)(uintptr_t)KD;
        bf16x8 af[4];
#pragma unroll
        for (int ks = 0; ks < 4; ++ks) af[ks] = tr_frag(vb + (unsigned)(16 * ks * GLA_VP * 2), GLA_VP * 2, lane);
#pragma unroll
        for (int cb = 0; cb < 4; ++cb) { acc[cb] = (f32x16){};
#pragma unroll
            for (int ks = 0; ks < 4; ++ks) acc[cb] = __builtin_amdgcn_mfma_f32_32x32x16_bf16(af[ks], tr_frag(kb + (unsigned)(16 * ks * GLA_KP1 * 2 + 32 * cb * 2), GLA_KP1 * 2, lane), acc[cb], 0, 0, 0); }
    }
    __syncthreads();
    {   LAS bf16* LT = (LAS bf16*)F.lds;
#pragma unroll
        for (int cb = 0; cb < 4; ++cb)
#pragma unroll
            for (int r = 0; r < 16; ++r) LT[(32 * wid + (r & 3) + 8 * (r >> 2) + 4 * hi) * 128 + 32 * cb + r32] = (bf16)f2bf(acc[cb][r]);
        __syncthreads();
        const LAS v4u* src = (const LAS v4u*)F.lds; GAS v4u* d4 = (GAS v4u*)dst;
#pragma unroll
        for (int q = 0; q < 8; ++q) d4[q * 512 + tid] = src[q * 512 + tid];
    }
    if (tid < 128) DEC[(size_t)((b * 4 + h) * 128 + n) * 128 + tid] = declast;
    __syncthreads();
    TOC(12);
}
__device__ __forceinline__ void g2_scan(Frame& F) {
    GAS bf16* ST = (GAS bf16*)(F.ws + WS_ST); const GAS float* DEC = (const GAS float*)(F.ws + WS_DEC);
    const int NG = F.G * NWAVES * 64;
    for (int e = F.vcu * (NWAVES * 64) + F.tid; e < 8 * 16384; e += NG) {
        const int bh = e >> 14, rem = e & 16383, v = rem >> 6, k = (rem & 63) * 2;
        GAS unsigned* p = (GAS unsigned*)(ST + ((size_t)bh * 128 * 256 + v) * 128 + k);
        const GAS float* d = DEC + (size_t)bh * 128 * 128 + k;
        float s0 = 0.f, s1 = 0.f;
        for (int n = 0; n < 128; n += 8) {
            unsigned w[8]; float d0[8], d1[8];
#pragma unroll
            for (int u = 0; u < 8; ++u) { w[u] = p[(size_t)(n + u) * 16384]; d0[u] = d[(n + u) * 128]; d1[u] = d[(n + u) * 128 + 1]; }
#pragma unroll
            for (int u = 0; u < 8; ++u) { s0 = fmaf(s0, d0[u], bflo(w[u])); s1 = fmaf(s1, d1[u], bfhi(w[u])); p[(size_t)(n + u) * 16384] = pk2(s0, s1); }
        }
    }
}
__device__ __forceinline__ void g3_unit(Frame& F, int b, int h, int c, const float* Wg, const float* bg, const float* ggla) {
    const int lane = F.lane, wid = F.wave, r32 = lane & 31, hi = lane >> 5, tid = F.tid;
    LAS float* BC = (LAS float*)F.lds; LAS bf16* Q1 = (LAS bf16*)(F.lds + 32768); LAS bf16* Q2 = (LAS bf16*)(F.lds + 50176); LAS bf16* KD = (LAS bf16*)(F.lds + 67584);
    LAS bf16* Vn = (LAS bf16*)(F.lds + 84992); LAS bf16* AT = (LAS bf16*)(F.lds + 121856); LAS float* OS = (LAS float*)F.lds; LAS float* GLs = (LAS float*)(F.lds + 133120);
    const GAS bf16* GQ = (const GAS bf16*)(F.ws + WS_GQ); const GAS bf16* GK = (const GAS bf16*)(F.ws + WS_GK); const GAS bf16* GO = (const GAS bf16*)(F.ws + WS_GO);
    const GAS bf16* ST = (const GAS bf16*)(F.ws + WS_ST); GAS bf16* MIXA = (GAS bf16*)(F.ws + WS_MIXA);
    const int rbI = wid & 1, cbV = (wid >> 1) * 2;
    bf16x8 sf[8][2];
    { const GAS bf16* sp = ST + ((size_t)((b * 4 + h) * 128 + (c - 1)) * 256) * 128;
#pragma unroll
      for (int ks = 0; ks < 8; ++ks)
#pragma unroll
        for (int t = 0; t < 2; ++t) sf[ks][t] = *(const GAS bf16x8*)(sp + (size_t)(32 * (cbV + t) + r32) * 128 + ks * 16 + 8 * hi); }
    TIC(13); gla_bcum(F, BC, (LAS float*)(F.lds + 131072), GLs, b, h, c, Wg, bg); TOC(13); TIC(14);
    { const int k0 = 8 * (tid & 15);
#pragma unroll
      for (int pass = 0; pass < 2; ++pass) {
        const int i = (tid >> 4) + 32 * pass, pp = 64 * c + i;
        const v4u rq = *(const GAS v4u*)(GQ + ((size_t)b * TKV + pp) * 512 + h * 128 + k0);
        const v4u rk = *(const GAS v4u*)(GK + ((size_t)b * TKV + pp) * 512 + h * 128 + k0);
        const unsigned qw[4] = {rq.x, rq.y, rq.z, rq.w}, kw[4] = {rk.x, rk.y, rk.z, rk.w};
        const f32x4 bc0 = *(const LAS f32x4*)(BC + i * 128 + k0), bc1 = *(const LAS f32x4*)(BC + i * 128 + k0 + 4), bl0 = *(const LAS f32x4*)(BC + 63 * 128 + k0), bl1 = *(const LAS f32x4*)(BC + 63 * 128 + k0 + 4);
        const float bcv[8] = {bc0.x, bc0.y, bc0.z, bc0.w, bc1.x, bc1.y, bc1.z, bc1.w}, blv[8] = {bl0.x, bl0.y, bl0.z, bl0.w, bl1.x, bl1.y, bl1.z, bl1.w};
        float q1[8], q2[8], kd[8];
#pragma unroll
        for (int j = 0; j < 8; ++j) { const float qv = (j & 1) ? bfhi(qw[j >> 1]) : bflo(qw[j >> 1]), kv = (j & 1) ? bfhi(kw[j >> 1]) : bflo(kw[j >> 1]);
            const float e1 = __expf(bcv[j] - blv[j]);
            q1[j] = qv * __expf(bcv[j]); q2[j] = qv * e1; kd[j] = kv * __builtin_amdgcn_rcpf(e1); }
        *(LAS v4u*)(Q1 + i * 136 + k0) = (v4u){pk2(q1[0], q1[1]), pk2(q1[2], q1[3]), pk2(q1[4], q1[5]), pk2(q1[6], q1[7])};
        *(LAS v4u*)(Q2 + i * 136 + k0) = (v4u){pk2(q2[0], q2[1]), pk2(q2[2], q2[3]), pk2(q2[4], q2[5]), pk2(q2[6], q2[7])};
        *(LAS v4u*)(KD + i * 136 + k0) = (v4u){pk2(kd[0], kd[1]), pk2(kd[2], kd[3]), pk2(kd[4], kd[5]), pk2(kd[6], kd[7])};
      } }
    gla_load_vn(F, Vn, b, h, c);
    __syncthreads();
    TOC(14); TIC(15);
    f32x16 acc[2] = {};
#pragma unroll
    for (int ks = 0; ks < 8; ++ks) {
        const bf16x8 a = *(const LAS bf16x8*)(Q1 + (32 * rbI + r32) * 136 + ks * 16 + 8 * hi);
#pragma unroll
        for (int t = 0; t < 2; ++t) acc[t] = __builtin_amdgcn_mfma_f32_32x32x16_bf16(a, sf[ks][t], acc[t], 0, 0, 0);
    }
    if (wid < 4) {
        const int ib = wid & 1, jb = wid >> 1;
        f32x16 at = {};
        mma_ll<8>(at, Q2 + (32 * ib) * 136, 136, KD + (32 * jb) * 136, 136, r32, hi);
#pragma unroll
        for (int r = 0; r < 16; ++r) { const int i = 32 * ib + (r & 3) + 8 * (r >> 2) + 4 * hi, j = 32 * jb + r32;
            AT[i * 72 + j] = (bf16)f2bf(j <= i ? at[r] : 0.f); }
    }
    __syncthreads();
    TOC(15); TIC(16);
    {
        const unsigned vb = (unsigned)(uintptr_t)Vn;
#pragma unroll
        for (int ks = 0; ks < 4; ++ks) {
            const bf16x8 a = *(const LAS bf16x8*)(AT + (32 * rbI + r32) * 72 + ks * 16 + 8 * hi);
#pragma unroll
            for (int t = 0; t < 2; ++t) acc[t] = __builtin_amdgcn_mfma_f32_32x32x16_bf16(a, tr_frag(vb + (unsigned)(16 * ks * GLA_VP * 2 + 32 * (cbV + t) * 2), GLA_VP * 2, lane), acc[t], 0, 0, 0);
        }
    }
    __syncthreads();
#pragma unroll
    for (int t = 0; t < 2; ++t)
#pragma unroll
        for (int r = 0; r < 16; ++r) OS[(32 * rbI + (r & 3) + 8 * (r >> 2) + 4 * hi) * 260 + 32 * (cbV + t) + r32] = acc[t][r];
    __syncthreads();
    {
        const int i = tid >> 3, seg = tid & 7; const LAS float* orow = OS + i * 260 + 32 * seg;
        float ss = 0.f; f32x4 ov[8];
#pragma unroll
        for (int q = 0; q < 8; ++q) { ov[q] = *(const LAS f32x4*)(orow + 4 * q); ss += (ov[q].x * ov[q].x + ov[q].y * ov[q].y) + (ov[q].z * ov[q].z + ov[q].w * ov[q].w); }
        ss += __shfl_xor(ss, 1); ss += __shfl_xor(ss, 2); ss += __shfl_xor(ss, 4);
        const float rs = 1.0f / sqrtf(ss * (1.0f / 256.0f) + EPS);
        const size_t row = (size_t)b * SEQ + 64 * (c - 1) + i;
        const float* gn = ggla + 32 * seg;
        const GAS bf16* gp = GO + row * 1024 + h * 256 + 32 * seg;
        GAS bf16* op = MIXA + row * 2048 + 1024 + h * 256 + 32 * seg;
#pragma unroll
        for (int q2 = 0; q2 < 4; ++q2) {
            const v4u gw = *(const GAS v4u*)(gp + 8 * q2);
            const f32x4 g0 = *(const f32x4*)(gn + 8 * q2), g1 = *(const f32x4*)(gn + 8 * q2 + 4);
            const f32x4 a = ov[2 * q2], bq = ov[2 * q2 + 1];
            float y[8];
            y[0] = a.x * rs * g0.x * pg8::silu_f(bflo(gw.x)); y[1] = a.y * rs * g0.y * pg8::silu_f(bfhi(gw.x));
            y[2] = a.z * rs * g0.z * pg8::silu_f(bflo(gw.y)); y[3] = a.w * rs * g0.w * pg8::silu_f(bfhi(gw.y));
            y[4] = bq.x * rs * g1.x * pg8::silu_f(bflo(gw.z)); y[5] = bq.y * rs * g1.y * pg8::silu_f(bfhi(gw.z));
            y[6] = bq.z * rs * g1.z * pg8::silu_f(bflo(gw.w)); y[7] = bq.w * rs * g1.w * pg8::silu_f(bfhi(gw.w));
            *(GAS v4u*)(op + 8 * q2) = (v4u){pk2(y[0], y[1]), pk2(y[2], y[3]), pk2(y[4], y[5]), pk2(y[6], y[7])};
        }
    }
    __syncthreads();
    TOC(16);
}
__device__ __forceinline__ att::BlockRef att_ref(Frame& F, int bh, int qb) {
    const int b = bh >> 3, h = bh & 7; att::BlockRef r;
    r.Q = (const bf16*)(F.ws + WS_QH) + ((size_t)bh * SEQ + (size_t)qb * 256) * 128;
    r.K = (const bf16*)(F.ws + WS_KH) + (size_t)bh * TKV * 128; r.V = (const bf16*)(F.ws + WS_VH) + (size_t)bh * TKV * 128;
    r.O = (bf16*)(F.ws + WS_MIXA) + ((size_t)b * SEQ + (size_t)qb * 256) * 2048 + h * 128;
    r.M = (const u64*)(F.ws + WS_MASK) + ((size_t)b * SEQ + (size_t)qb * 256) * 130;
    r.NT = 4 * qb + 5;
    return r;
}
__device__ __forceinline__ void p7_attention(Frame& F) {
    constexpr int total = 256;
    int L = F.vcu; if (L >= total) return;
    int pass = 0;
    att::BlockRef cur = att_ref(F, L >> 4, L & 15);
    att::Seam S;
    att::att_prime(cur, (char*)F.ldsg, S);
    for (;;) {
        const bool more_pass = pass == 0, more_item = L + F.G < total, last = !more_pass && !more_item;
        int passn = pass + 1, Ln = L;
        if (!more_pass) { passn = 0; Ln = more_item ? L + F.G : L; }
        const att::BlockRef nxt = last ? cur : att_ref(F, Ln >> 4, passn ? 31 - (Ln & 15) : (Ln & 15));
        att::att_block(cur, nxt, (char*)F.ldsg, S);
        if (last) break;
        cur = nxt; pass = passn; L = Ln;
    }
}
typedef float f32x4s __attribute__((ext_vector_type(4)));
template <int KSTEPS>
__device__ __forceinline__ f32x4s skinny_k(const GAS bf16* a, const GAS bf16* b) {
    f32x4s acc = {0.f, 0.f, 0.f, 0.f};
#pragma unroll
    for (int ks = 0; ks < KSTEPS; ++ks) acc = __builtin_amdgcn_mfma_f32_16x16x32_bf16(*(const GAS bf16x8*)(a + 32 * ks), *(const GAS bf16x8*)(b + 32 * ks), acc, 0, 0, 0);
    return acc;
}
__device__ __forceinline__ f32x4s wg_reduce(Frame& F, LAS f32x4s* red, f32x4s v) {
    red[F.wave * 64 + F.lane] = v;
    __syncthreads();
    f32x4s s = red[F.lane];
#pragma unroll
    for (int w = 1; w < NWAVES; ++w) s += red[w * 64 + F.lane];
    __syncthreads();
    return s;
}
template <int STEPS>
__device__ __forceinline__ f32x4s skinny_k8(const GAS unsigned char* a, const GAS unsigned char* b) {
    typedef int v8i_s __attribute__((ext_vector_type(8)));
    f32x4s acc = {0.f, 0.f, 0.f, 0.f};
#pragma unroll
    for (int st = 0; st < STEPS; ++st) {
        const v4u a0 = *(const GAS v4u*)(a + 128 * st), a1 = *(const GAS v4u*)(a + 128 * st + 16), b0 = *(const GAS v4u*)(b + 128 * st), b1 = *(const GAS v4u*)(b + 128 * st + 16);
        const v8i_s av = {(int)a0.x, (int)a0.y, (int)a0.z, (int)a0.w, (int)a1.x, (int)a1.y, (int)a1.z, (int)a1.w}, bv = {(int)b0.x, (int)b0.y, (int)b0.z, (int)b0.w, (int)b1.x, (int)b1.y, (int)b1.z, (int)b1.w};
        acc = __builtin_amdgcn_mfma_scale_f32_16x16x128_f8f6f4(av, bv, acc, 0, 0, 0, 0x7f7f7f7f, 0, 0x7f7f7f7f);
    }
    return acc;
}
template <bool FP8>
__device__ __forceinline__ void meta_p1(Frame& F) {
    const int c = F.lane & 15, kq = F.lane >> 4; LAS f32x4s* red = (LAS f32x4s*)F.lds;
    const GAS bf16* AB = (const GAS bf16*)(F.ws + WS_AB); const GAS bf16* WGU = (const GAS bf16*)(F.ws + WS_WGU); GAS bf16* ACT = (GAS bf16*)(F.ws + WS_ACT);
    const GAS unsigned char* X8 = (const GAS unsigned char*)(F.ws + WS_F); const GAS unsigned char* W8 = (const GAS unsigned char*)(F.ws + WS_WGU);
    const GAS float* rstd = (const GAS float*)(F.ws + WS_RSTD1);
    for (int u = F.vcu; u < 352; u += F.G) {
        const int tile = u >> 3, j = u & 7, k0 = F.wave * (DM / 8);
        f32x4s ag, au;
        if (FP8) { const GAS unsigned char* a = X8 + (size_t)(R + c) * DM + k0 + 32 * kq; const GAS unsigned char* bg = W8 + (size_t)(tile * 256 + 16 * j + c) * DM + k0 + 32 * kq;
            ag = wg_reduce(F, red, skinny_k8<DM / 1024>(a, bg)); au = wg_reduce(F, red, skinny_k8<DM / 1024>(a, bg + (size_t)128 * DM)); }
        else { const GAS bf16* a = AB + (size_t)(R + c) * DM + k0 + 8 * kq; const GAS bf16* bg = WGU + (size_t)(tile * 256 + 16 * j + c) * DM + k0 + 8 * kq;
            ag = wg_reduce(F, red, skinny_k<DM / 256>(a, bg)); au = wg_reduce(F, red, skinny_k<DM / 256>(a, bg + (size_t)128 * DM)); }
        if (F.wave == 0) {
#pragma unroll
            for (int q = 0; q < 4; ++q) { const int m = 4 * kq + q; const float rs = rstd[R + m] * (FP8 ? 1.0f / W8_SCALE : 1.0f);
                ACT[(size_t)(R + m) * DFF + tile * 128 + 16 * j + c] = (bf16)f2bf(pg8::silu_f(ag[q] * rs) * (au[q] * rs)); }
        }
    }
}
__device__ __forceinline__ void meta_p2(Frame& F) {
    const int c = F.lane & 15, kq = F.lane >> 4; LAS f32x4s* red = (LAS f32x4s*)F.lds;
    const GAS bf16* ACT = (const GAS bf16*)(F.ws + WS_ACT); const GAS bf16* WD = (const GAS bf16*)(F.ws + WS_WD); GAS bf16* FB = (GAS bf16*)(F.ws + WS_F);
    for (int u = F.vcu; u < 128; u += F.G) {
        const int k0 = F.wave * (DFF / 8);
        const f32x4s acc = wg_reduce(F, red, skinny_k<DFF / 256>(ACT + (size_t)(R + c) * DFF + k0 + 8 * kq, WD + (size_t)(16 * u + c) * DFF + k0 + 8 * kq));
        if (F.wave == 0) {
#pragma unroll
            for (int q = 0; q < 4; ++q) FB[(size_t)(R + 4 * kq + q) * DM + 16 * u + c] = (bf16)f2bf(acc[q]);
        }
    }
}
__device__ __forceinline__ void meta_p4(Frame& F) {
    const int c = F.lane & 15, kq = F.lane >> 4; LAS f32x4s* red = (LAS f32x4s*)F.lds;
    const GAS bf16* AB = (const GAS bf16*)(F.ws + WS_AB); const GAS bf16* WIN = (const GAS bf16*)(F.ws + WS_WIN); const GAS float* rstd = (const GAS float*)(F.ws + WS_RSTD2);
    GAS bf16* Kh = (GAS bf16*)(F.ws + WS_KH); GAS bf16* Vh = (GAS bf16*)(F.ws + WS_VH); GAS bf16* GK = (GAS bf16*)(F.ws + WS_GK); GAS bf16* GV = (GAS bf16*)(F.ws + WS_GV);
    GAS bf16* IK = (GAS bf16*)(F.ws + WS_IK); GAS float* GLOW = (GAS float*)(F.ws + WS_GLOW);
    for (int u = F.vcu; u < 230; u += F.G) {
        int sec, cs;
        if (u < 64) { sec = 0; cs = u * 16; } else if (u < 128) { sec = 1; cs = (u - 64) * 16; } else if (u < 160) { sec = 2; cs = (u - 128) * 16; } else if (u < 224) { sec = 3; cs = (u - 160) * 16; } else { sec = 4; cs = (u - 224) * 16; }
        const int wrow = (sec == 0 ? 4 * 256 : sec == 1 ? 8 * 256 : sec == 2 ? 18 * 256 : sec == 3 ? 20 * 256 : 7168) + cs, k0 = F.wave * (DM / 8);
        const f32x4s acc = wg_reduce(F, red, skinny_k<DM / 256>(AB + (size_t)(R + c) * DM + k0 + 8 * kq, WIN + (size_t)(wrow + c) * DM + k0 + 8 * kq));
        if (F.wave == 0) {
            const int col = cs + c;
#pragma unroll
            for (int q = 0; q < 4; ++q) { const int m = 4 * kq + q; const float vf = acc[q] * rstd[R + m]; const bf16 v = (bf16)f2bf(vf);
                if (sec == 4) {
                    if (col < 64) { const int ch = col >> 3, fo = (ch >> 1) * 512 + (ch & 1) * 256 + (col & 7); IK[fo + m * 8] = v; IK[(size_t)TKV * 64 + fo + m * 8] = v; }
                    else if (col >= 80) { GLOW[((size_t)48 + m) * 16 + (col - 80)] = vf; GLOW[((size_t)TKV + 48 + m) * 16 + (col - 80)] = vf; }
                } else if (sec < 2) { GAS bf16* base = sec == 0 ? Kh : Vh; const int h = col >> 7, d = col & 127;
                    base[((size_t)h * TKV + m) * 128 + d] = v; base[((size_t)(8 + h) * TKV + m) * 128 + d] = v; }
                else if (sec == 2) { GK[((size_t)48 + m) * 512 + col] = v; GK[((size_t)TKV + 48 + m) * 512 + col] = v; }
                else { GV[((size_t)48 + m) * 1024 + col] = v; GV[((size_t)TKV + 48 + m) * 1024 + col] = v; }
            }
        }
    }
}
__device__ __forceinline__ void small_cols(Frame& F) {
    const int c = F.lane & 15, kq = F.lane >> 4, rg = F.wave & 3, ch3 = (F.wave >> 2) * 3;
    const GAS bf16* AB = (const GAS bf16*)(F.ws + WS_AB); const GAS bf16* WIN = (const GAS bf16*)(F.ws + WS_WIN); const GAS float* rstd = (const GAS float*)(F.ws + WS_RSTD2);
    GAS bf16* IK = (GAS bf16*)(F.ws + WS_IK); GAS float* IW = (GAS float*)(F.ws + WS_IW); GAS float* GLOW = (GAS float*)(F.ws + WS_GLOW);
    LAS bf16* Bs = (LAS bf16*)F.lds; constexpr int BP = 264;
    for (int u = F.vcu; u < 256; u += F.G) {
        const int r0 = 64 * u + 16 * rg;
        const GAS bf16* a = AB + (size_t)(r0 + c) * DM + 8 * kq;
        const GAS bf16* bsrc = WIN + (size_t)7168 * DM;
        f32x4s acc[3];
#pragma unroll
        for (int g = 0; g < 3; ++g) acc[g] = (f32x4s){0.f, 0.f, 0.f, 0.f};
        v4u breg[6]; bf16x8 an[8];
#pragma unroll
        for (int i = 0; i < 6; ++i) { const int p = F.tid + 512 * i; breg[i] = *(const GAS v4u*)(bsrc + (size_t)(p >> 5) * DM + (p & 31) * 8); }
#pragma unroll
        for (int ks = 0; ks < 8; ++ks) an[ks] = *(const GAS bf16x8*)(a + 32 * ks);
        for (int kc = 0; kc < 8; ++kc) {
#pragma unroll
            for (int i = 0; i < 6; ++i) { const int p = F.tid + 512 * i; *(LAS v4u*)(Bs + (p >> 5) * BP + (p & 31) * 8) = breg[i]; }
            bf16x8 ac[8];
#pragma unroll
            for (int ks = 0; ks < 8; ++ks) ac[ks] = an[ks];
            __syncthreads();
            if (kc + 1 < 8) {
#pragma unroll
                for (int i = 0; i < 6; ++i) { const int p = F.tid + 512 * i; breg[i] = *(const GAS v4u*)(bsrc + (size_t)(p >> 5) * DM + (kc + 1) * 256 + (p & 31) * 8); }
#pragma unroll
                for (int ks = 0; ks < 8; ++ks) an[ks] = *(const GAS bf16x8*)(a + (kc + 1) * 256 + 32 * ks);
            }
#pragma unroll
            for (int ks = 0; ks < 8; ++ks)
#pragma unroll
                for (int g = 0; g < 3; ++g) acc[g] = __builtin_amdgcn_mfma_f32_16x16x32_bf16(ac[ks], *(const LAS bf16x8*)(Bs + (16 * (ch3 + g) + c) * BP + 32 * ks + 8 * kq), acc[g], 0, 0, 0);
            __syncthreads();
        }
#pragma unroll
        for (int q = 0; q < 4; ++q) {
            const int row = r0 + 4 * kq + q; const float rs = rstd[row]; const int bb = row >> 13, s = row & 8191, pos = 16 + s;
#pragma unroll
            for (int g = 0; g < 3; ++g) {
                const float v = acc[g][q] * rs; const int col = 16 * (ch3 + g) + c;
                if (col < 64) {
                    const int ch = col >> 3, fo = (ch >> 1) * 512 + (ch & 1) * 256 + (col & 7);
                    IK[(size_t)bb * TKV * 64 + (size_t)(pos >> 5) * 2048 + fo + (pos & 31) * 8] = (bf16)f2bf(v);
                } else if (col < 80) IW[(size_t)row * 16 + (col - 64)] = v * 0.25f;
                else GLOW[((size_t)bb * TKV + 64 + s) * 16 + (col - 80)] = v;
            }
        }
    }
}

struct Args { const float* in[19]; float* out; unsigned char* ws; int ph_lo, ph_hi; };
#ifndef FFN1_FP8
#define FFN1_FP8 false
#endif
#ifndef FFN2D_FP8
#define FFN2D_FP8 true
#endif
#ifndef FFN2_FP8
#define FFN2_FP8 true
#endif
#ifndef PG8_SP2
#define PG8_SP2 true
#endif
#ifndef PG8_ALIGN
#define PG8_ALIGN true
#endif
__global__ void __launch_bounds__(NWAVES * 64, 2) hymba_fwd(Args args) {
    extern __shared__ __attribute__((aligned(16))) unsigned char lds[];
    Frame F;
    F.lds = (LAS unsigned char*)lds; F.ldsg = lds;
    F.MISC = (volatile LAS unsigned*)(F.lds + MISC_OFF);
    F.tid = threadIdx.x; F.lane = F.tid & 63; F.wave = __builtin_amdgcn_readfirstlane(F.tid >> 6);
    F.G = gridDim.x; { const int bx = blockIdx.x; F.vcu = (F.G % 8 == 0) ? (bx % 8) * (F.G / 8) + bx / 8 : bx; }
    F.ws = args.ws; F.ctl = (unsigned*)(args.ws + WS_CTL); F.out = args.out;
    for (int u = F.tid; u < (LDS_BYTES - MISC_OFF) / 4; u += NWAVES * 64) ((LAS unsigned*)(F.lds + MISC_OFF))[u] = 0u;
    __syncthreads();
    XcdBarrier bar; bar.bar = F.ctl + CW_BAR; bar.x = 0; bar.st = nullptr;
    if (!MK_PER_PHASE) bar = xcd_barrier_post(F.ctl + CW_BAR, F.MISC + 8);
    const int lo = args.ph_lo, hi = args.ph_hi;
#define PHASE_BEGIN() do { int t_ = threadIdx.x; asm volatile("" : "+v"(t_)); F.tid = t_; F.lane = t_ & 63; F.wave = __builtin_amdgcn_readfirstlane(t_ >> 6); } while (0)
#ifndef PH_MASK
#define PH_MASK 0x1fff
#endif
#define IN(k) ((((PH_MASK) >> (k)) & 1) && lo <= (k) && (k) < hi)
#define SEAM(k) do { if (!MK_PER_PHASE && IN((k) + 1)) { TIC(30); TIC(40 + (k)); xcd_barrier(bar); TOC(40 + (k)); TOC(30); } } while (0)
#ifndef PH_DUP
#define PH_DUP 0
#endif
#define AB ((bf16*)(F.ws + WS_AB))
#define ACT ((bf16*)(F.ws + WS_ACT))
#define FB ((bf16*)(F.ws + WS_F))
#define WGU ((bf16*)(F.ws + WS_WGU))
#define WD ((bf16*)(F.ws + WS_WD))
#define WIN ((bf16*)(F.ws + WS_WIN))
#define WOUT ((bf16*)(F.ws + WS_WOUT))
#define rstd1 ((float*)(F.ws + WS_RSTD1))
#define rstd2 ((float*)(F.ws + WS_RSTD2))
#define rstd3 ((float*)(F.ws + WS_RSTD3))

    #define BODY0 do { TIC(70); convert_ffn<FFN1_FP8, false>(F, args.in[I_W1G], args.in[I_W1U], args.in[I_W1D], args.in[I_G1PRE], WGU, WD); TOC(70); TIC(71); p0_rows<FFN1_FP8>(F, args.in[I_X], args.in[I_META], F.ws + WS_F); TOC(71); } while (0)
    if (IN(0)) { PHASE_BEGIN();
#if (PH_DUP >> 0) & 1
        BODY0; xcd_barrier(bar);
#endif
        BODY0; SEAM(0); }
    if (IN(1)) { PHASE_BEGIN();
        pg8::Gemm g{FFN1_FP8 ? (const bf16*)(F.ws + WS_F) : AB, WGU, R, NGU, FFN1_FP8 ? DM / 2 : DM}; pg8::StaticOrder S; S.init(R, NGU, F.G, (int)blockIdx.x);
        pg8::EpiSwiGLU<false> E{ACT, DFF, rstd1, FFN1_FP8 ? 1.0f / W8_SCALE : 1.0f};
#if (PH_DUP >> 1) & 1
        pg8::gemm_phase<pg8::EpiSwiGLU<false>, pg8::StaticOrder, PG8_ALIGN, PG8_SP2, FFN1_FP8>(F.lds, g, S, E); xcd_barrier(bar);
#endif
        TIC(60); TICC(61); pg8::gemm_phase<pg8::EpiSwiGLU<false>, pg8::StaticOrder, PG8_ALIGN, PG8_SP2, FFN1_FP8>(F.lds, g, S, E); TOCC(61); TOC(60);
        TIC(6); meta_p1<FFN1_FP8>(F); TOC(6);
        SEAM(1);
    }
    if (IN(2)) { PHASE_BEGIN();
        pg8::Gemm g{ACT, WD, R, DM, DFF}; pg8::StaticOrder S; S.init(R, DM, F.G, (int)blockIdx.x);
        pg8::EpiStoreBf16 E{FB, DM, 1.0f};
        pg8::gemm_phase<pg8::EpiStoreBf16, pg8::StaticOrder, PG8_ALIGN, PG8_SP2>(F.lds, g, S, E);
        TIC(7); meta_p2(F); TOC(7);
        SEAM(2);
    }
    #define BODY3 do { norm_rows<0>(F, args.in[I_G1POST], rstd2, args.in[I_X], args.in[I_META]); convert_mix(F, args.in[I_WIN], args.in[I_WOUT], args.in[I_GMIX], WIN, WOUT); } while (0)
    if (IN(3)) { PHASE_BEGIN();
#if (PH_DUP >> 3) & 1
        BODY3; xcd_barrier(bar);
#endif
        BODY3; SEAM(3); }
    if (IN(4)) { PHASE_BEGIN();
        zero_pads(F);
        pg8::Gemm g{AB, WIN, R, 7168, DM}; pg8::StaticOrder S; S.init(R, 7168, F.G, (int)blockIdx.x);
        pg8::EpiProj E{F.ws, WS_RSTD2, WS_QH, WS_KH, WS_VH, WS_IQ, WS_GQ, WS_GK, WS_GV, WS_GO, WS_IK, WS_IW, WS_GLOW};
        pg8::gemm_phase<pg8::EpiProj, pg8::StaticOrder, PG8_ALIGN, PG8_SP2>(F.lds, g, S, E);
        TIC(8); meta_p4(F); TOC(8); TIC(9); small_cols(F); TOC(9);
        SEAM(4);
    }
#define BODY5A do { for (int v = F.vcu; v < 256; v += F.G) \
            for (int bq = 0; bq < 8; ++bq) { const int b = bq >> 2, q = bq & 3; const int t = q == 0 ? v : (q == 1 ? 511 - v : (q == 2 ? 512 + v : 1023 - v)); p5_item(F, b, t); } } while (0)
#define BODY5B do { PHASE_BEGIN(); for (int u = F.vcu; u < 1024; u += F.G) g1_unit(F, u >> 9, (u >> 7) & 3, u & 127, args.in[I_WGATE], args.in[I_BGATE]); } while (0)
    if (IN(5)) { PHASE_BEGIN();
#if (PH_DUP >> 5) & 1
        BODY5A; xcd_barrier(bar);
#endif
#if (PH_DUP >> 13) & 1
        BODY5B; xcd_barrier(bar);
#endif
        BODY5A; BODY5B;
        SEAM(5);
    }
    if (IN(6)) { PHASE_BEGIN(); TIC(17); g2_scan(F); TOC(17); SEAM(6); }
#define BODY7A do { TIC(18); p7_attention(F); TOC(18); } while (0)
#define BODY7B do { PHASE_BEGIN(); for (int u = F.vcu; u < 1024; u += F.G) g3_unit(F, u >> 9, (u >> 7) & 3, (u & 127) + 1, args.in[I_WGATE], args.in[I_BGATE], args.in[I_GGLA]); } while (0)
    if (IN(7)) { PHASE_BEGIN();
#if (PH_DUP >> 7) & 1
        BODY7A; xcd_barrier(bar);
#endif
#if (PH_DUP >> 14) & 1
        BODY7B; xcd_barrier(bar);
#endif
#ifndef SKIP_ATT
        BODY7A;
#endif
#ifndef SKIP_G3
        BODY7B;
#endif
        SEAM(7);
    }
    if (IN(8)) { PHASE_BEGIN();
        pg8::Gemm g{(const bf16*)(F.ws + WS_MIXA), WOUT, R, DM, DM}; pg8::StaticOrder S; S.init(R, DM, F.G, (int)blockIdx.x);
        pg8::EpiStoreBf16 E{FB, DM, 1.0f};
        pg8::gemm_phase<pg8::EpiStoreBf16, pg8::StaticOrder, PG8_ALIGN, PG8_SP2>(F.lds, g, S, E);
        SEAM(8);
    }
    if (IN(9)) { PHASE_BEGIN(); norm_rows<1, FFN2_FP8>(F, args.in[I_GMIXPOST], rstd3, nullptr, nullptr, F.ws + WS_ST); convert_ffn<FFN2_FP8, FFN2D_FP8>(F, args.in[I_W2G], args.in[I_W2U], args.in[I_W2D], args.in[I_G2PRE], WGU, WD); SEAM(9); }
    if (IN(10)) { PHASE_BEGIN();
        pg8::Gemm g{FFN2_FP8 ? (const bf16*)(F.ws + WS_ST) : AB, WGU, R, NGU, FFN2_FP8 ? DM / 2 : DM}; pg8::StaticOrder S; S.init(R, NGU, F.G, (int)blockIdx.x);
        pg8::EpiSwiGLU<FFN2D_FP8> E{ACT, DFF, rstd3, FFN2_FP8 ? 1.0f / W8_SCALE : 1.0f};
        pg8::gemm_phase<pg8::EpiSwiGLU<FFN2D_FP8>, pg8::StaticOrder, PG8_ALIGN, PG8_SP2, FFN2_FP8>(F.lds, g, S, E);
        SEAM(10);
    }
    if (IN(11)) { PHASE_BEGIN();
        pg8::Gemm g{ACT, WD, R, DM, FFN2D_FP8 ? DFF / 2 : DFF}; pg8::StaticOrder S; S.init(R, DM, F.G, (int)blockIdx.x);
        pg8::EpiStoreBf16 E{FB, DM, FFN2D_FP8 ? 1.0f / W8D_SCALE : 1.0f};
        pg8::gemm_phase<pg8::EpiStoreBf16, pg8::StaticOrder, PG8_ALIGN, PG8_SP2, FFN2D_FP8>(F.lds, g, S, E);
        SEAM(11);
    }
    if (IN(12)) { PHASE_BEGIN(); norm_rows<2>(F, args.in[I_G2POST], nullptr, nullptr, nullptr); PROBE_SPIN(); }
#undef IN
#undef SEAM
#undef AB
#undef ACT
#undef FB
#undef WGU
#undef WD
#undef WIN
#undef WOUT
#undef rstd1
#undef rstd2
#undef rstd3
}

extern "C" void kernel_launch(void* const* d_in, const int* in_sizes, int n_in, void* d_out, int out_size, void* d_ws, size_t ws_size, hipStream_t stream) {
    static int grid = 0;
    if (grid == 0) {
        if (n_in != 19 || in_sizes[0] != R * DM || out_size != R * DM || ws_size < WS_END) {
            fprintf(stderr, "kernel_launch: unexpected shapes (n_in %d, in0 %d, out %d, ws %zu; need ws >= %zu); nothing launched\n", n_in, n_in > 0 ? in_sizes[0] : -1, out_size, ws_size, (size_t)WS_END); grid = -1; return; }
        int dev = 0, cus = 0, per_cu = 0;
        if (hipGetDevice(&dev) != hipSuccess || hipDeviceGetAttribute(&cus, hipDeviceAttributeMultiprocessorCount, dev) != hipSuccess) { grid = -1; return; }
        if (hipFuncSetAttribute((const void*)hymba_fwd, hipFuncAttributeMaxDynamicSharedMemorySize, LDS_BYTES) != hipSuccess) { fprintf(stderr, "kernel_launch: hipFuncSetAttribute failed\n"); grid = -1; return; }
        if (hipOccupancyMaxActiveBlocksPerMultiprocessor(&per_cu, (const void*)hymba_fwd, NWAVES * 64, LDS_BYTES) != hipSuccess || per_cu < 1)
            fprintf(stderr, "kernel_launch: note: occupancy query reports %d workgroups per CU\n", per_cu);
        (void)hipGetLastError();
        grid = cus;
    }
    if (grid < 0) return;
    if (hipMemsetAsync((char*)d_ws + WS_CTL, 0, CTL_ZERO_BYTES, stream) != hipSuccess) return;
    Args a{};
    for (int i = 0; i < 19; ++i) a.in[i] = (const float*)d_in[i];
    a.out = (float*)d_out; a.ws = (unsigned char*)d_ws;
#if MK_PER_PHASE
    for (int p = 0; p < N_PHASES; ++p) { a.ph_lo = p; a.ph_hi = p + 1; hipLaunchKernelGGL(hymba_fwd, dim3(grid), dim3(NWAVES * 64), LDS_BYTES, stream, a); }
#else
    a.ph_lo = 0; a.ph_hi = N_PHASES;
    hipLaunchKernelGGL(hymba_fwd, dim3(grid), dim3(NWAVES * 64), LDS_BYTES, stream, a);
#endif
    const hipError_t le = hipPeekAtLastError();
    if (le != hipSuccess) fprintf(stderr, "kernel_launch: launch failed: %s\n", hipGetErrorName(le));
}
```

```cpp
#include <hip/hip_runtime.h>
#include <cstdio>
#include <cstdint>
#define MK_PER_PHASE 0
namespace pg8 {
#define PG8_LAS __attribute__((address_space(3)))
typedef unsigned short bf16_t;
typedef short bf16x8 __attribute__((ext_vector_type(8)));
typedef float f32x4 __attribute__((ext_vector_type(4)));
typedef unsigned u32x4 __attribute__((ext_vector_type(4)));
constexpr int BM = 256, BK = 64, HALF = 128, HTB = HALF * BK * 2  , STAGE_BYTES = 8 * HTB, NXCD = 8, WGM = 8;

__host__ __device__ __forceinline__ int lds_byte(int r, int c) { const int st = (r >> 4) * 2 + (c >> 5), rr = r & 15, cc = c & 31, ob = rr * 64 + cc * 2; return st * 1024 + (ob ^ (((ob >> 9) & 1) << 5)); }
__host__ __device__ __forceinline__ void stage_rc(int b, int& R, int& C) { const int st = b / 1024, sb = b % 1024, swz = sb ^ (((sb >> 9) & 1) << 5); R = (st >> 1) * 16 + swz / 64; C = (st & 1) * 32 + (swz % 64) / 2; }
__host__ __device__ __forceinline__ int perm32(int rho) { const int n = rho >> 4, i = rho & 15; return 8 * (i >> 2) + 4 * n + (i & 3); }

struct Unit { int pm, pn; };
struct Gemm { const bf16_t* A; const bf16_t* Bt; int M, N, K; };

struct StaticOrder {
    int nM, nN, nwg, G, c;
    __host__ __device__ void init(int M, int N, int G_, int c_) { nM = M / BM; nN = N / BM; nwg = nM * nN; G = G_; c = c_; }
    __host__ __device__ bool next(int i, Unit& u) const {
        const long L = (long)i * G + c; if (L >= nwg) return false;
        int wgid = (int)L; { const int q = nwg / NXCD, r = nwg % NXCD, xcd = wgid % NXCD, off = wgid / NXCD; wgid = (xcd < r ? xcd * (q + 1) : r * (q + 1) + (xcd - r) * q) + off; }
        const int nig = WGM * nN, gid = wgid / nig, fm = gid * WGM, gsz = (nM - fm) < WGM ? (nM - fm) : WGM;
        u.pm = fm + ((wgid % nig) % gsz); u.pn = (wgid % nig) / gsz; return true;
    }
    __device__ __forceinline__ void a_ready(const Unit&) const {}
    __device__ __forceinline__ void done(const Unit&) const {}
};

__device__ __forceinline__ unsigned cvt_pk_bf16(float lo, float hi) { unsigned r; asm volatile("v_cvt_pk_bf16_f32 %0, %1, %2" : "=v"(r) : "v"(lo), "v"(hi)); return r; }
typedef float f32x2 __attribute__((ext_vector_type(2)));

__device__ __forceinline__ void st8bf(bf16_t* p, const f32x4 v0, const f32x4 v1) {
    u32x4 w; w.x = cvt_pk_bf16(v0[0], v0[1]); w.y = cvt_pk_bf16(v0[2], v0[3]); w.z = cvt_pk_bf16(v1[0], v1[1]); w.w = cvt_pk_bf16(v1[2], v1[3]);
    *(u32x4*)p = w;
}
__device__ __forceinline__ float silu_f(float x) { return x * __builtin_amdgcn_rcpf(1.0f + __builtin_amdgcn_exp2f(-1.4426950408889634f * x)); }

struct EpiStoreBf16 {
    static constexpr bool PERM = true, AFTER_DRAIN = false;
    bf16_t* O; int ldc; float osc;
    __device__ __forceinline__ void operator()(const f32x4 (&acc)[2][2][4][2], const Unit& u, int wr, int wc, int fr, int fq) const {
        const int row0 = u.pm * BM + wr * 64 + fr, col0 = u.pn * BM + wc * 32 + 8 * fq;
#pragma unroll
        for (int ai = 0; ai < 2; ++ai)
#pragma unroll
            for (int m = 0; m < 4; ++m) { bf16_t* rowp = O + (size_t)(row0 + ai * HALF + m * 16) * ldc + col0;
#pragma unroll
                for (int bj = 0; bj < 2; ++bj) st8bf(rowp + bj * HALF, acc[ai][bj][m][0] * osc, acc[ai][bj][m][1] * osc); }
    }
};
template <bool OUT8>
struct EpiSwiGLU {
    static constexpr bool PERM = true, AFTER_DRAIN = false;
    bf16_t* O; int ldc; const float* rstd; float osc;
    __device__ __forceinline__ void operator()(const f32x4 (&acc)[2][2][4][2], const Unit& u, int wr, int wc, int fr, int fq) const {
        const int row0 = u.pm * BM + wr * 64 + fr, col0 = u.pn * HALF + wc * 32 + 8 * fq;
#pragma unroll
        for (int ai = 0; ai < 2; ++ai)
#pragma unroll
            for (int m = 0; m < 4; ++m) { const int row = row0 + ai * HALF + m * 16; const float rs = rstd[row] * osc;
                f32x4 o0, o1;
#pragma unroll
                for (int j = 0; j < 4; ++j) { o0[j] = silu_f(acc[ai][0][m][0][j] * rs) * (acc[ai][1][m][0][j] * rs); o1[j] = silu_f(acc[ai][0][m][1][j] * rs) * (acc[ai][1][m][1][j] * rs); }
                if constexpr (OUT8) { typedef unsigned u32x2e __attribute__((ext_vector_type(2)));
                    float c_[8] = {o0[0], o0[1], o0[2], o0[3], o1[0], o1[1], o1[2], o1[3]};
#pragma unroll
                    for (int j = 0; j < 8; ++j) c_[j] = fminf(fmaxf(c_[j], -448.f), 448.f);
                    int w0 = 0, w1 = 0; w0 = __builtin_amdgcn_cvt_pk_fp8_f32(c_[0], c_[1], w0, false); w0 = __builtin_amdgcn_cvt_pk_fp8_f32(c_[2], c_[3], w0, true);
                    w1 = __builtin_amdgcn_cvt_pk_fp8_f32(c_[4], c_[5], w1, false); w1 = __builtin_amdgcn_cvt_pk_fp8_f32(c_[6], c_[7], w1, true);
                    *(u32x2e*)((unsigned char*)O + (size_t)row * ldc + col0) = (u32x2e){(unsigned)w0, (unsigned)w1}; }
                else st8bf(O + (size_t)row * ldc + col0, o0, o1); }
    }
};
struct EpiProj {
    static constexpr bool PERM = true, AFTER_DRAIN = false;
    static constexpr int TKV = 8256;
    unsigned char* ws; size_t o_rstd, o_qh, o_kh, o_vh, o_iq, o_gq, o_gk, o_gv, o_go, o_ik, o_iw, o_glow;
    float osc; int pn_off;
    __device__ __forceinline__ void operator()(const f32x4 (&acc)[2][2][4][2], const Unit& u, int wr, int wc, int fr, int fq) const {
        const float* rstd = (const float*)(ws + o_rstd);
        bf16_t* Qh = (bf16_t*)(ws + o_qh); bf16_t* Kh = (bf16_t*)(ws + o_kh); bf16_t* Vh = (bf16_t*)(ws + o_vh); bf16_t* IQ = (bf16_t*)(ws + o_iq); bf16_t* GQ = (bf16_t*)(ws + o_gq);
        bf16_t* GK = (bf16_t*)(ws + o_gk); bf16_t* GV = (bf16_t*)(ws + o_gv); bf16_t* GO = (bf16_t*)(ws + o_go); bf16_t* IK = (bf16_t*)(ws + o_ik); float* IW = (float*)(ws + o_iw); float* GLOW = (float*)(ws + o_glow);
        const int pn = u.pn + pn_off;
        const int row0 = u.pm * BM + wr * 64 + fr;
#pragma unroll
        for (int ai = 0; ai < 2; ++ai)
#pragma unroll
            for (int m = 0; m < 4; ++m) {
                const int row = row0 + ai * HALF + m * 16; const float rs = rstd[row] * osc;
                const bool mainr = row < 16384, metar = (row >= 16384) && (row < 16400);
                const int b = row >> 13, s = row & 8191, mi = row - 16384;
#pragma unroll
                for (int bj = 0; bj < 2; ++bj) {
                    const int col = bj * HALF + wc * 32 + 8 * fq;
                    f32x4 v0 = acc[ai][bj][m][0] * rs, v1 = acc[ai][bj][m][1] * rs;
                    if (pn < 4) {
                        if (mainr) { const int h = pn * 2 + (col >> 7), d = col & 127; st8bf(Qh + ((size_t)(b * 8 + h) * 8192 + s) * 128 + d, v0, v1); }
                    } else if (pn < 12) {
                        bf16_t* base = pn < 8 ? Kh : Vh; const int h = (pn & 3) * 2 + (col >> 7), d = col & 127;
                        if (mainr) st8bf(base + ((size_t)(b * 8 + h) * TKV + 16 + s) * 128 + d, v0, v1);
                        else if (metar) { st8bf(base + ((size_t)h * TKV + mi) * 128 + d, v0, v1); st8bf(base + ((size_t)(8 + h) * TKV + mi) * 128 + d, v0, v1); }
                    } else if (pn < 16) {
                        if (mainr) st8bf(IQ + (size_t)row * 1024 + (pn - 12) * 256 + col, v0 * 0.125f, v1 * 0.125f);
                    } else if (pn < 18) {
                        if (mainr) st8bf(GQ + ((size_t)b * TKV + 64 + s) * 512 + (pn - 16) * 256 + col, v0 * 0.08838834764831845f, v1 * 0.08838834764831845f);
                    } else if (pn < 20) {
                        const int c = (pn - 18) * 256 + col;
                        if (mainr) st8bf(GK + ((size_t)b * TKV + 64 + s) * 512 + c, v0, v1);
                        else if (metar) { st8bf(GK + ((size_t)48 + mi) * 512 + c, v0, v1); st8bf(GK + ((size_t)TKV + 48 + mi) * 512 + c, v0, v1); }
                    } else if (pn < 24) {
                        const int c = (pn - 20) * 256 + col;
                        if (mainr) st8bf(GV + ((size_t)b * TKV + 64 + s) * 1024 + c, v0, v1);
                        else if (metar) { st8bf(GV + ((size_t)48 + mi) * 1024 + c, v0, v1); st8bf(GV + ((size_t)TKV + 48 + mi) * 1024 + c, v0, v1); }
                    } else if (pn < 28) {
                        if (mainr) st8bf(GO + (size_t)row * 1024 + (pn - 24) * 256 + col, v0, v1);
                    } else {
                        if (col < 64) {
                            const int ch = col >> 3, fo = (ch >> 1) * 512 + (ch & 1) * 256;
                            if (mainr) { const int pos = 16 + s; st8bf(IK + (size_t)b * TKV * 64 + (size_t)(pos >> 5) * 2048 + fo + (pos & 31) * 8, v0, v1); }
                            else if (metar) { st8bf(IK + fo + mi * 8, v0, v1); st8bf(IK + (size_t)TKV * 64 + fo + mi * 8, v0, v1); }
                        } else if (col < 80) {
                            if (mainr) { float* p = IW + (size_t)row * 16 + (col - 64); *(f32x4*)p = v0 * 0.25f; *(f32x4*)(p + 4) = v1 * 0.25f; }
                        } else if (col < 96) {
                            const int c = col - 80;
                            if (mainr) { float* p = GLOW + ((size_t)b * TKV + 64 + s) * 16 + c; *(f32x4*)p = v0; *(f32x4*)(p + 4) = v1; }
                            else if (metar) { float* p = GLOW + ((size_t)48 + mi) * 16 + c; *(f32x4*)p = v0; *(f32x4*)(p + 4) = v1;
                                              float* p2 = GLOW + ((size_t)TKV + 48 + mi) * 16 + c; *(f32x4*)p2 = v0; *(f32x4*)(p2 + 4) = v1; }
                        }
                    }
                }
            }
    }
};
typedef int v8i_t __attribute__((ext_vector_type(8)));
__device__ __forceinline__ v8i_t cat8(bf16x8 lo, bf16x8 hi) { typedef int v4i_t __attribute__((ext_vector_type(4)));
    return __builtin_shufflevector(__builtin_bit_cast(v4i_t, lo), __builtin_bit_cast(v4i_t, hi), 0, 1, 2, 3, 4, 5, 6, 7); }
template <class Epi, class Sched, bool ALIGN_EPI = false, bool SP2 = false, bool FP8 = false>
__device__ __forceinline__ void gemm_phase(PG8_LAS unsigned char* lds, const Gemm g, const Sched& S, const Epi& E) {
    int tid_ = threadIdx.x; asm volatile("" : "+v"(tid_));
    const int tid = tid_, wid = __builtin_amdgcn_readfirstlane(tid >> 6), lane = tid & 63, wr = wid >> 2, wc = wid & 3, fr = lane & 15, fq = lane >> 4;
    const int K = g.K, nt = K / BK;
    unsigned voffA[2], voffB[2];
#pragma unroll
    for (int i = 0; i < 2; ++i) { int R, C; stage_rc(tid * 16 + i * 8192, R, C); const int Rb = Epi::PERM ? ((R & ~31) + perm32(R & 31)) : R;
        voffA[i] = (unsigned)(R * K + C) * 2u; voffB[i] = (unsigned)(Rb * K + C) * 2u; }
    const size_t kstep = (size_t)(BK * 2);
    const size_t hstep = (size_t)HALF * K * 2;
    const size_t tstep = 2 * hstep;
    const unsigned ldsw = (unsigned)wid * 1024u;
    const int f8o = (fq >> 1) * 1024 + ((fr * 64 + 32 * (fq & 1)) ^ (((fr >> 3) & 1) << 5));
    const int aoff = FP8 ? wr * 8192 + f8o : lds_byte(wr * 64 + fr, fq * 8), boff = FP8 ? wc * 4096 + f8o : lds_byte(wc * 32 + fr, fq * 8);
    constexpr int KSTR = FP8 ? 16 : 1024;
    int sc8 = 0x7f7f7f7f; if (FP8) asm volatile("" : "+v"(sc8));
#define PG8_SA(b, h) (((b) * 2 + (h)) * HTB)
#define PG8_SB(b, h) ((4 + (b) * 2 + (h)) * HTB)
#define PG8_STAGE(bufoff, gbase, voff) do { _Pragma("unroll") for (int _i = 0; _i < 2; ++_i) \
        __builtin_amdgcn_global_load_lds((const unsigned*)((const char*)(gbase) + (voff)[_i]), (PG8_LAS unsigned*)(lds + (bufoff) + ldsw + _i * 8192), 16, 0, 0); } while (0)
#define PG8_LDA(dst, b, h) do { _Pragma("unroll") for (int m = 0; m < 4; ++m) _Pragma("unroll") for (int k = 0; k < 2; ++k) dst[m][k] = *(const PG8_LAS bf16x8*)(lds + PG8_SA(b, h) + aoff + m * 2048 + k * KSTR); } while (0)
#define PG8_LDB(dst, b, h) do { _Pragma("unroll") for (int n = 0; n < 2; ++n) _Pragma("unroll") for (int k = 0; k < 2; ++k) dst[n][k] = *(const PG8_LAS bf16x8*)(lds + PG8_SB(b, h) + boff + n * 2048 + k * KSTR); } while (0)
#define PG8_MMA(ai, bj, At, Bt) do { __builtin_amdgcn_s_setprio(1); _Pragma("unroll") for (int m = 0; m < 4; ++m) _Pragma("unroll") for (int n = 0; n < 2; ++n) { \
        if constexpr (FP8) { const v8i_t b8_ = cat8(Bt[n][0], Bt[n][1]), a8_ = cat8(At[m][0], At[m][1]);     \
            asm volatile("v_mfma_scale_f32_16x16x128_f8f6f4 %0, %1, %2, %0, %3, %3 op_sel_hi:[0,0,0]" : "+v"(acc[ai][bj][m][n]) : "v"(b8_), "v"(a8_), "v"(sc8)); } \
        else { _Pragma("unroll") for (int k = 0; k < 2; ++k) acc[ai][bj][m][n] = __builtin_amdgcn_mfma_f32_16x16x32_bf16(Bt[n][k], At[m][k], acc[ai][bj][m][n], 0, 0, 0); } } __builtin_amdgcn_s_setprio(0); } while (0)
#define PG8_WAIT_V(n) asm volatile("s_waitcnt vmcnt(" #n ")" ::: "memory")
#define PG8_WAIT_L(n) asm volatile("s_waitcnt lgkmcnt(" #n ")" ::: "memory")
#define PG8_BAR __builtin_amdgcn_s_barrier()
#define PG8_SCHED __builtin_amdgcn_sched_barrier(0)
    Unit cur, nxt; int ui = 0;
    if (!S.next(0, cur)) return;
    f32x4 acc[2][2][4][2];
#pragma unroll
    for (int a = 0; a < 2; ++a)
#pragma unroll
        for (int b = 0; b < 2; ++b)
#pragma unroll
            for (int m = 0; m < 4; ++m)
#pragma unroll
                for (int n = 0; n < 2; ++n) acc[a][b][m][n] = (f32x4){0.f, 0.f, 0.f, 0.f};
    bf16x8 At[4][2], B0[2][2], B1[2][2];
    const char* cA = (const char*)g.A + (size_t)cur.pm * tstep; const char* cB = (const char*)g.Bt + (size_t)cur.pn * tstep;
    S.a_ready(cur);
    if constexpr (SP2) {
        PG8_STAGE(PG8_SB(0, 0), cB, voffB); PG8_STAGE(PG8_SB(0, 1), cB + hstep, voffB); PG8_STAGE(PG8_SA(0, 0), cA, voffA); PG8_STAGE(PG8_SA(0, 1), cA + hstep, voffA);
        if (wr == 1) PG8_BAR;
        PG8_WAIT_V(2); PG8_BAR;
        PG8_STAGE(PG8_SB(1, 0), cB + kstep, voffB); PG8_STAGE(PG8_SA(1, 0), cA + kstep, voffA); PG8_STAGE(PG8_SB(1, 1), cB + hstep + kstep, voffB);
        PG8_WAIT_V(6); PG8_BAR;
    } else {
        PG8_STAGE(PG8_SB(0, 0), cB, voffB); PG8_STAGE(PG8_SA(0, 0), cA, voffA); PG8_STAGE(PG8_SB(0, 1), cB + hstep, voffB); PG8_STAGE(PG8_SA(0, 1), cA + hstep, voffA);
        if (wr == 1) PG8_BAR;
        PG8_WAIT_V(4); PG8_BAR;
        PG8_STAGE(PG8_SB(1, 0), cB + kstep, voffB); PG8_STAGE(PG8_SA(1, 0), cA + kstep, voffA); PG8_STAGE(PG8_SB(1, 1), cB + hstep + kstep, voffB);
        PG8_WAIT_V(6); PG8_BAR;
    }
    for (;;) {
        const bool has_next = S.next(ui + 1, nxt);
        const char* nA = has_next ? (const char*)g.A + (size_t)nxt.pm * tstep : cA; const char* nB = has_next ? (const char*)g.Bt + (size_t)nxt.pn * tstep : cB;
        for (int t = 0; t < nt; t += 2) {
            const bool last = (t == nt - 2);
            const char* a1 = cA + (size_t)(t + 1) * kstep;
            const char* a2 = last ? nA : cA + (size_t)(t + 2) * kstep; const char* b2 = last ? nB : cB + (size_t)(t + 2) * kstep;
            const char* a3 = a2 + kstep; const char* b3 = b2 + kstep;
            if (last && has_next) S.a_ready(nxt);
            if constexpr (SP2) {
            PG8_LDB(B0, 0, 0); PG8_LDB(B1, 0, 1); PG8_SCHED; PG8_LDA(At, 0, 0); PG8_STAGE(PG8_SA(1, 1), a1 + hstep, voffA);
            PG8_WAIT_V(8); PG8_WAIT_L(0); PG8_BAR; PG8_MMA(0, 0, At, B0); PG8_MMA(0, 1, At, B1); PG8_BAR; PG8_SCHED;
            PG8_LDA(At, 0, 1); PG8_STAGE(PG8_SB(0, 0), b2, voffB); PG8_STAGE(PG8_SB(0, 1), b2 + hstep, voffB); PG8_STAGE(PG8_SA(0, 0), a2, voffA);
            PG8_WAIT_V(8); PG8_WAIT_L(0); PG8_BAR; PG8_MMA(1, 0, At, B0); PG8_MMA(1, 1, At, B1); PG8_BAR; PG8_SCHED;
            PG8_LDB(B0, 1, 0); PG8_LDB(B1, 1, 1); PG8_SCHED; PG8_LDA(At, 1, 0); PG8_STAGE(PG8_SA(0, 1), a2 + hstep, voffA);
            PG8_WAIT_V(8); PG8_WAIT_L(0); PG8_BAR; PG8_MMA(0, 0, At, B0); PG8_MMA(0, 1, At, B1); PG8_BAR; PG8_SCHED;
            PG8_LDA(At, 1, 1); PG8_STAGE(PG8_SB(1, 0), b3, voffB); PG8_STAGE(PG8_SB(1, 1), b3 + hstep, voffB); PG8_STAGE(PG8_SA(1, 0), a3, voffA);
            PG8_WAIT_V(8); PG8_WAIT_L(0); PG8_BAR; PG8_MMA(1, 0, At, B0); PG8_MMA(1, 1, At, B1); PG8_BAR; PG8_SCHED;
            } else {
            PG8_LDB(B0, 0, 0); PG8_SCHED; PG8_LDA(At, 0, 0); PG8_STAGE(PG8_SA(1, 1), a1 + hstep, voffA);
            PG8_WAIT_L(8); PG8_BAR; PG8_WAIT_L(0); PG8_MMA(0, 0, At, B0); PG8_BAR; PG8_SCHED;
            PG8_LDB(B1, 0, 1); PG8_STAGE(PG8_SB(0, 0), b2, voffB);
            PG8_BAR; PG8_WAIT_L(0); PG8_MMA(0, 1, At, B1); PG8_BAR;
            PG8_LDA(At, 0, 1); PG8_STAGE(PG8_SA(0, 0), a2, voffA);
            PG8_BAR; PG8_WAIT_L(0); PG8_MMA(1, 0, At, B0); PG8_BAR; PG8_SCHED;
            PG8_STAGE(PG8_SB(0, 1), b2 + hstep, voffB);
            PG8_WAIT_V(6); PG8_BAR; PG8_MMA(1, 1, At, B1); PG8_BAR;
            PG8_LDB(B0, 1, 0); PG8_SCHED; PG8_LDA(At, 1, 0); PG8_STAGE(PG8_SA(0, 1), a2 + hstep, voffA);
            PG8_WAIT_L(8); PG8_BAR; PG8_WAIT_L(0); PG8_MMA(0, 0, At, B0); PG8_BAR; PG8_SCHED;
            PG8_LDB(B1, 1, 1); PG8_STAGE(PG8_SB(1, 0), b3, voffB);
            PG8_BAR; PG8_WAIT_L(0); PG8_MMA(0, 1, At, B1); PG8_BAR;
            PG8_LDA(At, 1, 1); PG8_STAGE(PG8_SA(1, 0), a3, voffA);
            PG8_BAR; PG8_WAIT_L(0); PG8_MMA(1, 0, At, B0); PG8_BAR; PG8_SCHED;
            PG8_STAGE(PG8_SB(1, 1), b3 + hstep, voffB);
            PG8_WAIT_V(6); PG8_BAR; PG8_MMA(1, 1, At, B1); PG8_BAR;
            }
        }
        if constexpr (FP8) asm volatile("s_nop 15\n\ts_nop 15" ::: "memory");
        if constexpr (ALIGN_EPI) { if (wr == 0) PG8_BAR; }
        if constexpr (!Epi::AFTER_DRAIN) { E(acc, cur, wr, wc, fr, fq); S.done(cur); }
        if (!has_next) break;
#pragma unroll
        for (int a = 0; a < 2; ++a)
#pragma unroll
            for (int b = 0; b < 2; ++b)
#pragma unroll
                for (int m = 0; m < 4; ++m)
#pragma unroll
                    for (int n = 0; n < 2; ++n) acc[a][b][m][n] = (f32x4){0.f, 0.f, 0.f, 0.f};
        cur = nxt; cA = nA; cB = nB; ++ui;
        if constexpr (ALIGN_EPI) { if (wr == 1) PG8_BAR; }
    }
    PG8_WAIT_V(0);
    if constexpr (!ALIGN_EPI) { if (wr == 0) PG8_BAR; }
    PG8_BAR;
    if constexpr (Epi::AFTER_DRAIN) { E.fused(acc, cur, wr, wc, fr, fq, lds, wid, lane); S.done(cur); }
#undef PG8_SA
#undef PG8_SB
#undef PG8_STAGE
#undef PG8_LDA
#undef PG8_LDB
#undef PG8_MMA
#undef PG8_WAIT_V
#undef PG8_WAIT_L
#undef PG8_BAR
#undef PG8_SCHED
}
}

namespace att {
typedef unsigned short bf16;
typedef short bf16x8 __attribute__((ext_vector_type(8)));
typedef short s16x4 __attribute__((ext_vector_type(4)));
typedef float f32x16 __attribute__((ext_vector_type(16)));
typedef float f32x4 __attribute__((ext_vector_type(4)));
typedef unsigned u32x4 __attribute__((ext_vector_type(4)));
typedef unsigned long long u64;
constexpr int HD = 128, NW = 8, QBLK = 32, KVBLK = 64, QB = NW * QBLK;
constexpr int SHM_V = KVBLK * HD * 2, SHM_K = KVBLK * HD * 2;
constexpr int ATT_LDS_BYTES = 2 * SHM_V + 2 * SHM_K + NW * 64 * 4;
constexpr float SCALE = 0.08838834764831845f;
constexpr float THR = 8.f;
constexpr int OSTR = 2048;
constexpr int MWORDS = 130;

#define KSWZ(row, colB) ((row) * 256 + ((colB) ^ (((row) & 7) << 4)))
#define SBAR() __builtin_amdgcn_sched_barrier(0)
__device__ __forceinline__ int v_st(int k, int c) { const int kk = (k & ~0xC) | ((k & 4) << 1) | ((k & 8) >> 1); return ((kk >> 3) * 4 + (c >> 5)) * 512 + ((kk & 7) * 32 + (c & 31)) * 2; }
__device__ __forceinline__ int v_rd_base(int lane) { return ((lane & 3) << 3) | (((lane >> 2) & 3) << 6) | (((lane >> 4) & 1) << 5) | (((lane >> 5) & 1) << 8); }
constexpr int v_rd_off(int d0, int ks, int half) { return d0 * 512 + ks * 4096 + half * 2048; }
__device__ __forceinline__ int crow(int r, int hi) { return (r & 3) + 8 * (r >> 2) + 4 * hi; }
__device__ __forceinline__ unsigned cvtpk(float lo, float hi) {
    unsigned r; asm volatile("v_cvt_pk_bf16_f32 %0, %1, %2" : "=v"(r) : "v"(lo), "v"(hi)); return r;
}
__device__ __forceinline__ bf16x8 load8(const bf16* p) { return *reinterpret_cast<const bf16x8*>(p); }
__device__ __forceinline__ void mask_bits(f32x16& p0, f32x16& p1, unsigned mw) {
    const float NEG = -__builtin_inff();
#pragma unroll
    for (int r = 0; r < 16; ++r) {
        if (!((mw >> r) & 1u)) p0[r] = NEG;
        if (!((mw >> (16 + r)) & 1u)) p1[r] = NEG;
    }
}
__device__ __forceinline__ void partialSM(f32x16& p0, f32x16& p1, float& m_reg, float& mn, float& alpha) {
    float pmax = p0[0]; for (int r = 1; r < 16; ++r) pmax = fmaxf(pmax, p0[r]); for (int r = 0; r < 16; ++r) pmax = fmaxf(pmax, p1[r]);
    { auto rr = __builtin_amdgcn_permlane32_swap(__float_as_uint(pmax), __float_as_uint(pmax), false, false);
      pmax = fmaxf(__uint_as_float(rr[0]), __uint_as_float(rr[1])); }
    constexpr float C2 = 1.4426950408889634f * SCALE;
    if (__builtin_expect(__all((pmax - m_reg) * SCALE <= THR), 1)) { mn = m_reg; alpha = 1.f; }
    else { mn = fmaxf(m_reg, pmax); alpha = __builtin_amdgcn_exp2f((m_reg - mn) * C2); m_reg = mn; }
    const float mnL = -mn * C2;
    for (int r = 0; r < 16; ++r) p0[r] = fmaf(p0[r], C2, mnL); for (int r = 0; r < 16; ++r) p1[r] = fmaf(p1[r], C2, mnL);
    for (int r = 0; r < 16; ++r) p0[r] = __builtin_amdgcn_exp2f(p0[r]);
}
__device__ __forceinline__ void finishSM(f32x16& p0, f32x16& p1, float alpha, float& l_reg, bf16x8& pa0, bf16x8& pa1, bf16x8& pa2, bf16x8& pa3) {
    for (int r = 0; r < 16; ++r) p1[r] = __builtin_amdgcn_exp2f(p1[r]);
    float ps = 0; for (int r = 0; r < 16; ++r) ps += p0[r]; for (int r = 0; r < 16; ++r) ps += p1[r];
    { auto rr = __builtin_amdgcn_permlane32_swap(__float_as_uint(ps), __float_as_uint(ps), false, false);
      ps = __uint_as_float(rr[0]) + __uint_as_float(rr[1]); }
    l_reg = l_reg * alpha + ps;
#define PK4(P, B_, OUT) do { unsigned a0 = cvtpk(P[B_+0], P[B_+1]), a1 = cvtpk(P[B_+2], P[B_+3]);                          \
        unsigned b0 = cvtpk(P[B_+4], P[B_+5]), b1 = cvtpk(P[B_+6], P[B_+7]);                                             \
        auto r0 = __builtin_amdgcn_permlane32_swap(a0, b0, false, false); auto r1 = __builtin_amdgcn_permlane32_swap(a1, b1, false, false); \
        u32x4 w = {r0[0], r1[0], r0[1], r1[1]}; OUT = *reinterpret_cast<bf16x8*>(&w); } while (0)
    PK4(p0, 0, pa0); PK4(p0, 8, pa1); PK4(p1, 0, pa2); PK4(p1, 8, pa3);
#undef PK4
}
template <int KB>
__device__ __forceinline__ void qkt(f32x16& p0, f32x16& p1, const char* K_lds, int r32, int hi, const bf16x8* qr) {
    p0 = f32x16{}; p1 = f32x16{};
    const char* kb[4];
#pragma unroll
    for (int dd = 0; dd < 4; ++dd) kb[dd] = K_lds + KB * SHM_K + KSWZ(r32, (dd * 16 + hi * 8) * 2);
#pragma unroll
    for (int d0 = 0; d0 < 8; ++d0) { const char* a = kb[d0 & 3] + (d0 >> 2) * 128;
        bf16x8 b0 = *reinterpret_cast<const bf16x8*>(a);
        bf16x8 b1 = *reinterpret_cast<const bf16x8*>(a + 32 * 256);
        p0 = __builtin_amdgcn_mfma_f32_32x32x16_bf16(b0, qr[d0], p0, 0, 0, 0);
        p1 = __builtin_amdgcn_mfma_f32_32x32x16_bf16(b1, qr[d0], p1, 0, 0, 0); }
}
template <int VB>
__device__ __forceinline__ void pv_tile(f32x16* o, int vb0, bf16x8 pa0, bf16x8 pa1, bf16x8 pa2, bf16x8 pa3) {
#define TRRD(dst, off) asm volatile("ds_read_b64_tr_b16 %0, %1 offset:%2" : "=&v"(dst) : "v"(vb0), "i"(off) : "memory")
#define PV_D0(d0) do { s16x4 l0, l1, l2, l3, h0, h1, h2, h3; constexpr int b_ = VB * SHM_V + v_rd_off(d0, 0, 0);     \
        TRRD(l0, b_); TRRD(h0, b_ + 2048); TRRD(l1, b_ + 4096); TRRD(h1, b_ + 6144); TRRD(l2, b_ + 8192); TRRD(h2, b_ + 10240); TRRD(l3, b_ + 12288); TRRD(h3, b_ + 14336); \
        asm volatile("s_waitcnt lgkmcnt(0)" ::: "memory"); SBAR();             \
        o[d0] = __builtin_amdgcn_mfma_f32_32x32x16_bf16(pa0, (bf16x8){l0[0], l0[1], l0[2], l0[3], h0[0], h0[1], h0[2], h0[3]}, o[d0], 0, 0, 0);   \
        o[d0] = __builtin_amdgcn_mfma_f32_32x32x16_bf16(pa1, (bf16x8){l1[0], l1[1], l1[2], l1[3], h1[0], h1[1], h1[2], h1[3]}, o[d0], 0, 0, 0);   \
        o[d0] = __builtin_amdgcn_mfma_f32_32x32x16_bf16(pa2, (bf16x8){l2[0], l2[1], l2[2], l2[3], h2[0], h2[1], h2[2], h2[3]}, o[d0], 0, 0, 0);   \
        o[d0] = __builtin_amdgcn_mfma_f32_32x32x16_bf16(pa3, (bf16x8){l3[0], l3[1], l3[2], l3[3], h3[0], h3[1], h3[2], h3[3]}, o[d0], 0, 0, 0); } while (0)
    PV_D0(0); PV_D0(1); PV_D0(2); PV_D0(3);
#undef PV_D0
#undef TRRD
}

struct BlockRef { const bf16* Q; const bf16* K; const bf16* V; bf16* O; const u64* M; int NT; };
struct Seam { bf16x8 qr[8]; bf16x8 st_v0, st_v1, st_k0, st_k1; };
#define VMW() asm volatile("s_waitcnt vmcnt(0)" ::: "memory")
#define VMWN(n) asm volatile("s_waitcnt vmcnt(%0)" :: "i"(n) : "memory")
#define SLOAD_H(Kp, Vp, k0) do { int t_ = tid; asm volatile("" : "+v"(t_)); const unsigned go_ = (unsigned)((k0) * (HD * 2)) + (unsigned)t_ * 16u;               \
                         S.st_v0 = load8((const bf16*)((const char*)(Vp) + go_)); S.st_v1 = load8((const bf16*)((const char*)(Vp) + (go_ + 8192u)));              \
                         S.st_k0 = load8((const bf16*)((const char*)(Kp) + go_)); S.st_k1 = load8((const bf16*)((const char*)(Kp) + (go_ + 8192u))); } while (0)
#define SWRITE_HK(bf) do { int t_ = tid; asm volatile("" : "+v"(t_)); const int sr_ = t_ >> 4, sc_ = (t_ & 15) * 8, kws_ = KSWZ(sr_, sc_ * 2);                      \
                         *(bf16x8*)(K_lds + (bf) * SHM_K + kws_) = S.st_k0; *(bf16x8*)(K_lds + (bf) * SHM_K + kws_ + 32 * 256) = S.st_k1; } while (0)
#define SWRITE_HV(bf) do { int t_ = tid; asm volatile("" : "+v"(t_)); const int sr_ = t_ >> 4, sc_ = (t_ & 15) * 8, vs_ = v_st(sr_, sc_);                            \
                         *(bf16x8*)(V_lds + (bf) * SHM_V + vs_) = S.st_v0; *(bf16x8*)(V_lds + (bf) * SHM_V + vs_ + 8192) = S.st_v1; } while (0)
#define SWRITE_H(bf) do { SWRITE_HV(bf); SWRITE_HK(bf); } while (0)
__device__ __forceinline__ void att_prime(const BlockRef& cur, char* lds, Seam& S) {
    const int tid = threadIdx.x, wid = __builtin_amdgcn_readfirstlane(tid >> 6), lane = tid & 63, r32 = lane & 31, hi = lane >> 5;
    char* K_lds = lds + 2 * SHM_V;
#pragma unroll
    for (int d0 = 0; d0 < 8; ++d0) S.qr[d0] = load8((const bf16*)((const char*)cur.Q + (unsigned)(((wid * QBLK + r32) * HD + hi * 8) * 2 + d0 * 32)));
    SLOAD_H(cur.K, cur.V, 0); VMW(); SWRITE_HK(0);
    __syncthreads();
}
__device__ __forceinline__ void att_block(const BlockRef& cur, const BlockRef& nxt, char* lds, Seam& S) {
    const int tid = threadIdx.x, wid = __builtin_amdgcn_readfirstlane(tid >> 6), lane = tid & 63, r32 = lane & 31, hi = lane >> 5;
    const int NT = cur.NT;
    char* V_lds = lds; char* K_lds = lds + 2 * SHM_V;
    float* ws = (float*)(lds + 2 * SHM_V + 2 * SHM_K) + wid * 64; float* li_l = ws, * al_l = ws + 32;
    float m_reg = -1e30f, l_reg = 0; f32x16 o[4] = {};
    const int vb0 = (int)(uintptr_t)V_lds + v_rd_base(lane);
    const bf16* Kh = cur.K; const bf16* Vh = cur.V;
    const char* Mb = (const char*)cur.M; const unsigned moff = (unsigned)((wid * QBLK + r32) * (MWORDS * 8) + hi * 4);
#define MLOAD(t) (*(const unsigned*)(Mb + (moff + (unsigned)(t) * 8u)))
    unsigned mwA = MLOAD(0), mwB = 0u;
#define RESC(a) do { if (__any((a) < 1.f)) { if (hi == 0) al_l[r32] = (a); asm volatile("s_waitcnt lgkmcnt(0)" ::: "memory");              \
                     for (int d_ = 0; d_ < 4; ++d_) for (int r = 0; r < 16; ++r) o[d_][r] *= al_l[crow(r, hi)]; } } while (0)
#define KBASE(t) ((t) * KVBLK)
    constexpr int NQL = 8;
#define SEAM_K0() do { VMWN(NQL); SWRITE_HK(0); SBAR(); } while (0)
    f32x16 pA0, pA1, pB0, pB1; float mnA, mnB, alA, alB; bf16x8 pa0, pa1, pa2, pa3;
    SWRITE_HV(0); SBAR();
    if (NT > 1) { SLOAD_H(Kh, Vh, KBASE(1)); }
    SBAR(); qkt<0>(pA0, pA1, K_lds, r32, hi, S.qr);
    mask_bits(pA0, pA1, mwA); partialSM(pA0, pA1, m_reg, mnA, alA);
    if (NT > 1) { VMW(); SWRITE_H(1); }
    __syncthreads();
#define HALF_STEP(PX0, PX1, mnX, alX, PY0, PY1, alY, t, KB, VB, SB, MWX, MWY) do {                                             \
        MWX = MLOAD(t);                                                                                                       \
        SBAR(); qkt<KB>(PX0, PX1, K_lds, r32, hi, S.qr);                                                                      \
        finishSM(PY0, PY1, alY, l_reg, pa0, pa1, pa2, pa3); SBAR();                                                           \
        if ((t) + 1 < NT) { SLOAD_H(Kh, Vh, KBASE((t) + 1)); SBAR(); }                                                        \
        pv_tile<VB>(o, vb0, pa0, pa1, pa2, pa3); mask_bits(PX0, PX1, MWX); partialSM(PX0, PX1, m_reg, mnX, alX);          \
        __syncthreads();                                                                                                      \
        if ((t) + 1 < NT) { VMW(); SWRITE_H(SB); }                                                                            \
        RESC(alX); __syncthreads(); } while (0)
    for (int t = 1; t + 1 < NT; t += 2) {
        HALF_STEP(pB0, pB1, mnB, alB, pA0, pA1, alA, t, 1, 0, 0, mwB, mwA);
        HALF_STEP(pA0, pA1, mnA, alA, pB0, pB1, alB, t + 1, 0, 1, 1, mwA, mwB);
    }
    const bool even = (NT & 1) == 0;
    if (even) { mwB = MLOAD(NT - 1); SBAR(); qkt<1>(pB0, pB1, K_lds, r32, hi, S.qr); SBAR(); }
    SLOAD_H(nxt.K, nxt.V, 0); SBAR();
#pragma unroll
    for (int d0 = 0; d0 < 8; ++d0) S.qr[d0] = load8((const bf16*)((const char*)nxt.Q + (unsigned)(((wid * QBLK + r32) * HD + hi * 8) * 2 + d0 * 32)));
    SBAR();
    finishSM(pA0, pA1, alA, l_reg, pa0, pa1, pa2, pa3); SBAR();
    pv_tile<0>(o, vb0, pa0, pa1, pa2, pa3);
    if (even) { mask_bits(pB0, pB1, mwB); partialSM(pB0, pB1, m_reg, mnB, alB); __syncthreads(); RESC(alB);
        finishSM(pB0, pB1, alB, l_reg, pa0, pa1, pa2, pa3); SBAR(); pv_tile<1>(o, vb0, pa0, pa1, pa2, pa3); }
    SBAR(); SEAM_K0();
    if (hi == 0) li_l[r32] = l_reg; asm volatile("s_waitcnt lgkmcnt(0)" ::: "memory");
    float rli[16];
#pragma unroll
    for (int r = 0; r < 16; ++r) rli[r] = __builtin_amdgcn_rcpf(li_l[crow(r, hi)]);
    char* Owb = (char*)(cur.O + (size_t)(wid * QBLK) * OSTR);
    int hi_e = hi, r32_e = r32; asm volatile("" : "+v"(hi_e), "+v"(r32_e));
    const unsigned lane_off = (unsigned)(4 * hi_e * OSTR + r32_e) * 2u;
#pragma unroll
    for (int r = 0; r < 16; ++r) { constexpr int dummy = 0; (void)dummy; const unsigned rowb = (unsigned)(((r & 3) + 8 * (r >> 2)) * OSTR * 2);
#pragma unroll
        for (int d0 = 0; d0 < 4; ++d0) { const float v = o[d0][r] * rli[r];
            const float vn = __shfl_xor(v, 1);
            if ((r32 & 1) == 0) *(unsigned*)(Owb + rowb + d0 * 64 + lane_off) = cvtpk(v, vn); } }
    __syncthreads();
#undef RESC
#undef KBASE
#undef SEAM_K0
#undef HALF_STEP
#undef MLOAD
}
#undef VMW
#undef VMWN
#undef SLOAD_H
#undef SWRITE_HK
#undef SWRITE_HV
#undef SWRITE_H
#undef KSWZ
#undef SBAR
}

constexpr int NWAVES = 8;
#ifndef MK_PER_PHASE
#define MK_PER_PHASE 0
#endif
constexpr int N_PHASES = 13;

constexpr int DM = 2048, SEQ = 8192, NBATCH = 2, NMETA = 16, DFF = 5632;
constexpr int R = NBATCH * SEQ;
constexpr int RP = 16640;
constexpr int TKV = 8256;
constexpr int NPROJ = 7424;
constexpr int NGU = 2 * DFF;
constexpr float EPS = 1e-6f;

constexpr size_t MiB = 1u << 20;
constexpr size_t WS_CTL = 0, CTL_ZERO_BYTES = 1 * MiB;
constexpr size_t WS_AB = 1 * MiB;
constexpr size_t WS_WB = 66 * MiB;
constexpr size_t WS_WGU = WS_WB, WS_WD = WS_WB + 44 * MiB, WS_WIN = WS_WB, WS_WOUT = WS_WB + 29 * MiB, WS_MASK = WS_WB + 40 * MiB;
constexpr size_t WS_SMALL = 132 * MiB;
constexpr size_t WS_RSTD1 = WS_SMALL, WS_RSTD2 = WS_SMALL + 128 * 1024, WS_RSTD3 = WS_SMALL + 256 * 1024, WS_DEC = WS_SMALL + 384 * 1024;
constexpr size_t WS_ACT = 133 * MiB;
constexpr size_t WS_F = 312 * MiB;
constexpr size_t WS_MIXA = 133 * MiB;
constexpr size_t WS_QH = 197 * MiB;
constexpr size_t WS_KH = 229 * MiB, WS_VH = 262 * MiB;
constexpr size_t WS_IQ = 295 * MiB;
constexpr size_t WS_GQ = 327 * MiB, WS_GK = 344 * MiB;
constexpr size_t WS_GV = 361 * MiB;
constexpr size_t WS_GO = 394 * MiB;
constexpr size_t WS_IK = 426 * MiB;
constexpr size_t WS_IW = 429 * MiB;
constexpr size_t WS_GLOW = 430 * MiB;
constexpr size_t WS_ST = 432 * MiB;
constexpr size_t WS_END = 496 * MiB;
constexpr int CW_BAR = 4096;

constexpr int SCR_BYTES = 147456;
constexpr int MISC_OFF = SCR_BYTES;
constexpr int LDS_BYTES = SCR_BYTES + 2048;

#define GAS __attribute__((address_space(1)))
#define LAS __attribute__((address_space(3)))
typedef unsigned short bf16;
typedef unsigned v4u __attribute__((ext_vector_type(4)));
typedef unsigned v2u __attribute__((ext_vector_type(2)));
typedef float f32x4 __attribute__((ext_vector_type(4)));
typedef float f32x16 __attribute__((ext_vector_type(16)));
typedef short bf16x8 __attribute__((ext_vector_type(8)));
typedef unsigned long long u64;
typedef GAS unsigned gu32;
#define RLX_AGENT __ATOMIC_RELAXED, __HIP_MEMORY_SCOPE_AGENT
#define LDS_WAIT() asm volatile("s_waitcnt lgkmcnt(0)" ::: "memory")
#define VM_WAIT() asm volatile("s_waitcnt vmcnt(0)" ::: "memory")
__device__ __forceinline__ unsigned f2bf(float f) { unsigned u = __builtin_bit_cast(unsigned, f); return (u + 0x7fffu + ((u >> 16) & 1u)) >> 16; }
__device__ __forceinline__ unsigned pk2(float lo, float hi) { return f2bf(lo) | (f2bf(hi) << 16); }
__device__ __forceinline__ float bf2f(unsigned short b) { return __builtin_bit_cast(float, (unsigned)b << 16); }
__device__ __forceinline__ float bflo(unsigned w) { return __builtin_bit_cast(float, w << 16); }
__device__ __forceinline__ float bfhi(unsigned w) { return __builtin_bit_cast(float, w & 0xffff0000u); }
#define XB_TMO      128
#define XB_XCNT(j)  (256  + 64 * (j))
#define XB_XSUB(j)  (1280 + 64 * (j))
#define XB_XGEN(j)  (2304 + 64 * (j))
#define XB_TOP      3328
#define XB_TOPGEN   3392
#define XCD_BAR_WORDS 3456
#define XB_SPIN_CAP (1u << 22)

__device__ __forceinline__ unsigned xb_ld(unsigned* p)              { return __hip_atomic_load(p, __ATOMIC_RELAXED, __HIP_MEMORY_SCOPE_AGENT); }
__device__ __forceinline__ unsigned xb_add(unsigned* p, unsigned v) { return __hip_atomic_fetch_add(p, v, __ATOMIC_RELAXED, __HIP_MEMORY_SCOPE_AGENT); }
__device__ __forceinline__ unsigned xb_xcc_id() { return (unsigned)__builtin_amdgcn_s_getreg((3 << 11) | 20) & 0xFu; }
#define XB_SPIN(cond, bar) do { unsigned _sp = 0; while (cond) { __builtin_amdgcn_s_sleep(1); \
    if ((++_sp & 255u) == 0u) { if (xb_ld(&(bar)[XB_TMO])) break; if (_sp > XB_SPIN_CAP) { atomicAdd(&(bar)[XB_TMO], 1u); break; } } } } while (0)

struct XcdBarrier {
    unsigned* bar; unsigned x;
    volatile LAS unsigned* st;
};

__device__ __forceinline__ XcdBarrier xcd_barrier_post(unsigned* bar, volatile LAS unsigned* st) {
    XcdBarrier b; b.bar = bar; b.x = xb_xcc_id(); b.st = st;
    if (threadIdx.x == 0) (void)xb_add(&bar[XB_XCNT(b.x)], 1u);
    return b;
}
__device__ __forceinline__ void xcd_barrier_complete(unsigned* bar, unsigned x, unsigned& nloc, unsigned& nx) {
    const unsigned G = gridDim.x * gridDim.y * gridDim.z;
    unsigned sum, cnt, mine, sp = 0u;
    for (;;) {
        sum = 0u; cnt = 0u; mine = 0u;
#pragma unroll
        for (unsigned j = 0; j < 16; ++j) { const unsigned c = xb_ld(&bar[XB_XCNT(j)]); sum += c; cnt += (c > 0u) ? 1u : 0u; mine = (j == x) ? c : mine; }
        if (sum == G) break;
        __builtin_amdgcn_s_sleep(1);
        if ((++sp & 255u) == 0u) { if (xb_ld(&bar[XB_TMO])) break; if (sp > XB_SPIN_CAP) { atomicAdd(&bar[XB_TMO], 1u); break; } }
    }
    nloc = mine > 0u ? mine : 1u; nx = cnt > 0u ? cnt : 1u;
}

__device__ __forceinline__ void xcd_barrier(const XcdBarrier& b) {
    asm volatile("s_waitcnt vmcnt(0)" ::: "memory");
    __syncthreads();
    if (threadIdx.x == 0) {
        unsigned* bar = b.bar;
        __builtin_amdgcn_s_waitcnt(0);
        unsigned nloc = b.st[0], nx = b.st[1];
        if (nloc == 0u) { xcd_barrier_complete(bar, b.x, nloc, nx); b.st[0] = nloc; b.st[1] = nx; }
        const unsigned old = xb_add(&bar[XB_XSUB(b.x)], 1u);
        const unsigned gen = old / nloc;
        if (old + 1u == (gen + 1u) * nloc) {
            __builtin_amdgcn_fence(__ATOMIC_RELEASE, "agent");
            asm volatile("s_waitcnt vmcnt(0)" ::: "memory");
            const unsigned og = xb_add(&bar[XB_TOP], 1u);
            const unsigned tg = og / nx;
            if (og + 1u == (tg + 1u) * nx) xb_add(&bar[XB_TOPGEN], 1u);
            else XB_SPIN(xb_ld(&bar[XB_TOPGEN]) == tg, bar);
            __builtin_amdgcn_fence(__ATOMIC_ACQUIRE, "agent");
            xb_add(&bar[XB_XGEN(b.x)], 1u);
            asm volatile("s_waitcnt vmcnt(0)" ::: "memory");
        } else {
            XB_SPIN(xb_ld(&bar[XB_XGEN(b.x)]) == gen, bar);
            __builtin_amdgcn_fence(__ATOMIC_ACQUIRE, "agent");
            asm volatile("s_waitcnt vmcnt(0)" ::: "memory");
        }
    }
    __syncthreads();
}

struct Frame {
    LAS unsigned char* lds;
    unsigned char* ldsg;
    volatile LAS unsigned* MISC;
    unsigned* ctl;
    int tid, lane, wave, vcu, G;
    float* out; unsigned char* ws;
};
enum { I_X = 0, I_META, I_G1PRE, I_W1G, I_W1U, I_W1D, I_G1POST, I_GMIX, I_WIN, I_WGATE, I_BGATE, I_GGLA, I_WOUT, I_GMIXPOST, I_G2PRE, I_W2G, I_W2U, I_W2D, I_G2POST };
#ifndef PROBE_K
#define PROBE_K (-1)
#endif
#ifndef PROBE_BLOCK
#define PROBE_BLOCK 37
#endif
#ifndef PROBE_AMP
#define PROBE_AMP 4
#endif
#define TIC(k) do { if (PROBE_K == (k) && blockIdx.x == PROBE_BLOCK && threadIdx.x == 0) { const unsigned long long t_ = __builtin_amdgcn_s_memrealtime(); F.MISC[20] = (unsigned)t_; F.MISC[21] = (unsigned)(t_ >> 32); } } while (0)
#define TOC(k) do { if (PROBE_K == (k) && blockIdx.x == PROBE_BLOCK && threadIdx.x == 0) { const unsigned long long t0_ = ((unsigned long long)F.MISC[21] << 32) | F.MISC[20]; \
        const unsigned long long a_ = (((unsigned long long)F.MISC[23] << 32) | F.MISC[22]) + (__builtin_amdgcn_s_memrealtime() - t0_); F.MISC[22] = (unsigned)a_; F.MISC[23] = (unsigned)(a_ >> 32); } } while (0)
#define TICC(k) do { if (PROBE_K == (k) && blockIdx.x == PROBE_BLOCK && threadIdx.x == 0) { const unsigned long long t_ = __builtin_amdgcn_s_memtime(); F.MISC[20] = (unsigned)t_; F.MISC[21] = (unsigned)(t_ >> 32); } } while (0)
#define TOCC(k) do { if (PROBE_K == (k) && blockIdx.x == PROBE_BLOCK && threadIdx.x == 0) { const unsigned long long t0_ = ((unsigned long long)F.MISC[21] << 32) | F.MISC[20]; \
        const unsigned long long a_ = (((unsigned long long)F.MISC[23] << 32) | F.MISC[22]) + (__builtin_amdgcn_s_memtime() - t0_) / 20ull; F.MISC[22] = (unsigned)a_; F.MISC[23] = (unsigned)(a_ >> 32); } } while (0)
#define PROBE_SPIN() do { if (PROBE_K >= 0 && blockIdx.x == PROBE_BLOCK && threadIdx.x == 0) { const unsigned long long a_ = (((unsigned long long)F.MISC[23] << 32) | F.MISC[22]) * PROBE_AMP; \
        const unsigned long long s_ = __builtin_amdgcn_s_memrealtime(); while (__builtin_amdgcn_s_memrealtime() - s_ < a_) __builtin_amdgcn_s_sleep(8); } } while (0)

__device__ __forceinline__ float wave_sum(float v) {
#pragma unroll
    for (int o = 1; o < 64; o <<= 1) v += __shfl_xor(v, o);
    return v;
}
__device__ __forceinline__ unsigned wave_sum_u(unsigned v) {
    v += (unsigned)__builtin_amdgcn_update_dpp(0, (int)v, 0xB1, 0xf, 0xf, false);
    v += (unsigned)__builtin_amdgcn_update_dpp(0, (int)v, 0x4E, 0xf, 0xf, false);
    v += (unsigned)__builtin_amdgcn_update_dpp(0, (int)v, 0x141, 0xf, 0xf, false);
    v += (unsigned)__builtin_amdgcn_update_dpp(0, (int)v, 0x140, 0xf, 0xf, false);
    return (unsigned)__builtin_amdgcn_readlane((int)v, 0) + (unsigned)__builtin_amdgcn_readlane((int)v, 16) + (unsigned)__builtin_amdgcn_readlane((int)v, 32) + (unsigned)__builtin_amdgcn_readlane((int)v, 48);
}

__device__ __forceinline__ unsigned pk4_fp8(float a, float b, float c, float d) {
    a = fminf(fmaxf(a, -448.f), 448.f); b = fminf(fmaxf(b, -448.f), 448.f); c = fminf(fmaxf(c, -448.f), 448.f); d = fminf(fmaxf(d, -448.f), 448.f);
    int w = 0; w = __builtin_amdgcn_cvt_pk_fp8_f32(a, b, w, false); w = __builtin_amdgcn_cvt_pk_fp8_f32(c, d, w, true); return (unsigned)w;
}
constexpr float W8_SCALE = 32.0f;
template <int KR>
__device__ __forceinline__ void tr_item8(const float* W, int N, int K, unsigned char* W8, int drow0, int scol, const float* gain, float wscale, LAS float* scr, int k0, int lane) {
#pragma unroll 8
    for (int i = 0; i < KR / 2; ++i) { const int kk = 2 * i + (lane >> 5); float v = W[(size_t)(k0 + kk) * N + scol] * wscale;
        if (gain) v *= gain[k0 + kk];
        scr[kk * 33 + (lane & 31)] = v; }
    LDS_WAIT(); asm volatile("" ::: "memory");
#pragma unroll
    for (int j = 0; j < (KR == 64 ? 2 : 1); ++j) { const int pc = lane + 64 * j, n = KR == 64 ? pc >> 2 : pc, c = KR == 64 ? pc & 3 : 0;
        if (KR == 64 || lane < 32) { const LAS float* s = scr + (16 * c) * 33 + n;
            v4u o; o.x = pk4_fp8(s[0 * 33], s[1 * 33], s[2 * 33], s[3 * 33]); o.y = pk4_fp8(s[4 * 33], s[5 * 33], s[6 * 33], s[7 * 33]);
            o.z = pk4_fp8(s[8 * 33], s[9 * 33], s[10 * 33], s[11 * 33]); o.w = pk4_fp8(s[12 * 33], s[13 * 33], s[14 * 33], s[15 * 33]);
            *(GAS v4u*)(W8 + (size_t)(drow0 + n) * K + k0 + 16 * c) = o; } }
    LDS_WAIT(); asm volatile("" ::: "memory");
}
constexpr float W8D_SCALE = 64.0f;
template <int KR>
__device__ __forceinline__ void tr_item(const float* W, int N, int K, bf16* WT, int drow0, int scol, const float* gain, LAS float* scr, int k0, int lane) {
#pragma unroll 8
    for (int i = 0; i < KR / 2; ++i) { const int kk = 2 * i + (lane >> 5); float v = 0.f;
        if (scol >= 0) v = W[(size_t)(k0 + kk) * N + scol];
        if (gain) v *= gain[k0 + kk];
        scr[kk * 33 + (lane & 31)] = v; }
    LDS_WAIT(); asm volatile("" ::: "memory");
    if (KR == 64) {
        const int c = lane & 7;
#pragma unroll
        for (int j = 0; j < 4; ++j) { const int n = (lane >> 3) + 8 * j; const LAS float* s = scr + (8 * c) * 33 + n;
            v4u o; o.x = pk2(s[0 * 33], s[1 * 33]); o.y = pk2(s[2 * 33], s[3 * 33]); o.z = pk2(s[4 * 33], s[5 * 33]); o.w = pk2(s[6 * 33], s[7 * 33]);
            *(GAS v4u*)(WT + (size_t)(drow0 + n) * K + k0 + 8 * c) = o; }
    } else {
        const int c = lane & 1, n = lane >> 1; const LAS float* s = scr + (8 * c) * 33 + n;
        v4u o; o.x = pk2(s[0 * 33], s[1 * 33]); o.y = pk2(s[2 * 33], s[3 * 33]); o.z = pk2(s[4 * 33], s[5 * 33]); o.w = pk2(s[6 * 33], s[7 * 33]);
        *(GAS v4u*)(WT + (size_t)(drow0 + n) * K + k0 + 8 * c) = o;
    }
    LDS_WAIT(); asm volatile("" ::: "memory");
}
template <int KR, bool GU8, bool D8>
__device__ __forceinline__ void ffn_item(Frame& F, int it, int ksub, const float* Wg, const float* Wu, const float* Wd, const float* gain, bf16* WGU, bf16* WD, LAS float* scr) {
    constexpr int I_GU = (NGU / 32) * (DM / 64);
    if (it < I_GU) { const int g = it % (NGU / 32), kb = it / (NGU / 32), tile = g >> 3, w = g & 7;
        if (GU8) tr_item8<KR>(w < 4 ? Wg : Wu, DFF, DM, (unsigned char*)WGU, g * 32, tile * 128 + (w & 3) * 32 + (F.lane & 31), gain, W8_SCALE, scr, kb * 64 + ksub * 16, F.lane);
        else tr_item<KR>(w < 4 ? Wg : Wu, DFF, DM, WGU, g * 32, tile * 128 + (w & 3) * 32 + (F.lane & 31), gain, scr, kb * 64 + ksub * 16, F.lane); }
    else { const int r = it - I_GU, g = r % (DM / 32), kb = r / (DM / 32);
        if (D8) tr_item8<KR>(Wd, DM, DFF, (unsigned char*)WD, g * 32, g * 32 + (F.lane & 31), nullptr, W8D_SCALE, scr, kb * 64 + ksub * 16, F.lane);
        else tr_item<KR>(Wd, DM, DFF, WD, g * 32, g * 32 + (F.lane & 31), nullptr, scr, kb * 64 + ksub * 16, F.lane); }
}
template <bool GU8, bool D8>
__device__ __forceinline__ void convert_ffn(Frame& F, const float* Wg, const float* Wu, const float* Wd, const float* gain, bf16* WGU, bf16* WD) {
    LAS float* scr = (LAS float*)(F.lds + F.wave * 16384);
    const int gw = F.vcu * NWAVES + F.wave, NGW = F.G * NWAVES;
    constexpr int NIT = (NGU / 32) * (DM / 64) + (DM / 32) * (DFF / 64);
    const int nmain = (NIT / NGW) * NGW;
    for (int it = gw; it < nmain; it += NGW) ffn_item<64, GU8, D8>(F, it, 0, Wg, Wu, Wd, gain, WGU, WD, scr);
    for (int q = gw; q < 4 * (NIT - nmain); q += NGW) ffn_item<16, GU8, D8>(F, nmain + (q >> 2), q & 3, Wg, Wu, Wd, gain, WGU, WD, scr);
}
__device__ __forceinline__ int win_src_col(int j) {
    const int t = j >> 8, c = j & 255;
    if (t < 16) return j;
    if (t < 18) return 4176 + (j - 4096);
    if (t < 20) return 4688 + (j - 4608);
    if (t < 24) return 5200 + (j - 5120);
    if (t < 28) return 6240 + (j - 6144);
    if (c < 64) return 4096 + c;
    if (c < 80) return 4160 + (c - 64);
    if (c < 96) return 6224 + (c - 80);
    return -1;
}
constexpr int WIN8_ROWS = 3072;
template <int KR, bool P8>
__device__ __forceinline__ void mix_item(Frame& F, int it, int ksub, const float* Win, const float* Wout, const float* gain, bf16* WIN, bf16* WOUT, LAS float* scr) {
    constexpr int I_IN = (NPROJ / 32) * (DM / 64);
    if (it < I_IN) { const int g = it % (NPROJ / 32), kb = it / (NPROJ / 32);
        if (P8 && g * 32 < WIN8_ROWS) tr_item8<KR>(Win, 7264, DM, (unsigned char*)WIN, g * 32, win_src_col(g * 32 + (F.lane & 31)), gain, W8_SCALE, scr, kb * 64 + ksub * 16, F.lane);
        else tr_item<KR>(Win, 7264, DM, WIN, g * 32, win_src_col(g * 32 + (F.lane & 31)), gain, scr, kb * 64 + ksub * 16, F.lane); }
    else { const int r = it - I_IN, g = r % (DM / 32), kb = r / (DM / 32);
        tr_item<KR>(Wout, DM, DM, WOUT, g * 32, g * 32 + (F.lane & 31), nullptr, scr, kb * 64 + ksub * 16, F.lane); }
}
template <bool P8>
__device__ __forceinline__ void convert_mix(Frame& F, const float* Win, const float* Wout, const float* gain, bf16* WIN, bf16* WOUT) {
    LAS float* scr = (LAS float*)(F.lds + F.wave * 16384);
    const int gw = F.vcu * NWAVES + F.wave, NGW = F.G * NWAVES;
    constexpr int NIT = (NPROJ / 32) * (DM / 64) + (DM / 32) * (DM / 64);
    const int nmain = (NIT / NGW) * NGW;
    for (int it = gw; it < nmain; it += NGW) mix_item<64, P8>(F, it, 0, Win, Wout, gain, WIN, WOUT, scr);
    for (int q = gw; q < 4 * (NIT - nmain); q += NGW) mix_item<16, P8>(F, nmain + (q >> 2), q & 3, Win, Wout, gain, WIN, WOUT, scr);
}

template <bool OUT8>
__device__ __forceinline__ void p0_rows(Frame& F, const float* X, const float* META, unsigned char* X8) {
    const int gw = F.vcu * NWAVES + F.wave, NGW = F.G * NWAVES;
    bf16* AB = (bf16*)(F.ws + WS_AB); float* rstd = (float*)(F.ws + WS_RSTD1);
    for (int row = gw; row < RP; row += NGW) {
        GAS v2u* o = (GAS v2u*)(AB + (size_t)row * DM) + F.lane;
        if (row < R + NMETA) {
            const float* xr = row < R ? X + (size_t)row * DM : META + (size_t)(row - R) * DM;
            const GAS f32x4* xp = (const GAS f32x4*)xr + F.lane;
            f32x4 v[8]; float ss = 0.f;
#pragma unroll
            for (int j = 0; j < 8; ++j) { v[j] = xp[64 * j]; ss += (v[j].x * v[j].x + v[j].y * v[j].y) + (v[j].z * v[j].z + v[j].w * v[j].w); }
            ss = wave_sum(ss);
#pragma unroll
            for (int j = 0; j < 8; ++j) o[64 * j] = (v2u){pk2(v[j].x, v[j].y), pk2(v[j].z, v[j].w)};
            if (OUT8) { GAS unsigned* x8 = (GAS unsigned*)(X8 + (size_t)row * DM) + F.lane;
#pragma unroll
                for (int j = 0; j < 8; ++j) x8[64 * j] = pk4_fp8(v[j].x, v[j].y, v[j].z, v[j].w); }
            if (F.lane == 0) rstd[row] = 1.0f / sqrtf(ss * (1.0f / DM) + EPS);
        } else {
#pragma unroll
            for (int j = 0; j < 8; ++j) o[64 * j] = (v2u){0u, 0u};
            if (OUT8) { GAS unsigned* x8 = (GAS unsigned*)(X8 + (size_t)row * DM) + F.lane;
#pragma unroll
                for (int j = 0; j < 8; ++j) x8[64 * j] = 0u; }
            if (F.lane == 0) rstd[row] = 0.f;
        }
    }
}
template <int MODE, bool OUT8 = false>
__device__ __forceinline__ void norm_rows(Frame& F, const float* g, float* rstd_out, const float* X, const float* META, unsigned char* H8 = nullptr) {
    const int gw = F.vcu * NWAVES + F.wave, NGW = F.G * NWAVES;
    bf16* AB = (bf16*)(F.ws + WS_AB); const bf16* FB = (const bf16*)(F.ws + WS_F);
    const int nrows = (MODE == 0) ? RP : R;
    f32x4 gv[8];
#pragma unroll
    for (int j = 0; j < 8; ++j) gv[j] = ((const GAS f32x4*)g)[64 * j + F.lane];
    for (int row = gw; row < nrows; row += NGW) {
        if (MODE == 0 && row >= R + NMETA) { if (F.lane == 0) rstd_out[row] = 0.f; continue; }
        const GAS v2u* fp = (const GAS v2u*)(FB + (size_t)row * DM) + F.lane;
        GAS v2u* ab = (GAS v2u*)(AB + (size_t)row * DM) + F.lane;
        f32x4 f[8], h[8]; float ss = 0.f;
#pragma unroll
        for (int j = 0; j < 8; ++j) { const v2u w = fp[64 * j]; f[j] = (f32x4){bflo(w.x), bfhi(w.x), bflo(w.y), bfhi(w.y)};
            ss += (f[j].x * f[j].x + f[j].y * f[j].y) + (f[j].z * f[j].z + f[j].w * f[j].w); }
        {
#pragma unroll
            for (int j = 0; j < 8; ++j) { const v2u w = ab[64 * j]; h[j] = (f32x4){bflo(w.x), bfhi(w.x), bflo(w.y), bfhi(w.y)}; }
        }
        ss = wave_sum(ss);
        const float rf = (MODE == 1 ? 1.0f : 0.5f) / sqrtf(ss * (1.0f / DM) + EPS);
        float s2 = 0.f;
#pragma unroll
        for (int j = 0; j < 8; ++j) { h[j] = h[j] + f[j] * gv[j] * rf; s2 += (h[j].x * h[j].x + h[j].y * h[j].y) + (h[j].z * h[j].z + h[j].w * h[j].w); }
        if (MODE == 2) {
            GAS f32x4* op = (GAS f32x4*)(F.out + (size_t)row * DM) + F.lane;
#pragma unroll
            for (int j = 0; j < 8; ++j) op[64 * j] = h[j];
        } else {
            s2 = wave_sum(s2);
#pragma unroll
            for (int j = 0; j < 8; ++j) ab[64 * j] = (v2u){pk2(h[j].x, h[j].y), pk2(h[j].z, h[j].w)};
            if (OUT8) { GAS unsigned* h8 = (GAS unsigned*)(H8 + (size_t)row * DM) + F.lane;
#pragma unroll
                for (int j = 0; j < 8; ++j) h8[64 * j] = pk4_fp8(h[j].x, h[j].y, h[j].z, h[j].w); }
            if (F.lane == 0) rstd_out[row] = 1.0f / sqrtf(s2 * (1.0f / DM) + EPS);
        }
    }
}

__device__ __forceinline__ void zero_pads(Frame& F) {
    const int gt = F.vcu * (NWAVES * 64) + F.tid, NG = F.G * NWAVES * 64;
    bf16* Kh = (bf16*)(F.ws + WS_KH); bf16* Vh = (bf16*)(F.ws + WS_VH); bf16* IK = (bf16*)(F.ws + WS_IK);
    const v4u z = {0u, 0u, 0u, 0u};
    for (int i = gt; i < 2 * 16 * 768 + 2 * 384; i += NG) {
        if (i < 2 * 16 * 768) { const int which = i / (16 * 768), r = i % (16 * 768), bh = r / 768, o = r % 768;
            *(GAS v4u*)((which ? Vh : Kh) + ((size_t)bh * TKV + 8208) * 128 + o * 8) = z; }
        else { const int r = i - 2 * 16 * 768, b = r / 384, o = r % 384, pos = 8208 + (o >> 3), ch = o & 7;
               *(GAS v4u*)(IK + (size_t)b * TKV * 64 + (size_t)(pos >> 5) * 2048 + (ch >> 1) * 512 + (ch & 1) * 256 + (pos & 31) * 8) = z; }
    }
}

__device__ __forceinline__ unsigned row_or16(unsigned v) {
    v |= (unsigned)__builtin_amdgcn_update_dpp(0, (int)v, 0xB1, 0xf, 0xf, false);
    v |= (unsigned)__builtin_amdgcn_update_dpp(0, (int)v, 0x4E, 0xf, 0xf, false);
    v |= (unsigned)__builtin_amdgcn_update_dpp(0, (int)v, 0x141, 0xf, 0xf, false);
    v |= (unsigned)__builtin_amdgcn_update_dpp(0, (int)v, 0x140, 0xf, 0xf, false);
    return v;
}
#ifndef P5_REP_SCORE
#define P5_REP_SCORE 1
#endif
#ifndef P5_REP_SEL
#define P5_REP_SEL 1
#endif
#ifndef P5_REP_MMA
#define P5_REP_MMA 1
#endif
#ifndef P5_REP_SCV
#define P5_REP_SCV 1
#endif
#ifndef P5_REP_BIS
#define P5_REP_BIS 1
#endif
#ifndef P5_REP_EMIT
#define P5_REP_EMIT 1
#endif
__device__ __forceinline__ void p5_item(Frame& F, int b, int t) {
    const int lane = F.lane, wid = F.wave, r32 = lane & 31, hi = lane >> 5;
    const GAS bf16* IQ = (const GAS bf16*)(F.ws + WS_IQ); const GAS bf16* IK = (const GAS bf16*)(F.ws + WS_IK); const GAS float* IW = (const GAS float*)(F.ws + WS_IW);
    GAS u64* MASK = (GAS u64*)(F.ws + WS_MASK);
    LAS unsigned short* S16 = (LAS unsigned short*)F.lds;
    constexpr int SROWD = 129 * 33, SROWH = 2 * SROWD;
    const int s0 = 8 * t, qb = s0 >> 8, nwords = 4 * qb + 5;
    const int kmax = 16 + s0 + 7, nkt = (kmax >> 5) + 1;
    TIC(0); TIC(1);
    {
        bf16x8 Af[4][4];
        LAS float* WL = (LAS float*)(F.lds + 8 * SROWH * 2);
        if (F.tid < 128) WL[F.tid] = 0.5f * IW[((size_t)(b * SEQ + s0)) * 16 + F.tid];
        LAS bf16* QL = (LAS bf16*)(F.lds + 8 * SROWH * 2 + 512);
        { const int q = F.tid >> 6, dd = F.tid & 63; const GAS bf16* qrow = IQ + ((size_t)(b * SEQ + s0 + q)) * 1024 + dd; const GAS float* wrow = IW + ((size_t)(b * SEQ + s0 + q)) * 16;
          float s = 0.f;
#pragma unroll
          for (int hh = 0; hh < 16; ++hh) s = fmaf(0.5f * wrow[hh], bf2f(qrow[hh * 64]), s);
          QL[q * 64 + dd] = (bf16)f2bf(s); }
        {
            const int qo = (r32 >> 2) & 1, h = (r32 & 3) + 4 * (r32 >> 3);
#pragma unroll
            for (int rb = 0; rb < 4; ++rb) {
                const GAS bf16* qp = IQ + ((size_t)(b * SEQ + s0 + 2 * rb + qo)) * 1024 + h * 64 + 8 * hi;
#pragma unroll
                for (int ks = 0; ks < 4; ++ks) Af[rb][ks] = *(const GAS bf16x8*)(qp + ks * 16);
            }
        }
        __syncthreads();
        bf16x8 Al[4];
#pragma unroll
        for (int ks = 0; ks < 4; ++ks) { bf16x8 z = {0, 0, 0, 0, 0, 0, 0, 0};
            if (r32 < 8) z = *(const LAS bf16x8*)(QL + (r32 < 4 ? 2 * r32 : 2 * (r32 - 4) + 1) * 64 + ks * 16 + 8 * hi);
            Al[ks] = z; }
        TOC(1); TIC(2);
        const GAS char* kbase = (const GAS char*)(IK + (size_t)b * TKV * 64);
        const unsigned koff = (unsigned)(lane * 16);
        bf16x8 Bn[4];
        for (int rep_ = 0; rep_ < P5_REP_SCORE; ++rep_) {
        if (wid < nkt) {
#pragma unroll
            for (int ks = 0; ks < 4; ++ks) Bn[ks] = *(const GAS bf16x8*)(kbase + (koff + (unsigned)(wid * 4096 + ks * 1024)));
        }
        for (int kt = wid; kt < nkt; kt += 8) {
            bf16x8 Bf[4];
#pragma unroll
            for (int ks = 0; ks < 4; ++ks) Bf[ks] = Bn[ks];
            if (kt + 8 < nkt) {
#pragma unroll
                for (int ks = 0; ks < 4; ++ks) Bn[ks] = *(const GAS bf16x8*)(kbase + (koff + (unsigned)((kt + 8) * 4096 + ks * 1024)));
            }
            const int key = kt * 32 + r32;
            int wlo = hi * 16; asm volatile("" : "+v"(wlo));
            f32x16 acc[4], accl;
#pragma unroll
            for (int m_ = 0; m_ < P5_REP_MMA; ++m_) {
#pragma unroll
            for (int rb = 0; rb < 4; ++rb) acc[rb] = (f32x16){};
            accl = (f32x16){};
            __builtin_amdgcn_s_setprio(1);
#pragma unroll
            for (int ks = 0; ks < 4; ++ks) {
#pragma unroll
                for (int rb = 0; rb < 4; ++rb) acc[rb] = __builtin_amdgcn_mfma_f32_32x32x16_bf16(Af[rb][ks], Bf[ks], acc[rb], 0, 0, 0);
                accl = __builtin_amdgcn_mfma_f32_32x32x16_bf16(Al[ks], Bf[ks], accl, 0, 0, 0); }
            __builtin_amdgcn_s_setprio(0);
            if (m_ + 1 < P5_REP_MMA) asm volatile("" : "+v"(acc[0]), "+v"(acc[1]), "+v"(acc[2]), "+v"(acc[3]));
            }
#pragma unroll
            for (int v_ = 0; v_ < P5_REP_SCV; ++v_)
#pragma unroll
            for (int rb = 0; rb < 4; ++rb) {
                if (P5_REP_SCV > 1) asm volatile("" : "+v"(acc[rb]));
                const LAS f32x4* wl = (const LAS f32x4*)(WL + wlo + 32 * rb);
                const f32x4 w0 = wl[0], w1 = wl[1], w2 = wl[2], w3 = wl[3];
                const float wvr[16] = {w0.x, w0.y, w0.z, w0.w, w1.x, w1.y, w1.z, w1.w, w2.x, w2.y, w2.z, w2.w, w3.x, w3.y, w3.z, w3.w};
                float sc = accl[rb];
#pragma unroll
                for (int r = 0; r < 16; ++r) { const float a_ = acc[rb][r]; sc = fmaf(__builtin_fabsf(a_), wvr[r], sc); }
                sc = fminf(fmaxf(sc, -60000.f), 60000.f);
                const _Float16 hf = (_Float16)sc;
                const unsigned hb = (unsigned)__builtin_bit_cast(unsigned short, hf);
                unsigned sk = (hb & 0x8000u) ? (~hb & 0xffffu) : (hb | 0x8000u);
                sk = (sk >> 1) | 0x8000u;
                if (key > 16 + s0 + 2 * rb + hi) sk = 0x81ffu;
                S16[(2 * rb + hi) * SROWH + (key >> 6) * 66 + (key & 63)] = (unsigned short)sk;
            }
        }
        }
    }
    TOC(2); TIC(3);
    {
        LAS unsigned* row = (LAS unsigned*)(S16 + wid * SROWH);
        for (int k2 = nkt * 16 + lane; k2 < 4128; k2 += 64) row[(k2 >> 5) * 33 + (k2 & 31)] = 0x81ff81ffu;
    }
    asm volatile("s_waitcnt lgkmcnt(0)" ::: "memory"); __builtin_amdgcn_s_barrier(); asm volatile("" ::: "memory");
    TOC(3); TIC(4);
    {
        const LAS unsigned* srow = (const LAS unsigned*)(S16 + wid * SROWH);
        const bool second = nwords > 64, last = nwords > 128;
        unsigned d[64];
#pragma unroll
        for (int i = 0; i < 32; ++i) d[i] = srow[lane * 33 + i];
#pragma unroll
        for (int i = 0; i < 32; ++i) { const unsigned x = srow[(lane + 64) * 33 + i]; d[32 + i] = second ? x : 0x81ff81ffu; }
        unsigned d128 = 0x81ff81ffu;
        if (last) d128 = 0x81ff0000u | (unsigned)(S16 + wid * SROWH)[128 * 66 + lane];
#define CNT_GE(cnt_, c15) do { const unsigned C_ = (unsigned)(c15) * 0x10001u; \
            _Pragma("unroll") for (int i = 0; i < 32; ++i) cnt_ += (unsigned)__builtin_popcount((d[i] - C_) & 0x80008000u); \
            if (second) { _Pragma("unroll") for (int i = 32; i < 64; ++i) cnt_ += (unsigned)__builtin_popcount((d[i] - C_) & 0x80008000u); \
                cnt_ += (unsigned)__builtin_popcount((d128 - C_) & 0x80008000u); } } while (0)
        unsigned thr = 0u;
        for (int bit = 14; bit >= 0; --bit) {
            const unsigned cand = thr | (1u << bit); unsigned c = 0u;
            CNT_GE(c, cand);
            if (wave_sum_u(c) >= 256u) thr = cand;
        }
        TOC(4); TIC(5);
        if (thr < 0x0200u) thr = 0x0200u;
        unsigned cg = 0u, ce = 0u;
        CNT_GE(cg, thr + 1u); CNT_GE(ce, thr);
        const unsigned cgt = wave_sum_u(cg), cge = wave_sum_u(ce);
#undef CNT_GE
        const int need = 256 - (int)cgt;
        GAS unsigned* mrow = (GAS unsigned*)(MASK + ((size_t)(b * SEQ + s0 + wid)) * 130);
        if (cge <= 256u) {
            const unsigned T_ = thr * 0x10001u;
#pragma unroll
            for (int tt = 0; tt < 2; ++tt) {
                if (tt == 0 || second) {
                    unsigned w0 = 0u, w1 = 0u;
#pragma unroll
                    for (int i = 0; i < 32; ++i) {
                        const unsigned sw = d[32 * tt + i] - T_;
                        const unsigned b2 = ((sw >> 15) & 1u) | ((sw >> 30) & 2u);
                        constexpr int dummy_ = 0; (void)dummy_;
                        const int pos = 16 * (i >> 4) + 2 * (i & 1) + 4 * ((i & 15) >> 2);
                        if (((i & 15) >> 1) & 1) w1 |= b2 << pos; else w0 |= b2 << pos;
                    }
                    *(GAS v2u*)(mrow + 2 * (64 * tt + lane)) = (v2u){w0, w1};
                }
            }
            if (last) {
                const u64 w = __ballot((((d128 - T_) >> 15) & 1u) != 0u);
                const unsigned vl = (unsigned)w, vh = (unsigned)(w >> 32), ul = vl >> 4, uh = vh >> 4;
                const unsigned a0 = (vl & 0xFu) | ((vl >> 4) & 0xF0u) | ((vl >> 8) & 0xF00u) | ((vl >> 12) & 0xF000u), a1 = (ul & 0xFu) | ((ul >> 4) & 0xF0u) | ((ul >> 8) & 0xF00u) | ((ul >> 12) & 0xF000u);
                const unsigned b0 = (vh & 0xFu) | ((vh >> 4) & 0xF0u) | ((vh >> 8) & 0xF00u) | ((vh >> 12) & 0xF000u), b1 = (uh & 0xFu) | ((uh >> 4) & 0xF0u) | ((uh >> 8) & 0xF00u) | ((uh >> 12) & 0xF000u);
                if (lane == 0) { mrow[256] = a0 | (b0 << 16); mrow[257] = a1 | (b1 << 16); }
            }
        } else {
            const unsigned T_ = thr * 0x10001u, T1_ = (thr + 1u) * 0x10001u;
            unsigned e1 = 0u, e2 = 0u;
#pragma unroll
            for (int i = 0; i < 32; ++i) e1 += (unsigned)__builtin_popcount((d[i] - T_) & 0x80008000u) - (unsigned)__builtin_popcount((d[i] - T1_) & 0x80008000u);
#pragma unroll
            for (int i = 32; i < 64; ++i) e2 += (unsigned)__builtin_popcount((d[i] - T_) & 0x80008000u) - (unsigned)__builtin_popcount((d[i] - T1_) & 0x80008000u);
            int base1 = 0, base2 = 0, tot1 = 0, tot2 = 0;
#pragma unroll
            for (int bt = 0; bt < 7; ++bt) {
                const u64 m1 = __ballot(((e1 >> bt) & 1u) != 0u), m2 = __ballot(((e2 >> bt) & 1u) != 0u);
                base1 += (int)__builtin_amdgcn_mbcnt_hi((unsigned)(m1 >> 32), __builtin_amdgcn_mbcnt_lo((unsigned)m1, 0u)) << bt; tot1 += __popcll(m1) << bt;
                base2 += (int)__builtin_amdgcn_mbcnt_hi((unsigned)(m2 >> 32), __builtin_amdgcn_mbcnt_lo((unsigned)m2, 0u)) << bt; tot2 += __popcll(m2) << bt;
            }
#pragma unroll
            for (int tt = 0; tt < 2; ++tt) {
                if (tt == 0 || second) {
                    int quota = need - (tt == 0 ? base1 : tot1 + base2);
                    unsigned w0 = 0u, w1 = 0u;
#pragma unroll
                    for (int i = 0; i < 32; ++i) {
                        const unsigned sw = d[32 * tt + i] - T_, sg = d[32 * tt + i] - T1_;
                        const unsigned ge_lo = (sw >> 15) & 1u, ge_hi = (sw >> 31) & 1u, gt_lo = (sg >> 15) & 1u, gt_hi = (sg >> 31) & 1u;
                        const unsigned eq_lo = ge_lo ^ gt_lo, eq_hi = ge_hi ^ gt_hi;
                        const unsigned s_lo = gt_lo | (eq_lo & (quota > 0 ? 1u : 0u)); quota -= (int)eq_lo;
                        const unsigned s_hi = gt_hi | (eq_hi & (quota > 0 ? 1u : 0u)); quota -= (int)eq_hi;
                        const unsigned b2 = s_lo | (s_hi << 1);
                        const int pos = 16 * (i >> 4) + 2 * (i & 1) + 4 * ((i & 15) >> 2);
                        if (((i & 15) >> 1) & 1) w1 |= b2 << pos; else w0 |= b2 << pos;
                    }
                    *(GAS v2u*)(mrow + 2 * (64 * tt + lane)) = (v2u){w0, w1};
                }
            }
            if (last) {
                const unsigned k128 = d128 & 0x7fffu;
                const u64 em = __ballot(k128 == thr);
                const int rank = tot1 + tot2 + (int)__builtin_amdgcn_mbcnt_hi((unsigned)(em >> 32), __builtin_amdgcn_mbcnt_lo((unsigned)em, 0u));
                const u64 w = __ballot(k128 > thr || (k128 == thr && rank < need));
                const unsigned vl = (unsigned)w, vh = (unsigned)(w >> 32), ul = vl >> 4, uh = vh >> 4;
                const unsigned a0 = (vl & 0xFu) | ((vl >> 4) & 0xF0u) | ((vl >> 8) & 0xF00u) | ((vl >> 12) & 0xF000u), a1 = (ul & 0xFu) | ((ul >> 4) & 0xF0u) | ((ul >> 8) & 0xF00u) | ((ul >> 12) & 0xF000u);
                const unsigned b0 = (vh & 0xFu) | ((vh >> 4) & 0xF0u) | ((vh >> 8) & 0xF00u) | ((vh >> 12) & 0xF000u), b1 = (uh & 0xFu) | ((uh >> 4) & 0xF0u) | ((uh >> 8) & 0xF00u) | ((uh >> 12) & 0xF000u);
                if (lane == 0) { mrow[256] = a0 | (b0 << 16); mrow[257] = a1 | (b1 << 16); }
            }
        }
    }
    asm volatile("s_waitcnt lgkmcnt(0)" ::: "memory"); __builtin_amdgcn_s_barrier(); asm volatile("" ::: "memory");
    TOC(5); TOC(0);
}

typedef short s16x4g __attribute__((ext_vector_type(4)));
template <int KSTEPS>
__device__ __forceinline__ void mma_ll(f32x16& acc, const LAS bf16* A, int sa, const LAS bf16* B, int sb, int r32, int hi) {
#pragma unroll
    for (int ks = 0; ks < KSTEPS; ++ks) {
        const bf16x8 a = *(const LAS bf16x8*)(A + r32 * sa + ks * 16 + 8 * hi), bb = *(const LAS bf16x8*)(B + r32 * sb + ks * 16 + 8 * hi);
        acc = __builtin_amdgcn_mfma_f32_32x32x16_bf16(a, bb, acc, 0, 0, 0);
    }
}
__device__ __forceinline__ bf16x8 tr_frag(unsigned base, int pb, int lane) {
    const unsigned a0 = base + (unsigned)((8 * (lane >> 5) + ((lane >> 2) & 3)) * pb + (16 * ((lane >> 4) & 1) + 4 * (lane & 3)) * 2), a1 = a0 + 4u * (unsigned)pb;
    s16x4g lo, hh;
    asm volatile("ds_read_b64_tr_b16 %0, %2\n\tds_read_b64_tr_b16 %1, %3\n\ts_waitcnt lgkmcnt(0)" : "=&v"(lo), "=&v"(hh) : "v"(a0), "v"(a1) : "memory");
    return (bf16x8){lo[0], lo[1], lo[2], lo[3], hh[0], hh[1], hh[2], hh[3]};
}
__device__ __forceinline__ float log_sigmoid_f(float z) { return fminf(z, 0.f) - __logf(1.0f + __expf(-fabsf(z))); }
__device__ __forceinline__ void gla_bcum(Frame& F, LAS float* BC, LAS float* GT, LAS float* GLs, int b, int h, int n, const float* Wg, const float* bg) {
    const GAS float* GLOW = (const GAS float*)(F.ws + WS_GLOW);
    const int k = F.tid & 127, ig = __builtin_amdgcn_readfirstlane(F.tid >> 7);
    if (F.tid < 256) { const int i = F.tid >> 2, pc = F.tid & 3; f32x4 v = {0.f, 0.f, 0.f, 0.f};
        if (!(n == 0 && i < 48)) v = *(const GAS f32x4*)(GLOW + ((size_t)b * TKV + 64 * n + i) * 16 + 4 * pc);
        *(LAS f32x4*)(GLs + i * 16 + 4 * pc) = v; }
    float wc[16];
#pragma unroll
    for (int r = 0; r < 16; ++r) wc[r] = Wg[r * 512 + h * 128 + k];
    const float bk = bg[h * 128 + k];
    __syncthreads();
    float run = 0.f, pre[16];
#pragma unroll
    for (int ii = 0; ii < 16; ++ii) {
        const int i = 16 * ig + ii; float lg = 0.f;
        if (!(n == 0 && i < 48)) {
            const LAS f32x4* gl = (const LAS f32x4*)(GLs + i * 16); float z = bk;
#pragma unroll
            for (int r4 = 0; r4 < 4; ++r4) { const f32x4 g4 = gl[r4];
                z = fmaf(g4.x, wc[4 * r4 + 0], z); z = fmaf(g4.y, wc[4 * r4 + 1], z); z = fmaf(g4.z, wc[4 * r4 + 2], z); z = fmaf(g4.w, wc[4 * r4 + 3], z); }
            lg = log_sigmoid_f(z) * (1.0f / 16.0f);
        }
        run += lg; pre[ii] = run;
    }
    GT[ig * 128 + k] = run;
    __syncthreads();
    float off = 0.f;
#pragma unroll
    for (int gq = 0; gq < 3; ++gq) off += (gq < ig) ? GT[gq * 128 + k] : 0.f;
#pragma unroll
    for (int ii = 0; ii < 16; ++ii) BC[(16 * ig + ii) * 128 + k] = pre[ii] + off;
    __syncthreads();
}
constexpr int GLA_VP = 288, GLA_KP1 = 160;
__device__ __forceinline__ void gla_load_vn(Frame& F, LAS bf16* Vn, int b, int h, int n) {
    const GAS bf16* GV = (const GAS bf16*)(F.ws + WS_GV);
    const int v0 = 8 * (F.tid & 31);
#pragma unroll
    for (int pass = 0; pass < 4; ++pass) {
        const int i = (F.tid >> 5) + 16 * pass, pp = 64 * n + i;
        v4u raw = {0u, 0u, 0u, 0u};
        if (!(n == 0 && i < 48)) raw = *(const GAS v4u*)(GV + ((size_t)b * TKV + pp) * 1024 + h * 256 + v0);
        *(LAS v4u*)(Vn + i * GLA_VP + v0) = raw;
    }
}
__device__ __forceinline__ void g1_unit(Frame& F, int b, int h, int n, const float* Wg, const float* bg) {
    const int lane = F.lane, wid = F.wave, r32 = lane & 31, hi = lane >> 5, tid = F.tid;
    LAS float* BC = (LAS float*)F.lds; LAS float* GLs = (LAS float*)(F.lds + 32768); LAS bf16* KD = (LAS bf16*)(F.lds + 36864); LAS bf16* Vn = (LAS bf16*)(F.lds + 57344);
    const GAS bf16* GK = (const GAS bf16*)(F.ws + WS_GK); GAS bf16* ST = (GAS bf16*)(F.ws + WS_ST); GAS float* DEC = (GAS float*)(F.ws + WS_DEC);
    TIC(10); gla_bcum(F, BC, (LAS float*)(F.lds + 131072), GLs, b, h, n, Wg, bg); TOC(10); TIC(11);
    { const int k0 = 8 * (tid & 15);
#pragma unroll
      for (int pass = 0; pass < 2; ++pass) {
        const int i = (tid >> 4) + 32 * pass, pp = 64 * n + i;
        v4u raw = {0u, 0u, 0u, 0u};
        if (!(n == 0 && i < 48)) raw = *(const GAS v4u*)(GK + ((size_t)b * TKV + pp) * 512 + h * 128 + k0);
        const unsigned rw[4] = {raw.x, raw.y, raw.z, raw.w}; float kd[8];
        const f32x4 bc0 = *(const LAS f32x4*)(BC + i * 128 + k0), bc1 = *(const LAS f32x4*)(BC + i * 128 + k0 + 4), bl0 = *(const LAS f32x4*)(BC + 63 * 128 + k0), bl1 = *(const LAS f32x4*)(BC + 63 * 128 + k0 + 4);
        const float bcv[8] = {bc0.x, bc0.y, bc0.z, bc0.w, bc1.x, bc1.y, bc1.z, bc1.w}, blv[8] = {bl0.x, bl0.y, bl0.z, bl0.w, bl1.x, bl1.y, bl1.z, bl1.w};
#pragma unroll
        for (int j = 0; j < 8; ++j) { const float kv = (j & 1) ? bfhi(rw[j >> 1]) : bflo(rw[j >> 1]); kd[j] = kv * __expf(blv[j] - bcv[j]); }
        *(LAS v4u*)(KD + i * GLA_KP1 + k0) = (v4u){pk2(kd[0], kd[1]), pk2(kd[2], kd[3]), pk2(kd[4], kd[5]), pk2(kd[6], kd[7])};
      } }
    gla_load_vn(F, Vn, b, h, n);
    __syncthreads();
    TOC(11); TIC(12);
    GAS bf16* dst = ST + ((size_t)((b * 4 + h) * 128 + n) * 256) * 128;
    const float declast = (tid < 128) ? __expf(BC[63 * 128 + tid]) : 0.f;
    f32x16 acc[4];
    {
        const unsigned vb = (unsigned)(uintptr_t)Vn + (unsigned)(32 * wid * 2), kb = (unsigned)(uintptr_t)KD;
        bf16x8 af[4];
#pragma unroll
        for (int ks = 0; ks < 4; ++ks) af[ks] = tr_frag(vb + (unsigned)(16 * ks * GLA_VP * 2), GLA_VP * 2, lane);
#pragma unroll
        for (int cb = 0; cb < 4; ++cb) { acc[cb] = (f32x16){};
#pragma unroll
            for (int ks = 0; ks < 4; ++ks) acc[cb] = __builtin_amdgcn_mfma_f32_32x32x16_bf16(af[ks], tr_frag(kb + (unsigned)(16 * ks * GLA_KP1 * 2 + 32 * cb * 2), GLA_KP1 * 2, lane), acc[cb], 0, 0, 0); }
    }
    __syncthreads();
    {   LAS bf16* LT = (LAS bf16*)F.lds;
#pragma unroll
        for (int cb = 0; cb < 4; ++cb)
#pragma unroll
            for (int r = 0; r < 16; ++r) LT[(32 * wid + (r & 3) + 8 * (r >> 2) + 4 * hi) * 128 + 32 * cb + r32] = (bf16)f2bf(acc[cb][r]);
        __syncthreads();
        const LAS v4u* src = (const LAS v4u*)F.lds; GAS v4u* d4 = (GAS v4u*)dst;
#pragma unroll
        for (int q = 0; q < 8; ++q) d4[q * 512 + tid] = src[q * 512 + tid];
    }
    if (tid < 128) DEC[(size_t)((b * 4 + h) * 128 + n) * 128 + tid] = declast;
    __syncthreads();
    TOC(12);
}
__device__ __forceinline__ void g2_scan(Frame& F) {
    GAS bf16* ST = (GAS bf16*)(F.ws + WS_ST); const GAS float* DEC = (const GAS float*)(F.ws + WS_DEC);
    const int NG = F.G * NWAVES * 64;
    for (int e = F.vcu * (NWAVES * 64) + F.tid; e < 8 * 16384; e += NG) {
        const int bh = e >> 14, rem = e & 16383, v = rem >> 6, k = (rem & 63) * 2;
        GAS unsigned* p = (GAS unsigned*)(ST + ((size_t)bh * 128 * 256 + v) * 128 + k);
        const GAS float* d = DEC + (size_t)bh * 128 * 128 + k;
        float s0 = 0.f, s1 = 0.f;
        for (int n = 0; n < 128; n += 8) {
            unsigned w[8]; float d0[8], d1[8];
#pragma unroll
            for (int u = 0; u < 8; ++u) { w[u] = p[(size_t)(n + u) * 16384]; d0[u] = d[(n + u) * 128]; d1[u] = d[(n + u) * 128 + 1]; }
#pragma unroll
            for (int u = 0; u < 8; ++u) { s0 = fmaf(s0, d0[u], bflo(w[u])); s1 = fmaf(s1, d1[u], bfhi(w[u])); p[(size_t)(n + u) * 16384] = pk2(s0, s1); }
        }
    }
}
__device__ __forceinline__ void g3_unit(Frame& F, int b, int h, int c, const float* Wg, const float* bg, const float* ggla) {
    const int lane = F.lane, wid = F.wave, r32 = lane & 31, hi = lane >> 5, tid = F.tid;
    LAS float* BC = (LAS float*)F.lds; LAS bf16* Q1 = (LAS bf16*)(F.lds + 32768); LAS bf16* Q2 = (LAS bf16*)(F.lds + 50176); LAS bf16* KD = (LAS bf16*)(F.lds + 67584);
    LAS bf16* Vn = (LAS bf16*)(F.lds + 84992); LAS bf16* AT = (LAS bf16*)(F.lds + 121856); LAS float* OS = (LAS float*)F.lds; LAS float* GLs = (LAS float*)(F.lds + 133120);
    const GAS bf16* GQ = (const GAS bf16*)(F.ws + WS_GQ); const GAS bf16* GK = (const GAS bf16*)(F.ws + WS_GK); const GAS bf16* GO = (const GAS bf16*)(F.ws + WS_GO);
    const GAS bf16* ST = (const GAS bf16*)(F.ws + WS_ST); GAS bf16* MIXA = (GAS bf16*)(F.ws + WS_MIXA);
    const int rbI = wid & 1, cbV = (wid >> 1) * 2;
    bf16x8 sf[8][2];
    { const GAS bf16* sp = ST + ((size_t)((b * 4 + h) * 128 + (c - 1)) * 256) * 128;
#pragma unroll
      for (int ks = 0; ks < 8; ++ks)
#pragma unroll
        for (int t = 0; t < 2; ++t) sf[ks][t] = *(const GAS bf16x8*)(sp + (size_t)(32 * (cbV + t) + r32) * 128 + ks * 16 + 8 * hi); }
    TIC(13); gla_bcum(F, BC, (LAS float*)(F.lds + 131072), GLs, b, h, c, Wg, bg); TOC(13); TIC(14);
    { const int k0 = 8 * (tid & 15);
#pragma unroll
      for (int pass = 0; pass < 2; ++pass) {
        const int i = (tid >> 4) + 32 * pass, pp = 64 * c + i;
        const v4u rq = *(const GAS v4u*)(GQ + ((size_t)b * TKV + pp) * 512 + h * 128 + k0);
        const v4u rk = *(const GAS v4u*)(GK + ((size_t)b * TKV + pp) * 512 + h * 128 + k0);
        const unsigned qw[4] = {rq.x, rq.y, rq.z, rq.w}, kw[4] = {rk.x, rk.y, rk.z, rk.w};
        const f32x4 bc0 = *(const LAS f32x4*)(BC + i * 128 + k0), bc1 = *(const LAS f32x4*)(BC + i * 128 + k0 + 4), bl0 = *(const LAS f32x4*)(BC + 63 * 128 + k0), bl1 = *(const LAS f32x4*)(BC + 63 * 128 + k0 + 4);
        const float bcv[8] = {bc0.x, bc0.y, bc0.z, bc0.w, bc1.x, bc1.y, bc1.z, bc1.w}, blv[8] = {bl0.x, bl0.y, bl0.z, bl0.w, bl1.x, bl1.y, bl1.z, bl1.w};
        float q1[8], q2[8], kd[8];
#pragma unroll
        for (int j = 0; j < 8; ++j) { const float qv = (j & 1) ? bfhi(qw[j >> 1]) : bflo(qw[j >> 1]), kv = (j & 1) ? bfhi(kw[j >> 1]) : bflo(kw[j >> 1]);
            const float e1 = __expf(bcv[j] - blv[j]);
            q1[j] = qv * __expf(bcv[j]); q2[j] = qv * e1; kd[j] = kv * __builtin_amdgcn_rcpf(e1); }
        *(LAS v4u*)(Q1 + i * 136 + k0) = (v4u){pk2(q1[0], q1[1]), pk2(q1[2], q1[3]), pk2(q1[4], q1[5]), pk2(q1[6], q1[7])};
        *(LAS v4u*)(Q2 + i * 136 + k0) = (v4u){pk2(q2[0], q2[1]), pk2(q2[2], q2[3]), pk2(q2[4], q2[5]), pk2(q2[6], q2[7])};
        *(LAS v4u*)(KD + i * 136 + k0) = (v4u){pk2(kd[0], kd[1]), pk2(kd[2], kd[3]), pk2(kd[4], kd[5]), pk2(kd[6], kd[7])};
      } }
    gla_load_vn(F, Vn, b, h, c);
    __syncthreads();
    TOC(14); TIC(15);
    f32x16 acc[2] = {};
#pragma unroll
    for (int ks = 0; ks < 8; ++ks) {
        const bf16x8 a = *(const LAS bf16x8*)(Q1 + (32 * rbI + r32) * 136 + ks * 16 + 8 * hi);
#pragma unroll
        for (int t = 0; t < 2; ++t) acc[t] = __builtin_amdgcn_mfma_f32_32x32x16_bf16(a, sf[ks][t], acc[t], 0, 0, 0);
    }
    if (wid < 4) {
        const int ib = wid & 1, jb = wid >> 1;
        f32x16 at = {};
        mma_ll<8>(at, Q2 + (32 * ib) * 136, 136, KD + (32 * jb) * 136, 136, r32, hi);
#pragma unroll
        for (int r = 0; r < 16; ++r) { const int i = 32 * ib + (r & 3) + 8 * (r >> 2) + 4 * hi, j = 32 * jb + r32;
            AT[i * 72 + j] = (bf16)f2bf(j <= i ? at[r] : 0.f); }
    }
    __syncthreads();
    TOC(15); TIC(16);
    {
        const unsigned vb = (unsigned)(uintptr_t)Vn;
#pragma unroll
        for (int ks = 0; ks < 4; ++ks) {
            const bf16x8 a = *(const LAS bf16x8*)(AT + (32 * rbI + r32) * 72 + ks * 16 + 8 * hi);
#pragma unroll
            for (int t = 0; t < 2; ++t) acc[t] = __builtin_amdgcn_mfma_f32_32x32x16_bf16(a, tr_frag(vb + (unsigned)(16 * ks * GLA_VP * 2 + 32 * (cbV + t) * 2), GLA_VP * 2, lane), acc[t], 0, 0, 0);
        }
    }
    __syncthreads();
#pragma unroll
    for (int t = 0; t < 2; ++t)
#pragma unroll
        for (int r = 0; r < 16; ++r) OS[(32 * rbI + (r & 3) + 8 * (r >> 2) + 4 * hi) * 260 + 32 * (cbV + t) + r32] = acc[t][r];
    __syncthreads();
    {
        const int i = tid >> 3, seg = tid & 7; const LAS float* orow = OS + i * 260 + 32 * seg;
        float ss = 0.f; f32x4 ov[8];
#pragma unroll
        for (int q = 0; q < 8; ++q) { ov[q] = *(const LAS f32x4*)(orow + 4 * q); ss += (ov[q].x * ov[q].x + ov[q].y * ov[q].y) + (ov[q].z * ov[q].z + ov[q].w * ov[q].w); }
        ss += __shfl_xor(ss, 1); ss += __shfl_xor(ss, 2); ss += __shfl_xor(ss, 4);
        const float rs = 1.0f / sqrtf(ss * (1.0f / 256.0f) + EPS);
        const size_t row = (size_t)b * SEQ + 64 * (c - 1) + i;
        const float* gn = ggla + 32 * seg;
        const GAS bf16* gp = GO + row * 1024 + h * 256 + 32 * seg;
        GAS bf16* op = MIXA + row * 2048 + 1024 + h * 256 + 32 * seg;
#pragma unroll
        for (int q2 = 0; q2 < 4; ++q2) {
            const v4u gw = *(const GAS v4u*)(gp + 8 * q2);
            const f32x4 g0 = *(const f32x4*)(gn + 8 * q2), g1 = *(const f32x4*)(gn + 8 * q2 + 4);
            const f32x4 a = ov[2 * q2], bq = ov[2 * q2 + 1];
            float y[8];
            y[0] = a.x * rs * g0.x * pg8::silu_f(bflo(gw.x)); y[1] = a.y * rs * g0.y * pg8::silu_f(bfhi(gw.x));
            y[2] = a.z * rs * g0.z * pg8::silu_f(bflo(gw.y)); y[3] = a.w * rs * g0.w * pg8::silu_f(bfhi(gw.y));
            y[4] = bq.x * rs * g1.x * pg8::silu_f(bflo(gw.z)); y[5] = bq.y * rs * g1.y * pg8::silu_f(bfhi(gw.z));
            y[6] = bq.z * rs * g1.z * pg8::silu_f(bflo(gw.w)); y[7] = bq.w * rs * g1.w * pg8::silu_f(bfhi(gw.w));
            *(GAS v4u*)(op + 8 * q2) = (v4u){pk2(y[0], y[1]), pk2(y[2], y[3]), pk2(y[4], y[5]), pk2(y[6], y[7])};
        }
    }
    __syncthreads();
    TOC(16);
}
__device__ __forceinline__ att::BlockRef att_ref(Frame& F, int bh, int qb) {
    const int b = bh >> 3, h = bh & 7; att::BlockRef r;
    r.Q = (const bf16*)(F.ws + WS_QH) + ((size_t)bh * SEQ + (size_t)qb * 256) * 128;
    r.K = (const bf16*)(F.ws + WS_KH) + (size_t)bh * TKV * 128; r.V = (const bf16*)(F.ws + WS_VH) + (size_t)bh * TKV * 128;
    r.O = (bf16*)(F.ws + WS_MIXA) + ((size_t)b * SEQ + (size_t)qb * 256) * 2048 + h * 128;
    r.M = (const u64*)(F.ws + WS_MASK) + ((size_t)b * SEQ + (size_t)qb * 256) * 130;
    r.NT = 4 * qb + 5;
    return r;
}
__device__ __forceinline__ void p7_attention(Frame& F) {
    constexpr int total = 256;
    int L = F.vcu; if (L >= total) return;
    int pass = 0;
    att::BlockRef cur = att_ref(F, L >> 4, L & 15);
    att::Seam S;
    att::att_prime(cur, (char*)F.ldsg, S);
    for (;;) {
        const bool more_pass = pass == 0, more_item = L + F.G < total, last = !more_pass && !more_item;
        int passn = pass + 1, Ln = L;
        if (!more_pass) { passn = 0; Ln = more_item ? L + F.G : L; }
        const att::BlockRef nxt = last ? cur : att_ref(F, Ln >> 4, passn ? 31 - (Ln & 15) : (Ln & 15));
        att::att_block(cur, nxt, (char*)F.ldsg, S);
        if (last) break;
        cur = nxt; pass = passn; L = Ln;
    }
}
typedef float f32x4s __attribute__((ext_vector_type(4)));
template <int KSTEPS>
__device__ __forceinline__ f32x4s skinny_k(const GAS bf16* a, const GAS bf16* b) {
    f32x4s acc = {0.f, 0.f, 0.f, 0.f};
#pragma unroll
    for (int ks = 0; ks < KSTEPS; ++ks) acc = __builtin_amdgcn_mfma_f32_16x16x32_bf16(*(const GAS bf16x8*)(a + 32 * ks), *(const GAS bf16x8*)(b + 32 * ks), acc, 0, 0, 0);
    return acc;
}
__device__ __forceinline__ f32x4s wg_reduce(Frame& F, LAS f32x4s* red, f32x4s v) {
    red[F.wave * 64 + F.lane] = v;
    __syncthreads();
    f32x4s s = red[F.lane];
#pragma unroll
    for (int w = 1; w < NWAVES; ++w) s += red[w * 64 + F.lane];
    __syncthreads();
    return s;
}
template <int STEPS>
__device__ __forceinline__ f32x4s skinny_k8(const GAS unsigned char* a, const GAS unsigned char* b) {
    typedef int v8i_s __attribute__((ext_vector_type(8)));
    f32x4s acc = {0.f, 0.f, 0.f, 0.f};
#pragma unroll
    for (int st = 0; st < STEPS; ++st) {
        const v4u a0 = *(const GAS v4u*)(a + 128 * st), a1 = *(const GAS v4u*)(a + 128 * st + 16), b0 = *(const GAS v4u*)(b + 128 * st), b1 = *(const GAS v4u*)(b + 128 * st + 16);
        const v8i_s av = {(int)a0.x, (int)a0.y, (int)a0.z, (int)a0.w, (int)a1.x, (int)a1.y, (int)a1.z, (int)a1.w}, bv = {(int)b0.x, (int)b0.y, (int)b0.z, (int)b0.w, (int)b1.x, (int)b1.y, (int)b1.z, (int)b1.w};
        acc = __builtin_amdgcn_mfma_scale_f32_16x16x128_f8f6f4(av, bv, acc, 0, 0, 0, 0x7f7f7f7f, 0, 0x7f7f7f7f);
    }
    return acc;
}
template <bool FP8>
__device__ __forceinline__ void meta_p1(Frame& F) {
    const int c = F.lane & 15, kq = F.lane >> 4; LAS f32x4s* red = (LAS f32x4s*)F.lds;
    const GAS bf16* AB = (const GAS bf16*)(F.ws + WS_AB); const GAS bf16* WGU = (const GAS bf16*)(F.ws + WS_WGU); GAS bf16* ACT = (GAS bf16*)(F.ws + WS_ACT);
    const GAS unsigned char* X8 = (const GAS unsigned char*)(F.ws + WS_F); const GAS unsigned char* W8 = (const GAS unsigned char*)(F.ws + WS_WGU);
    const GAS float* rstd = (const GAS float*)(F.ws + WS_RSTD1);
    for (int u = F.vcu; u < 352; u += F.G) {
        const int tile = u >> 3, j = u & 7, k0 = F.wave * (DM / 8);
        f32x4s ag, au;
        if (FP8) { const GAS unsigned char* a = X8 + (size_t)(R + c) * DM + k0 + 32 * kq; const GAS unsigned char* bg = W8 + (size_t)(tile * 256 + 16 * j + c) * DM + k0 + 32 * kq;
            ag = wg_reduce(F, red, skinny_k8<DM / 1024>(a, bg)); au = wg_reduce(F, red, skinny_k8<DM / 1024>(a, bg + (size_t)128 * DM)); }
        else { const GAS bf16* a = AB + (size_t)(R + c) * DM + k0 + 8 * kq; const GAS bf16* bg = WGU + (size_t)(tile * 256 + 16 * j + c) * DM + k0 + 8 * kq;
            ag = wg_reduce(F, red, skinny_k<DM / 256>(a, bg)); au = wg_reduce(F, red, skinny_k<DM / 256>(a, bg + (size_t)128 * DM)); }
        if (F.wave == 0) {
#pragma unroll
            for (int q = 0; q < 4; ++q) { const int m = 4 * kq + q; const float rs = rstd[R + m] * (FP8 ? 1.0f / W8_SCALE : 1.0f);
                ACT[(size_t)(R + m) * DFF + tile * 128 + 16 * j + c] = (bf16)f2bf(pg8::silu_f(ag[q] * rs) * (au[q] * rs)); }
        }
    }
}
__device__ __forceinline__ void meta_p2(Frame& F) {
    const int c = F.lane & 15, kq = F.lane >> 4; LAS f32x4s* red = (LAS f32x4s*)F.lds;
    const GAS bf16* ACT = (const GAS bf16*)(F.ws + WS_ACT); const GAS bf16* WD = (const GAS bf16*)(F.ws + WS_WD); GAS bf16* FB = (GAS bf16*)(F.ws + WS_F);
    for (int u = F.vcu; u < 128; u += F.G) {
        const int k0 = F.wave * (DFF / 8);
        const f32x4s acc = wg_reduce(F, red, skinny_k<DFF / 256>(ACT + (size_t)(R + c) * DFF + k0 + 8 * kq, WD + (size_t)(16 * u + c) * DFF + k0 + 8 * kq));
        if (F.wave == 0) {
#pragma unroll
            for (int q = 0; q < 4; ++q) FB[(size_t)(R + 4 * kq + q) * DM + 16 * u + c] = (bf16)f2bf(acc[q]);
        }
    }
}
template <bool P8>
__device__ __forceinline__ void meta_p4(Frame& F) {
    const int c = F.lane & 15, kq = F.lane >> 4; LAS f32x4s* red = (LAS f32x4s*)F.lds;
    const GAS bf16* AB = (const GAS bf16*)(F.ws + WS_AB); const GAS bf16* WIN = (const GAS bf16*)(F.ws + WS_WIN); const GAS float* rstd = (const GAS float*)(F.ws + WS_RSTD2);
    GAS bf16* Kh = (GAS bf16*)(F.ws + WS_KH); GAS bf16* Vh = (GAS bf16*)(F.ws + WS_VH); GAS bf16* GK = (GAS bf16*)(F.ws + WS_GK); GAS bf16* GV = (GAS bf16*)(F.ws + WS_GV);
    GAS bf16* IK = (GAS bf16*)(F.ws + WS_IK); GAS float* GLOW = (GAS float*)(F.ws + WS_GLOW);
    for (int u = F.vcu; u < 230; u += F.G) {
        int sec, cs;
        if (u < 64) { sec = 0; cs = u * 16; } else if (u < 128) { sec = 1; cs = (u - 64) * 16; } else if (u < 160) { sec = 2; cs = (u - 128) * 16; } else if (u < 224) { sec = 3; cs = (u - 160) * 16; } else { sec = 4; cs = (u - 224) * 16; }
        const int wrow = (sec == 0 ? 4 * 256 : sec == 1 ? 8 * 256 : sec == 2 ? 18 * 256 : sec == 3 ? 20 * 256 : 7168) + cs, k0 = F.wave * (DM / 8);
        f32x4s acc;
        if (P8 && sec < 2) acc = wg_reduce(F, red, skinny_k8<DM / 1024>((const GAS unsigned char*)(F.ws + WS_ST) + (size_t)(R + c) * DM + k0 + 32 * kq, (const GAS unsigned char*)WIN + (size_t)(wrow + c) * DM + k0 + 32 * kq)) * (1.0f / W8_SCALE);
        else acc = wg_reduce(F, red, skinny_k<DM / 256>(AB + (size_t)(R + c) * DM + k0 + 8 * kq, WIN + (size_t)(wrow + c) * DM + k0 + 8 * kq));
        if (F.wave == 0) {
            const int col = cs + c;
#pragma unroll
            for (int q = 0; q < 4; ++q) { const int m = 4 * kq + q; const float vf = acc[q] * rstd[R + m]; const bf16 v = (bf16)f2bf(vf);
                if (sec == 4) {
                    if (col < 64) { const int ch = col >> 3, fo = (ch >> 1) * 512 + (ch & 1) * 256 + (col & 7); IK[fo + m * 8] = v; IK[(size_t)TKV * 64 + fo + m * 8] = v; }
                    else if (col >= 80) { GLOW[((size_t)48 + m) * 16 + (col - 80)] = vf; GLOW[((size_t)TKV + 48 + m) * 16 + (col - 80)] = vf; }
                } else if (sec < 2) { GAS bf16* base = sec == 0 ? Kh : Vh; const int h = col >> 7, d = col & 127;
                    base[((size_t)h * TKV + m) * 128 + d] = v; base[((size_t)(8 + h) * TKV + m) * 128 + d] = v; }
                else if (sec == 2) { GK[((size_t)48 + m) * 512 + col] = v; GK[((size_t)TKV + 48 + m) * 512 + col] = v; }
                else { GV[((size_t)48 + m) * 1024 + col] = v; GV[((size_t)TKV + 48 + m) * 1024 + col] = v; }
            }
        }
    }
}
__device__ __forceinline__ void small_cols(Frame& F) {
    const int c = F.lane & 15, kq = F.lane >> 4, rg = F.wave & 3, ch3 = (F.wave >> 2) * 3;
    const GAS bf16* AB = (const GAS bf16*)(F.ws + WS_AB); const GAS bf16* WIN = (const GAS bf16*)(F.ws + WS_WIN); const GAS float* rstd = (const GAS float*)(F.ws + WS_RSTD2);
    GAS bf16* IK = (GAS bf16*)(F.ws + WS_IK); GAS float* IW = (GAS float*)(F.ws + WS_IW); GAS float* GLOW = (GAS float*)(F.ws + WS_GLOW);
    LAS bf16* Bs = (LAS bf16*)F.lds; constexpr int BP = 264;
    for (int u = F.vcu; u < 256; u += F.G) {
        const int r0 = 64 * u + 16 * rg;
        const GAS bf16* a = AB + (size_t)(r0 + c) * DM + 8 * kq;
        const GAS bf16* bsrc = WIN + (size_t)7168 * DM;
        f32x4s acc[3];
#pragma unroll
        for (int g = 0; g < 3; ++g) acc[g] = (f32x4s){0.f, 0.f, 0.f, 0.f};
        v4u breg[6]; bf16x8 an[8];
#pragma unroll
        for (int i = 0; i < 6; ++i) { const int p = F.tid + 512 * i; breg[i] = *(const GAS v4u*)(bsrc + (size_t)(p >> 5) * DM + (p & 31) * 8); }
#pragma unroll
        for (int ks = 0; ks < 8; ++ks) an[ks] = *(const GAS bf16x8*)(a + 32 * ks);
        for (int kc = 0; kc < 8; ++kc) {
#pragma unroll
            for (int i = 0; i < 6; ++i) { const int p = F.tid + 512 * i; *(LAS v4u*)(Bs + (p >> 5) * BP + (p & 31) * 8) = breg[i]; }
            bf16x8 ac[8];
#pragma unroll
            for (int ks = 0; ks < 8; ++ks) ac[ks] = an[ks];
            __syncthreads();
            if (kc + 1 < 8) {
#pragma unroll
                for (int i = 0; i < 6; ++i) { const int p = F.tid + 512 * i; breg[i] = *(const GAS v4u*)(bsrc + (size_t)(p >> 5) * DM + (kc + 1) * 256 + (p & 31) * 8); }
#pragma unroll
                for (int ks = 0; ks < 8; ++ks) an[ks] = *(const GAS bf16x8*)(a + (kc + 1) * 256 + 32 * ks);
            }
#pragma unroll
            for (int ks = 0; ks < 8; ++ks)
#pragma unroll
                for (int g = 0; g < 3; ++g) acc[g] = __builtin_amdgcn_mfma_f32_16x16x32_bf16(ac[ks], *(const LAS bf16x8*)(Bs + (16 * (ch3 + g) + c) * BP + 32 * ks + 8 * kq), acc[g], 0, 0, 0);
            __syncthreads();
        }
#pragma unroll
        for (int q = 0; q < 4; ++q) {
            const int row = r0 + 4 * kq + q; const float rs = rstd[row]; const int bb = row >> 13, s = row & 8191, pos = 16 + s;
#pragma unroll
            for (int g = 0; g < 3; ++g) {
                const float v = acc[g][q] * rs; const int col = 16 * (ch3 + g) + c;
                if (col < 64) {
                    const int ch = col >> 3, fo = (ch >> 1) * 512 + (ch & 1) * 256 + (col & 7);
                    IK[(size_t)bb * TKV * 64 + (size_t)(pos >> 5) * 2048 + fo + (pos & 31) * 8] = (bf16)f2bf(v);
                } else if (col < 80) IW[(size_t)row * 16 + (col - 64)] = v * 0.25f;
                else GLOW[((size_t)bb * TKV + 64 + s) * 16 + (col - 80)] = v;
            }
        }
    }
}

struct Args { const float* in[19]; float* out; unsigned char* ws; int ph_lo, ph_hi; };
#ifndef FFN1_FP8
#define FFN1_FP8 false
#endif
#ifndef PROJ_FP8
#define PROJ_FP8 true
#endif
#ifndef FFN2D_FP8
#define FFN2D_FP8 true
#endif
#ifndef FFN2_FP8
#define FFN2_FP8 true
#endif
#ifndef PG8_SP2
#define PG8_SP2 true
#endif
#ifndef PG8_ALIGN
#define PG8_ALIGN true
#endif
__global__ void __launch_bounds__(NWAVES * 64, 2) hymba_fwd(Args args) {
    extern __shared__ __attribute__((aligned(16))) unsigned char lds[];
    Frame F;
    F.lds = (LAS unsigned char*)lds; F.ldsg = lds;
    F.MISC = (volatile LAS unsigned*)(F.lds + MISC_OFF);
    F.tid = threadIdx.x; F.lane = F.tid & 63; F.wave = __builtin_amdgcn_readfirstlane(F.tid >> 6);
    F.G = gridDim.x; { const int bx = blockIdx.x; F.vcu = (F.G % 8 == 0) ? (bx % 8) * (F.G / 8) + bx / 8 : bx; }
    F.ws = args.ws; F.ctl = (unsigned*)(args.ws + WS_CTL); F.out = args.out;
    for (int u = F.tid; u < (LDS_BYTES - MISC_OFF) / 4; u += NWAVES * 64) ((LAS unsigned*)(F.lds + MISC_OFF))[u] = 0u;
    __syncthreads();
    XcdBarrier bar; bar.bar = F.ctl + CW_BAR; bar.x = 0; bar.st = nullptr;
    if (!MK_PER_PHASE) bar = xcd_barrier_post(F.ctl + CW_BAR, F.MISC + 8);
    const int lo = args.ph_lo, hi = args.ph_hi;
#define PHASE_BEGIN() do { int t_ = threadIdx.x; asm volatile("" : "+v"(t_)); F.tid = t_; F.lane = t_ & 63; F.wave = __builtin_amdgcn_readfirstlane(t_ >> 6); } while (0)
#ifndef PH_MASK
#define PH_MASK 0x1fff
#endif
#define IN(k) ((((PH_MASK) >> (k)) & 1) && lo <= (k) && (k) < hi)
#define SEAM(k) do { if (!MK_PER_PHASE && IN((k) + 1)) { TIC(30); TIC(40 + (k)); xcd_barrier(bar); TOC(40 + (k)); TOC(30); } } while (0)
#ifndef PH_DUP
#define PH_DUP 0
#endif
#define AB ((bf16*)(F.ws + WS_AB))
#define ACT ((bf16*)(F.ws + WS_ACT))
#define FB ((bf16*)(F.ws + WS_F))
#define WGU ((bf16*)(F.ws + WS_WGU))
#define WD ((bf16*)(F.ws + WS_WD))
#define WIN ((bf16*)(F.ws + WS_WIN))
#define WOUT ((bf16*)(F.ws + WS_WOUT))
#define rstd1 ((float*)(F.ws + WS_RSTD1))
#define rstd2 ((float*)(F.ws + WS_RSTD2))
#define rstd3 ((float*)(F.ws + WS_RSTD3))

    #define BODY0 do { TIC(70); convert_ffn<FFN1_FP8, false>(F, args.in[I_W1G], args.in[I_W1U], args.in[I_W1D], args.in[I_G1PRE], WGU, WD); TOC(70); TIC(71); p0_rows<FFN1_FP8>(F, args.in[I_X], args.in[I_META], F.ws + WS_F); TOC(71); } while (0)
    if (IN(0)) { PHASE_BEGIN();
#if (PH_DUP >> 0) & 1
        BODY0; xcd_barrier(bar);
#endif
        BODY0; SEAM(0); }
    if (IN(1)) { PHASE_BEGIN();
        pg8::Gemm g{FFN1_FP8 ? (const bf16*)(F.ws + WS_F) : AB, WGU, R, NGU, FFN1_FP8 ? DM / 2 : DM}; pg8::StaticOrder S; S.init(R, NGU, F.G, (int)blockIdx.x);
        pg8::EpiSwiGLU<false> E{ACT, DFF, rstd1, FFN1_FP8 ? 1.0f / W8_SCALE : 1.0f};
#if (PH_DUP >> 1) & 1
        pg8::gemm_phase<pg8::EpiSwiGLU<false>, pg8::StaticOrder, PG8_ALIGN, PG8_SP2, FFN1_FP8>(F.lds, g, S, E); xcd_barrier(bar);
#endif
        TIC(60); TICC(61); pg8::gemm_phase<pg8::EpiSwiGLU<false>, pg8::StaticOrder, PG8_ALIGN, PG8_SP2, FFN1_FP8>(F.lds, g, S, E); TOCC(61); TOC(60);
        TIC(6); meta_p1<FFN1_FP8>(F); TOC(6);
        SEAM(1);
    }
    if (IN(2)) { PHASE_BEGIN();
        pg8::Gemm g{ACT, WD, R, DM, DFF}; pg8::StaticOrder S; S.init(R, DM, F.G, (int)blockIdx.x);
        pg8::EpiStoreBf16 E{FB, DM, 1.0f};
        pg8::gemm_phase<pg8::EpiStoreBf16, pg8::StaticOrder, PG8_ALIGN, PG8_SP2>(F.lds, g, S, E);
        TIC(7); meta_p2(F); TOC(7);
        SEAM(2);
    }
    #define BODY3 do { norm_rows<0, PROJ_FP8>(F, args.in[I_G1POST], rstd2, args.in[I_X], args.in[I_META], F.ws + WS_ST); convert_mix<PROJ_FP8>(F, args.in[I_WIN], args.in[I_WOUT], args.in[I_GMIX], WIN, WOUT); } while (0)
    if (IN(3)) { PHASE_BEGIN();
#if (PH_DUP >> 3) & 1
        BODY3; xcd_barrier(bar);
#endif
        BODY3; SEAM(3); }
    if (IN(4)) { PHASE_BEGIN();
        zero_pads(F);
        if (PROJ_FP8) {
            {   pg8::Gemm g{(const bf16*)(F.ws + WS_ST), WIN, R, WIN8_ROWS, DM / 2}; pg8::StaticOrder S; S.init(R, WIN8_ROWS, F.G, (int)blockIdx.x);
                pg8::EpiProj E{F.ws, WS_RSTD2, WS_QH, WS_KH, WS_VH, WS_IQ, WS_GQ, WS_GK, WS_GV, WS_GO, WS_IK, WS_IW, WS_GLOW, 1.0f / W8_SCALE, 0};
                pg8::gemm_phase<pg8::EpiProj, pg8::StaticOrder, PG8_ALIGN, PG8_SP2, true>(F.lds, g, S, E); }
            {   pg8::Gemm g{AB, WIN + (size_t)WIN8_ROWS * DM, R, 7168 - WIN8_ROWS, DM}; pg8::StaticOrder S; S.init(R, 7168 - WIN8_ROWS, F.G, (int)blockIdx.x);
                pg8::EpiProj E{F.ws, WS_RSTD2, WS_QH, WS_KH, WS_VH, WS_IQ, WS_GQ, WS_GK, WS_GV, WS_GO, WS_IK, WS_IW, WS_GLOW, 1.0f, WIN8_ROWS / 256};
                pg8::gemm_phase<pg8::EpiProj, pg8::StaticOrder, PG8_ALIGN, PG8_SP2, false>(F.lds, g, S, E); }
        } else {
            pg8::Gemm g{AB, WIN, R, 7168, DM}; pg8::StaticOrder S; S.init(R, 7168, F.G, (int)blockIdx.x);
            pg8::EpiProj E{F.ws, WS_RSTD2, WS_QH, WS_KH, WS_VH, WS_IQ, WS_GQ, WS_GK, WS_GV, WS_GO, WS_IK, WS_IW, WS_GLOW, 1.0f, 0};
            pg8::gemm_phase<pg8::EpiProj, pg8::StaticOrder, PG8_ALIGN, PG8_SP2>(F.lds, g, S, E);
        }
        TIC(8); meta_p4<PROJ_FP8>(F); TOC(8); TIC(9); small_cols(F); TOC(9);
        SEAM(4);
    }
#define BODY5A do { for (int v = F.vcu; v < 256; v += F.G) \
            for (int bq = 0; bq < 8; ++bq) { const int b = bq >> 2, q = bq & 3; const int t = q == 0 ? v : (q == 1 ? 511 - v : (q == 2 ? 512 + v : 1023 - v)); p5_item(F, b, t); } } while (0)
#define BODY5B do { PHASE_BEGIN(); for (int u = F.vcu; u < 1024; u += F.G) g1_unit(F, u >> 9, (u >> 7) & 3, u & 127, args.in[I_WGATE], args.in[I_BGATE]); } while (0)
    if (IN(5)) { PHASE_BEGIN();
#if (PH_DUP >> 5) & 1
        BODY5A; xcd_barrier(bar);
#endif
#if (PH_DUP >> 13) & 1
        BODY5B; xcd_barrier(bar);
#endif
        BODY5A; BODY5B;
        SEAM(5);
    }
    if (IN(6)) { PHASE_BEGIN(); TIC(17); g2_scan(F); TOC(17); SEAM(6); }
#define BODY7A do { TIC(18); p7_attention(F); TOC(18); } while (0)
#define BODY7B do { PHASE_BEGIN(); for (int u = F.vcu; u < 1024; u += F.G) g3_unit(F, u >> 9, (u >> 7) & 3, (u & 127) + 1, args.in[I_WGATE], args.in[I_BGATE], args.in[I_GGLA]); } while (0)
    if (IN(7)) { PHASE_BEGIN();
#if (PH_DUP >> 7) & 1
        BODY7A; xcd_barrier(bar);
#endif
#if (PH_DUP >> 14) & 1
        BODY7B; xcd_barrier(bar);
#endif
#ifndef SKIP_ATT
        BODY7A;
#endif
#ifndef SKIP_G3
        BODY7B;
#endif
        SEAM(7);
    }
    if (IN(8)) { PHASE_BEGIN();
        pg8::Gemm g{(const bf16*)(F.ws + WS_MIXA), WOUT, R, DM, DM}; pg8::StaticOrder S; S.init(R, DM, F.G, (int)blockIdx.x);
        pg8::EpiStoreBf16 E{FB, DM, 1.0f};
        pg8::gemm_phase<pg8::EpiStoreBf16, pg8::StaticOrder, PG8_ALIGN, PG8_SP2>(F.lds, g, S, E);
        SEAM(8);
    }
    if (IN(9)) { PHASE_BEGIN(); norm_rows<1, FFN2_FP8>(F, args.in[I_GMIXPOST], rstd3, nullptr, nullptr, F.ws + WS_ST); convert_ffn<FFN2_FP8, FFN2D_FP8>(F, args.in[I_W2G], args.in[I_W2U], args.in[I_W2D], args.in[I_G2PRE], WGU, WD); SEAM(9); }
    if (IN(10)) { PHASE_BEGIN();
        pg8::Gemm g{FFN2_FP8 ? (const bf16*)(F.ws + WS_ST) : AB, WGU, R, NGU, FFN2_FP8 ? DM / 2 : DM}; pg8::StaticOrder S; S.init(R, NGU, F.G, (int)blockIdx.x);
        pg8::EpiSwiGLU<FFN2D_FP8> E{ACT, DFF, rstd3, FFN2_FP8 ? 1.0f / W8_SCALE : 1.0f};
        pg8::gemm_phase<pg8::EpiSwiGLU<FFN2D_FP8>, pg8::StaticOrder, PG8_ALIGN, PG8_SP2, FFN2_FP8>(F.lds, g, S, E);
        SEAM(10);
    }
    if (IN(11)) { PHASE_BEGIN();
        pg8::Gemm g{ACT, WD, R, DM, FFN2D_FP8 ? DFF / 2 : DFF}; pg8::StaticOrder S; S.init(R, DM, F.G, (int)blockIdx.x);
        pg8::EpiStoreBf16 E{FB, DM, FFN2D_FP8 ? 1.0f / W8D_SCALE : 1.0f};
        pg8::gemm_phase<pg8::EpiStoreBf16, pg8::StaticOrder, PG8_ALIGN, PG8_SP2, FFN2D_FP8>(F.lds, g, S, E);
        SEAM(11);
    }
    if (IN(12)) { PHASE_BEGIN(); norm_rows<2>(F, args.in[I_G2POST], nullptr, nullptr, nullptr); PROBE_SPIN(); }
#undef IN
#undef SEAM
#undef AB
#undef ACT
#undef FB
#undef WGU
#undef WD
#undef WIN
#undef WOUT
#undef rstd1
#undef rstd2
#undef rstd3
}

extern "C" void kernel_launch(void* const* d_in, const int* in_sizes, int n_in, void* d_out, int out_size, void* d_ws, size_t ws_size, hipStream_t stream) {
    static int grid = 0;
    if (grid == 0) {
        if (n_in != 19 || in_sizes[0] != R * DM || out_size != R * DM || ws_size < WS_END) {
            fprintf(stderr, "kernel_launch: unexpected shapes (n_in %d, in0 %d, out %d, ws %zu; need ws >= %zu); nothing launched\n", n_in, n_in > 0 ? in_sizes[0] : -1, out_size, ws_size, (size_t)WS_END); grid = -1; return; }
        int dev = 0, cus = 0, per_cu = 0;
        if (hipGetDevice(&dev) != hipSuccess || hipDeviceGetAttribute(&cus, hipDeviceAttributeMultiprocessorCount, dev) != hipSuccess) { grid = -1; return; }
        if (hipFuncSetAttribute((const void*)hymba_fwd, hipFuncAttributeMaxDynamicSharedMemorySize, LDS_BYTES) != hipSuccess) { fprintf(stderr, "kernel_launch: hipFuncSetAttribute failed\n"); grid = -1; return; }
        if (hipOccupancyMaxActiveBlocksPerMultiprocessor(&per_cu, (const void*)hymba_fwd, NWAVES * 64, LDS_BYTES) != hipSuccess || per_cu < 1)
            fprintf(stderr, "kernel_launch: note: occupancy query reports %d workgroups per CU\n", per_cu);
        (void)hipGetLastError();
        grid = cus;
    }
    if (grid < 0) return;
    if (hipMemsetAsync((char*)d_ws + WS_CTL, 0, CTL_ZERO_BYTES, stream) != hipSuccess) return;
    Args a{};
    for (int i = 0; i < 19; ++i) a.in[i] = (const float*)d_in[i];
    a.out = (float*)d_out; a.ws = (unsigned char*)d_ws;
#if MK_PER_PHASE
    for (int p = 0; p < N_PHASES; ++p) { a.ph_lo = p; a.ph_hi = p + 1; hipLaunchKernelGGL(hymba_fwd, dim3(grid), dim3(NWAVES * 64), LDS_BYTES, stream, a); }
#else
    a.ph_lo = 0; a.ph_hi = N_PHASES;
    hipLaunchKernelGGL(hymba_fwd, dim3(grid), dim3(NWAVES * 64), LDS_BYTES, stream, a);
#endif
    const hipError_t le = hipPeekAtLastError();
    if (le != hipSuccess) fprintf(stderr, "kernel_launch: launch failed: %s\n", hipGetErrorName(le));
}
```
